# Optimizing an MI355X kernel written in HIP

```python
import jax
import jax.numpy as jnp
from jax import lax
import numpy as np

D_MODEL = 1024
BATCH = 2
SEQ = 8192
DEPTH = 4
DEC_BATCH = 32
DEC_SEQ = 4
PAST_LEN = 8192
PAGE_SIZE = 128

N_MIXERS = 3
NORM_EPS = 1e-6
D_FF = -(-(8 * D_MODEL) // (3 * 256)) * 256

SSM_D_INNER = 2 * D_MODEL
SSM_HEAD_DIM = 64
SSM_N_HEADS = SSM_D_INNER // SSM_HEAD_DIM
SSM_N_GROUPS = 4
SSM_D_STATE = 128
SSM_CONV = 4
SSM_CHUNK = 128
SSM_CONV_DIM = SSM_D_INNER + 2 * SSM_N_GROUPS * SSM_D_STATE
SSM_IN_DIM = SSM_D_INNER + SSM_CONV_DIM + SSM_N_HEADS

GLA_N_HEADS = 4
GLA_DK = D_MODEL // 2
GLA_DV = D_MODEL
GLA_HEAD_K = GLA_DK // GLA_N_HEADS
GLA_HEAD_V = GLA_DV // GLA_N_HEADS
GLA_GATE_RANK = 16
GLA_GATE_NORM = 16.0
GLA_CHUNK = 32
GLA_IN_DIM = 2 * GLA_DK + 2 * GLA_DV + GLA_GATE_RANK

ATT_GROUPS = ((128, 1), (512, 4), (2048, 16))
ATT_HEADS_PER_GROUP = 4
ATT_HEAD_DIM = 64
ATT_N_HEADS = ATT_HEADS_PER_GROUP * len(ATT_GROUPS)
ATT_ROT_DIM = ATT_HEAD_DIM // 4
ROPE_THETA = 500000.0
ATT_BLOCK = 128

N_SSM_LAYERS = len(range(0, DEPTH, N_MIXERS))
N_GLA_LAYERS = len(range(1, DEPTH, N_MIXERS))
N_ATT_LAYERS = len(range(2, DEPTH, N_MIXERS))

kernel_name = 'hybrid_ssd_gla_dilated_swa_step'


def rmsnorm(x, g):
    xf = x.astype(jnp.float32)
    inv = lax.rsqrt(jnp.mean(xf * xf, axis=-1, keepdims=True) + NORM_EPS)
    return (xf * inv).astype(x.dtype) * g


def swiglu(x, w_gate, w_up, w_down):
    return (jax.nn.silu(x @ w_gate) * (x @ w_up)) @ w_down


def causal_dwconv(x, buf, w, b):
    xp = jnp.concatenate([buf, x], axis=1)
    L = x.shape[1]
    y = b
    for t in range(SSM_CONV):
        y = y + xp[:, t:t + L] * w[t]
    return y, xp[:, -(SSM_CONV - 1):]


def segsum(a):
    T = a.shape[-1]
    cs = jnp.cumsum(a, axis=-1)
    diff = cs[..., :, None] - cs[..., None, :]
    lower = jnp.arange(T)[:, None] >= jnp.arange(T)[None, :]
    return jnp.where(lower, diff, -jnp.inf)


def ssd_scan(x, dt, A, Bm, Cm, h0, chunk):
    b, l, H, P = x.shape
    G, N = Bm.shape[-2:]
    hg = H // G
    c = l // chunk
    xdt = (x * dt[..., None].astype(x.dtype)).reshape(b, c, chunk, G, hg, P)
    a = (A * dt).reshape(b, c, chunk, G, hg).transpose(0, 3, 4, 1, 2)
    Bc = Bm.reshape(b, c, chunk, G, N)
    Cc = Cm.reshape(b, c, chunk, G, N)
    a_cs = jnp.cumsum(a, axis=-1)
    Ldec = jnp.exp(segsum(a)).astype(x.dtype)
    CB = jnp.einsum('bcqgn,bcsgn->bgcqs', Cc, Bc)
    y_diag = jnp.einsum('bgcqs,bghcqs,bcsghp->bcqghp', CB, Ldec, xdt)
    decay_st = jnp.exp(a_cs[..., -1:] - a_cs).astype(x.dtype)
    st = jnp.einsum('bcqgn,bghcq,bcqghp->bcghpn', Bc, decay_st, xdt)
    st = jnp.concatenate([h0.reshape(b, 1, G, hg, P, N).astype(st.dtype), st], axis=1)
    a_last = jnp.pad(a_cs[..., -1], ((0, 0), (0, 0), (0, 0), (1, 0)))
    dchunk = jnp.exp(segsum(a_last)).astype(x.dtype)
    new_st = jnp.einsum('bghzc,bcghpn->bzghpn', dchunk, st)
    st_in, h_final = new_st[:, :-1], new_st[:, -1]
    y_off = jnp.einsum('bcqgn,bcghpn,bghcq->bcqghp', Cc, st_in, jnp.exp(a_cs).astype(x.dtype))
    y = (y_diag + y_off).reshape(b, l, H, P)
    return y, h_final.reshape(b, H, P, N)


def mamba2_mixer(h, conv_buf, ssm_state, w_in, conv_w, conv_b, dt_bias, a_log, d_skip, norm_w, w_out, chunk):
    b, l, _ = h.shape
    z, xbc, dt = jnp.split(h @ w_in, [SSM_D_INNER, SSM_D_INNER + SSM_CONV_DIM], axis=-1)
    xbc, conv_new = causal_dwconv(xbc, conv_buf, conv_w, conv_b)
    xbc = jax.nn.silu(xbc)
    xs, Bm, Cm = jnp.split(xbc, [SSM_D_INNER, SSM_D_INNER + SSM_N_GROUPS * SSM_D_STATE], axis=-1)
    xs = xs.reshape(b, l, SSM_N_HEADS, SSM_HEAD_DIM)
    Bm = Bm.reshape(b, l, SSM_N_GROUPS, SSM_D_STATE)
    Cm = Cm.reshape(b, l, SSM_N_GROUPS, SSM_D_STATE)
    dt = jax.nn.softplus((dt + dt_bias).astype(jnp.float32))
    A = -jnp.exp(a_log.astype(jnp.float32))
    y, ssm_new = ssd_scan(xs, dt, A, Bm, Cm, ssm_state, chunk)
    y = (y + xs * d_skip[:, None]).reshape(b, l, SSM_D_INNER) * jax.nn.silu(z)
    y = rmsnorm(y.reshape(b, l, SSM_N_GROUPS, -1), norm_w.reshape(SSM_N_GROUPS, -1)).reshape(b, l, SSM_D_INNER)
    return y @ w_out, conv_new, ssm_new.astype(ssm_state.dtype)


def gla_chunk_scan(q, k, v, log_a, s0, chunk):
    b, l, H, _ = q.shape
    c = l // chunk
    causal = jnp.arange(chunk)[:, None] >= jnp.arange(chunk)[None, :]

    def to_chunks(t):
        return t.reshape(b, c, chunk, H, t.shape[-1]).swapaxes(0, 1)

    def step(S, inp):
        qc, kc, vc, gc = inp
        bcum = jnp.cumsum(gc, axis=1)
        q_t = qc * jnp.exp(bcum).astype(qc.dtype)
        k_t = kc * jnp.exp(-bcum).astype(kc.dtype)
        att = jnp.where(causal, jnp.einsum('bqhk,bshk->bhqs', q_t, k_t), 0.0)
        o = jnp.einsum('bhqs,bshv->bqhv', att, vc) + jnp.einsum('bqhk,bhkv->bqhv', q_t, S)
        b_last = bcum[:, -1]
        k_dec = kc * jnp.exp(b_last[:, None] - bcum).astype(kc.dtype)
        S_new = S * jnp.exp(b_last)[..., None].astype(S.dtype) + jnp.einsum('bqhk,bqhv->bhkv', k_dec, vc)
        return S_new.astype(S.dtype), o

    S, o = lax.scan(step, s0, (to_chunks(q), to_chunks(k), to_chunks(v), to_chunks(log_a)))
    return o.swapaxes(0, 1).reshape(b, l, H, v.shape[-1]), S


def gla_mixer(h, s0, w_in, w_gate, gate_bias, norm_w, w_out, chunk):
    b, l, _ = h.shape
    q, k, v, r, g_low = jnp.split(h @ w_in, [GLA_DK, 2 * GLA_DK, 2 * GLA_DK + GLA_DV, 2 * GLA_DK + 2 * GLA_DV], axis=-1)
    log_a = jax.nn.log_sigmoid((g_low @ w_gate + gate_bias).astype(jnp.float32)) / GLA_GATE_NORM
    hk = lambda t: t.reshape(b, l, GLA_N_HEADS, GLA_HEAD_K)
    o, s_new = gla_chunk_scan(hk(q) * GLA_HEAD_K ** -0.5, hk(k), v.reshape(b, l, GLA_N_HEADS, GLA_HEAD_V),
                              hk(log_a), s0, chunk)
    o = rmsnorm(o, norm_w).reshape(b, l, GLA_DV) * jax.nn.silu(r)
    return o @ w_out, s_new


def rope_partial(x, pos):
    inv_freq = ROPE_THETA ** (-jnp.arange(0, ATT_ROT_DIM, 2, dtype=jnp.float32) / ATT_ROT_DIM)
    ang = pos.astype(jnp.float32)[:, None] * inv_freq
    cos, sin = jnp.cos(ang)[:, None, :], jnp.sin(ang)[:, None, :]
    half = ATT_ROT_DIM // 2
    x1, x2, rest = x[..., :half], x[..., half:ATT_ROT_DIM], x[..., ATT_ROT_DIM:]
    rot = jnp.concatenate([x1 * cos - x2 * sin, x2 * cos + x1 * sin], axis=-1).astype(x.dtype)
    return jnp.concatenate([rot, rest], axis=-1)


def masked_softmax_stats(s, valid):
    s = jnp.where(valid, s, -jnp.inf)
    mx = jnp.max(s, axis=-1, keepdims=True)
    p = jnp.exp(s - mx)
    den = jnp.sum(p, axis=-1, keepdims=True)
    return p / den, (mx + jnp.log(den))[..., 0]


def dilated_window_prompt(q, kv, window, dilation):
    b, l, hg, dh = q.shape
    m = l // dilation
    span = window // dilation
    N = b * dilation

    def by_residue(t):
        t = t.reshape((b, m, dilation) + t.shape[2:])
        return jnp.moveaxis(t, 2, 1).reshape((N, m) + t.shape[3:])

    def pad_seq(t, front, back):
        return jnp.pad(t, [(0, 0), (front, back)] + [(0, 0)] * (t.ndim - 2))

    qs, kvs = by_residue(q), by_residue(kv)
    nb = -(-m // ATT_BLOCK)
    mp = nb * ATT_BLOCK
    qb = pad_seq(qs, 0, mp - m).reshape(N, nb, ATT_BLOCK, hg, dh)
    kvp = pad_seq(kvs, ATT_BLOCK, mp - m).reshape(N, nb + 1, ATT_BLOCK, 2, hg, dh)
    kvb = jnp.concatenate([kvp[:, :-1], kvp[:, 1:]], axis=2)
    s = jnp.einsum('nbqhd,nbkhd->nbhqk', qb, kvb[:, :, :, 0]).astype(jnp.float32) * ATT_HEAD_DIM ** -0.5
    qi = jnp.arange(ATT_BLOCK)[:, None]
    kj = jnp.arange(2 * ATT_BLOCK)[None, :]
    dist = ATT_BLOCK + qi - kj
    key_pos = jnp.arange(nb)[:, None, None] * ATT_BLOCK - ATT_BLOCK + kj[None]
    valid = (dist >= 0)[None] & (dist <= span)[None] & (key_pos >= 0)
    p, lse = masked_softmax_stats(s, valid[None, :, None])
    o = jnp.einsum('nbhqk,nbkhd->nbqhd', p.astype(q.dtype), kvb[:, :, :, 1])
    o = o.reshape(N, mp, hg, dh)[:, :m].reshape(b, dilation, m, hg, dh)
    o = jnp.moveaxis(o, 1, 2).reshape(b, l, hg, dh)
    lse = lse.transpose(0, 1, 3, 2).reshape(N, mp, hg)[:, :m].reshape(b, dilation, m, hg)
    lse = jnp.moveaxis(lse, 1, 2).reshape(b, l, hg)
    return o, lse


def dilated_window_sample(q, kv_new, kv_buf, window, dilation):
    L = kv_buf.shape[1]
    s_len = q.shape[1]
    kvx = jnp.concatenate([kv_buf, kv_new], axis=1)
    span = window // dilation
    idx = L + jnp.arange(s_len)[:, None] - dilation * jnp.arange(span + 1)[None, :]
    valid = idx >= 0
    g = kvx[:, jnp.maximum(idx, 0)]
    sc = jnp.einsum('bshd,bsjhd->bshj', q, g[:, :, :, 0]).astype(jnp.float32) * ATT_HEAD_DIM ** -0.5
    p, lse = masked_softmax_stats(sc, valid[None, :, None, :])
    o = jnp.einsum('bshj,bsjhd->bshd', p.astype(q.dtype), g[:, :, :, 1])
    keep = min(window, L + s_len)
    return o, lse, kvx[:, -keep:]


def dilated_attn_mixer(h, pos, kv_bufs, w_qkv, w_out):
    b, l, _ = h.shape
    qkv = (h @ w_qkv).reshape(b, l, 3, ATT_N_HEADS, ATT_HEAD_DIM)
    q = rope_partial(qkv[:, :, 0], pos)
    k = rope_partial(qkv[:, :, 1], pos)
    v = qkv[:, :, 2]
    outs, lses, new_kv = [], [], []
    for gi, (window, dilation) in enumerate(ATT_GROUPS):
        hs = slice(gi * ATT_HEADS_PER_GROUP, (gi + 1) * ATT_HEADS_PER_GROUP)
        kv = jnp.stack([k[:, :, hs], v[:, :, hs]], axis=2)
        if kv_bufs is None:
            o, lse = dilated_window_prompt(q[:, :, hs], kv, window, dilation)
            new_kv.append(kv[:, -min(window, l):])
        else:
            o, lse, kv_upd = dilated_window_sample(q[:, :, hs], kv, kv_bufs[gi], window, dilation)
            new_kv.append(kv_upd)
        outs.append(o)
        lses.append(lse)
    alpha = jax.nn.softmax(jnp.stack(lses, axis=0), axis=0)
    mixed = jnp.concatenate([o * alpha[gi][..., None].astype(o.dtype) for gi, o in enumerate(outs)], axis=2)
    return mixed.reshape(b, l, ATT_N_HEADS * ATT_HEAD_DIM) @ w_out, new_kv


def setup_inputs(seed: int = 0) -> dict:
    key = jax.random.key(seed)
    k = jax.random.split(key, 32)
    nrm = lambda kk, shape, scale: jax.random.normal(kk, shape, jnp.float32) * scale
    u = jax.random.uniform(k[16], (N_SSM_LAYERS, SSM_N_HEADS), jnp.float32)
    dt0 = jnp.exp(u * (jnp.log(0.1) - jnp.log(0.001)) + jnp.log(0.001))
    kv_shape = lambda w: (N_ATT_LAYERS, DEC_BATCH, min(w, PAST_LEN), 2, ATT_HEADS_PER_GROUP, ATT_HEAD_DIM)
    return {
        'x_prompt': nrm(k[0], (BATCH, SEQ, D_MODEL), 1.0),
        'x_sample': nrm(k[1], (DEC_BATCH, DEC_SEQ, D_MODEL), 1.0),
        'state_ssm': nrm(k[2], (N_SSM_LAYERS, DEC_BATCH, SSM_N_HEADS, SSM_HEAD_DIM, SSM_D_STATE), 0.1),
        'state_ssm_conv': nrm(k[3], (N_SSM_LAYERS, DEC_BATCH, SSM_CONV - 1, SSM_CONV_DIM), 1.0),
        'state_gla': nrm(k[4], (N_GLA_LAYERS, DEC_BATCH, GLA_N_HEADS, GLA_HEAD_K, GLA_HEAD_V), 0.1),
        'cache_kv_g0': nrm(k[5], kv_shape(ATT_GROUPS[0][0]), 1.0),
        'cache_kv_g1': nrm(k[6], kv_shape(ATT_GROUPS[1][0]), 1.0),
        'cache_kv_g2': nrm(k[7], kv_shape(ATT_GROUPS[2][0]), 1.0),
        'norm_mix': 1.0 + nrm(k[8], (DEPTH, D_MODEL), 0.02),
        'norm_ffn': 1.0 + nrm(k[9], (DEPTH, D_MODEL), 0.02),
        'ffn_gate': nrm(k[10], (DEPTH, D_MODEL, D_FF), D_MODEL ** -0.5),
        'ffn_up': nrm(k[11], (DEPTH, D_MODEL, D_FF), D_MODEL ** -0.5),
        'ffn_down': nrm(k[12], (DEPTH, D_FF, D_MODEL), D_FF ** -0.5),
        'ssm_w_in': nrm(k[13], (N_SSM_LAYERS, D_MODEL, SSM_IN_DIM), D_MODEL ** -0.5),
        'ssm_conv_w': nrm(k[14], (N_SSM_LAYERS, SSM_CONV, SSM_CONV_DIM), SSM_CONV ** -0.5),
        'ssm_conv_b': nrm(k[15], (N_SSM_LAYERS, SSM_CONV_DIM), 0.01),
        'ssm_dt_bias': dt0 + jnp.log(-jnp.expm1(-dt0)),
        'ssm_a_log': jnp.log(jax.random.uniform(k[17], (N_SSM_LAYERS, SSM_N_HEADS), jnp.float32, 1.0, 16.0)),
        'ssm_d': 1.0 + nrm(k[18], (N_SSM_LAYERS, SSM_N_HEADS), 0.1),
        'ssm_norm': 1.0 + nrm(k[19], (N_SSM_LAYERS, SSM_D_INNER), 0.02),
        'ssm_w_out': nrm(k[20], (N_SSM_LAYERS, SSM_D_INNER, D_MODEL), SSM_D_INNER ** -0.5),
        'gla_w_in': nrm(k[21], (N_GLA_LAYERS, D_MODEL, GLA_IN_DIM), D_MODEL ** -0.5),
        'gla_w_gate': nrm(k[22], (N_GLA_LAYERS, GLA_GATE_RANK, GLA_DK), GLA_GATE_RANK ** -0.5),
        'gla_gate_bias': nrm(k[23], (N_GLA_LAYERS, GLA_DK), 0.1),
        'gla_norm': 1.0 + nrm(k[24], (N_GLA_LAYERS, GLA_HEAD_V), 0.02),
        'gla_w_out': nrm(k[25], (N_GLA_LAYERS, GLA_DV, D_MODEL), GLA_DV ** -0.5),
        'att_w_qkv': nrm(k[26], (N_ATT_LAYERS, D_MODEL, 3 * ATT_N_HEADS * ATT_HEAD_DIM), D_MODEL ** -0.5),
        'att_w_out': nrm(k[27], (N_ATT_LAYERS, ATT_N_HEADS * ATT_HEAD_DIM, D_MODEL), (ATT_N_HEADS * ATT_HEAD_DIM) ** -0.5),
        'norm_final': 1.0 + nrm(k[28], (D_MODEL,), 0.02),
    }


def reference(x_prompt, x_sample, state_ssm, state_ssm_conv, state_gla, cache_kv_g0, cache_kv_g1, cache_kv_g2,
              norm_mix, norm_ffn, ffn_gate, ffn_up, ffn_down,
              ssm_w_in, ssm_conv_w, ssm_conv_b, ssm_dt_bias, ssm_a_log, ssm_d, ssm_norm, ssm_w_out,
              gla_w_in, gla_w_gate, gla_gate_bias, gla_norm, gla_w_out,
              att_w_qkv, att_w_out, norm_final):
    bp, lp = x_prompt.shape[:2]
    ls = x_sample.shape[1]
    pos_p = jnp.arange(lp)
    pos_s = PAST_LEN + jnp.arange(ls)
    xp, xs = x_prompt, x_sample
    att_caches = (cache_kv_g0, cache_kv_g1, cache_kv_g2)
    ssm_p, ssm_s, conv_p, conv_s, gla_p, gla_s = [], [], [], [], [], []
    kv_p, kv_s = [[], [], []], [[], [], []]
    for i in range(DEPTH):
        m, j = i % N_MIXERS, i // N_MIXERS
        hp = rmsnorm(xp, norm_mix[i])
        hs = rmsnorm(xs, norm_mix[i])
        if m == 0:
            w = (ssm_w_in[j], ssm_conv_w[j], ssm_conv_b[j], ssm_dt_bias[j], ssm_a_log[j], ssm_d[j], ssm_norm[j], ssm_w_out[j])
            conv0 = jnp.zeros((bp, SSM_CONV - 1, SSM_CONV_DIM), hp.dtype)
            h0 = jnp.zeros((bp, SSM_N_HEADS, SSM_HEAD_DIM, SSM_D_STATE), hp.dtype)
            op, cp, sp = mamba2_mixer(hp, conv0, h0, *w, chunk=min(SSM_CHUNK, lp))
            os_, cs, ss = mamba2_mixer(hs, state_ssm_conv[j], state_ssm[j], *w, chunk=ls)
            conv_p.append(cp); conv_s.append(cs); ssm_p.append(sp); ssm_s.append(ss)
        elif m == 1:
            w = (gla_w_in[j], gla_w_gate[j], gla_gate_bias[j], gla_norm[j], gla_w_out[j])
            s0 = jnp.zeros((bp, GLA_N_HEADS, GLA_HEAD_K, GLA_HEAD_V), hp.dtype)
            op, sp = gla_mixer(hp, s0, *w, chunk=min(GLA_CHUNK, lp))
            os_, ss = gla_mixer(hs, state_gla[j], *w, chunk=ls)
            gla_p.append(sp); gla_s.append(ss)
        else:
            op, nkp = dilated_attn_mixer(hp, pos_p, None, att_w_qkv[j], att_w_out[j])
            os_, nks = dilated_attn_mixer(hs, pos_s, [c[j] for c in att_caches], att_w_qkv[j], att_w_out[j])
            for gi in range(len(ATT_GROUPS)):
                kv_p[gi].append(nkp[gi]); kv_s[gi].append(nks[gi])
        xp = xp + op
        xs = xs + os_
        xp = xp + swiglu(rmsnorm(xp, norm_ffn[i]), ffn_gate[i], ffn_up[i], ffn_down[i])
        xs = xs + swiglu(rmsnorm(xs, norm_ffn[i]), ffn_gate[i], ffn_up[i], ffn_down[i])
    y_prompt = rmsnorm(xp, norm_final)
    y_sample = rmsnorm(xs, norm_final)
    return (y_prompt, y_sample,
            jnp.stack(ssm_p), jnp.stack(ssm_s), jnp.stack(conv_p), jnp.stack(conv_s),
            jnp.stack(gla_p), jnp.stack(gla_s),
            jnp.stack(kv_p[0]), jnp.stack(kv_s[0]), jnp.stack(kv_p[1]), jnp.stack(kv_s[1]),
            jnp.stack(kv_p[2]), jnp.stack(kv_s[2]))
```

```cpp
#include <hip/hip_runtime.h>
#include <hip/hip_cooperative_groups.h>
#include <cstdio>
#include <cstring>
namespace cg = cooperative_groups;

#ifndef ONE_LAUNCH
#define ONE_LAUNCH 1
#endif

typedef unsigned short bf16_t;
typedef short bf16x8 __attribute__((ext_vector_type(8)));
typedef float f32x16 __attribute__((ext_vector_type(16)));
typedef float f32x4 __attribute__((ext_vector_type(4)));
typedef unsigned u32x4 __attribute__((ext_vector_type(4)));
#define DEVI __device__ __forceinline__

constexpr int D = 1024, TP = 16384, TS = 128, T = TP + TS, SEQ = 8192, DFF = 2816;
constexpr int SSM_IN = 5152, SSM_INP = 5248, DI = 2048, CONVD = 3072;
constexpr int GLA_IN = 3088, GLA_INP = 3200;
constexpr int QKVD = 2304, ATTD = 768;
constexpr float EPS = 1e-6f;

constexpr size_t O_YP = 0, O_YS = O_YP + (size_t)TP * D, O_SSMP = O_YS + (size_t)TS * D, O_SSMS = O_SSMP + 2ull * 2 * 262144,
                 O_CONVP = O_SSMS + 2ull * 32 * 262144, O_CONVS = O_CONVP + 2ull * 2 * 3 * CONVD, O_GLAP = O_CONVS + 2ull * 32 * 3 * CONVD,
                 O_GLAS = O_GLAP + 2ull * 4 * 32768, O_KV0P = O_GLAS + 32ull * 4 * 32768, O_KV0S = O_KV0P + 2ull * 128 * 512,
                 O_KV1P = O_KV0S + 32ull * 128 * 512, O_KV1S = O_KV1P + 2ull * 512 * 512, O_KV2P = O_KV1S + 32ull * 512 * 512,
                 O_KV2S = O_KV2P + 2ull * 2048 * 512, O_END = O_KV2S + 32ull * 2048 * 512;

constexpr size_t al(size_t x) { return (x + 255) & ~(size_t)255; }
constexpr size_t W_SSM_IN = 0, W_SSM_OUT = W_SSM_IN + 2ull * SSM_INP * D * 2, W_GLA_IN = W_SSM_OUT + 2ull * D * DI * 2,
                 W_GLA_OUT = W_GLA_IN + (size_t)GLA_INP * D * 2, W_ATT_QKV = W_GLA_OUT + (size_t)D * D * 2, W_ATT_OUT = W_ATT_QKV + (size_t)QKVD * D * 2,
                 W_FFN_GU = W_ATT_OUT + (size_t)D * ATTD * 2, W_FFN_DN = W_FFN_GU + 4ull * 2 * DFF * D * 2, W_END = W_FFN_DN + 4ull * D * DFF * 2;
constexpr size_t B_HB = al(W_END), B_R3 = B_HB + (size_t)T * D * 2, B_R4 = B_R3 + (size_t)T * DI * 2, B_R5 = B_R4 + (size_t)T * CONVD * 2,
                 B_R6 = B_R5 + (size_t)T * CONVD * 2, B_DT = B_R6 + 67108864ull, B_DTS = B_DT + (size_t)T * 32 * 4, B_ACS = B_DTS + (size_t)T * 32 * 4,
                 B_GLOW = B_ACS + (size_t)T * 32 * 4, B_END = B_GLOW + (size_t)T * 16 * 4;

struct WDesc { const float* src; const float* gain; bf16_t* dst; int K, N, Npad, mode, tile0, gmod, pad; };
constexpr int NWD = 20;
struct Params {
    const float* in[29];
    float* out;
    unsigned char* ws;
    WDesc wd[NWD];
    int wtiles, nphase;
    unsigned char prog[64][2];
};

constexpr int LDS_BYTES = 79872;
__shared__ __attribute__((aligned(16))) unsigned char smem[LDS_BYTES];

DEVI int tidx() { int t = threadIdx.x; asm volatile("" : "+v"(t)); return t; }
DEVI int bidx() { int b = blockIdx.x; asm volatile("" : "+s"(b)); return b; }
DEVI unsigned short f2bf(float f) { unsigned u = __float_as_uint(f); u += 0x7fffu + ((u >> 16) & 1u); return (unsigned short)(u >> 16); }
DEVI float bf2f(unsigned short h) { return __uint_as_float(((unsigned)h) << 16); }
DEVI unsigned pack2(float a, float b) { return (unsigned)f2bf(a) | ((unsigned)f2bf(b) << 16); }
DEVI float silu_f(float x) { return x / (1.f + __expf(-x)); }
DEVI float softplus_f(float x) { return x > 20.f ? x : log1pf(__expf(x)); }
DEVI float logsigmoid_f(float x) { return fminf(x, 0.f) - log1pf(__expf(-fabsf(x))); }
DEVI float wave_sum(float v) { for (int o = 32; o > 0; o >>= 1) v += __shfl_xor(v, o); return v; }
DEVI float wave_max(float v) { for (int o = 32; o > 0; o >>= 1) v = fmaxf(v, __shfl_xor(v, o)); return v; }
DEVI bf16x8 ldsfrag(const bf16_t* base, int row, int stride, int k) { return *(const bf16x8*)(base + row * stride + k); }
DEVI f32x16 mfma32(bf16x8 a, bf16x8 b, f32x16 c) { return __builtin_amdgcn_mfma_f32_32x32x16_bf16(a, b, c, 0, 0, 0); }
DEVI void unpack8(uint4 v, float* f) {
    f[0] = __uint_as_float(v.x << 16); f[1] = __uint_as_float(v.x & 0xffff0000u); f[2] = __uint_as_float(v.y << 16); f[3] = __uint_as_float(v.y & 0xffff0000u);
    f[4] = __uint_as_float(v.z << 16); f[5] = __uint_as_float(v.z & 0xffff0000u); f[6] = __uint_as_float(v.w << 16); f[7] = __uint_as_float(v.w & 0xffff0000u);
}
DEVI void unpack4(uint2 v, float* f) {
    f[0] = __uint_as_float(v.x << 16); f[1] = __uint_as_float(v.x & 0xffff0000u); f[2] = __uint_as_float(v.y << 16); f[3] = __uint_as_float(v.y & 0xffff0000u);
}

__device__ void convert_weights(const Params& p) {
    float* tile = (float*)smem;
    const int tid = tidx();
    for (int it = bidx(); it < p.wtiles; it += gridDim.x) {
        int di = 0;
        for (int i = 1; i < NWD; ++i) if (it >= p.wd[i].tile0) di = i;
        const WDesc& d = p.wd[di];
        const int lt = it - d.tile0, nkt = d.K / 64, ntile = lt / nkt, ktile = lt % nkt;
        const int n0 = ntile * 64, k0 = ktile * 64;
        __syncthreads();
        {
            const int nn = tid & 63, n = n0 + nn;
            for (int kk = tid >> 6; kk < 64; kk += 4) {
                float v = 0.f;
                if (n < d.N) { v = d.src[(size_t)(k0 + kk) * d.N + n]; if (d.gain) v *= d.gain[(k0 + kk) % d.gmod]; }
                tile[kk * 65 + nn] = v;
            }
        }
        __syncthreads();
        {
            const int r = tid >> 2, seg = tid & 3, n = n0 + r;
            int drow = n;
            if (d.mode) { const int t = n >> 6, c = n & 63; drow = t * 128 + (c >> 5) * 64 + (d.mode == 2 ? 32 : 0) + (c & 31); }
            unsigned w[8];
#pragma unroll
            for (int e = 0; e < 8; ++e) w[e] = pack2(tile[(seg * 16 + 2 * e) * 65 + r], tile[(seg * 16 + 2 * e + 1) * 65 + r]);
            uint4* dp = (uint4*)(d.dst + (size_t)drow * d.K + k0 + seg * 16);
            dp[0] = make_uint4(w[0], w[1], w[2], w[3]); dp[1] = make_uint4(w[4], w[5], w[6], w[7]);
        }
    }
}

__device__ void copy_caches(const Params& p) {
    const size_t gtid = (size_t)bidx() * blockDim.x + tidx(), gsz = (size_t)gridDim.x * blockDim.x;
    const int Ws[3] = {128, 512, 2048};
    const size_t oo[3] = {O_KV0S, O_KV1S, O_KV2S};
#pragma unroll
    for (int g = 0; g < 3; ++g) {
        const int W = Ws[g];
        const size_t per = (size_t)(W - 4) * 128, tot = 32 * per;
        const float4* src = (const float4*)p.in[5 + g];
        float4* dst = (float4*)(p.out + oo[g]);
        for (size_t i = gtid; i < tot; i += gsz) {
            const size_t sb = i / per, rem = i % per;
            dst[sb * W * 128 + rem] = src[(sb * W + 4) * 128 + rem];
        }
    }
}

__device__ void norm_phase(const Params& p, int mode) {
    const int lane = tidx() & 63, wv = (bidx() * blockDim.x + tidx()) >> 6, nw = (gridDim.x * blockDim.x) >> 6;
    float* X = p.out;
    bf16_t* Hb = (bf16_t*)(p.ws + B_HB);
    for (int r = wv; r < T; r += nw) {
        const float* src = mode == 0 ? (r < TP ? p.in[0] + (size_t)r * D : p.in[1] + (size_t)(r - TP) * D) : X + (size_t)r * D;
        float4 v[4]; float ss = 0.f;
#pragma unroll
        for (int i = 0; i < 4; ++i) { v[i] = ((const float4*)src)[i * 64 + lane]; ss += v[i].x * v[i].x + v[i].y * v[i].y + v[i].z * v[i].z + v[i].w * v[i].w; }
        ss = wave_sum(ss);
        const float inv = rsqrtf(ss * (1.f / D) + EPS);
        if (mode == 2) {
            const float4* g = (const float4*)p.in[28];
#pragma unroll
            for (int i = 0; i < 4; ++i) { float4 gg = g[i * 64 + lane]; ((float4*)(X + (size_t)r * D))[i * 64 + lane] = make_float4(v[i].x * inv * gg.x, v[i].y * inv * gg.y, v[i].z * inv * gg.z, v[i].w * inv * gg.w); }
        } else {
#pragma unroll
            for (int i = 0; i < 4; ++i) {
                if (mode == 0) ((float4*)(X + (size_t)r * D))[i * 64 + lane] = v[i];
                ((uint2*)(Hb + (size_t)r * D))[i * 64 + lane] = make_uint2(pack2(v[i].x * inv, v[i].y * inv), pack2(v[i].z * inv, v[i].w * inv));
            }
        }
    }
}

enum { EPI_SSM_IN = 0, EPI_GLA_IN = 1, EPI_ATT_IN = 2, EPI_RESADD = 3, EPI_SWIGLU = 4 };
constexpr int GST = 72;

template <int EPI>
__device__ void gemm_phase(const Params& p, const bf16_t* __restrict__ A, const bf16_t* __restrict__ Bt, int K, int nN) {
    const int tid = tidx(), lane = tid & 63, wave = tid >> 6, wm = wave >> 1, wn = wave & 1, l31 = lane & 31, lh = lane >> 5;
    bf16_t* sA = (bf16_t*)smem; bf16_t* sB = sA + 128 * GST;
    const int nM = T / 128, ntiles = nM * nN, nk = K / 64;
    for (int tile = bidx(); tile < ntiles; tile += gridDim.x) {
        const int mt = tile / nN, nt = tile % nN;
        const bf16_t* Ag = A + (size_t)mt * 128 * K; const bf16_t* Bg = Bt + (size_t)nt * 128 * K;
        f32x16 acc[2][2];
#pragma unroll
        for (int i = 0; i < 2; ++i)
#pragma unroll
            for (int j = 0; j < 2; ++j)
#pragma unroll
                for (int e = 0; e < 16; ++e) acc[i][j][e] = 0.f;
        u32x4 ra[4], rb[4];
#pragma unroll
        for (int i = 0; i < 4; ++i) { const int v = tid + 256 * i, row = v >> 3, cv = v & 7; ra[i] = *(const u32x4*)(Ag + (size_t)row * K + cv * 8); rb[i] = *(const u32x4*)(Bg + (size_t)row * K + cv * 8); }
        for (int kt = 0; kt < nk; ++kt) {
            __syncthreads();
#pragma unroll
            for (int i = 0; i < 4; ++i) { const int v = tid + 256 * i, row = v >> 3, cv = v & 7; *(u32x4*)(sA + row * GST + cv * 8) = ra[i]; *(u32x4*)(sB + row * GST + cv * 8) = rb[i]; }
            __syncthreads();
            const int kn = (kt + 1 < nk) ? kt + 1 : kt;
#pragma unroll
            for (int i = 0; i < 4; ++i) { const int v = tid + 256 * i, row = v >> 3, cv = v & 7; ra[i] = *(const u32x4*)(Ag + (size_t)row * K + kn * 64 + cv * 8); rb[i] = *(const u32x4*)(Bg + (size_t)row * K + kn * 64 + cv * 8); }
#pragma unroll
            for (int ks = 0; ks < 4; ++ks) {
                bf16x8 a[2], b[2];
#pragma unroll
                for (int i = 0; i < 2; ++i) { a[i] = ldsfrag(sA, 64 * wm + 32 * i + l31, GST, ks * 16 + 8 * lh); b[i] = ldsfrag(sB, 64 * wn + 32 * i + l31, GST, ks * 16 + 8 * lh); }
#pragma unroll
                for (int i = 0; i < 2; ++i)
#pragma unroll
                    for (int j = 0; j < 2; ++j) acc[i][j] = mfma32(b[j], a[i], acc[i][j]);
            }
        }
#pragma unroll
        for (int i = 0; i < 2; ++i) {
            const int row = mt * 128 + 64 * wm + 32 * i + l31;
            if (EPI == EPI_SWIGLU) {
                bf16_t* H = (bf16_t*)(p.ws + B_R4);
#pragma unroll
                for (int rg = 0; rg < 4; ++rg) {
                    const int hc = nt * 64 + wn * 32 + 8 * rg + 4 * lh;
                    float o[4];
#pragma unroll
                    for (int e = 0; e < 4; ++e) o[e] = silu_f(acc[i][0][4 * rg + e]) * acc[i][1][4 * rg + e];
                    *(uint2*)(H + (size_t)row * DFF + hc) = make_uint2(pack2(o[0], o[1]), pack2(o[2], o[3]));
                }
            } else {
#pragma unroll
                for (int j = 0; j < 2; ++j)
#pragma unroll
                    for (int rg = 0; rg < 4; ++rg) {
                        const int col = nt * 128 + 64 * wn + 32 * j + 8 * rg + 4 * lh;
                        const float v0 = acc[i][j][4 * rg], v1 = acc[i][j][4 * rg + 1], v2 = acc[i][j][4 * rg + 2], v3 = acc[i][j][4 * rg + 3];
                        if (EPI == EPI_RESADD) {
                            float4* xp = (float4*)(p.out + (size_t)row * D + col);
                            float4 x = *xp; x.x += v0; x.y += v1; x.z += v2; x.w += v3; *xp = x;
                        } else if (EPI == EPI_SSM_IN) {
                            const uint2 pk = make_uint2(pack2(v0, v1), pack2(v2, v3));
                            if (col < DI) *(uint2*)((bf16_t*)(p.ws + B_R3) + (size_t)row * DI + col) = pk;
                            else if (col < DI + CONVD) *(uint2*)((bf16_t*)(p.ws + B_R4) + (size_t)row * CONVD + (col - DI)) = pk;
                            else if (col < SSM_IN) *(float4*)((float*)(p.ws + B_DT) + (size_t)row * 32 + (col - DI - CONVD)) = make_float4(v0, v1, v2, v3);
                        } else if (EPI == EPI_GLA_IN) {
                            if (col < 3072) *(uint2*)((bf16_t*)(p.ws + B_R4) + (size_t)row * 3072 + col) = make_uint2(pack2(v0, v1), pack2(v2, v3));
                            else if (col < GLA_IN) *(float4*)((float*)(p.ws + B_GLOW) + (size_t)row * 16 + (col - 3072)) = make_float4(v0, v1, v2, v3);
                        } else {
                            *(uint2*)((bf16_t*)(p.ws + B_R4) + (size_t)row * QKVD + col) = make_uint2(pack2(v0, v1), pack2(v2, v3));
                        }
                    }
            }
        }
    }
}

__device__ void ssm_conv_phase(const Params& p, int j) {
    const bf16_t* raw = (const bf16_t*)(p.ws + B_R4);
    bf16_t* act = (bf16_t*)(p.ws + B_R5);
    const float* cw = p.in[14] + (size_t)j * 4 * CONVD; const float* cb = p.in[15] + (size_t)j * CONVD;
    const float* sbuf = p.in[3] + (size_t)j * 32 * 3 * CONVD;
    float* convp = p.out + O_CONVP + (size_t)j * 2 * 3 * CONVD; float* convs = p.out + O_CONVS + (size_t)j * 32 * 3 * CONVD;
    const size_t gtid = (size_t)bidx() * blockDim.x + tidx(), gsz = (size_t)gridDim.x * blockDim.x;
    const size_t tot = (size_t)T * (CONVD / 8);
    for (size_t it = gtid; it < tot; it += gsz) {
        const int t = (int)(it / (CONVD / 8)), c8 = (int)(it % (CONVD / 8)) * 8;
        int pos, sb = 0; bool samp = t >= TP;
        if (samp) { sb = (t - TP) >> 2; pos = (t - TP) & 3; } else pos = t & (SEQ - 1);
        float accv[8], xr[4][8];
#pragma unroll
        for (int e = 0; e < 8; ++e) accv[e] = cb[c8 + e];
#pragma unroll
        for (int d = 0; d < 4; ++d) {
            if (pos - d >= 0) unpack8(*(const uint4*)(raw + (size_t)(t - d) * CONVD + c8), xr[d]);
            else if (samp) {
                const float* bp = sbuf + ((size_t)sb * 3 + (3 + pos - d)) * CONVD + c8;
#pragma unroll
                for (int e = 0; e < 8; ++e) xr[d][e] = bp[e];
            } else {
#pragma unroll
                for (int e = 0; e < 8; ++e) xr[d][e] = 0.f;
            }
            const float* wp = cw + (size_t)(3 - d) * CONVD + c8;
#pragma unroll
            for (int e = 0; e < 8; ++e) accv[e] += xr[d][e] * wp[e];
        }
        unsigned w[4];
#pragma unroll
        for (int e = 0; e < 4; ++e) w[e] = pack2(silu_f(accv[2 * e]), silu_f(accv[2 * e + 1]));
        *(uint4*)(act + (size_t)t * CONVD + c8) = make_uint4(w[0], w[1], w[2], w[3]);
        if (!samp && pos >= SEQ - 3) {
            float* o = convp + ((size_t)(t >> 13) * 3 + (pos - (SEQ - 3))) * CONVD + c8;
#pragma unroll
            for (int e = 0; e < 8; ++e) o[e] = xr[0][e];
        }
        if (samp && pos >= 1) {
            float* o = convs + ((size_t)sb * 3 + (pos - 1)) * CONVD + c8;
#pragma unroll
            for (int e = 0; e < 8; ++e) o[e] = xr[0][e];
        }
    }
    const float* DT = (const float*)(p.ws + B_DT); float* DTS = (float*)(p.ws + B_DTS); float* ACS = (float*)(p.ws + B_ACS);
    const float* dtb = p.in[16] + j * 32; const float* alog = p.in[17] + j * 32;
    for (size_t it = gtid; it < 128 * 32 + TS * 32; it += gsz) {
        if (it < 128 * 32) {
            const int c = (int)(it >> 5), h = (int)(it & 31);
            const float Ah = -__expf(alog[h]), bh = dtb[h]; float run = 0.f;
            for (int q = 0; q < 128; ++q) { const size_t o = (size_t)(c * 128 + q) * 32 + h; const float d = softplus_f(DT[o] + bh); DTS[o] = d; run += Ah * d; ACS[o] = run; }
        } else {
            const int r = (int)(it - 128 * 32), h = r & 31; const size_t o = (size_t)(TP + (r >> 5)) * 32 + h;
            const float d = softplus_f(DT[o] + dtb[h]); DTS[o] = d; ACS[o] = -__expf(alog[h]) * d;
        }
    }
}

constexpr int SST = 136;
__device__ void ssm_state_phase(const Params& p, int j) {
    const bf16_t* act = (const bf16_t*)(p.ws + B_R5);
    const float* DTS = (const float*)(p.ws + B_DTS); const float* ACS = (const float*)(p.ws + B_ACS);
    bf16_t* ST = (bf16_t*)(p.ws + B_R6);
    const int tid = tidx(), lane = tid & 63, wave = tid >> 6, l31 = lane & 31, lh = lane >> 5;
    bf16_t* sBt = (bf16_t*)smem;
    bf16_t* sXt = sBt + 128 * SST;
    float* sw = (float*)(sXt + 64 * SST);
    const int nprompt = 128 * 4, nitems = nprompt + 32 * 4;
    for (int item = bidx(); item < nitems; item += gridDim.x) {
        if (item < nprompt) {
            const int c = item >> 2, g = item & 3, t0 = c * 128;
            __syncthreads();
            for (int idx = tid; idx < 128 * 16; idx += 256) {
                const int q = idx >> 4, n8 = (idx & 15) * 8;
                const uint4 v = *(const uint4*)(act + (size_t)(t0 + q) * CONVD + DI + g * 128 + n8);
                const unsigned short* s = (const unsigned short*)&v;
#pragma unroll
                for (int e = 0; e < 8; ++e) sBt[(n8 + e) * SST + q] = s[e];
            }
            for (int hh = 0; hh < 8; ++hh) {
                const int h = g * 8 + hh;
                __syncthreads();
                if (tid < 128) sw[tid] = DTS[(size_t)(t0 + tid) * 32 + h] * __expf(ACS[(size_t)(t0 + 127) * 32 + h] - ACS[(size_t)(t0 + tid) * 32 + h]);
                __syncthreads();
                for (int idx = tid; idx < 128 * 8; idx += 256) {
                    const int q = idx >> 3, p8 = (idx & 7) * 8;
                    float f[8]; unpack8(*(const uint4*)(act + (size_t)(t0 + q) * CONVD + h * 64 + p8), f);
                    const float w = sw[q];
#pragma unroll
                    for (int e = 0; e < 8; ++e) sXt[(p8 + e) * SST + q] = f2bf(f[e] * w);
                }
                __syncthreads();
                f32x16 acc[2];
#pragma unroll
                for (int i = 0; i < 2; ++i)
#pragma unroll
                    for (int e = 0; e < 16; ++e) acc[i][e] = 0.f;
#pragma unroll
                for (int ks = 0; ks < 8; ++ks) {
                    const bf16x8 a = ldsfrag(sBt, 32 * wave + l31, SST, ks * 16 + 8 * lh);
#pragma unroll
                    for (int i = 0; i < 2; ++i) acc[i] = mfma32(a, ldsfrag(sXt, 32 * i + l31, SST, ks * 16 + 8 * lh), acc[i]);
                }
#pragma unroll
                for (int i = 0; i < 2; ++i)
#pragma unroll
                    for (int rg = 0; rg < 4; ++rg) {
                        const int n = 32 * wave + 8 * rg + 4 * lh, pp = 32 * i + l31;
                        *(uint2*)(ST + (((size_t)c * 32 + h) * 64 + pp) * 128 + n) = make_uint2(pack2(acc[i][4 * rg], acc[i][4 * rg + 1]), pack2(acc[i][4 * rg + 2], acc[i][4 * rg + 3]));
                    }
            }
        } else {
            const int sb = (item - nprompt) >> 2, g = (item - nprompt) & 3, pp = tid >> 2, nq = tid & 3;
            const float* st_in = p.in[2] + (size_t)j * 32 * 262144; float* st_out = p.out + O_SSMS + (size_t)j * 32 * 262144;
            const bf16_t* Z = (const bf16_t*)(p.ws + B_R3); bf16_t* Y = (bf16_t*)(p.ws + B_R4);
            const float* dsk = p.in[18] + j * 32;
            float* red = (float*)smem;
            float ssq[4] = {0.f, 0.f, 0.f, 0.f};
            __syncthreads();
            for (int hh = 0; hh < 8; ++hh) {
                const int h = g * 8 + hh;
                const size_t sbase = (((size_t)sb * 32 + h) * 64 + pp) * 128;
                float hs[32];
#pragma unroll
                for (int i = 0; i < 8; ++i) { const float4 v = *(const float4*)(st_in + sbase + 4 * nq + 16 * i); hs[4 * i] = v.x; hs[4 * i + 1] = v.y; hs[4 * i + 2] = v.z; hs[4 * i + 3] = v.w; }
                const float Dh = dsk[h];
#pragma unroll
                for (int s = 0; s < 4; ++s) {
                    const int tok = TP + sb * 4 + s;
                    const float dt = DTS[(size_t)tok * 32 + h], dA = __expf(ACS[(size_t)tok * 32 + h]);
                    const float x = bf2f(act[(size_t)tok * CONVD + h * 64 + pp]), xdt = x * dt;
                    float yp = 0.f;
#pragma unroll
                    for (int i = 0; i < 8; ++i) {
                        float bf[4], cf[4];
                        unpack4(*(const uint2*)(act + (size_t)tok * CONVD + DI + g * 128 + 4 * nq + 16 * i), bf);
                        unpack4(*(const uint2*)(act + (size_t)tok * CONVD + DI + 512 + g * 128 + 4 * nq + 16 * i), cf);
#pragma unroll
                        for (int e = 0; e < 4; ++e) { hs[4 * i + e] = dA * hs[4 * i + e] + xdt * bf[e]; yp += hs[4 * i + e] * cf[e]; }
                    }
                    yp += __shfl_xor(yp, 1); yp += __shfl_xor(yp, 2);
                    float y = yp + Dh * x;
                    y *= silu_f(bf2f(Z[(size_t)tok * DI + h * 64 + pp]));
                    if (nq == 0) { ssq[s] += y * y; Y[(size_t)tok * DI + h * 64 + pp] = f2bf(y); }
                }
#pragma unroll
                for (int i = 0; i < 8; ++i) *(float4*)(st_out + sbase + 4 * nq + 16 * i) = make_float4(hs[4 * i], hs[4 * i + 1], hs[4 * i + 2], hs[4 * i + 3]);
            }
#pragma unroll
            for (int s = 0; s < 4; ++s) red[s * 256 + tid] = ssq[s];
            __syncthreads();
            for (int o = 128; o > 0; o >>= 1) {
                if (tid < o) {
#pragma unroll
                    for (int s = 0; s < 4; ++s) red[s * 256 + tid] += red[s * 256 + tid + o];
                }
                __syncthreads();
            }
            if (nq == 0) {
#pragma unroll
                for (int s = 0; s < 4; ++s) {
                    const float inv = rsqrtf(red[s * 256] * (1.f / 512.f) + EPS);
                    const int tok = TP + sb * 4 + s;
                    for (int hh = 0; hh < 8; ++hh) { bf16_t* yp = Y + (size_t)tok * DI + (g * 8 + hh) * 64 + pp; *yp = f2bf(bf2f(*yp) * inv); }
                }
            }
            __syncthreads();
        }
    }
}

__device__ void ssm_scan_phase(const Params& p, int j) {
    bf16_t* ST = (bf16_t*)(p.ws + B_R6);
    const float* ACS = (const float*)(p.ws + B_ACS);
    float* outp = p.out + O_SSMP + (size_t)j * 2 * 262144;
    const int gtid = bidx() * blockDim.x + tidx(), gsz = gridDim.x * blockDim.x;
    for (int it = gtid; it < 2 * 32 * 2048; it += gsz) {
        const int b = it >> 16, h = (it >> 11) & 31, e4 = (it & 2047) * 4;
        float s0 = 0.f, s1 = 0.f, s2 = 0.f, s3 = 0.f;
#pragma unroll 8
        for (int cc = 0; cc < 64; ++cc) {
            const int c = b * 64 + cc;
            uint2* ptr = (uint2*)(ST + ((size_t)c * 32 + h) * 8192 + e4);
            float f[4]; unpack4(*ptr, f);
            *ptr = make_uint2(pack2(s0, s1), pack2(s2, s3));
            const float dec = __expf(ACS[(size_t)(c * 128 + 127) * 32 + h]);
            s0 = dec * s0 + f[0]; s1 = dec * s1 + f[1]; s2 = dec * s2 + f[2]; s3 = dec * s3 + f[3];
        }
        *(float4*)(outp + ((size_t)b * 32 + h) * 8192 + e4) = make_float4(s0, s1, s2, s3);
    }
}

__device__ void ssm_out_phase(const Params& p, int j) {
    const bf16_t* act = (const bf16_t*)(p.ws + B_R5);
    const float* DTS = (const float*)(p.ws + B_DTS); const float* ACS = (const float*)(p.ws + B_ACS);
    const bf16_t* ST = (const bf16_t*)(p.ws + B_R6); const bf16_t* Z = (const bf16_t*)(p.ws + B_R3);
    bf16_t* Y = (bf16_t*)(p.ws + B_R4);
    const float* dsk = p.in[18] + j * 32;
    const int tid = tidx(), lane = tid & 63, wave = tid >> 6, l31 = lane & 31, lh = lane >> 5;
    bf16_t* RA = (bf16_t*)smem;
    bf16_t* RB = RA + 128 * SST;
    float* sacs = (float*)(RB + 128 * SST);
    float* sdts = sacs + 1024;
    for (int item = bidx(); item < 512; item += gridDim.x) {
        const int c = item >> 2, g = item & 3, t0 = c * 128;
        __syncthreads();
        for (int idx = tid; idx < 128 * 16; idx += 256) {
            const int q = idx >> 4, n8 = (idx & 15) * 8;
            *(uint4*)(RB + q * SST + n8) = *(const uint4*)(act + (size_t)(t0 + q) * CONVD + DI + g * 128 + n8);
            *(uint4*)(RA + q * SST + n8) = *(const uint4*)(act + (size_t)(t0 + q) * CONVD + DI + 512 + g * 128 + n8);
        }
        for (int idx = tid; idx < 1024; idx += 256) {
            const int hh = idx >> 7, q = idx & 127;
            sacs[idx] = ACS[(size_t)(t0 + q) * 32 + g * 8 + hh]; sdts[idx] = DTS[(size_t)(t0 + q) * 32 + g * 8 + hh];
        }
        __syncthreads();
        f32x16 X[4]; bf16x8 cf[8];
#pragma unroll
        for (int st = 0; st < 4; ++st)
#pragma unroll
            for (int e = 0; e < 16; ++e) X[st][e] = 0.f;
#pragma unroll
        for (int ks = 0; ks < 8; ++ks) {
            cf[ks] = ldsfrag(RA, 32 * wave + l31, SST, ks * 16 + 8 * lh);
#pragma unroll
            for (int st = 0; st < 4; ++st) X[st] = mfma32(ldsfrag(RB, 32 * st + l31, SST, ks * 16 + 8 * lh), cf[ks], X[st]);
        }
        const int q = 32 * wave + l31;
        float ssq = 0.f;
        for (int hh = 0; hh < 8; ++hh) {
            const int h = g * 8 + hh;
            __syncthreads();
            for (int idx = tid; idx < 128 * 8; idx += 256) {
                const int s = idx >> 3, p8 = (idx & 7) * 8;
                float f[8]; unpack8(*(const uint4*)(act + (size_t)(t0 + s) * CONVD + h * 64 + p8), f);
                const float w = sdts[hh * 128 + s];
#pragma unroll
                for (int e = 0; e < 8; ++e) RA[(p8 + e) * SST + s] = f2bf(f[e] * w);
            }
            for (int idx = tid; idx < 64 * 16; idx += 256) {
                const int pp = idx >> 4, n8 = (idx & 15) * 8;
                *(uint4*)(RA + (64 + pp) * SST + n8) = *(const uint4*)(ST + (((size_t)c * 32 + h) * 64 + pp) * 128 + n8);
            }
            const float aq = sacs[hh * 128 + q];
#pragma unroll
            for (int st = 0; st < 4; ++st)
#pragma unroll
                for (int rg = 0; rg < 4; ++rg) {
                    const int s0 = 32 * st + 8 * rg + 4 * lh;
                    float m[4];
#pragma unroll
                    for (int e = 0; e < 4; ++e) { const int s = s0 + e; m[e] = (s <= q) ? X[st][4 * rg + e] * __expf(aq - sacs[hh * 128 + s]) : 0.f; }
                    *(uint2*)(RB + q * SST + s0) = make_uint2(pack2(m[0], m[1]), pack2(m[2], m[3]));
                }
            __syncthreads();
            f32x16 ad[2], ao[2];
#pragma unroll
            for (int i = 0; i < 2; ++i)
#pragma unroll
                for (int e = 0; e < 16; ++e) { ad[i][e] = 0.f; ao[i][e] = 0.f; }
#pragma unroll
            for (int ks = 0; ks < 8; ++ks) {
                const bf16x8 mb = ldsfrag(RB, q, SST, ks * 16 + 8 * lh);
#pragma unroll
                for (int i = 0; i < 2; ++i) {
                    ad[i] = mfma32(ldsfrag(RA, 32 * i + l31, SST, ks * 16 + 8 * lh), mb, ad[i]);
                    ao[i] = mfma32(ldsfrag(RA, 64 + 32 * i + l31, SST, ks * 16 + 8 * lh), cf[ks], ao[i]);
                }
            }
            const float eq = __expf(aq), Dh = dsk[h];
            const size_t trow = (size_t)(t0 + q);
#pragma unroll
            for (int i = 0; i < 2; ++i)
#pragma unroll
                for (int rg = 0; rg < 4; ++rg) {
                    const int pc = h * 64 + 32 * i + 8 * rg + 4 * lh;
                    float xf[4], zf[4], y[4];
                    unpack4(*(const uint2*)(act + trow * CONVD + pc), xf);
                    unpack4(*(const uint2*)(Z + trow * DI + pc), zf);
#pragma unroll
                    for (int e = 0; e < 4; ++e) { y[e] = (ad[i][4 * rg + e] + eq * ao[i][4 * rg + e] + Dh * xf[e]) * silu_f(zf[e]); ssq += y[e] * y[e]; }
                    *(uint2*)(Y + trow * DI + pc) = make_uint2(pack2(y[0], y[1]), pack2(y[2], y[3]));
                }
        }
        ssq += __shfl_xor(ssq, 32);
        const float inv = rsqrtf(ssq * (1.f / 512.f) + EPS);
        const size_t trow = (size_t)(t0 + q);
        for (int hh = 0; hh < 8; ++hh)
#pragma unroll
            for (int i = 0; i < 2; ++i)
#pragma unroll
                for (int rg = 0; rg < 4; ++rg) {
                    uint2* yp = (uint2*)(Y + trow * DI + (g * 8 + hh) * 64 + 32 * i + 8 * rg + 4 * lh);
                    float f[4]; unpack4(*yp, f);
                    *yp = make_uint2(pack2(f[0] * inv, f[1] * inv), pack2(f[2] * inv, f[3] * inv));
                }
    }
}

constexpr int GCH = 64;
__device__ void gla_gate_phase(const Params& p) {
    const float* GLOW = (const float*)(p.ws + B_GLOW); float* BC = (float*)(p.ws + B_HB);
    const float* wg = p.in[22]; const float* gb = p.in[23];
    const int tid = tidx();
    const int nitems = TP / GCH + 32;
    for (int item = bidx(); item < nitems; item += gridDim.x) {
        int t0, len;
        if (item < TP / GCH) { t0 = item * GCH; len = GCH; } else { t0 = TP + (item - TP / GCH) * 4; len = 4; }
        float w0[16], w1[16];
#pragma unroll
        for (int r = 0; r < 16; ++r) { w0[r] = wg[r * 512 + tid]; w1[r] = wg[r * 512 + 256 + tid]; }
        const float b0 = gb[tid], b1 = gb[256 + tid];
        float r0 = 0.f, r1 = 0.f;
        for (int q = 0; q < len; ++q) {
            const float* gl = GLOW + (size_t)(t0 + q) * 16;
            float a0 = b0, a1 = b1;
#pragma unroll
            for (int r = 0; r < 16; ++r) { const float gv = gl[r]; a0 += gv * w0[r]; a1 += gv * w1[r]; }
            r0 += logsigmoid_f(a0) * (1.f / 16.f); r1 += logsigmoid_f(a1) * (1.f / 16.f);
            BC[(size_t)(t0 + q) * 512 + tid] = r0; BC[(size_t)(t0 + q) * 512 + 256 + tid] = r1;
        }
    }
}

constexpr int QST = 72;
__device__ void gla_state_phase(const Params& p) {
    const bf16_t* QK = (const bf16_t*)(p.ws + B_R4);
    const float* BC = (const float*)(p.ws + B_HB);
    bf16_t* U = (bf16_t*)(p.ws + B_R6);
    const int tid = tidx(), lane = tid & 63, wave = tid >> 6, l31 = lane & 31, lh = lane >> 5;
    bf16_t* sVt = (bf16_t*)smem;
    bf16_t* sKt = sVt + 256 * QST;
    const int nprompt = (TP / GCH) * 4, nitems = nprompt + 128;
    for (int item = bidx(); item < nitems; item += gridDim.x) {
        __syncthreads();
        if (item < nprompt) {
            const int c = item >> 2, h = item & 3, t0 = c * GCH;
            for (int idx = tid; idx < GCH * 32; idx += 256) {
                const int q = idx >> 5, v8 = (idx & 31) * 8;
                const uint4 v = *(const uint4*)(QK + (size_t)(t0 + q) * 3072 + 1024 + h * 256 + v8);
                const unsigned short* s = (const unsigned short*)&v;
#pragma unroll
                for (int e = 0; e < 8; ++e) sVt[(v8 + e) * QST + q] = s[e];
            }
            for (int idx = tid; idx < GCH * 16; idx += 256) {
                const int q = idx >> 4, k8 = (idx & 15) * 8;
                float f[8]; unpack8(*(const uint4*)(QK + (size_t)(t0 + q) * 3072 + 512 + h * 128 + k8), f);
                const float* bl = BC + (size_t)(t0 + GCH - 1) * 512 + h * 128 + k8; const float* bq = BC + (size_t)(t0 + q) * 512 + h * 128 + k8;
#pragma unroll
                for (int e = 0; e < 8; ++e) sKt[(k8 + e) * QST + q] = f2bf(f[e] * __expf(bl[e] - bq[e]));
            }
            __syncthreads();
            f32x16 acc[2][4];
#pragma unroll
            for (int i = 0; i < 2; ++i)
#pragma unroll
                for (int kk = 0; kk < 4; ++kk)
#pragma unroll
                    for (int e = 0; e < 16; ++e) acc[i][kk][e] = 0.f;
#pragma unroll
            for (int ks = 0; ks < 4; ++ks) {
                bf16x8 vb[2];
#pragma unroll
                for (int i = 0; i < 2; ++i) vb[i] = ldsfrag(sVt, 64 * wave + 32 * i + l31, QST, ks * 16 + 8 * lh);
#pragma unroll
                for (int kk = 0; kk < 4; ++kk) {
                    const bf16x8 ka = ldsfrag(sKt, 32 * kk + l31, QST, ks * 16 + 8 * lh);
#pragma unroll
                    for (int i = 0; i < 2; ++i) acc[i][kk] = mfma32(ka, vb[i], acc[i][kk]);
                }
            }
#pragma unroll
            for (int i = 0; i < 2; ++i)
#pragma unroll
                for (int kk = 0; kk < 4; ++kk)
#pragma unroll
                    for (int rg = 0; rg < 4; ++rg) {
                        const int v = 64 * wave + 32 * i + l31, k = 32 * kk + 8 * rg + 4 * lh;
                        *(uint2*)(U + (((size_t)c * 4 + h) * 256 + v) * 128 + k) = make_uint2(pack2(acc[i][kk][4 * rg], acc[i][kk][4 * rg + 1]), pack2(acc[i][kk][4 * rg + 2], acc[i][kk][4 * rg + 3]));
                    }
        } else {
            const int sb = (item - nprompt) >> 2, h = (item - nprompt) & 3, v = tid;
            const float* s_in = p.in[4] + ((size_t)sb * 4 + h) * 32768; float* s_out = p.out + O_GLAS + ((size_t)sb * 4 + h) * 32768;
            bf16_t* OG = (bf16_t*)(p.ws + B_R3);
            float* sq = (float*)smem; float* sk = sq + 128; float* sa = sk + 128; float* red = sa + 128;
            float S[128];
#pragma unroll
            for (int k = 0; k < 128; ++k) S[k] = s_in[(size_t)k * 256 + v];
            for (int s = 0; s < 4; ++s) {
                const int tok = TP + sb * 4 + s;
                __syncthreads();
                if (tid < 128) {
                    sq[tid] = bf2f(QK[(size_t)tok * 3072 + h * 128 + tid]) * 0.08838834764831845f;
                    sk[tid] = bf2f(QK[(size_t)tok * 3072 + 512 + h * 128 + tid]);
                    const float bcur = BC[(size_t)tok * 512 + h * 128 + tid], bprev = s ? BC[(size_t)(tok - 1) * 512 + h * 128 + tid] : 0.f;
                    sa[tid] = __expf(bcur - bprev);
                }
                __syncthreads();
                const float vv = bf2f(QK[(size_t)tok * 3072 + 1024 + h * 256 + v]);
                float o = 0.f;
#pragma unroll
                for (int k = 0; k < 128; ++k) { S[k] = sa[k] * S[k] + sk[k] * vv; o += sq[k] * S[k]; }
                red[tid] = o * o;
                __syncthreads();
                for (int st = 128; st > 0; st >>= 1) { if (tid < st) red[tid] += red[tid + st]; __syncthreads(); }
                const float inv = rsqrtf(red[0] * (1.f / 256.f) + EPS);
                const float r = bf2f(QK[(size_t)tok * 3072 + 2048 + h * 256 + v]);
                OG[(size_t)tok * D + h * 256 + v] = f2bf(o * inv * silu_f(r));
            }
#pragma unroll
            for (int k = 0; k < 128; ++k) s_out[(size_t)k * 256 + v] = S[k];
        }
    }
}

__device__ void gla_scan_phase(const Params& p) {
    bf16_t* U = (bf16_t*)(p.ws + B_R6);
    const float* BC = (const float*)(p.ws + B_HB);
    float* outp = p.out + O_GLAP;
    const int gtid = bidx() * blockDim.x + tidx(), gsz = gridDim.x * blockDim.x;
    for (int it = gtid; it < 2 * 4 * 8192; it += gsz) {
        const int b = it >> 15, h = (it >> 13) & 3, v = (it >> 5) & 255, k4 = (it & 31) * 4;
        float s0 = 0.f, s1 = 0.f, s2 = 0.f, s3 = 0.f;
#pragma unroll 8
        for (int cc = 0; cc < SEQ / GCH; ++cc) {
            const int c = b * (SEQ / GCH) + cc;
            uint2* ptr = (uint2*)(U + (((size_t)c * 4 + h) * 256 + v) * 128 + k4);
            float f[4]; unpack4(*ptr, f);
            *ptr = make_uint2(pack2(s0, s1), pack2(s2, s3));
            const float4 bl = *(const float4*)(BC + (size_t)(c * GCH + GCH - 1) * 512 + h * 128 + k4);
            s0 = __expf(bl.x) * s0 + f[0]; s1 = __expf(bl.y) * s1 + f[1]; s2 = __expf(bl.z) * s2 + f[2]; s3 = __expf(bl.w) * s3 + f[3];
        }
        float* o = outp + (((size_t)b * 4 + h) * 128 + k4) * 256 + v;
        o[0] = s0; o[256] = s1; o[512] = s2; o[768] = s3;
    }
}

__device__ void gla_out_phase(const Params& p) {
    const bf16_t* QK = (const bf16_t*)(p.ws + B_R4);
    const float* BC = (const float*)(p.ws + B_HB);
    const bf16_t* U = (const bf16_t*)(p.ws + B_R6);
    bf16_t* OG = (bf16_t*)(p.ws + B_R3);
    const int tid = tidx(), lane = tid & 63, wave = tid >> 6, l31 = lane & 31, lh = lane >> 5;
    bf16_t* sQ = (bf16_t*)smem;
    bf16_t* sK = sQ + 64 * SST;
    bf16_t* sVt = sK + 64 * SST;
    float* sred = (float*)(sVt + 256 * QST);
    const int nitems = (TP / GCH) * 4;
    for (int item = bidx(); item < nitems; item += gridDim.x) {
        const int c = item >> 2, h = item & 3, t0 = c * GCH;
        __syncthreads();
        for (int idx = tid; idx < GCH * 16; idx += 256) {
            const int q = idx >> 4, k8 = (idx & 15) * 8;
            float fq[8], fk[8];
            unpack8(*(const uint4*)(QK + (size_t)(t0 + q) * 3072 + h * 128 + k8), fq);
            unpack8(*(const uint4*)(QK + (size_t)(t0 + q) * 3072 + 512 + h * 128 + k8), fk);
            const float* bq = BC + (size_t)(t0 + q) * 512 + h * 128 + k8;
            unsigned wq[4], wk[4];
#pragma unroll
            for (int e = 0; e < 4; ++e) {
                const float e0 = __expf(bq[2 * e]), e1 = __expf(bq[2 * e + 1]);
                wq[e] = pack2(fq[2 * e] * e0 * 0.08838834764831845f, fq[2 * e + 1] * e1 * 0.08838834764831845f);
                wk[e] = pack2(fk[2 * e] / e0, fk[2 * e + 1] / e1);
            }
            *(uint4*)(sQ + q * SST + k8) = make_uint4(wq[0], wq[1], wq[2], wq[3]);
            *(uint4*)(sK + q * SST + k8) = make_uint4(wk[0], wk[1], wk[2], wk[3]);
        }
        for (int idx = tid; idx < GCH * 32; idx += 256) {
            const int q = idx >> 5, v8 = (idx & 31) * 8;
            const uint4 v = *(const uint4*)(QK + (size_t)(t0 + q) * 3072 + 1024 + h * 256 + v8);
            const unsigned short* s = (const unsigned short*)&v;
#pragma unroll
            for (int e = 0; e < 8; ++e) sVt[(v8 + e) * QST + q] = s[e];
        }
        __syncthreads();
        const int qt = wave & 1, stl = wave >> 1;
        f32x16 at;
#pragma unroll
        for (int e = 0; e < 16; ++e) at[e] = 0.f;
#pragma unroll
        for (int ks = 0; ks < 8; ++ks) at = mfma32(ldsfrag(sK, 32 * stl + l31, SST, ks * 16 + 8 * lh), ldsfrag(sQ, 32 * qt + l31, SST, ks * 16 + 8 * lh), at);
        f32x16 acc[2][2];
#pragma unroll
        for (int i = 0; i < 2; ++i)
#pragma unroll
            for (int jq = 0; jq < 2; ++jq)
#pragma unroll
                for (int e = 0; e < 16; ++e) acc[i][jq][e] = 0.f;
        const bf16_t* Uc = U + ((size_t)c * 4 + h) * 32768;
#pragma unroll
        for (int ks = 0; ks < 8; ++ks) {
            bf16x8 qb[2];
#pragma unroll
            for (int jq = 0; jq < 2; ++jq) qb[jq] = ldsfrag(sQ, 32 * jq + l31, SST, ks * 16 + 8 * lh);
#pragma unroll
            for (int i = 0; i < 2; ++i) {
                const bf16x8 sa = *(const bf16x8*)(Uc + (size_t)(64 * wave + 32 * i + l31) * 128 + ks * 16 + 8 * lh);
#pragma unroll
                for (int jq = 0; jq < 2; ++jq) acc[i][jq] = mfma32(sa, qb[jq], acc[i][jq]);
            }
        }
        __syncthreads();
        bf16_t* sP = sK;
        {
            const int q = 32 * qt + l31;
#pragma unroll
            for (int rg = 0; rg < 4; ++rg) {
                const int s0 = 32 * stl + 8 * rg + 4 * lh;
                float m[4];
#pragma unroll
                for (int e = 0; e < 4; ++e) m[e] = (s0 + e <= q) ? at[4 * rg + e] : 0.f;
                *(uint2*)(sP + q * QST + s0) = make_uint2(pack2(m[0], m[1]), pack2(m[2], m[3]));
            }
        }
        __syncthreads();
#pragma unroll
        for (int ks = 0; ks < 4; ++ks) {
            bf16x8 pb[2];
#pragma unroll
            for (int jq = 0; jq < 2; ++jq) pb[jq] = ldsfrag(sP, 32 * jq + l31, QST, ks * 16 + 8 * lh);
#pragma unroll
            for (int i = 0; i < 2; ++i) {
                const bf16x8 va = ldsfrag(sVt, 64 * wave + 32 * i + l31, QST, ks * 16 + 8 * lh);
#pragma unroll
                for (int jq = 0; jq < 2; ++jq) acc[i][jq] = mfma32(va, pb[jq], acc[i][jq]);
            }
        }
        float ss[2] = {0.f, 0.f};
#pragma unroll
        for (int jq = 0; jq < 2; ++jq)
#pragma unroll
            for (int i = 0; i < 2; ++i)
#pragma unroll
                for (int e = 0; e < 16; ++e) ss[jq] += acc[i][jq][e] * acc[i][jq][e];
#pragma unroll
        for (int jq = 0; jq < 2; ++jq) { ss[jq] += __shfl_xor(ss[jq], 32); if (lh == 0) sred[wave * 64 + 32 * jq + l31] = ss[jq]; }
        __syncthreads();
#pragma unroll
        for (int jq = 0; jq < 2; ++jq) {
            const int q = 32 * jq + l31;
            const float tot = sred[q] + sred[64 + q] + sred[128 + q] + sred[192 + q];
            const float inv = rsqrtf(tot * (1.f / 256.f) + EPS);
            const size_t trow = (size_t)(t0 + q);
#pragma unroll
            for (int i = 0; i < 2; ++i)
#pragma unroll
                for (int rg = 0; rg < 4; ++rg) {
                    const int vc = h * 256 + 64 * wave + 32 * i + 8 * rg + 4 * lh;
                    float rf[4]; unpack4(*(const uint2*)(QK + trow * 3072 + 2048 + vc), rf);
                    float o[4];
#pragma unroll
                    for (int e = 0; e < 4; ++e) o[e] = acc[i][jq][4 * rg + e] * inv * silu_f(rf[e]);
                    *(uint2*)(OG + trow * D + vc) = make_uint2(pack2(o[0], o[1]), pack2(o[2], o[3]));
                }
        }
    }
}

__device__ void att_rope_phase(const Params& p) {
    bf16_t* QKV = (bf16_t*)(p.ws + B_R4);
    const int gtid = bidx() * blockDim.x + tidx(), gsz = gridDim.x * blockDim.x;
    const int Ws[3] = {128, 512, 2048};
    const size_t op[3] = {O_KV0P, O_KV1P, O_KV2P}, os[3] = {O_KV0S, O_KV1S, O_KV2S};
    for (int it = gtid; it < T * 12; it += gsz) {
        const int t = it / 12, hd = it % 12, g = hd >> 2, hg = hd & 3;
        const bool samp = t >= TP;
        const int pos = samp ? SEQ + ((t - TP) & 3) : (t & (SEQ - 1));
        float cs[8], sn[8];
#pragma unroll
        for (int i = 0; i < 8; ++i) { const float fr = powf(500000.f, -(float)i * 0.125f); sincosf((float)pos * fr, &sn[i], &cs[i]); }
        bf16_t* qp = QKV + (size_t)t * QKVD + hd * 64; bf16_t* kp = qp + 768; const bf16_t* vp = qp + 1536;
        float kf[64];
        {
            float f[16];
            unpack8(*(const uint4*)qp, f); unpack8(*(const uint4*)(qp + 8), f + 8);
            unsigned w[8];
#pragma unroll
            for (int i = 0; i < 4; ++i) {
                w[i] = pack2(f[2 * i] * cs[2 * i] - f[2 * i + 8] * sn[2 * i], f[2 * i + 1] * cs[2 * i + 1] - f[2 * i + 9] * sn[2 * i + 1]);
                w[4 + i] = pack2(f[2 * i + 8] * cs[2 * i] + f[2 * i] * sn[2 * i], f[2 * i + 9] * cs[2 * i + 1] + f[2 * i + 1] * sn[2 * i + 1]);
            }
            *(uint4*)qp = make_uint4(w[0], w[1], w[2], w[3]); *(uint4*)(qp + 8) = make_uint4(w[4], w[5], w[6], w[7]);
        }
#pragma unroll
        for (int i = 0; i < 8; ++i) unpack8(*(const uint4*)(kp + 8 * i), kf + 8 * i);
        {
            float r[16];
#pragma unroll
            for (int i = 0; i < 8; ++i) { r[i] = kf[i] * cs[i] - kf[i + 8] * sn[i]; r[i + 8] = kf[i + 8] * cs[i] + kf[i] * sn[i]; }
            unsigned w[8];
#pragma unroll
            for (int i = 0; i < 8; ++i) { w[i] = pack2(r[2 * i], r[2 * i + 1]); kf[2 * i] = bf2f(f2bf(r[2 * i])); kf[2 * i + 1] = bf2f(f2bf(r[2 * i + 1])); }
            *(uint4*)kp = make_uint4(w[0], w[1], w[2], w[3]); *(uint4*)(kp + 8) = make_uint4(w[4], w[5], w[6], w[7]);
        }
        const int W = Ws[g];
        float* dst = nullptr;
        if (!samp) { const int b = t >> 13, tp = t & (SEQ - 1); if (tp >= SEQ - W) dst = p.out + op[g] + (((size_t)b * W + (tp - (SEQ - W))) * 2) * 256 + hg * 64; }
        else { const int sb = (t - TP) >> 2, s = (t - TP) & 3; dst = p.out + os[g] + (((size_t)sb * W + (W - 4 + s)) * 2) * 256 + hg * 64; }
        if (dst) {
#pragma unroll
            for (int i = 0; i < 16; ++i) ((float4*)dst)[i] = make_float4(kf[4 * i], kf[4 * i + 1], kf[4 * i + 2], kf[4 * i + 3]);
#pragma unroll
            for (int i = 0; i < 8; ++i) { float f[8]; unpack8(*(const uint4*)(vp + 8 * i), f); ((float4*)(dst + 256))[2 * i] = make_float4(f[0], f[1], f[2], f[3]); ((float4*)(dst + 256))[2 * i + 1] = make_float4(f[4], f[5], f[6], f[7]); }
        }
    }
}

__device__ void att_phase(const Params& p) {
    const bf16_t* QKV = (const bf16_t*)(p.ws + B_R4);
    bf16_t* AO = (bf16_t*)(p.ws + B_R3);
    const int lane = tidx() & 63, wib = tidx() >> 6;
    const int wv = (bidx() * blockDim.x + tidx()) >> 6, nw = (gridDim.x * blockDim.x) >> 6;
    float* sq = (float*)smem + wib * 256;
    float* sp = sq + 64;
    const int dil[3] = {1, 4, 16}, Ws[3] = {128, 512, 2048};
    for (int it = wv; it < T * 4; it += nw) {
        const int t = it >> 2, hg = it & 3;
        const bool samp = t >= TP;
        const int sb = samp ? (t - TP) >> 2 : 0, s = samp ? (t - TP) & 3 : 0, tp = t & (SEQ - 1);
        float o[3], lse[3];
#pragma unroll
        for (int g = 0; g < 3; ++g) {
            const int hd = g * 4 + hg, d = dil[g], W = Ws[g];
            sq[lane] = bf2f(QKV[(size_t)t * QKVD + hd * 64 + lane]) * 0.125f;
            const float* cache = p.in[5 + g];
            float sc[3];
#pragma unroll
            for (int r = 0; r < 3; ++r) {
                const int jj = r * 64 + lane;
                float v = -INFINITY;
                if (jj <= 128) {
                    if (!samp) {
                        const int kt = tp - jj * d;
                        if (kt >= 0) {
                            const bf16_t* kp = QKV + (size_t)(t - jj * d) * QKVD + 768 + hd * 64;
                            float a = 0.f;
#pragma unroll
                            for (int i = 0; i < 8; ++i) { float f[8]; unpack8(*(const uint4*)(kp + 8 * i), f);
#pragma unroll
                                for (int e = 0; e < 8; ++e) a += f[e] * sq[8 * i + e]; }
                            v = a;
                        }
                    } else {
                        const int idx = W + s - jj * d;
                        float a = 0.f;
                        if (idx >= W) {
                            const bf16_t* kp = QKV + (size_t)(TP + sb * 4 + (idx - W)) * QKVD + 768 + hd * 64;
#pragma unroll
                            for (int i = 0; i < 8; ++i) { float f[8]; unpack8(*(const uint4*)(kp + 8 * i), f);
#pragma unroll
                                for (int e = 0; e < 8; ++e) a += f[e] * sq[8 * i + e]; }
                        } else {
                            const float4* kp = (const float4*)(cache + (((size_t)sb * W + idx) * 2) * 256 + hg * 64);
#pragma unroll
                            for (int i = 0; i < 16; ++i) { const float4 f = kp[i]; a += f.x * sq[4 * i] + f.y * sq[4 * i + 1] + f.z * sq[4 * i + 2] + f.w * sq[4 * i + 3]; }
                        }
                        v = a;
                    }
                }
                sc[r] = v;
            }
            const float mx = wave_max(fmaxf(sc[0], fmaxf(sc[1], sc[2])));
            float ps = 0.f;
#pragma unroll
            for (int r = 0; r < 3; ++r) { const float e = (sc[r] == -INFINITY) ? 0.f : __expf(sc[r] - mx); sp[r * 64 + lane] = e; ps += e; }
            const float den = wave_sum(ps);
            lse[g] = mx + __logf(den);
            float a = 0.f;
            const int nj = samp ? 129 : min(129, tp / d + 1);
            if (!samp) {
                const bf16_t* vp = QKV + (size_t)t * QKVD + 1536 + hd * 64 + lane;
#pragma unroll 4
                for (int jj = 0; jj < nj; ++jj) a += sp[jj] * bf2f(vp[-(ptrdiff_t)jj * d * QKVD]);
            } else {
                for (int jj = 0; jj < nj; ++jj) {
                    const int idx = W + s - jj * d;
                    const float vv = idx >= W ? bf2f(QKV[(size_t)(TP + sb * 4 + (idx - W)) * QKVD + 1536 + hd * 64 + lane]) : cache[(((size_t)sb * W + idx) * 2 + 1) * 256 + hg * 64 + lane];
                    a += sp[jj] * vv;
                }
            }
            o[g] = a / den;
        }
        const float ml = fmaxf(lse[0], fmaxf(lse[1], lse[2]));
        const float e0 = __expf(lse[0] - ml), e1 = __expf(lse[1] - ml), e2 = __expf(lse[2] - ml), rs = 1.f / (e0 + e1 + e2);
        AO[(size_t)t * ATTD + (0 * 4 + hg) * 64 + lane] = f2bf(o[0] * e0 * rs);
        AO[(size_t)t * ATTD + (1 * 4 + hg) * 64 + lane] = f2bf(o[1] * e1 * rs);
        AO[(size_t)t * ATTD + (2 * 4 + hg) * 64 + lane] = f2bf(o[2] * e2 * rs);
    }
}

enum { OP_INIT = 0, OP_NORM, OP_FINAL, OP_SSM_IN, OP_SSM_CONV, OP_SSM_STATE, OP_SSM_SCAN, OP_SSM_OUT, OP_SSM_OG, OP_GLA_IN, OP_GLA_GATE, OP_GLA_STATE, OP_GLA_SCAN,
       OP_GLA_OUT, OP_GLA_OG, OP_ATT_IN, OP_ATT_ROPE, OP_ATT_ATT, OP_ATT_OG, OP_FFN_GU, OP_FFN_DN };
__device__ void run_phase(const Params& p, int ph) {
    const bf16_t* Hb = (const bf16_t*)(p.ws + B_HB);
    int op = p.prog[ph][0]; const int a = p.prog[ph][1];
#ifdef ONLY_OP
    if (op != ONLY_OP) return;
    op = ONLY_OP;
#endif
    switch (op) {
        case OP_INIT: convert_weights(p); copy_caches(p); norm_phase(p, 0); break;
        case OP_NORM: norm_phase(p, 1); break;
        case OP_FINAL: norm_phase(p, 2); break;
        case OP_SSM_IN: gemm_phase<EPI_SSM_IN>(p, Hb, (const bf16_t*)(p.ws + W_SSM_IN) + (size_t)a * SSM_INP * D, D, SSM_INP / 128); break;
        case OP_SSM_CONV: ssm_conv_phase(p, a); break;
        case OP_SSM_STATE: ssm_state_phase(p, a); break;
        case OP_SSM_SCAN: ssm_scan_phase(p, a); break;
        case OP_SSM_OUT: ssm_out_phase(p, a); break;
        case OP_SSM_OG: gemm_phase<EPI_RESADD>(p, (const bf16_t*)(p.ws + B_R4), (const bf16_t*)(p.ws + W_SSM_OUT) + (size_t)a * D * DI, DI, 8); break;
        case OP_GLA_IN: gemm_phase<EPI_GLA_IN>(p, Hb, (const bf16_t*)(p.ws + W_GLA_IN), D, GLA_INP / 128); break;
        case OP_GLA_GATE: gla_gate_phase(p); break;
        case OP_GLA_STATE: gla_state_phase(p); break;
        case OP_GLA_SCAN: gla_scan_phase(p); break;
        case OP_GLA_OUT: gla_out_phase(p); break;
        case OP_GLA_OG: gemm_phase<EPI_RESADD>(p, (const bf16_t*)(p.ws + B_R3), (const bf16_t*)(p.ws + W_GLA_OUT), D, 8); break;
        case OP_ATT_IN: gemm_phase<EPI_ATT_IN>(p, Hb, (const bf16_t*)(p.ws + W_ATT_QKV), D, QKVD / 128); break;
        case OP_ATT_ROPE: att_rope_phase(p); break;
        case OP_ATT_ATT: att_phase(p); break;
        case OP_ATT_OG: gemm_phase<EPI_RESADD>(p, (const bf16_t*)(p.ws + B_R3), (const bf16_t*)(p.ws + W_ATT_OUT), ATTD, 8); break;
        case OP_FFN_GU: gemm_phase<EPI_SWIGLU>(p, Hb, (const bf16_t*)(p.ws + W_FFN_GU) + (size_t)a * 2 * DFF * D, D, 2 * DFF / 128); break;
        case OP_FFN_DN: gemm_phase<EPI_RESADD>(p, (const bf16_t*)(p.ws + B_R4), (const bf16_t*)(p.ws + W_FFN_DN) + (size_t)a * D * DFF, DFF, 8); break;
        default: break;
    }
}

__global__ void __launch_bounds__(256, 2) mega(Params p, int ph_lo, int ph_hi) {
    for (int ph = ph_lo; ph < ph_hi; ++ph) {
        run_phase(p, ph);
        if (ph + 1 < ph_hi) cg::this_grid().sync();
    }
}

static void add_wd(Params& p, int& n, int& tiles, const float* src, const float* gain, bf16_t* dst, int K, int N, int Npad, int mode, int gmod = 0) {
    WDesc& d = p.wd[n++]; d.src = src; d.gain = gain; d.dst = dst; d.K = K; d.N = N; d.Npad = Npad; d.mode = mode; d.tile0 = tiles; d.gmod = gmod ? gmod : K;
    tiles += (Npad / 64) * (K / 64);
}

extern "C" void kernel_launch(void* const* d_in, const int* in_sizes, int n_in, void* d_out, int out_size, void* d_ws, size_t ws_size, hipStream_t stream) {
    if (ws_size < B_END) { fprintf(stderr, "workspace too small: %zu < %zu\n", ws_size, (size_t)B_END); return; }
    Params p; memset(&p, 0, sizeof(p));
    for (int i = 0; i < 29; ++i) p.in[i] = (const float*)d_in[i];
    p.out = (float*)d_out; p.ws = (unsigned char*)d_ws;
    unsigned char* ws = p.ws;
    int n = 0, tiles = 0;
    for (int j = 0; j < 2; ++j) {
        const int layer = j * 3;
        add_wd(p, n, tiles, p.in[13] + (size_t)j * D * SSM_IN, p.in[8] + layer * D, (bf16_t*)(ws + W_SSM_IN) + (size_t)j * SSM_INP * D, D, SSM_IN, SSM_INP, 0);
        add_wd(p, n, tiles, p.in[20] + (size_t)j * DI * D, p.in[19] + j * DI, (bf16_t*)(ws + W_SSM_OUT) + (size_t)j * D * DI, DI, D, D, 0);
    }
    add_wd(p, n, tiles, p.in[21], p.in[8] + 1 * D, (bf16_t*)(ws + W_GLA_IN), D, GLA_IN, GLA_INP, 0);
    add_wd(p, n, tiles, p.in[25], p.in[24], (bf16_t*)(ws + W_GLA_OUT), D, D, D, 0, 256);
    add_wd(p, n, tiles, p.in[26], p.in[8] + 2 * D, (bf16_t*)(ws + W_ATT_QKV), D, QKVD, QKVD, 0);
    add_wd(p, n, tiles, p.in[27], nullptr, (bf16_t*)(ws + W_ATT_OUT), ATTD, D, D, 0);
    for (int l = 0; l < 4; ++l) {
        add_wd(p, n, tiles, p.in[10] + (size_t)l * D * DFF, p.in[9] + l * D, (bf16_t*)(ws + W_FFN_GU) + (size_t)l * 2 * DFF * D, D, DFF, DFF, 1);
        add_wd(p, n, tiles, p.in[11] + (size_t)l * D * DFF, p.in[9] + l * D, (bf16_t*)(ws + W_FFN_GU) + (size_t)l * 2 * DFF * D, D, DFF, DFF, 2);
        add_wd(p, n, tiles, p.in[12] + (size_t)l * DFF * D, nullptr, (bf16_t*)(ws + W_FFN_DN) + (size_t)l * D * DFF, DFF, D, D, 0);
    }
    p.wtiles = tiles;
    {
        int np = 0;
        auto add = [&](int op, int a) { p.prog[np][0] = (unsigned char)op; p.prog[np][1] = (unsigned char)a; ++np; };
        add(OP_INIT, 0);
        for (int l = 0; l < 4; ++l) {
            const int m = l % 3, j = l / 3;
            if (m == 0) { add(OP_SSM_IN, j); add(OP_SSM_CONV, j); add(OP_SSM_STATE, j); add(OP_SSM_SCAN, j); add(OP_SSM_OUT, j); add(OP_SSM_OG, j); }
            else if (m == 1) { add(OP_GLA_IN, 0); add(OP_GLA_GATE, 0); add(OP_GLA_STATE, 0); add(OP_GLA_SCAN, 0); add(OP_GLA_OUT, 0); add(OP_GLA_OG, 0); }
            else { add(OP_ATT_IN, 0); add(OP_ATT_ROPE, 0); add(OP_ATT_ATT, 0); add(OP_ATT_OG, 0); }
            add(OP_NORM, 0); add(OP_FFN_GU, l); add(OP_FFN_DN, l);
            add(l < 3 ? OP_NORM : OP_FINAL, 0);
        }
        p.nphase = np;
    }
    static int grid_blocks = 0;
    if (!grid_blocks) {
        int dev = 0, cus = 0, per_cu = 0;
        hipGetDevice(&dev);
        hipDeviceGetAttribute(&cus, hipDeviceAttributeMultiprocessorCount, dev);
        hipOccupancyMaxActiveBlocksPerMultiprocessor(&per_cu, mega, 256, 0);
        if (per_cu > 2) per_cu = 2;
        if (per_cu < 1) per_cu = 1;
        grid_blocks = cus * per_cu;
    }
#if ONE_LAUNCH
    int lo = 0, hi = p.nphase;
    void* args[] = {&p, &lo, &hi};
    hipError_t e = hipLaunchCooperativeKernel((void*)mega, dim3(grid_blocks), dim3(256), args, 0, stream);
    if (e != hipSuccess) fprintf(stderr, "cooperative launch failed: %s (grid %d)\n", hipGetErrorString(e), grid_blocks);
#else
    for (int ph = 0; ph < p.nphase; ++ph) mega<<<grid_blocks, 256, 0, stream>>>(p, ph, ph + 1);
#endif
}
```

```cpp
#include <hip/hip_runtime.h>
#include <hip/hip_cooperative_groups.h>
#include <cstdio>
#include <cstring>
namespace cg = cooperative_groups;

#ifndef ONE_LAUNCH
#define ONE_LAUNCH 1
#endif

typedef unsigned short bf16_t;
typedef short bf16x8 __attribute__((ext_vector_type(8)));
typedef float f32x16 __attribute__((ext_vector_type(16)));
typedef float f32x4 __attribute__((ext_vector_type(4)));
typedef unsigned u32x4 __attribute__((ext_vector_type(4)));
#define DEVI __device__ __forceinline__

constexpr int D = 1024, TP = 16384, TS = 128, T = TP + TS, SEQ = 8192, DFF = 2816;
constexpr int SSM_IN = 5152, SSM_INP = 5248, DI = 2048, CONVD = 3072;
constexpr int GLA_IN = 3088, GLA_INP = 3200;
constexpr int QKVD = 2304, ATTD = 768;
constexpr float EPS = 1e-6f;

constexpr size_t O_YP = 0, O_YS = O_YP + (size_t)TP * D, O_SSMP = O_YS + (size_t)TS * D, O_SSMS = O_SSMP + 2ull * 2 * 262144,
                 O_CONVP = O_SSMS + 2ull * 32 * 262144, O_CONVS = O_CONVP + 2ull * 2 * 3 * CONVD, O_GLAP = O_CONVS + 2ull * 32 * 3 * CONVD,
                 O_GLAS = O_GLAP + 2ull * 4 * 32768, O_KV0P = O_GLAS + 32ull * 4 * 32768, O_KV0S = O_KV0P + 2ull * 128 * 512,
                 O_KV1P = O_KV0S + 32ull * 128 * 512, O_KV1S = O_KV1P + 2ull * 512 * 512, O_KV2P = O_KV1S + 32ull * 512 * 512,
                 O_KV2S = O_KV2P + 2ull * 2048 * 512, O_END = O_KV2S + 32ull * 2048 * 512;

constexpr size_t al(size_t x) { return (x + 255) & ~(size_t)255; }
constexpr size_t W_SSM_IN = 0, W_SSM_OUT = W_SSM_IN + 2ull * SSM_INP * D * 2, W_GLA_IN = W_SSM_OUT + 2ull * D * DI * 2,
                 W_GLA_OUT = W_GLA_IN + (size_t)GLA_INP * D * 2, W_ATT_QKV = W_GLA_OUT + (size_t)D * D * 2, W_ATT_OUT = W_ATT_QKV + (size_t)QKVD * D * 2,
                 W_FFN_GU = W_ATT_OUT + (size_t)D * ATTD * 2, W_FFN_DN = W_FFN_GU + 4ull * 2 * DFF * D * 2, W_END = W_FFN_DN + 4ull * D * DFF * 2;
constexpr size_t B_HB = al(W_END), B_R3 = B_HB + (size_t)T * D * 2, B_R4 = B_R3 + (size_t)T * DI * 2, B_R5 = B_R4 + (size_t)T * CONVD * 2,
                 B_R6 = B_R5 + (size_t)T * CONVD * 2, B_DT = B_R6 + 67108864ull, B_DTS = B_DT + (size_t)T * 32 * 4, B_ACS = B_DTS + (size_t)T * 32 * 4,
                 B_GLOW = B_ACS + (size_t)T * 32 * 4, B_BAR = al(B_GLOW + (size_t)T * 16 * 4), B_END = B_BAR + 16384;

struct WDesc { const float* src; const float* gain; bf16_t* dst; int K, N, Npad, mode, tile0, gmod, pad; };
constexpr int NWD = 20;
struct Params {
    const float* in[29];
    float* out;
    unsigned char* ws;
    WDesc wd[NWD];
    int wtiles, nphase;
    unsigned char prog[64][2];
};

constexpr int LDS_BYTES = 79872;
__shared__ __attribute__((aligned(16))) unsigned char smem[LDS_BYTES];

DEVI int tidx() { int t = threadIdx.x; asm volatile("" : "+v"(t)); return t; }
DEVI int bidx() { int b = blockIdx.x; asm volatile("" : "+s"(b)); return b; }
DEVI unsigned short f2bf(float f) { unsigned u = __float_as_uint(f); u += 0x7fffu + ((u >> 16) & 1u); return (unsigned short)(u >> 16); }
DEVI float bf2f(unsigned short h) { return __uint_as_float(((unsigned)h) << 16); }
DEVI unsigned pack2(float a, float b) { return (unsigned)f2bf(a) | ((unsigned)f2bf(b) << 16); }
DEVI float silu_f(float x) { return x / (1.f + __expf(-x)); }
DEVI float softplus_f(float x) { return x > 20.f ? x : log1pf(__expf(x)); }
DEVI float logsigmoid_f(float x) { return fminf(x, 0.f) - log1pf(__expf(-fabsf(x))); }
DEVI float wave_sum(float v) { for (int o = 32; o > 0; o >>= 1) v += __shfl_xor(v, o); return v; }
DEVI float wave_max(float v) { for (int o = 32; o > 0; o >>= 1) v = fmaxf(v, __shfl_xor(v, o)); return v; }
DEVI bf16x8 ldsfrag(const bf16_t* base, int row, int stride, int k) { return *(const bf16x8*)(base + row * stride + k); }
DEVI f32x16 mfma32(bf16x8 a, bf16x8 b, f32x16 c) { return __builtin_amdgcn_mfma_f32_32x32x16_bf16(a, b, c, 0, 0, 0); }
DEVI void unpack8(uint4 v, float* f) {
    f[0] = __uint_as_float(v.x << 16); f[1] = __uint_as_float(v.x & 0xffff0000u); f[2] = __uint_as_float(v.y << 16); f[3] = __uint_as_float(v.y & 0xffff0000u);
    f[4] = __uint_as_float(v.z << 16); f[5] = __uint_as_float(v.z & 0xffff0000u); f[6] = __uint_as_float(v.w << 16); f[7] = __uint_as_float(v.w & 0xffff0000u);
}
DEVI void unpack4(uint2 v, float* f) {
    f[0] = __uint_as_float(v.x << 16); f[1] = __uint_as_float(v.x & 0xffff0000u); f[2] = __uint_as_float(v.y << 16); f[3] = __uint_as_float(v.y & 0xffff0000u);
}


#define XB_TMO      128
#define XB_XCNT(j)  (256  + 64 * (j))
#define XB_XSUB(j)  (1280 + 64 * (j))
#define XB_XGEN(j)  (2304 + 64 * (j))
#define XB_TOP      3328
#define XB_TOPGEN   3392
#define XCD_BAR_WORDS 3456
#define XB_SPIN_CAP (1u << 22)
#define LAS __attribute__((address_space(3)))
DEVI unsigned xb_ld(unsigned* p)              { return __hip_atomic_load(p, __ATOMIC_RELAXED, __HIP_MEMORY_SCOPE_AGENT); }
DEVI unsigned xb_add(unsigned* p, unsigned v) { return __hip_atomic_fetch_add(p, v, __ATOMIC_RELAXED, __HIP_MEMORY_SCOPE_AGENT); }
DEVI unsigned xb_xcc_id() { return (unsigned)__builtin_amdgcn_s_getreg((3 << 11) | 20) & 0xFu; }
#define XB_SPIN(cond, bar) do { unsigned _sp = 0; while (cond) { __builtin_amdgcn_s_sleep(1); \
    if ((++_sp & 255u) == 0u) { if (xb_ld(&(bar)[XB_TMO])) break; if (_sp > XB_SPIN_CAP) { atomicAdd(&(bar)[XB_TMO], 1u); break; } } } } while (0)
struct XcdBarrier { unsigned* bar; unsigned x; volatile LAS unsigned* st; };
DEVI XcdBarrier xcd_barrier_post(unsigned* bar, volatile LAS unsigned* st) {
    XcdBarrier b; b.bar = bar; b.x = xb_xcc_id(); b.st = st;
    if (threadIdx.x == 0) (void)xb_add(&bar[XB_XCNT(b.x)], 1u);
    return b;
}
DEVI void xcd_barrier_complete(unsigned* bar, unsigned x, unsigned& nloc, unsigned& nx) {
    const unsigned G = gridDim.x * gridDim.y * gridDim.z;
    unsigned sum, cnt, mine, sp = 0u;
    for (;;) {
        sum = 0u; cnt = 0u; mine = 0u;
#pragma unroll
        for (unsigned j = 0; j < 16; ++j) { const unsigned c = xb_ld(&bar[XB_XCNT(j)]); sum += c; cnt += (c > 0u) ? 1u : 0u; mine = (j == x) ? c : mine; }
        if (sum == G) break;
        __builtin_amdgcn_s_sleep(1);
        if ((++sp & 255u) == 0u) { if (xb_ld(&bar[XB_TMO])) break; if (sp > XB_SPIN_CAP) { atomicAdd(&bar[XB_TMO], 1u); break; } }
    }
    nloc = mine > 0u ? mine : 1u; nx = cnt > 0u ? cnt : 1u;
}
DEVI void xcd_barrier(const XcdBarrier& b) {
    asm volatile("s_waitcnt vmcnt(0)" ::: "memory");
    __syncthreads();
    if (threadIdx.x == 0) {
        unsigned* bar = b.bar;
        __builtin_amdgcn_s_waitcnt(0);
        unsigned nloc = b.st[0], nx = b.st[1];
        if (nloc == 0u) { xcd_barrier_complete(bar, b.x, nloc, nx); b.st[0] = nloc; b.st[1] = nx; }
        const unsigned old = xb_add(&bar[XB_XSUB(b.x)], 1u);
        const unsigned gen = old / nloc;
        if (old + 1u == (gen + 1u) * nloc) {
            __builtin_amdgcn_fence(__ATOMIC_RELEASE, "agent");
            asm volatile("s_waitcnt vmcnt(0)" ::: "memory");
            const unsigned og = xb_add(&bar[XB_TOP], 1u);
            const unsigned tg = og / nx;
            if (og + 1u == (tg + 1u) * nx) xb_add(&bar[XB_TOPGEN], 1u);
            else XB_SPIN(xb_ld(&bar[XB_TOPGEN]) == tg, bar);
            __builtin_amdgcn_fence(__ATOMIC_ACQUIRE, "agent");
            xb_add(&bar[XB_XGEN(b.x)], 1u);
            asm volatile("s_waitcnt vmcnt(0)" ::: "memory");
        } else {
            XB_SPIN(xb_ld(&bar[XB_XGEN(b.x)]) == gen, bar);
            __builtin_amdgcn_fence(__ATOMIC_ACQUIRE, "agent");
            asm volatile("s_waitcnt vmcnt(0)" ::: "memory");
        }
    }
    __syncthreads();
}

__device__ void convert_weights(const Params& p) {
    float* tile = (float*)smem;
    const int tid = tidx();
    for (int it = bidx(); it < p.wtiles; it += gridDim.x) {
        int di = 0;
        for (int i = 1; i < NWD; ++i) if (it >= p.wd[i].tile0) di = i;
        const WDesc& d = p.wd[di];
        const int lt = it - d.tile0, nkt = d.K / 64, ntile = lt / nkt, ktile = lt % nkt;
        const int n0 = ntile * 64, k0 = ktile * 64;
        __syncthreads();
        {
            const int nn = tid & 63, n = n0 + nn;
            for (int kk = tid >> 6; kk < 64; kk += 4) {
                float v = 0.f;
                if (n < d.N) { v = d.src[(size_t)(k0 + kk) * d.N + n]; if (d.gain) v *= d.gain[(k0 + kk) % d.gmod]; }
                tile[kk * 65 + nn] = v;
            }
        }
        __syncthreads();
        {
            const int r = tid >> 2, seg = tid & 3, n = n0 + r;
            int drow = n;
            if (d.mode) { const int t = n >> 6, c = n & 63; drow = t * 128 + (c >> 5) * 64 + (d.mode == 2 ? 32 : 0) + (c & 31); }
            unsigned w[8];
#pragma unroll
            for (int e = 0; e < 8; ++e) w[e] = pack2(tile[(seg * 16 + 2 * e) * 65 + r], tile[(seg * 16 + 2 * e + 1) * 65 + r]);
            uint4* dp = (uint4*)(d.dst + (size_t)drow * d.K + k0 + seg * 16);
            dp[0] = make_uint4(w[0], w[1], w[2], w[3]); dp[1] = make_uint4(w[4], w[5], w[6], w[7]);
        }
    }
}

__device__ void copy_caches(const Params& p) {
    const size_t gtid = (size_t)bidx() * blockDim.x + tidx(), gsz = (size_t)gridDim.x * blockDim.x;
    const int Ws[3] = {128, 512, 2048};
    const size_t oo[3] = {O_KV0S, O_KV1S, O_KV2S};
#pragma unroll
    for (int g = 0; g < 3; ++g) {
        const int W = Ws[g];
        const size_t per = (size_t)(W - 4) * 128, tot = 32 * per;
        const float4* src = (const float4*)p.in[5 + g];
        float4* dst = (float4*)(p.out + oo[g]);
        for (size_t i = gtid; i < tot; i += gsz) {
            const size_t sb = i / per, rem = i % per;
            dst[sb * W * 128 + rem] = src[(sb * W + 4) * 128 + rem];
        }
    }
}

__device__ void norm_phase(const Params& p, int mode) {
    const int lane = tidx() & 63, wv = (bidx() * blockDim.x + tidx()) >> 6, nw = (gridDim.x * blockDim.x) >> 6;
    float* X = p.out;
    bf16_t* Hb = (bf16_t*)(p.ws + B_HB);
    for (int r = wv; r < T; r += nw) {
        const float* src = mode == 0 ? (r < TP ? p.in[0] + (size_t)r * D : p.in[1] + (size_t)(r - TP) * D) : X + (size_t)r * D;
        float4 v[4]; float ss = 0.f;
#pragma unroll
        for (int i = 0; i < 4; ++i) { v[i] = ((const float4*)src)[i * 64 + lane]; ss += v[i].x * v[i].x + v[i].y * v[i].y + v[i].z * v[i].z + v[i].w * v[i].w; }
        ss = wave_sum(ss);
        const float inv = rsqrtf(ss * (1.f / D) + EPS);
        if (mode == 2) {
            const float4* g = (const float4*)p.in[28];
#pragma unroll
            for (int i = 0; i < 4; ++i) { float4 gg = g[i * 64 + lane]; ((float4*)(X + (size_t)r * D))[i * 64 + lane] = make_float4(v[i].x * inv * gg.x, v[i].y * inv * gg.y, v[i].z * inv * gg.z, v[i].w * inv * gg.w); }
        } else {
#pragma unroll
            for (int i = 0; i < 4; ++i) {
                if (mode == 0) ((float4*)(X + (size_t)r * D))[i * 64 + lane] = v[i];
                ((uint2*)(Hb + (size_t)r * D))[i * 64 + lane] = make_uint2(pack2(v[i].x * inv, v[i].y * inv), pack2(v[i].z * inv, v[i].w * inv));
            }
        }
    }
}

enum { EPI_SSM_IN = 0, EPI_GLA_IN = 1, EPI_ATT_IN = 2, EPI_RESADD = 3, EPI_SWIGLU = 4 };
constexpr int GST = 72;

template <int EPI>
__device__ void gemm_phase(const Params& p, const bf16_t* __restrict__ A, const bf16_t* __restrict__ Bt, int K, int nN) {
    const int tid = tidx(), lane = tid & 63, wave = tid >> 6, wm = wave >> 1, wn = wave & 1, l31 = lane & 31, lh = lane >> 5;
    bf16_t* sA = (bf16_t*)smem; bf16_t* sB = sA + 128 * GST;
    const int nM = T / 128, ntiles = nM * nN, nk = K / 64;
    for (int tile = bidx(); tile < ntiles; tile += gridDim.x) {
        const int mt = tile / nN, nt = tile % nN;
        const bf16_t* Ag = A + (size_t)mt * 128 * K; const bf16_t* Bg = Bt + (size_t)nt * 128 * K;
        f32x16 acc[2][2];
#pragma unroll
        for (int i = 0; i < 2; ++i)
#pragma unroll
            for (int j = 0; j < 2; ++j)
#pragma unroll
                for (int e = 0; e < 16; ++e) acc[i][j][e] = 0.f;
        u32x4 ra[4], rb[4];
#pragma unroll
        for (int i = 0; i < 4; ++i) { const int v = tid + 256 * i, row = v >> 3, cv = v & 7; ra[i] = *(const u32x4*)(Ag + (size_t)row * K + cv * 8); rb[i] = *(const u32x4*)(Bg + (size_t)row * K + cv * 8); }
        for (int kt = 0; kt < nk; ++kt) {
            __syncthreads();
#pragma unroll
            for (int i = 0; i < 4; ++i) { const int v = tid + 256 * i, row = v >> 3, cv = v & 7; *(u32x4*)(sA + row * GST + cv * 8) = ra[i]; *(u32x4*)(sB + row * GST + cv * 8) = rb[i]; }
            __syncthreads();
            const int kn = (kt + 1 < nk) ? kt + 1 : kt;
#pragma unroll
            for (int i = 0; i < 4; ++i) { const int v = tid + 256 * i, row = v >> 3, cv = v & 7; ra[i] = *(const u32x4*)(Ag + (size_t)row * K + kn * 64 + cv * 8); rb[i] = *(const u32x4*)(Bg + (size_t)row * K + kn * 64 + cv * 8); }
#pragma unroll
            for (int ks = 0; ks < 4; ++ks) {
                bf16x8 a[2], b[2];
#pragma unroll
                for (int i = 0; i < 2; ++i) { a[i] = ldsfrag(sA, 64 * wm + 32 * i + l31, GST, ks * 16 + 8 * lh); b[i] = ldsfrag(sB, 64 * wn + 32 * i + l31, GST, ks * 16 + 8 * lh); }
#pragma unroll
                for (int i = 0; i < 2; ++i)
#pragma unroll
                    for (int j = 0; j < 2; ++j) acc[i][j] = mfma32(b[j], a[i], acc[i][j]);
            }
        }
#pragma unroll
        for (int i = 0; i < 2; ++i) {
            const int row = mt * 128 + 64 * wm + 32 * i + l31;
            if (EPI == EPI_SWIGLU) {
                bf16_t* H = (bf16_t*)(p.ws + B_R4);
#pragma unroll
                for (int rg = 0; rg < 4; ++rg) {
                    const int hc = nt * 64 + wn * 32 + 8 * rg + 4 * lh;
                    float o[4];
#pragma unroll
                    for (int e = 0; e < 4; ++e) o[e] = silu_f(acc[i][0][4 * rg + e]) * acc[i][1][4 * rg + e];
                    *(uint2*)(H + (size_t)row * DFF + hc) = make_uint2(pack2(o[0], o[1]), pack2(o[2], o[3]));
                }
            } else {
#pragma unroll
                for (int j = 0; j < 2; ++j)
#pragma unroll
                    for (int rg = 0; rg < 4; ++rg) {
                        const int col = nt * 128 + 64 * wn + 32 * j + 8 * rg + 4 * lh;
                        const float v0 = acc[i][j][4 * rg], v1 = acc[i][j][4 * rg + 1], v2 = acc[i][j][4 * rg + 2], v3 = acc[i][j][4 * rg + 3];
                        if (EPI == EPI_RESADD) {
                            float4* xp = (float4*)(p.out + (size_t)row * D + col);
                            float4 x = *xp; x.x += v0; x.y += v1; x.z += v2; x.w += v3; *xp = x;
                        } else if (EPI == EPI_SSM_IN) {
                            const uint2 pk = make_uint2(pack2(v0, v1), pack2(v2, v3));
                            if (col < DI) *(uint2*)((bf16_t*)(p.ws + B_R3) + (size_t)row * DI + col) = pk;
                            else if (col < DI + CONVD) *(uint2*)((bf16_t*)(p.ws + B_R4) + (size_t)row * CONVD + (col - DI)) = pk;
                            else if (col < SSM_IN) *(float4*)((float*)(p.ws + B_DT) + (size_t)row * 32 + (col - DI - CONVD)) = make_float4(v0, v1, v2, v3);
                        } else if (EPI == EPI_GLA_IN) {
                            if (col < 3072) *(uint2*)((bf16_t*)(p.ws + B_R4) + (size_t)row * 3072 + col) = make_uint2(pack2(v0, v1), pack2(v2, v3));
                            else if (col < GLA_IN) *(float4*)((float*)(p.ws + B_GLOW) + (size_t)row * 16 + (col - 3072)) = make_float4(v0, v1, v2, v3);
                        } else {
                            *(uint2*)((bf16_t*)(p.ws + B_R4) + (size_t)row * QKVD + col) = make_uint2(pack2(v0, v1), pack2(v2, v3));
                        }
                    }
            }
        }
    }
}

__device__ void ssm_conv_phase(const Params& p, int j) {
    const bf16_t* raw = (const bf16_t*)(p.ws + B_R4);
    bf16_t* act = (bf16_t*)(p.ws + B_R5);
    const float* cw = p.in[14] + (size_t)j * 4 * CONVD; const float* cb = p.in[15] + (size_t)j * CONVD;
    const float* sbuf = p.in[3] + (size_t)j * 32 * 3 * CONVD;
    float* convp = p.out + O_CONVP + (size_t)j * 2 * 3 * CONVD; float* convs = p.out + O_CONVS + (size_t)j * 32 * 3 * CONVD;
    const size_t gtid = (size_t)bidx() * blockDim.x + tidx(), gsz = (size_t)gridDim.x * blockDim.x;
    const size_t tot = (size_t)T * (CONVD / 8);
    for (size_t it = gtid; it < tot; it += gsz) {
        const int t = (int)(it / (CONVD / 8)), c8 = (int)(it % (CONVD / 8)) * 8;
        int pos, sb = 0; bool samp = t >= TP;
        if (samp) { sb = (t - TP) >> 2; pos = (t - TP) & 3; } else pos = t & (SEQ - 1);
        float accv[8], xr[4][8];
#pragma unroll
        for (int e = 0; e < 8; ++e) accv[e] = cb[c8 + e];
#pragma unroll
        for (int d = 0; d < 4; ++d) {
            if (pos - d >= 0) unpack8(*(const uint4*)(raw + (size_t)(t - d) * CONVD + c8), xr[d]);
            else if (samp) {
                const float* bp = sbuf + ((size_t)sb * 3 + (3 + pos - d)) * CONVD + c8;
#pragma unroll
                for (int e = 0; e < 8; ++e) xr[d][e] = bp[e];
            } else {
#pragma unroll
                for (int e = 0; e < 8; ++e) xr[d][e] = 0.f;
            }
            const float* wp = cw + (size_t)(3 - d) * CONVD + c8;
#pragma unroll
            for (int e = 0; e < 8; ++e) accv[e] += xr[d][e] * wp[e];
        }
        unsigned w[4];
#pragma unroll
        for (int e = 0; e < 4; ++e) w[e] = pack2(silu_f(accv[2 * e]), silu_f(accv[2 * e + 1]));
        *(uint4*)(act + (size_t)t * CONVD + c8) = make_uint4(w[0], w[1], w[2], w[3]);
        if (!samp && pos >= SEQ - 3) {
            float* o = convp + ((size_t)(t >> 13) * 3 + (pos - (SEQ - 3))) * CONVD + c8;
#pragma unroll
            for (int e = 0; e < 8; ++e) o[e] = xr[0][e];
        }
        if (samp && pos >= 1) {
            float* o = convs + ((size_t)sb * 3 + (pos - 1)) * CONVD + c8;
#pragma unroll
            for (int e = 0; e < 8; ++e) o[e] = xr[0][e];
        }
    }
    const float* DT = (const float*)(p.ws + B_DT); float* DTS = (float*)(p.ws + B_DTS); float* ACS = (float*)(p.ws + B_ACS);
    const float* dtb = p.in[16] + j * 32; const float* alog = p.in[17] + j * 32;
    for (size_t it = gtid; it < 128 * 32 + TS * 32; it += gsz) {
        if (it < 128 * 32) {
            const int c = (int)(it >> 5), h = (int)(it & 31);
            const float Ah = -__expf(alog[h]), bh = dtb[h]; float run = 0.f;
            for (int q = 0; q < 128; ++q) { const size_t o = (size_t)(c * 128 + q) * 32 + h; const float d = softplus_f(DT[o] + bh); DTS[o] = d; run += Ah * d; ACS[o] = run; }
        } else {
            const int r = (int)(it - 128 * 32), h = r & 31; const size_t o = (size_t)(TP + (r >> 5)) * 32 + h;
            const float d = softplus_f(DT[o] + dtb[h]); DTS[o] = d; ACS[o] = -__expf(alog[h]) * d;
        }
    }
}

constexpr int SST = 136;
__device__ void ssm_state_phase(const Params& p, int j) {
    const bf16_t* act = (const bf16_t*)(p.ws + B_R5);
    const float* DTS = (const float*)(p.ws + B_DTS); const float* ACS = (const float*)(p.ws + B_ACS);
    bf16_t* ST = (bf16_t*)(p.ws + B_R6);
    const int tid = tidx(), lane = tid & 63, wave = tid >> 6, l31 = lane & 31, lh = lane >> 5;
    bf16_t* sBt = (bf16_t*)smem;
    bf16_t* sXt = sBt + 128 * SST;
    float* sw = (float*)(sXt + 64 * SST);
    const int nprompt = 128 * 4, nitems = nprompt + 32 * 4;
    for (int item = bidx(); item < nitems; item += gridDim.x) {
        if (item < nprompt) {
            const int c = item >> 2, g = item & 3, t0 = c * 128;
            __syncthreads();
            for (int idx = tid; idx < 128 * 16; idx += 256) {
                const int q = idx >> 4, n8 = (idx & 15) * 8;
                const uint4 v = *(const uint4*)(act + (size_t)(t0 + q) * CONVD + DI + g * 128 + n8);
                const unsigned short* s = (const unsigned short*)&v;
#pragma unroll
                for (int e = 0; e < 8; ++e) sBt[(n8 + e) * SST + q] = s[e];
            }
            for (int hh = 0; hh < 8; ++hh) {
                const int h = g * 8 + hh;
                __syncthreads();
                if (tid < 128) sw[tid] = DTS[(size_t)(t0 + tid) * 32 + h] * __expf(ACS[(size_t)(t0 + 127) * 32 + h] - ACS[(size_t)(t0 + tid) * 32 + h]);
                __syncthreads();
                for (int idx = tid; idx < 128 * 8; idx += 256) {
                    const int q = idx >> 3, p8 = (idx & 7) * 8;
                    float f[8]; unpack8(*(const uint4*)(act + (size_t)(t0 + q) * CONVD + h * 64 + p8), f);
                    const float w = sw[q];
#pragma unroll
                    for (int e = 0; e < 8; ++e) sXt[(p8 + e) * SST + q] = f2bf(f[e] * w);
                }
                __syncthreads();
                f32x16 acc[2];
#pragma unroll
                for (int i = 0; i < 2; ++i)
#pragma unroll
                    for (int e = 0; e < 16; ++e) acc[i][e] = 0.f;
#pragma unroll
                for (int ks = 0; ks < 8; ++ks) {
                    const bf16x8 a = ldsfrag(sBt, 32 * wave + l31, SST, ks * 16 + 8 * lh);
#pragma unroll
                    for (int i = 0; i < 2; ++i) acc[i] = mfma32(a, ldsfrag(sXt, 32 * i + l31, SST, ks * 16 + 8 * lh), acc[i]);
                }
#pragma unroll
                for (int i = 0; i < 2; ++i)
#pragma unroll
                    for (int rg = 0; rg < 4; ++rg) {
                        const int n = 32 * wave + 8 * rg + 4 * lh, pp = 32 * i + l31;
                        *(uint2*)(ST + (((size_t)c * 32 + h) * 64 + pp) * 128 + n) = make_uint2(pack2(acc[i][4 * rg], acc[i][4 * rg + 1]), pack2(acc[i][4 * rg + 2], acc[i][4 * rg + 3]));
                    }
            }
        } else {
            const int sb = (item - nprompt) >> 2, g = (item - nprompt) & 3, pp = tid >> 2, nq = tid & 3;
            const float* st_in = p.in[2] + (size_t)j * 32 * 262144; float* st_out = p.out + O_SSMS + (size_t)j * 32 * 262144;
            const bf16_t* Z = (const bf16_t*)(p.ws + B_R3); bf16_t* Y = (bf16_t*)(p.ws + B_R4);
            const float* dsk = p.in[18] + j * 32;
            float* red = (float*)smem;
            float ssq[4] = {0.f, 0.f, 0.f, 0.f};
            __syncthreads();
            for (int hh = 0; hh < 8; ++hh) {
                const int h = g * 8 + hh;
                const size_t sbase = (((size_t)sb * 32 + h) * 64 + pp) * 128;
                float hs[32];
#pragma unroll
                for (int i = 0; i < 8; ++i) { const float4 v = *(const float4*)(st_in + sbase + 4 * nq + 16 * i); hs[4 * i] = v.x; hs[4 * i + 1] = v.y; hs[4 * i + 2] = v.z; hs[4 * i + 3] = v.w; }
                const float Dh = dsk[h];
#pragma unroll
                for (int s = 0; s < 4; ++s) {
                    const int tok = TP + sb * 4 + s;
                    const float dt = DTS[(size_t)tok * 32 + h], dA = __expf(ACS[(size_t)tok * 32 + h]);
                    const float x = bf2f(act[(size_t)tok * CONVD + h * 64 + pp]), xdt = x * dt;
                    float yp = 0.f;
#pragma unroll
                    for (int i = 0; i < 8; ++i) {
                        float bf[4], cf[4];
                        unpack4(*(const uint2*)(act + (size_t)tok * CONVD + DI + g * 128 + 4 * nq + 16 * i), bf);
                        unpack4(*(const uint2*)(act + (size_t)tok * CONVD + DI + 512 + g * 128 + 4 * nq + 16 * i), cf);
#pragma unroll
                        for (int e = 0; e < 4; ++e) { hs[4 * i + e] = dA * hs[4 * i + e] + xdt * bf[e]; yp += hs[4 * i + e] * cf[e]; }
                    }
                    yp += __shfl_xor(yp, 1); yp += __shfl_xor(yp, 2);
                    float y = yp + Dh * x;
                    y *= silu_f(bf2f(Z[(size_t)tok * DI + h * 64 + pp]));
                    if (nq == 0) { ssq[s] += y * y; Y[(size_t)tok * DI + h * 64 + pp] = f2bf(y); }
                }
#pragma unroll
                for (int i = 0; i < 8; ++i) *(float4*)(st_out + sbase + 4 * nq + 16 * i) = make_float4(hs[4 * i], hs[4 * i + 1], hs[4 * i + 2], hs[4 * i + 3]);
            }
#pragma unroll
            for (int s = 0; s < 4; ++s) red[s * 256 + tid] = ssq[s];
            __syncthreads();
            for (int o = 128; o > 0; o >>= 1) {
                if (tid < o) {
#pragma unroll
                    for (int s = 0; s < 4; ++s) red[s * 256 + tid] += red[s * 256 + tid + o];
                }
                __syncthreads();
            }
            if (nq == 0) {
#pragma unroll
                for (int s = 0; s < 4; ++s) {
                    const float inv = rsqrtf(red[s * 256] * (1.f / 512.f) + EPS);
                    const int tok = TP + sb * 4 + s;
                    for (int hh = 0; hh < 8; ++hh) { bf16_t* yp = Y + (size_t)tok * DI + (g * 8 + hh) * 64 + pp; *yp = f2bf(bf2f(*yp) * inv); }
                }
            }
            __syncthreads();
        }
    }
}

__device__ void ssm_scan_phase(const Params& p, int j) {
    bf16_t* ST = (bf16_t*)(p.ws + B_R6);
    const float* ACS = (const float*)(p.ws + B_ACS);
    float* outp = p.out + O_SSMP + (size_t)j * 2 * 262144;
    const int gtid = bidx() * blockDim.x + tidx(), gsz = gridDim.x * blockDim.x;
    for (int it = gtid; it < 2 * 32 * 2048; it += gsz) {
        const int b = it >> 16, h = (it >> 11) & 31, e4 = (it & 2047) * 4;
        float s0 = 0.f, s1 = 0.f, s2 = 0.f, s3 = 0.f;
#pragma unroll 8
        for (int cc = 0; cc < 64; ++cc) {
            const int c = b * 64 + cc;
            uint2* ptr = (uint2*)(ST + ((size_t)c * 32 + h) * 8192 + e4);
            float f[4]; unpack4(*ptr, f);
            *ptr = make_uint2(pack2(s0, s1), pack2(s2, s3));
            const float dec = __expf(ACS[(size_t)(c * 128 + 127) * 32 + h]);
            s0 = dec * s0 + f[0]; s1 = dec * s1 + f[1]; s2 = dec * s2 + f[2]; s3 = dec * s3 + f[3];
        }
        *(float4*)(outp + ((size_t)b * 32 + h) * 8192 + e4) = make_float4(s0, s1, s2, s3);
    }
}

__device__ void ssm_out_phase(const Params& p, int j) {
    const bf16_t* act = (const bf16_t*)(p.ws + B_R5);
    const float* DTS = (const float*)(p.ws + B_DTS); const float* ACS = (const float*)(p.ws + B_ACS);
    const bf16_t* ST = (const bf16_t*)(p.ws + B_R6); const bf16_t* Z = (const bf16_t*)(p.ws + B_R3);
    bf16_t* Y = (bf16_t*)(p.ws + B_R4);
    const float* dsk = p.in[18] + j * 32;
    const int tid = tidx(), lane = tid & 63, wave = tid >> 6, l31 = lane & 31, lh = lane >> 5;
    bf16_t* RA = (bf16_t*)smem;
    bf16_t* RB = RA + 128 * SST;
    float* sacs = (float*)(RB + 128 * SST);
    float* sdts = sacs + 1024;
    for (int item = bidx(); item < 512; item += gridDim.x) {
        const int c = item >> 2, g = item & 3, t0 = c * 128;
        __syncthreads();
        for (int idx = tid; idx < 128 * 16; idx += 256) {
            const int q = idx >> 4, n8 = (idx & 15) * 8;
            *(uint4*)(RB + q * SST + n8) = *(const uint4*)(act + (size_t)(t0 + q) * CONVD + DI + g * 128 + n8);
            *(uint4*)(RA + q * SST + n8) = *(const uint4*)(act + (size_t)(t0 + q) * CONVD + DI + 512 + g * 128 + n8);
        }
        for (int idx = tid; idx < 1024; idx += 256) {
            const int hh = idx >> 7, q = idx & 127;
            sacs[idx] = ACS[(size_t)(t0 + q) * 32 + g * 8 + hh]; sdts[idx] = DTS[(size_t)(t0 + q) * 32 + g * 8 + hh];
        }
        __syncthreads();
        f32x16 X[4]; bf16x8 cf[8];
#pragma unroll
        for (int st = 0; st < 4; ++st)
#pragma unroll
            for (int e = 0; e < 16; ++e) X[st][e] = 0.f;
#pragma unroll
        for (int ks = 0; ks < 8; ++ks) {
            cf[ks] = ldsfrag(RA, 32 * wave + l31, SST, ks * 16 + 8 * lh);
#pragma unroll
            for (int st = 0; st < 4; ++st) X[st] = mfma32(ldsfrag(RB, 32 * st + l31, SST, ks * 16 + 8 * lh), cf[ks], X[st]);
        }
        const int q = 32 * wave + l31;
        float ssq = 0.f;
        for (int hh = 0; hh < 8; ++hh) {
            const int h = g * 8 + hh;
            __syncthreads();
            for (int idx = tid; idx < 128 * 8; idx += 256) {
                const int s = idx >> 3, p8 = (idx & 7) * 8;
                float f[8]; unpack8(*(const uint4*)(act + (size_t)(t0 + s) * CONVD + h * 64 + p8), f);
                const float w = sdts[hh * 128 + s];
#pragma unroll
                for (int e = 0; e < 8; ++e) RA[(p8 + e) * SST + s] = f2bf(f[e] * w);
            }
            for (int idx = tid; idx < 64 * 16; idx += 256) {
                const int pp = idx >> 4, n8 = (idx & 15) * 8;
                *(uint4*)(RA + (64 + pp) * SST + n8) = *(const uint4*)(ST + (((size_t)c * 32 + h) * 64 + pp) * 128 + n8);
            }
            const float aq = sacs[hh * 128 + q];
#pragma unroll
            for (int st = 0; st < 4; ++st)
#pragma unroll
                for (int rg = 0; rg < 4; ++rg) {
                    const int s0 = 32 * st + 8 * rg + 4 * lh;
                    float m[4];
#pragma unroll
                    for (int e = 0; e < 4; ++e) { const int s = s0 + e; m[e] = (s <= q) ? X[st][4 * rg + e] * __expf(aq - sacs[hh * 128 + s]) : 0.f; }
                    *(uint2*)(RB + q * SST + s0) = make_uint2(pack2(m[0], m[1]), pack2(m[2], m[3]));
                }
            __syncthreads();
            f32x16 ad[2], ao[2];
#pragma unroll
            for (int i = 0; i < 2; ++i)
#pragma unroll
                for (int e = 0; e < 16; ++e) { ad[i][e] = 0.f; ao[i][e] = 0.f; }
#pragma unroll
            for (int ks = 0; ks < 8; ++ks) {
                const bf16x8 mb = ldsfrag(RB, q, SST, ks * 16 + 8 * lh);
#pragma unroll
                for (int i = 0; i < 2; ++i) {
                    ad[i] = mfma32(ldsfrag(RA, 32 * i + l31, SST, ks * 16 + 8 * lh), mb, ad[i]);
                    ao[i] = mfma32(ldsfrag(RA, 64 + 32 * i + l31, SST, ks * 16 + 8 * lh), cf[ks], ao[i]);
                }
            }
            const float eq = __expf(aq), Dh = dsk[h];
            const size_t trow = (size_t)(t0 + q);
#pragma unroll
            for (int i = 0; i < 2; ++i)
#pragma unroll
                for (int rg = 0; rg < 4; ++rg) {
                    const int pc = h * 64 + 32 * i + 8 * rg + 4 * lh;
                    float xf[4], zf[4], y[4];
                    unpack4(*(const uint2*)(act + trow * CONVD + pc), xf);
                    unpack4(*(const uint2*)(Z + trow * DI + pc), zf);
#pragma unroll
                    for (int e = 0; e < 4; ++e) { y[e] = (ad[i][4 * rg + e] + eq * ao[i][4 * rg + e] + Dh * xf[e]) * silu_f(zf[e]); ssq += y[e] * y[e]; }
                    *(uint2*)(Y + trow * DI + pc) = make_uint2(pack2(y[0], y[1]), pack2(y[2], y[3]));
                }
        }
        ssq += __shfl_xor(ssq, 32);
        const float inv = rsqrtf(ssq * (1.f / 512.f) + EPS);
        const size_t trow = (size_t)(t0 + q);
        for (int hh = 0; hh < 8; ++hh)
#pragma unroll
            for (int i = 0; i < 2; ++i)
#pragma unroll
                for (int rg = 0; rg < 4; ++rg) {
                    uint2* yp = (uint2*)(Y + trow * DI + (g * 8 + hh) * 64 + 32 * i + 8 * rg + 4 * lh);
                    float f[4]; unpack4(*yp, f);
                    *yp = make_uint2(pack2(f[0] * inv, f[1] * inv), pack2(f[2] * inv, f[3] * inv));
                }
    }
}

constexpr int GCH = 64;
__device__ void gla_gate_phase(const Params& p) {
    const float* GLOW = (const float*)(p.ws + B_GLOW); float* BC = (float*)(p.ws + B_HB);
    const float* wg = p.in[22]; const float* gb = p.in[23];
    const int tid = tidx();
    const int nitems = TP / GCH + 32;
    for (int item = bidx(); item < nitems; item += gridDim.x) {
        int t0, len;
        if (item < TP / GCH) { t0 = item * GCH; len = GCH; } else { t0 = TP + (item - TP / GCH) * 4; len = 4; }
        float w0[16], w1[16];
#pragma unroll
        for (int r = 0; r < 16; ++r) { w0[r] = wg[r * 512 + tid]; w1[r] = wg[r * 512 + 256 + tid]; }
        const float b0 = gb[tid], b1 = gb[256 + tid];
        float r0 = 0.f, r1 = 0.f;
        for (int q = 0; q < len; ++q) {
            const float* gl = GLOW + (size_t)(t0 + q) * 16;
            float a0 = b0, a1 = b1;
#pragma unroll
            for (int r = 0; r < 16; ++r) { const float gv = gl[r]; a0 += gv * w0[r]; a1 += gv * w1[r]; }
            r0 += logsigmoid_f(a0) * (1.f / 16.f); r1 += logsigmoid_f(a1) * (1.f / 16.f);
            BC[(size_t)(t0 + q) * 512 + tid] = r0; BC[(size_t)(t0 + q) * 512 + 256 + tid] = r1;
        }
    }
}

constexpr int QST = 72;
__device__ void gla_state_phase(const Params& p) {
    const bf16_t* QK = (const bf16_t*)(p.ws + B_R4);
    const float* BC = (const float*)(p.ws + B_HB);
    bf16_t* U = (bf16_t*)(p.ws + B_R6);
    const int tid = tidx(), lane = tid & 63, wave = tid >> 6, l31 = lane & 31, lh = lane >> 5;
    bf16_t* sVt = (bf16_t*)smem;
    bf16_t* sKt = sVt + 256 * QST;
    const int nprompt = (TP / GCH) * 4, nitems = nprompt + 128;
    for (int item = bidx(); item < nitems; item += gridDim.x) {
        __syncthreads();
        if (item < nprompt) {
            const int c = item >> 2, h = item & 3, t0 = c * GCH;
            for (int idx = tid; idx < GCH * 32; idx += 256) {
                const int q = idx >> 5, v8 = (idx & 31) * 8;
                const uint4 v = *(const uint4*)(QK + (size_t)(t0 + q) * 3072 + 1024 + h * 256 + v8);
                const unsigned short* s = (const unsigned short*)&v;
#pragma unroll
                for (int e = 0; e < 8; ++e) sVt[(v8 + e) * QST + q] = s[e];
            }
            for (int idx = tid; idx < GCH * 16; idx += 256) {
                const int q = idx >> 4, k8 = (idx & 15) * 8;
                float f[8]; unpack8(*(const uint4*)(QK + (size_t)(t0 + q) * 3072 + 512 + h * 128 + k8), f);
                const float* bl = BC + (size_t)(t0 + GCH - 1) * 512 + h * 128 + k8; const float* bq = BC + (size_t)(t0 + q) * 512 + h * 128 + k8;
#pragma unroll
                for (int e = 0; e < 8; ++e) sKt[(k8 + e) * QST + q] = f2bf(f[e] * __expf(bl[e] - bq[e]));
            }
            __syncthreads();
            f32x16 acc[2][4];
#pragma unroll
            for (int i = 0; i < 2; ++i)
#pragma unroll
                for (int kk = 0; kk < 4; ++kk)
#pragma unroll
                    for (int e = 0; e < 16; ++e) acc[i][kk][e] = 0.f;
#pragma unroll
            for (int ks = 0; ks < 4; ++ks) {
                bf16x8 vb[2];
#pragma unroll
                for (int i = 0; i < 2; ++i) vb[i] = ldsfrag(sVt, 64 * wave + 32 * i + l31, QST, ks * 16 + 8 * lh);
#pragma unroll
                for (int kk = 0; kk < 4; ++kk) {
                    const bf16x8 ka = ldsfrag(sKt, 32 * kk + l31, QST, ks * 16 + 8 * lh);
#pragma unroll
                    for (int i = 0; i < 2; ++i) acc[i][kk] = mfma32(ka, vb[i], acc[i][kk]);
                }
            }
#pragma unroll
            for (int i = 0; i < 2; ++i)
#pragma unroll
                for (int kk = 0; kk < 4; ++kk)
#pragma unroll
                    for (int rg = 0; rg < 4; ++rg) {
                        const int v = 64 * wave + 32 * i + l31, k = 32 * kk + 8 * rg + 4 * lh;
                        *(uint2*)(U + (((size_t)c * 4 + h) * 256 + v) * 128 + k) = make_uint2(pack2(acc[i][kk][4 * rg], acc[i][kk][4 * rg + 1]), pack2(acc[i][kk][4 * rg + 2], acc[i][kk][4 * rg + 3]));
                    }
        } else {
            const int sb = (item - nprompt) >> 2, h = (item - nprompt) & 3, v = tid;
            const float* s_in = p.in[4] + ((size_t)sb * 4 + h) * 32768; float* s_out = p.out + O_GLAS + ((size_t)sb * 4 + h) * 32768;
            bf16_t* OG = (bf16_t*)(p.ws + B_R3);
            float* sq = (float*)smem; float* sk = sq + 128; float* sa = sk + 128; float* red = sa + 128;
            float S[128];
#pragma unroll
            for (int k = 0; k < 128; ++k) S[k] = s_in[(size_t)k * 256 + v];
            for (int s = 0; s < 4; ++s) {
                const int tok = TP + sb * 4 + s;
                __syncthreads();
                if (tid < 128) {
                    sq[tid] = bf2f(QK[(size_t)tok * 3072 + h * 128 + tid]) * 0.08838834764831845f;
                    sk[tid] = bf2f(QK[(size_t)tok * 3072 + 512 + h * 128 + tid]);
                    const float bcur = BC[(size_t)tok * 512 + h * 128 + tid], bprev = s ? BC[(size_t)(tok - 1) * 512 + h * 128 + tid] : 0.f;
                    sa[tid] = __expf(bcur - bprev);
                }
                __syncthreads();
                const float vv = bf2f(QK[(size_t)tok * 3072 + 1024 + h * 256 + v]);
                float o = 0.f;
#pragma unroll
                for (int k = 0; k < 128; ++k) { S[k] = sa[k] * S[k] + sk[k] * vv; o += sq[k] * S[k]; }
                red[tid] = o * o;
                __syncthreads();
                for (int st = 128; st > 0; st >>= 1) { if (tid < st) red[tid] += red[tid + st]; __syncthreads(); }
                const float inv = rsqrtf(red[0] * (1.f / 256.f) + EPS);
                const float r = bf2f(QK[(size_t)tok * 3072 + 2048 + h * 256 + v]);
                OG[(size_t)tok * D + h * 256 + v] = f2bf(o * inv * silu_f(r));
            }
#pragma unroll
            for (int k = 0; k < 128; ++k) s_out[(size_t)k * 256 + v] = S[k];
        }
    }
}

__device__ void gla_scan_phase(const Params& p) {
    bf16_t* U = (bf16_t*)(p.ws + B_R6);
    const float* BC = (const float*)(p.ws + B_HB);
    float* outp = p.out + O_GLAP;
    const int gtid = bidx() * blockDim.x + tidx(), gsz = gridDim.x * blockDim.x;
    for (int it = gtid; it < 2 * 4 * 8192; it += gsz) {
        const int b = it >> 15, h = (it >> 13) & 3, v = (it >> 5) & 255, k4 = (it & 31) * 4;
        float s0 = 0.f, s1 = 0.f, s2 = 0.f, s3 = 0.f;
#pragma unroll 8
        for (int cc = 0; cc < SEQ / GCH; ++cc) {
            const int c = b * (SEQ / GCH) + cc;
            uint2* ptr = (uint2*)(U + (((size_t)c * 4 + h) * 256 + v) * 128 + k4);
            float f[4]; unpack4(*ptr, f);
            *ptr = make_uint2(pack2(s0, s1), pack2(s2, s3));
            const float4 bl = *(const float4*)(BC + (size_t)(c * GCH + GCH - 1) * 512 + h * 128 + k4);
            s0 = __expf(bl.x) * s0 + f[0]; s1 = __expf(bl.y) * s1 + f[1]; s2 = __expf(bl.z) * s2 + f[2]; s3 = __expf(bl.w) * s3 + f[3];
        }
        float* o = outp + (((size_t)b * 4 + h) * 128 + k4) * 256 + v;
        o[0] = s0; o[256] = s1; o[512] = s2; o[768] = s3;
    }
}

__device__ void gla_out_phase(const Params& p) {
    const bf16_t* QK = (const bf16_t*)(p.ws + B_R4);
    const float* BC = (const float*)(p.ws + B_HB);
    const bf16_t* U = (const bf16_t*)(p.ws + B_R6);
    bf16_t* OG = (bf16_t*)(p.ws + B_R3);
    const int tid = tidx(), lane = tid & 63, wave = tid >> 6, l31 = lane & 31, lh = lane >> 5;
    bf16_t* sQ = (bf16_t*)smem;
    bf16_t* sK = sQ + 64 * SST;
    bf16_t* sVt = sK + 64 * SST;
    float* sred = (float*)(sVt + 256 * QST);
    const int nitems = (TP / GCH) * 4;
    for (int item = bidx(); item < nitems; item += gridDim.x) {
        const int c = item >> 2, h = item & 3, t0 = c * GCH;
        __syncthreads();
        for (int idx = tid; idx < GCH * 16; idx += 256) {
            const int q = idx >> 4, k8 = (idx & 15) * 8;
            float fq[8], fk[8];
            unpack8(*(const uint4*)(QK + (size_t)(t0 + q) * 3072 + h * 128 + k8), fq);
            unpack8(*(const uint4*)(QK + (size_t)(t0 + q) * 3072 + 512 + h * 128 + k8), fk);
            const float* bq = BC + (size_t)(t0 + q) * 512 + h * 128 + k8;
            unsigned wq[4], wk[4];
#pragma unroll
            for (int e = 0; e < 4; ++e) {
                const float e0 = __expf(bq[2 * e]), e1 = __expf(bq[2 * e + 1]);
                wq[e] = pack2(fq[2 * e] * e0 * 0.08838834764831845f, fq[2 * e + 1] * e1 * 0.08838834764831845f);
                wk[e] = pack2(fk[2 * e] / e0, fk[2 * e + 1] / e1);
            }
            *(uint4*)(sQ + q * SST + k8) = make_uint4(wq[0], wq[1], wq[2], wq[3]);
            *(uint4*)(sK + q * SST + k8) = make_uint4(wk[0], wk[1], wk[2], wk[3]);
        }
        for (int idx = tid; idx < GCH * 32; idx += 256) {
            const int q = idx >> 5, v8 = (idx & 31) * 8;
            const uint4 v = *(const uint4*)(QK + (size_t)(t0 + q) * 3072 + 1024 + h * 256 + v8);
            const unsigned short* s = (const unsigned short*)&v;
#pragma unroll
            for (int e = 0; e < 8; ++e) sVt[(v8 + e) * QST + q] = s[e];
        }
        __syncthreads();
        const int qt = wave & 1, stl = wave >> 1;
        f32x16 at;
#pragma unroll
        for (int e = 0; e < 16; ++e) at[e] = 0.f;
#pragma unroll
        for (int ks = 0; ks < 8; ++ks) at = mfma32(ldsfrag(sK, 32 * stl + l31, SST, ks * 16 + 8 * lh), ldsfrag(sQ, 32 * qt + l31, SST, ks * 16 + 8 * lh), at);
        f32x16 acc[2][2];
#pragma unroll
        for (int i = 0; i < 2; ++i)
#pragma unroll
            for (int jq = 0; jq < 2; ++jq)
#pragma unroll
                for (int e = 0; e < 16; ++e) acc[i][jq][e] = 0.f;
        const bf16_t* Uc = U + ((size_t)c * 4 + h) * 32768;
#pragma unroll
        for (int ks = 0; ks < 8; ++ks) {
            bf16x8 qb[2];
#pragma unroll
            for (int jq = 0; jq < 2; ++jq) qb[jq] = ldsfrag(sQ, 32 * jq + l31, SST, ks * 16 + 8 * lh);
#pragma unroll
            for (int i = 0; i < 2; ++i) {
                const bf16x8 sa = *(const bf16x8*)(Uc + (size_t)(64 * wave + 32 * i + l31) * 128 + ks * 16 + 8 * lh);
#pragma unroll
                for (int jq = 0; jq < 2; ++jq) acc[i][jq] = mfma32(sa, qb[jq], acc[i][jq]);
            }
        }
        __syncthreads();
        bf16_t* sP = sK;
        {
            const int q = 32 * qt + l31;
#pragma unroll
            for (int rg = 0; rg < 4; ++rg) {
                const int s0 = 32 * stl + 8 * rg + 4 * lh;
                float m[4];
#pragma unroll
                for (int e = 0; e < 4; ++e) m[e] = (s0 + e <= q) ? at[4 * rg + e] : 0.f;
                *(uint2*)(sP + q * QST + s0) = make_uint2(pack2(m[0], m[1]), pack2(m[2], m[3]));
            }
        }
        __syncthreads();
#pragma unroll
        for (int ks = 0; ks < 4; ++ks) {
            bf16x8 pb[2];
#pragma unroll
            for (int jq = 0; jq < 2; ++jq) pb[jq] = ldsfrag(sP, 32 * jq + l31, QST, ks * 16 + 8 * lh);
#pragma unroll
            for (int i = 0; i < 2; ++i) {
                const bf16x8 va = ldsfrag(sVt, 64 * wave + 32 * i + l31, QST, ks * 16 + 8 * lh);
#pragma unroll
                for (int jq = 0; jq < 2; ++jq) acc[i][jq] = mfma32(va, pb[jq], acc[i][jq]);
            }
        }
        float ss[2] = {0.f, 0.f};
#pragma unroll
        for (int jq = 0; jq < 2; ++jq)
#pragma unroll
            for (int i = 0; i < 2; ++i)
#pragma unroll
                for (int e = 0; e < 16; ++e) ss[jq] += acc[i][jq][e] * acc[i][jq][e];
#pragma unroll
        for (int jq = 0; jq < 2; ++jq) { ss[jq] += __shfl_xor(ss[jq], 32); if (lh == 0) sred[wave * 64 + 32 * jq + l31] = ss[jq]; }
        __syncthreads();
#pragma unroll
        for (int jq = 0; jq < 2; ++jq) {
            const int q = 32 * jq + l31;
            const float tot = sred[q] + sred[64 + q] + sred[128 + q] + sred[192 + q];
            const float inv = rsqrtf(tot * (1.f / 256.f) + EPS);
            const size_t trow = (size_t)(t0 + q);
#pragma unroll
            for (int i = 0; i < 2; ++i)
#pragma unroll
                for (int rg = 0; rg < 4; ++rg) {
                    const int vc = h * 256 + 64 * wave + 32 * i + 8 * rg + 4 * lh;
                    float rf[4]; unpack4(*(const uint2*)(QK + trow * 3072 + 2048 + vc), rf);
                    float o[4];
#pragma unroll
                    for (int e = 0; e < 4; ++e) o[e] = acc[i][jq][4 * rg + e] * inv * silu_f(rf[e]);
                    *(uint2*)(OG + trow * D + vc) = make_uint2(pack2(o[0], o[1]), pack2(o[2], o[3]));
                }
        }
    }
}

__device__ void att_rope_phase(const Params& p) {
    bf16_t* QKV = (bf16_t*)(p.ws + B_R4);
    const int gtid = bidx() * blockDim.x + tidx(), gsz = gridDim.x * blockDim.x;
    const int Ws[3] = {128, 512, 2048};
    const size_t op[3] = {O_KV0P, O_KV1P, O_KV2P}, os[3] = {O_KV0S, O_KV1S, O_KV2S};
    for (int it = gtid; it < T * 12; it += gsz) {
        const int t = it / 12, hd = it % 12, g = hd >> 2, hg = hd & 3;
        const bool samp = t >= TP;
        const int pos = samp ? SEQ + ((t - TP) & 3) : (t & (SEQ - 1));
        float cs[8], sn[8];
#pragma unroll
        for (int i = 0; i < 8; ++i) { const float fr = powf(500000.f, -(float)i * 0.125f); sincosf((float)pos * fr, &sn[i], &cs[i]); }
        bf16_t* qp = QKV + (size_t)t * QKVD + hd * 64; bf16_t* kp = qp + 768; const bf16_t* vp = qp + 1536;
        float kf[64];
        {
            float f[16];
            unpack8(*(const uint4*)qp, f); unpack8(*(const uint4*)(qp + 8), f + 8);
            unsigned w[8];
#pragma unroll
            for (int i = 0; i < 4; ++i) {
                w[i] = pack2(f[2 * i] * cs[2 * i] - f[2 * i + 8] * sn[2 * i], f[2 * i + 1] * cs[2 * i + 1] - f[2 * i + 9] * sn[2 * i + 1]);
                w[4 + i] = pack2(f[2 * i + 8] * cs[2 * i] + f[2 * i] * sn[2 * i], f[2 * i + 9] * cs[2 * i + 1] + f[2 * i + 1] * sn[2 * i + 1]);
            }
            *(uint4*)qp = make_uint4(w[0], w[1], w[2], w[3]); *(uint4*)(qp + 8) = make_uint4(w[4], w[5], w[6], w[7]);
        }
#pragma unroll
        for (int i = 0; i < 8; ++i) unpack8(*(const uint4*)(kp + 8 * i), kf + 8 * i);
        {
            float r[16];
#pragma unroll
            for (int i = 0; i < 8; ++i) { r[i] = kf[i] * cs[i] - kf[i + 8] * sn[i]; r[i + 8] = kf[i + 8] * cs[i] + kf[i] * sn[i]; }
            unsigned w[8];
#pragma unroll
            for (int i = 0; i < 8; ++i) { w[i] = pack2(r[2 * i], r[2 * i + 1]); kf[2 * i] = bf2f(f2bf(r[2 * i])); kf[2 * i + 1] = bf2f(f2bf(r[2 * i + 1])); }
            *(uint4*)kp = make_uint4(w[0], w[1], w[2], w[3]); *(uint4*)(kp + 8) = make_uint4(w[4], w[5], w[6], w[7]);
        }
        const int W = Ws[g];
        float* dst = nullptr;
        if (!samp) { const int b = t >> 13, tp = t & (SEQ - 1); if (tp >= SEQ - W) dst = p.out + op[g] + (((size_t)b * W + (tp - (SEQ - W))) * 2) * 256 + hg * 64; }
        else { const int sb = (t - TP) >> 2, s = (t - TP) & 3; dst = p.out + os[g] + (((size_t)sb * W + (W - 4 + s)) * 2) * 256 + hg * 64; }
        if (dst) {
#pragma unroll
            for (int i = 0; i < 16; ++i) ((float4*)dst)[i] = make_float4(kf[4 * i], kf[4 * i + 1], kf[4 * i + 2], kf[4 * i + 3]);
#pragma unroll
            for (int i = 0; i < 8; ++i) { float f[8]; unpack8(*(const uint4*)(vp + 8 * i), f); ((float4*)(dst + 256))[2 * i] = make_float4(f[0], f[1], f[2], f[3]); ((float4*)(dst + 256))[2 * i + 1] = make_float4(f[4], f[5], f[6], f[7]); }
        }
    }
}

__device__ void att_phase(const Params& p) {
    const bf16_t* QKV = (const bf16_t*)(p.ws + B_R4);
    bf16_t* AO = (bf16_t*)(p.ws + B_R3);
    const int lane = tidx() & 63, wib = tidx() >> 6;
    const int wv = (bidx() * blockDim.x + tidx()) >> 6, nw = (gridDim.x * blockDim.x) >> 6;
    float* sq = (float*)smem + wib * 256;
    float* sp = sq + 64;
    const int dil[3] = {1, 4, 16}, Ws[3] = {128, 512, 2048};
    for (int it = TP * 4 + wv; it < T * 4; it += nw) {
        const int t = it >> 2, hg = it & 3;
        const bool samp = t >= TP;
        const int sb = samp ? (t - TP) >> 2 : 0, s = samp ? (t - TP) & 3 : 0, tp = t & (SEQ - 1);
        float o[3], lse[3];
#pragma unroll
        for (int g = 0; g < 3; ++g) {
            const int hd = g * 4 + hg, d = dil[g], W = Ws[g];
            sq[lane] = bf2f(QKV[(size_t)t * QKVD + hd * 64 + lane]) * 0.125f;
            const float* cache = p.in[5 + g];
            float sc[3];
#pragma unroll
            for (int r = 0; r < 3; ++r) {
                const int jj = r * 64 + lane;
                float v = -INFINITY;
                if (jj <= 128) {
                    if (!samp) {
                        const int kt = tp - jj * d;
                        if (kt >= 0) {
                            const bf16_t* kp = QKV + (size_t)(t - jj * d) * QKVD + 768 + hd * 64;
                            float a = 0.f;
#pragma unroll
                            for (int i = 0; i < 8; ++i) { float f[8]; unpack8(*(const uint4*)(kp + 8 * i), f);
#pragma unroll
                                for (int e = 0; e < 8; ++e) a += f[e] * sq[8 * i + e]; }
                            v = a;
                        }
                    } else {
                        const int idx = W + s - jj * d;
                        float a = 0.f;
                        if (idx >= W) {
                            const bf16_t* kp = QKV + (size_t)(TP + sb * 4 + (idx - W)) * QKVD + 768 + hd * 64;
#pragma unroll
                            for (int i = 0; i < 8; ++i) { float f[8]; unpack8(*(const uint4*)(kp + 8 * i), f);
#pragma unroll
                                for (int e = 0; e < 8; ++e) a += f[e] * sq[8 * i + e]; }
                        } else {
                            const float4* kp = (const float4*)(cache + (((size_t)sb * W + idx) * 2) * 256 + hg * 64);
#pragma unroll
                            for (int i = 0; i < 16; ++i) { const float4 f = kp[i]; a += f.x * sq[4 * i] + f.y * sq[4 * i + 1] + f.z * sq[4 * i + 2] + f.w * sq[4 * i + 3]; }
                        }
                        v = a;
                    }
                }
                sc[r] = v;
            }
            const float mx = wave_max(fmaxf(sc[0], fmaxf(sc[1], sc[2])));
            float ps = 0.f;
#pragma unroll
            for (int r = 0; r < 3; ++r) { const float e = (sc[r] == -INFINITY) ? 0.f : __expf(sc[r] - mx); sp[r * 64 + lane] = e; ps += e; }
            const float den = wave_sum(ps);
            lse[g] = mx + __logf(den);
            float a = 0.f;
            const int nj = samp ? 129 : min(129, tp / d + 1);
            if (!samp) {
                const bf16_t* vp = QKV + (size_t)t * QKVD + 1536 + hd * 64 + lane;
#pragma unroll 4
                for (int jj = 0; jj < nj; ++jj) a += sp[jj] * bf2f(vp[-(ptrdiff_t)jj * d * QKVD]);
            } else {
                for (int jj = 0; jj < nj; ++jj) {
                    const int idx = W + s - jj * d;
                    const float vv = idx >= W ? bf2f(QKV[(size_t)(TP + sb * 4 + (idx - W)) * QKVD + 1536 + hd * 64 + lane]) : cache[(((size_t)sb * W + idx) * 2 + 1) * 256 + hg * 64 + lane];
                    a += sp[jj] * vv;
                }
            }
            o[g] = a / den;
        }
        const float ml = fmaxf(lse[0], fmaxf(lse[1], lse[2]));
        const float e0 = __expf(lse[0] - ml), e1 = __expf(lse[1] - ml), e2 = __expf(lse[2] - ml), rs = 1.f / (e0 + e1 + e2);
        AO[(size_t)t * ATTD + (0 * 4 + hg) * 64 + lane] = f2bf(o[0] * e0 * rs);
        AO[(size_t)t * ATTD + (1 * 4 + hg) * 64 + lane] = f2bf(o[1] * e1 * rs);
        AO[(size_t)t * ATTD + (2 * 4 + hg) * 64 + lane] = f2bf(o[2] * e2 * rs);
    }
}


constexpr int VST = 264;
__device__ void att_prompt_phase(const Params& p) {
    const bf16_t* QKV = (const bf16_t*)(p.ws + B_R4);
    bf16_t* AO = (bf16_t*)(p.ws + B_R3);
    float* LSE = (float*)(p.ws + B_DT);
    const int tid = tidx(), lane = tid & 63, wave = tid >> 6, l31 = lane & 31, lh = lane >> 5;
    bf16_t* sK = (bf16_t*)smem;
    bf16_t* sVt = sK + 256 * GST;
    for (int item = bidx(); item < 2 * 12 * 64; item += gridDim.x) {
        const int b = item / 768, hd = (item / 64) % 12, blk = item & 63, g = hd >> 2;
        const int d = (g == 0) ? 1 : (g == 1 ? 4 : 16), nbr = (SEQ / d) / 128, r = blk / nbr, u0 = (blk % nbr) * 128;
        const size_t tb = (size_t)b * SEQ + r;
        __syncthreads();
        for (int idx = tid; idx < 256 * 8; idx += 256) {
            const int kj = idx >> 3, c8 = (idx & 7) * 8, u = u0 - 128 + kj;
            u32x4 kv = {0u, 0u, 0u, 0u}, vv = {0u, 0u, 0u, 0u};
            if (u >= 0) { const bf16_t* src = QKV + (tb + (size_t)u * d) * QKVD + 768 + hd * 64 + c8; kv = *(const u32x4*)src; vv = *(const u32x4*)(src + 768); }
            *(u32x4*)(sK + kj * GST + c8) = kv;
#pragma unroll
            for (int e = 0; e < 4; ++e) { sVt[(c8 + 2 * e) * VST + kj] = (bf16_t)(vv[e] & 0xffffu); sVt[(c8 + 2 * e + 1) * VST + kj] = (bf16_t)(vv[e] >> 16); }
        }
        const int qi = 32 * wave + l31;
        const size_t tq = tb + (size_t)(u0 + qi) * d;
        bf16x8 qf[4];
#pragma unroll
        for (int ks = 0; ks < 4; ++ks) qf[ks] = *(const bf16x8*)(QKV + tq * QKVD + hd * 64 + ks * 16 + 8 * lh);
        __syncthreads();
        f32x16 S[5];
#pragma unroll
        for (int tt = 0; tt < 5; ++tt) {
#pragma unroll
            for (int e = 0; e < 16; ++e) S[tt][e] = 0.f;
#pragma unroll
            for (int ks = 0; ks < 4; ++ks) S[tt] = mfma32(ldsfrag(sK, 32 * (wave + tt) + l31, GST, ks * 16 + 8 * lh), qf[ks], S[tt]);
        }
        float mx = -INFINITY;
#pragma unroll
        for (int tt = 0; tt < 5; ++tt)
#pragma unroll
            for (int e = 0; e < 16; ++e) {
                const int kj = 32 * (wave + tt) + (e & 3) + 8 * (e >> 2) + 4 * lh;
                const bool valid = (kj >= qi) && (kj <= qi + 128) && (u0 - 128 + kj >= 0);
                const float sv = valid ? S[tt][e] * 0.125f : -INFINITY;
                S[tt][e] = sv; mx = fmaxf(mx, sv);
            }
        mx = fmaxf(mx, __shfl_xor(mx, 32));
        float den = 0.f;
#pragma unroll
        for (int tt = 0; tt < 5; ++tt)
#pragma unroll
            for (int e = 0; e < 16; ++e) { const float pe = __expf(S[tt][e] - mx); S[tt][e] = pe; den += pe; }
        den += __shfl_xor(den, 32);
        f32x16 O[2];
#pragma unroll
        for (int i = 0; i < 2; ++i)
#pragma unroll
            for (int e = 0; e < 16; ++e) O[i][e] = 0.f;
#pragma unroll
        for (int tt = 0; tt < 5; ++tt)
#pragma unroll
            for (int s2 = 0; s2 < 2; ++s2) {
                union { bf16x8 v; unsigned u[4]; } pb;
#pragma unroll
                for (int e = 0; e < 4; ++e) pb.u[e] = pack2(S[tt][8 * s2 + 2 * e], S[tt][8 * s2 + 2 * e + 1]);
#pragma unroll
                for (int i = 0; i < 2; ++i) {
                    const bf16_t* vp = sVt + (32 * i + l31) * VST + 32 * (wave + tt) + 16 * s2 + 4 * lh;
                    union { bf16x8 v; uint2 h[2]; } va;
                    va.h[0] = *(const uint2*)vp; va.h[1] = *(const uint2*)(vp + 8);
                    O[i] = mfma32(va.v, pb.v, O[i]);
                }
            }
        const float rden = 1.f / den;
#pragma unroll
        for (int i = 0; i < 2; ++i)
#pragma unroll
            for (int rg = 0; rg < 4; ++rg)
                *(uint2*)(AO + tq * ATTD + hd * 64 + 32 * i + 8 * rg + 4 * lh) = make_uint2(pack2(O[i][4 * rg] * rden, O[i][4 * rg + 1] * rden), pack2(O[i][4 * rg + 2] * rden, O[i][4 * rg + 3] * rden));
        if (lh == 0) LSE[tq * 12 + hd] = mx + __logf(den);
    }
}

__device__ void att_mix_phase(const Params& p) {
    bf16_t* AO = (bf16_t*)(p.ws + B_R3);
    const float* LSE = (const float*)(p.ws + B_DT);
    const int gtid = bidx() * blockDim.x + tidx(), gsz = gridDim.x * blockDim.x;
    for (int it = gtid; it < TP * 32; it += gsz) {
        const int t = it >> 5, hg = (it >> 3) & 3, c8 = (it & 7) * 8;
        const float l0 = LSE[(size_t)t * 12 + hg], l1 = LSE[(size_t)t * 12 + 4 + hg], l2 = LSE[(size_t)t * 12 + 8 + hg];
        const float ml = fmaxf(l0, fmaxf(l1, l2));
        float al[3] = {__expf(l0 - ml), __expf(l1 - ml), __expf(l2 - ml)};
        const float rs = 1.f / (al[0] + al[1] + al[2]);
#pragma unroll
        for (int g = 0; g < 3; ++g) {
            u32x4* ptr = (u32x4*)(AO + (size_t)t * ATTD + (g * 4 + hg) * 64 + c8);
            const u32x4 v = *ptr; const float a = al[g] * rs;
            u32x4 o;
#pragma unroll
            for (int e = 0; e < 4; ++e) o[e] = pack2(__uint_as_float(v[e] << 16) * a, __uint_as_float(v[e] & 0xffff0000u) * a);
            *ptr = o;
        }
    }
}

enum { OP_INIT = 0, OP_NORM, OP_FINAL, OP_SSM_IN, OP_SSM_CONV, OP_SSM_STATE, OP_SSM_SCAN, OP_SSM_OUT, OP_SSM_OG, OP_GLA_IN, OP_GLA_GATE, OP_GLA_STATE, OP_GLA_SCAN,
       OP_GLA_OUT, OP_GLA_OG, OP_ATT_IN, OP_ATT_ROPE, OP_ATT_ATT, OP_ATT_OG, OP_FFN_GU, OP_FFN_DN, OP_ATT_MIX };
__device__ void run_phase(const Params& p, int ph) {
    const bf16_t* Hb = (const bf16_t*)(p.ws + B_HB);
    int op = p.prog[ph][0]; const int a = p.prog[ph][1];
#ifdef ONLY_OP
    if (op != ONLY_OP) return;
    op = ONLY_OP;
#endif
    switch (op) {
        case OP_INIT: convert_weights(p); copy_caches(p); norm_phase(p, 0); break;
        case OP_NORM: norm_phase(p, 1); break;
        case OP_FINAL: norm_phase(p, 2); break;
        case OP_SSM_IN: gemm_phase<EPI_SSM_IN>(p, Hb, (const bf16_t*)(p.ws + W_SSM_IN) + (size_t)a * SSM_INP * D, D, SSM_INP / 128); break;
        case OP_SSM_CONV: ssm_conv_phase(p, a); break;
        case OP_SSM_STATE: ssm_state_phase(p, a); break;
        case OP_SSM_SCAN: ssm_scan_phase(p, a); break;
        case OP_SSM_OUT: ssm_out_phase(p, a); break;
        case OP_SSM_OG: gemm_phase<EPI_RESADD>(p, (const bf16_t*)(p.ws + B_R4), (const bf16_t*)(p.ws + W_SSM_OUT) + (size_t)a * D * DI, DI, 8); break;
        case OP_GLA_IN: gemm_phase<EPI_GLA_IN>(p, Hb, (const bf16_t*)(p.ws + W_GLA_IN), D, GLA_INP / 128); break;
        case OP_GLA_GATE: gla_gate_phase(p); break;
        case OP_GLA_STATE: gla_state_phase(p); break;
        case OP_GLA_SCAN: gla_scan_phase(p); break;
        case OP_GLA_OUT: gla_out_phase(p); break;
        case OP_GLA_OG: gemm_phase<EPI_RESADD>(p, (const bf16_t*)(p.ws + B_R3), (const bf16_t*)(p.ws + W_GLA_OUT), D, 8); break;
        case OP_ATT_IN: gemm_phase<EPI_ATT_IN>(p, Hb, (const bf16_t*)(p.ws + W_ATT_QKV), D, QKVD / 128); break;
        case OP_ATT_ROPE: att_rope_phase(p); break;
        case OP_ATT_ATT: att_prompt_phase(p); __syncthreads(); att_phase(p); break;
        case OP_ATT_MIX: att_mix_phase(p); break;
        case OP_ATT_OG: gemm_phase<EPI_RESADD>(p, (const bf16_t*)(p.ws + B_R3), (const bf16_t*)(p.ws + W_ATT_OUT), ATTD, 8); break;
        case OP_FFN_GU: gemm_phase<EPI_SWIGLU>(p, Hb, (const bf16_t*)(p.ws + W_FFN_GU) + (size_t)a * 2 * DFF * D, D, 2 * DFF / 128); break;
        case OP_FFN_DN: gemm_phase<EPI_RESADD>(p, (const bf16_t*)(p.ws + B_R4), (const bf16_t*)(p.ws + W_FFN_DN) + (size_t)a * D * DFF, DFF, 8); break;
        default: break;
    }
}

#ifndef REPEAT_OP
#define REPEAT_OP -1
#endif
#ifndef REPEAT_N
#define REPEAT_N 1
#endif
__global__ void __launch_bounds__(256, 2) mega(Params p, int ph_lo, int ph_hi, int coop) {
    __shared__ uint4 xb_words;
    if (threadIdx.x == 0) xb_words = make_uint4(0u, 0u, 0u, 0u);
    __syncthreads();
    XcdBarrier xb = xcd_barrier_post((unsigned*)(p.ws + B_BAR), (volatile LAS unsigned*)&xb_words);
    if (coop < 0) cg::this_grid().sync();
    int rep = 0;
    for (int ph = ph_lo; ph < ph_hi;) {
        run_phase(p, ph);
        if (REPEAT_OP >= 0 && p.prog[ph][0] == REPEAT_OP && rep < REPEAT_N) { ++rep; __syncthreads(); continue; }
        rep = 0;
        if (ph + 1 < ph_hi) xcd_barrier(xb);
        ++ph;
    }
}

static void add_wd(Params& p, int& n, int& tiles, const float* src, const float* gain, bf16_t* dst, int K, int N, int Npad, int mode, int gmod = 0) {
    WDesc& d = p.wd[n++]; d.src = src; d.gain = gain; d.dst = dst; d.K = K; d.N = N; d.Npad = Npad; d.mode = mode; d.tile0 = tiles; d.gmod = gmod ? gmod : K;
    tiles += (Npad / 64) * (K / 64);
}

extern "C" void kernel_launch(void* const* d_in, const int* in_sizes, int n_in, void* d_out, int out_size, void* d_ws, size_t ws_size, hipStream_t stream) {
    if (ws_size < B_END) { fprintf(stderr, "workspace too small: %zu < %zu\n", ws_size, (size_t)B_END); return; }
    Params p; memset(&p, 0, sizeof(p));
    for (int i = 0; i < 29; ++i) p.in[i] = (const float*)d_in[i];
    p.out = (float*)d_out; p.ws = (unsigned char*)d_ws;
    unsigned char* ws = p.ws;
    int n = 0, tiles = 0;
    for (int j = 0; j < 2; ++j) {
        const int layer = j * 3;
        add_wd(p, n, tiles, p.in[13] + (size_t)j * D * SSM_IN, p.in[8] + layer * D, (bf16_t*)(ws + W_SSM_IN) + (size_t)j * SSM_INP * D, D, SSM_IN, SSM_INP, 0);
        add_wd(p, n, tiles, p.in[20] + (size_t)j * DI * D, p.in[19] + j * DI, (bf16_t*)(ws + W_SSM_OUT) + (size_t)j * D * DI, DI, D, D, 0);
    }
    add_wd(p, n, tiles, p.in[21], p.in[8] + 1 * D, (bf16_t*)(ws + W_GLA_IN), D, GLA_IN, GLA_INP, 0);
    add_wd(p, n, tiles, p.in[25], p.in[24], (bf16_t*)(ws + W_GLA_OUT), D, D, D, 0, 256);
    add_wd(p, n, tiles, p.in[26], p.in[8] + 2 * D, (bf16_t*)(ws + W_ATT_QKV), D, QKVD, QKVD, 0);
    add_wd(p, n, tiles, p.in[27], nullptr, (bf16_t*)(ws + W_ATT_OUT), ATTD, D, D, 0);
    for (int l = 0; l < 4; ++l) {
        add_wd(p, n, tiles, p.in[10] + (size_t)l * D * DFF, p.in[9] + l * D, (bf16_t*)(ws + W_FFN_GU) + (size_t)l * 2 * DFF * D, D, DFF, DFF, 1);
        add_wd(p, n, tiles, p.in[11] + (size_t)l * D * DFF, p.in[9] + l * D, (bf16_t*)(ws + W_FFN_GU) + (size_t)l * 2 * DFF * D, D, DFF, DFF, 2);
        add_wd(p, n, tiles, p.in[12] + (size_t)l * DFF * D, nullptr, (bf16_t*)(ws + W_FFN_DN) + (size_t)l * D * DFF, DFF, D, D, 0);
    }
    p.wtiles = tiles;
    {
        int np = 0;
        auto add = [&](int op, int a) { p.prog[np][0] = (unsigned char)op; p.prog[np][1] = (unsigned char)a; ++np; };
        add(OP_INIT, 0);
        for (int l = 0; l < 4; ++l) {
            const int m = l % 3, j = l / 3;
            if (m == 0) { add(OP_SSM_IN, j); add(OP_SSM_CONV, j); add(OP_SSM_STATE, j); add(OP_SSM_SCAN, j); add(OP_SSM_OUT, j); add(OP_SSM_OG, j); }
            else if (m == 1) { add(OP_GLA_IN, 0); add(OP_GLA_GATE, 0); add(OP_GLA_STATE, 0); add(OP_GLA_SCAN, 0); add(OP_GLA_OUT, 0); add(OP_GLA_OG, 0); }
            else { add(OP_ATT_IN, 0); add(OP_ATT_ROPE, 0); add(OP_ATT_ATT, 0); add(OP_ATT_MIX, 0); add(OP_ATT_OG, 0); }
            add(OP_NORM, 0); add(OP_FFN_GU, l); add(OP_FFN_DN, l);
            add(l < 3 ? OP_NORM : OP_FINAL, 0);
        }
        p.nphase = np;
    }
    static int grid_blocks = 0;
    if (!grid_blocks) {
        int dev = 0, cus = 0, per_cu = 0;
        hipGetDevice(&dev);
        hipDeviceGetAttribute(&cus, hipDeviceAttributeMultiprocessorCount, dev);
        hipOccupancyMaxActiveBlocksPerMultiprocessor(&per_cu, mega, 256, 0);
        if (per_cu > 2) per_cu = 2;
        if (per_cu < 1) per_cu = 1;
        grid_blocks = cus * per_cu;
    }
#if ONE_LAUNCH
    hipMemsetAsync(p.ws + B_BAR, 0, XCD_BAR_WORDS * 4, stream);
    int lo = 0, hi = p.nphase, coop = 1;
    void* args[] = {&p, &lo, &hi, &coop};
    hipError_t e = hipLaunchCooperativeKernel((void*)mega, dim3(grid_blocks), dim3(256), args, 0, stream);
    if (e != hipSuccess) fprintf(stderr, "cooperative launch failed: %s (grid %d)\n", hipGetErrorString(e), grid_blocks);
#else
    for (int ph = 0; ph < p.nphase; ++ph) mega<<<grid_blocks, 256, 0, stream>>>(p, ph, ph + 1, 0);
#endif
}
```

```cpp
#include <hip/hip_runtime.h>
#include <hip/hip_cooperative_groups.h>
#include <cstdio>
#include <cstring>
namespace cg = cooperative_groups;

#ifndef ONE_LAUNCH
#define ONE_LAUNCH 1
#endif

typedef unsigned short bf16_t;
typedef short bf16x8 __attribute__((ext_vector_type(8)));
typedef float f32x16 __attribute__((ext_vector_type(16)));
typedef float f32x4 __attribute__((ext_vector_type(4)));
typedef unsigned u32x4 __attribute__((ext_vector_type(4)));
#define DEVI __device__ __forceinline__

constexpr int D = 1024, TP = 16384, TS = 128, T = TP + TS, SEQ = 8192, DFF = 2816;
constexpr int SSM_IN = 5152, SSM_INP = 5376, DI = 2048, CONVD = 3072;
constexpr int GLA_IN = 3088, GLA_INP = 3328;
constexpr int QKVD = 2304, ATTD = 768;
constexpr float EPS = 1e-6f;

constexpr size_t O_YP = 0, O_YS = O_YP + (size_t)TP * D, O_SSMP = O_YS + (size_t)TS * D, O_SSMS = O_SSMP + 2ull * 2 * 262144,
                 O_CONVP = O_SSMS + 2ull * 32 * 262144, O_CONVS = O_CONVP + 2ull * 2 * 3 * CONVD, O_GLAP = O_CONVS + 2ull * 32 * 3 * CONVD,
                 O_GLAS = O_GLAP + 2ull * 4 * 32768, O_KV0P = O_GLAS + 32ull * 4 * 32768, O_KV0S = O_KV0P + 2ull * 128 * 512,
                 O_KV1P = O_KV0S + 32ull * 128 * 512, O_KV1S = O_KV1P + 2ull * 512 * 512, O_KV2P = O_KV1S + 32ull * 512 * 512,
                 O_KV2S = O_KV2P + 2ull * 2048 * 512, O_END = O_KV2S + 32ull * 2048 * 512;

constexpr size_t al(size_t x) { return (x + 255) & ~(size_t)255; }
constexpr size_t W_SSM_IN = 0, W_SSM_OUT = W_SSM_IN + 2ull * SSM_INP * D * 2, W_GLA_IN = W_SSM_OUT + 2ull * D * DI * 2,
                 W_GLA_OUT = W_GLA_IN + (size_t)GLA_INP * D * 2, W_ATT_QKV = W_GLA_OUT + (size_t)D * D * 2, W_ATT_OUT = W_ATT_QKV + (size_t)QKVD * D * 2,
                 W_FFN_GU = W_ATT_OUT + (size_t)D * ATTD * 2, W_FFN_DN = W_FFN_GU + 4ull * 2 * DFF * D * 2, W_END = W_FFN_DN + 4ull * D * DFF * 2;
constexpr size_t B_HB = al(W_END), B_R3 = B_HB + (size_t)T * D * 2, B_R4 = B_R3 + (size_t)T * DI * 2, B_R5 = B_R4 + (size_t)T * CONVD * 2,
                 B_R6 = B_R5 + (size_t)T * CONVD * 2, B_DT = B_R6 + 67108864ull, B_DTS = B_DT + (size_t)T * 32 * 4, B_ACS = B_DTS + (size_t)T * 32 * 4,
                 B_GLOW = B_ACS + (size_t)T * 32 * 4, B_BAR = al(B_GLOW + (size_t)T * 16 * 4), B_END = B_BAR + 16384;

struct WDesc { const float* src; const float* gain; bf16_t* dst; int K, N, mode, tile0, gmod; };
struct Params {
    const float* in[29];
    float* out;
    unsigned char* ws;
    int nphase, pad0;
};

constexpr int LDS_BYTES = 79872;
__shared__ __attribute__((aligned(16))) unsigned char smem[2 * LDS_BYTES];

DEVI int rtid() { int t = threadIdx.x; asm volatile("" : "+v"(t)); return t; }
DEVI int rbid() { int b = blockIdx.x; asm volatile("" : "+s"(b)); return b; }
DEVI int vhalf() { return __builtin_amdgcn_readfirstlane(rtid() >> 8); }
DEVI int tidx() { return rtid() & 255; }
DEVI int bidx() { return rbid() * 2 + vhalf(); }
#define VGRID ((int)gridDim.x * 2)
#define VSMEM (smem + vhalf() * LDS_BYTES)
DEVI unsigned short f2bf(float f) { unsigned u = __float_as_uint(f); u += 0x7fffu + ((u >> 16) & 1u); return (unsigned short)(u >> 16); }
DEVI float bf2f(unsigned short h) { return __uint_as_float(((unsigned)h) << 16); }
DEVI unsigned pack2(float a, float b) { return (unsigned)f2bf(a) | ((unsigned)f2bf(b) << 16); }
DEVI float silu_f(float x) { return x / (1.f + __expf(-x)); }
DEVI float softplus_f(float x) { return x > 20.f ? x : log1pf(__expf(x)); }
DEVI float logsigmoid_f(float x) { return fminf(x, 0.f) - log1pf(__expf(-fabsf(x))); }
DEVI float wave_sum(float v) { for (int o = 32; o > 0; o >>= 1) v += __shfl_xor(v, o); return v; }
DEVI float wave_max(float v) { for (int o = 32; o > 0; o >>= 1) v = fmaxf(v, __shfl_xor(v, o)); return v; }
DEVI bf16x8 ldsfrag(const bf16_t* base, int row, int stride, int k) { return *(const bf16x8*)(base + row * stride + k); }
DEVI f32x16 mfma32(bf16x8 a, bf16x8 b, f32x16 c) { return __builtin_amdgcn_mfma_f32_32x32x16_bf16(a, b, c, 0, 0, 0); }
DEVI void unpack8(uint4 v, float* f) {
    f[0] = __uint_as_float(v.x << 16); f[1] = __uint_as_float(v.x & 0xffff0000u); f[2] = __uint_as_float(v.y << 16); f[3] = __uint_as_float(v.y & 0xffff0000u);
    f[4] = __uint_as_float(v.z << 16); f[5] = __uint_as_float(v.z & 0xffff0000u); f[6] = __uint_as_float(v.w << 16); f[7] = __uint_as_float(v.w & 0xffff0000u);
}
DEVI void unpack4(uint2 v, float* f) {
    f[0] = __uint_as_float(v.x << 16); f[1] = __uint_as_float(v.x & 0xffff0000u); f[2] = __uint_as_float(v.y << 16); f[3] = __uint_as_float(v.y & 0xffff0000u);
}


#define XB_TMO      128
#define XB_XCNT(j)  (256  + 64 * (j))
#define XB_XSUB(j)  (1280 + 64 * (j))
#define XB_XGEN(j)  (2304 + 64 * (j))
#define XB_TOP      3328
#define XB_TOPGEN   3392
#define XCD_BAR_WORDS 3456
#define XB_SPIN_CAP (1u << 22)
#define LAS __attribute__((address_space(3)))
DEVI unsigned xb_ld(unsigned* p)              { return __hip_atomic_load(p, __ATOMIC_RELAXED, __HIP_MEMORY_SCOPE_AGENT); }
DEVI unsigned xb_add(unsigned* p, unsigned v) { return __hip_atomic_fetch_add(p, v, __ATOMIC_RELAXED, __HIP_MEMORY_SCOPE_AGENT); }
DEVI unsigned xb_xcc_id() { return (unsigned)__builtin_amdgcn_s_getreg((3 << 11) | 20) & 0xFu; }
#define XB_SPIN(cond, bar) do { unsigned _sp = 0; while (cond) { __builtin_amdgcn_s_sleep(1); \
    if ((++_sp & 255u) == 0u) { if (xb_ld(&(bar)[XB_TMO])) break; if (_sp > XB_SPIN_CAP) { atomicAdd(&(bar)[XB_TMO], 1u); break; } } } } while (0)
struct XcdBarrier { unsigned* bar; unsigned x; volatile LAS unsigned* st; };
DEVI XcdBarrier xcd_barrier_post(unsigned* bar, volatile LAS unsigned* st) {
    XcdBarrier b; b.bar = bar; b.x = xb_xcc_id(); b.st = st;
    if (threadIdx.x == 0) (void)xb_add(&bar[XB_XCNT(b.x)], 1u);
    return b;
}
DEVI void xcd_barrier_complete(unsigned* bar, unsigned x, unsigned& nloc, unsigned& nx) {
    const unsigned G = gridDim.x * gridDim.y * gridDim.z;
    unsigned sum, cnt, mine, sp = 0u;
    for (;;) {
        sum = 0u; cnt = 0u; mine = 0u;
#pragma unroll
        for (unsigned j = 0; j < 16; ++j) { const unsigned c = xb_ld(&bar[XB_XCNT(j)]); sum += c; cnt += (c > 0u) ? 1u : 0u; mine = (j == x) ? c : mine; }
        if (sum == G) break;
        __builtin_amdgcn_s_sleep(1);
        if ((++sp & 255u) == 0u) { if (xb_ld(&bar[XB_TMO])) break; if (sp > XB_SPIN_CAP) { atomicAdd(&bar[XB_TMO], 1u); break; } }
    }
    nloc = mine > 0u ? mine : 1u; nx = cnt > 0u ? cnt : 1u;
}
DEVI void xcd_barrier(const XcdBarrier& b) {
    asm volatile("s_waitcnt vmcnt(0)" ::: "memory");
    __syncthreads();
    if (threadIdx.x == 0) {
        unsigned* bar = b.bar;
        __builtin_amdgcn_s_waitcnt(0);
        unsigned nloc = b.st[0], nx = b.st[1];
        if (nloc == 0u) { xcd_barrier_complete(bar, b.x, nloc, nx); b.st[0] = nloc; b.st[1] = nx; }
        const unsigned old = xb_add(&bar[XB_XSUB(b.x)], 1u);
        const unsigned gen = old / nloc;
        if (old + 1u == (gen + 1u) * nloc) {
            __builtin_amdgcn_fence(__ATOMIC_RELEASE, "agent");
            asm volatile("s_waitcnt vmcnt(0)" ::: "memory");
            const unsigned og = xb_add(&bar[XB_TOP], 1u);
            const unsigned tg = og / nx;
            if (og + 1u == (tg + 1u) * nx) xb_add(&bar[XB_TOPGEN], 1u);
            else XB_SPIN(xb_ld(&bar[XB_TOPGEN]) == tg, bar);
            __builtin_amdgcn_fence(__ATOMIC_ACQUIRE, "agent");
            xb_add(&bar[XB_XGEN(b.x)], 1u);
            asm volatile("s_waitcnt vmcnt(0)" ::: "memory");
        } else {
            XB_SPIN(xb_ld(&bar[XB_XGEN(b.x)]) == gen, bar);
            __builtin_amdgcn_fence(__ATOMIC_ACQUIRE, "agent");
            asm volatile("s_waitcnt vmcnt(0)" ::: "memory");
        }
    }
    __syncthreads();
}

DEVI void convert_weights(const Params& p) {
    int z_; asm volatile("s_mov_b32 %0, 0" : "=s"(z_)); unsigned char* ws_ = p.ws + z_; float* out_ = p.out + z_; (void)ws_; (void)out_;
    float* tile = (float*)VSMEM;
    const int tid = tidx();
    constexpr int T_SI = (SSM_INP / 64) * (D / 64), T_SO = (D / 64) * (DI / 64), T_GI = (GLA_INP / 64) * (D / 64), T_GO = (D / 64) * (D / 64),
                  T_AQ = (QKVD / 64) * (D / 64), T_AO = (D / 64) * (ATTD / 64), T_FF = (DFF / 64) * (D / 64);
    constexpr int P0 = 2 * (T_SI + T_SO), P1 = P0 + T_GI, P2 = P1 + T_GO, P3 = P2 + T_AQ, P4 = P3 + T_AO, WT = P4 + 12 * T_FF;
    for (int it = bidx(); it < WT; it += VGRID) {
        WDesc d; d.gain = nullptr; d.mode = 0; d.gmod = 1 << 30;
        if (it < P0) {
            const int j = it / (T_SI + T_SO), r = it - j * (T_SI + T_SO);
            if (r < T_SI) { d.src = p.in[13] + (size_t)j * D * SSM_IN; d.gain = p.in[8] + j * 3 * D; d.dst = (bf16_t*)(ws_ + W_SSM_IN) + (size_t)j * SSM_INP * D; d.K = D; d.N = SSM_IN; d.tile0 = j * (T_SI + T_SO); }
            else { d.src = p.in[20] + (size_t)j * DI * D; d.gain = p.in[19] + j * DI; d.dst = (bf16_t*)(ws_ + W_SSM_OUT) + (size_t)j * D * DI; d.K = DI; d.N = D; d.tile0 = j * (T_SI + T_SO) + T_SI; }
        } else if (it < P1) { d.src = p.in[21]; d.gain = p.in[8] + D; d.dst = (bf16_t*)(ws_ + W_GLA_IN); d.K = D; d.N = GLA_IN; d.tile0 = P0; }
        else if (it < P2) { d.src = p.in[25]; d.gain = p.in[24]; d.gmod = 256; d.dst = (bf16_t*)(ws_ + W_GLA_OUT); d.K = D; d.N = D; d.tile0 = P1; }
        else if (it < P3) { d.src = p.in[26]; d.gain = p.in[8] + 2 * D; d.dst = (bf16_t*)(ws_ + W_ATT_QKV); d.K = D; d.N = QKVD; d.tile0 = P2; }
        else if (it < P4) { d.src = p.in[27]; d.dst = (bf16_t*)(ws_ + W_ATT_OUT); d.K = ATTD; d.N = D; d.tile0 = P3; }
        else {
            const int q = (it - P4) / T_FF, l = q / 3, w = q - l * 3;
            d.tile0 = P4 + q * T_FF;
            if (w < 2) { d.src = (w == 0 ? p.in[10] : p.in[11]) + (size_t)l * D * DFF; d.gain = p.in[9] + l * D; d.dst = (bf16_t*)(ws_ + W_FFN_GU) + (size_t)l * 2 * DFF * D; d.K = D; d.N = DFF; d.mode = 1 + w; }
            else { d.src = p.in[12] + (size_t)l * DFF * D; d.dst = (bf16_t*)(ws_ + W_FFN_DN) + (size_t)l * D * DFF; d.K = DFF; d.N = D; }
        }
        const int lt = it - d.tile0, nkt = d.K / 64, ntile = lt / nkt, ktile = lt % nkt;
        const int n0 = ntile * 64, k0 = ktile * 64;
        __syncthreads();
        {
            const int nn = tid & 63, n = n0 + nn;
            for (int kk = tid >> 6; kk < 64; kk += 4) {
                float v = 0.f;
                if (n < d.N) { v = d.src[(size_t)(k0 + kk) * d.N + n]; if (d.gain) v *= d.gain[(k0 + kk) & (d.gmod - 1)]; }
                tile[kk * 65 + nn] = v;
            }
        }
        __syncthreads();
        {
            const int r = tid >> 2, seg = tid & 3, n = n0 + r;
            int drow = n;
            if (d.mode) { const int t = n >> 7, c = n & 127; drow = t * 256 + (c >> 5) * 64 + (d.mode == 2 ? 32 : 0) + (c & 31); }
            unsigned w[8];
#pragma unroll
            for (int e = 0; e < 8; ++e) w[e] = pack2(tile[(seg * 16 + 2 * e) * 65 + r], tile[(seg * 16 + 2 * e + 1) * 65 + r]);
            uint4* dp = (uint4*)(d.dst + (size_t)drow * d.K + k0 + seg * 16);
            dp[0] = make_uint4(w[0], w[1], w[2], w[3]); dp[1] = make_uint4(w[4], w[5], w[6], w[7]);
        }
    }
}

DEVI void copy_caches(const Params& p) {
    int z_; asm volatile("s_mov_b32 %0, 0" : "=s"(z_)); unsigned char* ws_ = p.ws + z_; float* out_ = p.out + z_; (void)ws_; (void)out_;
    const size_t gtid = (size_t)bidx() * 256 + tidx(), gsz = (size_t)VGRID * 256;
    const int Ws[3] = {128, 512, 2048};
    const size_t oo[3] = {O_KV0S, O_KV1S, O_KV2S};
#pragma unroll
    for (int g = 0; g < 3; ++g) {
        const int W = Ws[g];
        const size_t per = (size_t)(W - 4) * 128, tot = 32 * per;
        const float4* src = (const float4*)p.in[5 + g];
        float4* dst = (float4*)(out_ + oo[g]);
        for (size_t i = gtid; i < tot; i += gsz) {
            const size_t sb = i / per, rem = i % per;
            dst[sb * W * 128 + rem] = src[(sb * W + 4) * 128 + rem];
        }
    }
}

DEVI void norm_phase(const Params& p, int mode) {
    int z_; asm volatile("s_mov_b32 %0, 0" : "=s"(z_)); unsigned char* ws_ = p.ws + z_; float* out_ = p.out + z_; (void)ws_; (void)out_;
    const int lane = tidx() & 63, wv = (bidx() * 256 + tidx()) >> 6, nw = (VGRID * 256) >> 6;
    float* X = out_;
    bf16_t* Hb = (bf16_t*)(ws_ + B_HB);
    for (int r = wv; r < T; r += nw) {
        const float* src = mode == 0 ? (r < TP ? p.in[0] + (size_t)r * D : p.in[1] + (size_t)(r - TP) * D) : X + (size_t)r * D;
        float4 v[4]; float ss = 0.f;
#pragma unroll
        for (int i = 0; i < 4; ++i) { v[i] = ((const float4*)src)[i * 64 + lane]; ss += v[i].x * v[i].x + v[i].y * v[i].y + v[i].z * v[i].z + v[i].w * v[i].w; }
        ss = wave_sum(ss);
        const float inv = rsqrtf(ss * (1.f / D) + EPS);
        if (mode == 2) {
            const float4* g = (const float4*)p.in[28];
#pragma unroll
            for (int i = 0; i < 4; ++i) { float4 gg = g[i * 64 + lane]; ((float4*)(X + (size_t)r * D))[i * 64 + lane] = make_float4(v[i].x * inv * gg.x, v[i].y * inv * gg.y, v[i].z * inv * gg.z, v[i].w * inv * gg.w); }
        } else {
#pragma unroll
            for (int i = 0; i < 4; ++i) {
                if (mode == 0) ((float4*)(X + (size_t)r * D))[i * 64 + lane] = v[i];
                ((uint2*)(Hb + (size_t)r * D))[i * 64 + lane] = make_uint2(pack2(v[i].x * inv, v[i].y * inv), pack2(v[i].z * inv, v[i].w * inv));
            }
        }
    }
}

enum { EPI_SSM_IN = 0, EPI_GLA_IN = 1, EPI_ATT_IN = 2, EPI_RESADD = 3, EPI_SWIGLU = 4 };
constexpr int GST = 72;
constexpr int GBUF = 2 * 128 * GST;

template <int EPI, int K>
DEVI void gemm_phase(const Params& p, const bf16_t* __restrict__ A, const bf16_t* __restrict__ Bt, int nN) {
    int z_; asm volatile("s_mov_b32 %0, 0" : "=s"(z_)); unsigned char* ws_ = p.ws + z_; float* out_ = p.out + z_; (void)ws_; (void)out_;
    const int tid = rtid(), lane = tid & 63, wave = tid >> 6, wm = wave >> 2, wn = wave & 3, l31 = lane & 31, lh = lane >> 5;
    constexpr int SBUF = 2 * 256 * GST;
    bf16_t* const s0 = (bf16_t*)smem;
    constexpr int nkfull = K / 64, KCH = 4;
    const int nMt = (EPI == EPI_RESADD) ? 64 : 65;
    const int nfull = nMt * nN, nch = (EPI == EPI_RESADD) ? (nkfull + KCH - 1) / KCH : 0, nunits = nfull + nch * nN;
    const int bid = rbid(), xcd = bid & 7, lb = bid >> 3, nper = (int)gridDim.x >> 3;
    for (int rnd = 0; rnd * (int)gridDim.x < nunits; ++rnd) {
        const int u = (rnd * 8 + xcd) * nper + lb;
        if (u >= nunits) continue;
        int mt, nt, kt0, kt1; bool atomic = false;
        if (u < nfull) {
            const int per_group = 8 * nN, gm = u / per_group, rem = u - gm * per_group, fm = gm * 8, gsz = (nMt - fm) < 8 ? (nMt - fm) : 8;
            mt = fm + rem % gsz; nt = rem / gsz; kt0 = 0; kt1 = nkfull;
        } else {
            const int v = u - nfull, ch = v / nN; mt = 64; nt = v - ch * nN; kt0 = ch * KCH; kt1 = (kt0 + KCH < nkfull) ? kt0 + KCH : nkfull; atomic = true;
        }
        const int nk = kt1 - kt0;
        const char* Ab = (const char*)A + (size_t)kt0 * 128; const char* Bb = (const char*)(Bt + (size_t)nt * 256 * K) + (size_t)kt0 * 128;
        unsigned aoff[4];
#pragma unroll
        for (int i = 0; i < 4; ++i) { int gr = mt * 256 + (tid >> 3) + 64 * i; gr = gr < T ? gr : T - 1; aoff[i] = (unsigned)gr * (unsigned)(K * 2) + (unsigned)((tid & 7) * 16); }
        const unsigned boff = (unsigned)(tid >> 3) * (unsigned)(K * 2) + (unsigned)((tid & 7) * 16);
        const unsigned lso = (unsigned)((tid >> 3) * GST + (tid & 7) * 8);
        f32x16 acc[4][2];
#pragma unroll
        for (int i = 0; i < 4; ++i)
#pragma unroll
            for (int j = 0; j < 2; ++j)
#pragma unroll
                for (int e = 0; e < 16; ++e) acc[i][j][e] = 0.f;
        u32x4 ra[4], rb[4];
#define G_LOAD(KT) { const int kk_ = (KT) < nk ? (KT) : nk - 1; const char* ab_ = Ab + (size_t)kk_ * 128; const char* bb_ = Bb + (size_t)kk_ * 128; \
            _Pragma("unroll") for (int i = 0; i < 4; ++i) ra[i] = *(const u32x4*)(ab_ + aoff[i]); \
            _Pragma("unroll") for (int i = 0; i < 4; ++i) rb[i] = *(const u32x4*)(bb_ + (size_t)i * 128 * K + boff); }
#define G_STORE(BUF) { bf16_t* sa_ = s0 + (BUF) * SBUF; bf16_t* sb_ = sa_ + 256 * GST; \
            _Pragma("unroll") for (int i = 0; i < 4; ++i) *(u32x4*)(sa_ + lso + i * 64 * GST) = ra[i]; \
            _Pragma("unroll") for (int i = 0; i < 4; ++i) *(u32x4*)(sb_ + lso + i * 64 * GST) = rb[i]; }
        __syncthreads();
        G_LOAD(0); G_STORE(0); G_LOAD(1);
        __syncthreads();
        for (int kt = 0; kt < nk; ++kt) {
            if (kt + 1 < nk) G_STORE((kt + 1) & 1);
            G_LOAD(kt + 2);
            const bf16_t* cA = s0 + (kt & 1) * SBUF; const bf16_t* cB = cA + 256 * GST;
#pragma unroll
            for (int ks = 0; ks < 4; ++ks) {
                bf16x8 a[4], b[2];
#pragma unroll
                for (int i = 0; i < 4; ++i) a[i] = ldsfrag(cA, 128 * wm + 32 * i + l31, GST, ks * 16 + 8 * lh);
#pragma unroll
                for (int j = 0; j < 2; ++j) b[j] = ldsfrag(cB, 64 * wn + 32 * j + l31, GST, ks * 16 + 8 * lh);
#pragma unroll
                for (int i = 0; i < 4; ++i)
#pragma unroll
                    for (int j = 0; j < 2; ++j) acc[i][j] = mfma32(b[j], a[i], acc[i][j]);
            }
            __syncthreads();
        }
#pragma unroll
        for (int i = 0; i < 4; ++i) {
            const int row = mt * 256 + 128 * wm + 32 * i + l31;
            if (row < T) {
                if (EPI == EPI_SWIGLU) {
                    bf16_t* H = (bf16_t*)(ws_ + B_R4);
#pragma unroll
                    for (int rg = 0; rg < 4; ++rg) {
                        const int hc = nt * 128 + wn * 32 + 8 * rg + 4 * lh;
                        float o[4];
#pragma unroll
                        for (int e = 0; e < 4; ++e) o[e] = silu_f(acc[i][0][4 * rg + e]) * acc[i][1][4 * rg + e];
                        *(uint2*)(H + (size_t)row * DFF + hc) = make_uint2(pack2(o[0], o[1]), pack2(o[2], o[3]));
                    }
                } else {
#pragma unroll
                    for (int j = 0; j < 2; ++j)
#pragma unroll
                        for (int rg = 0; rg < 4; ++rg) {
                            const int col = nt * 256 + 64 * wn + 32 * j + 8 * rg + 4 * lh;
                            const float v0 = acc[i][j][4 * rg], v1 = acc[i][j][4 * rg + 1], v2 = acc[i][j][4 * rg + 2], v3 = acc[i][j][4 * rg + 3];
                            if (EPI == EPI_RESADD) {
                                float* xf = out_ + (size_t)row * D + col;
                                if (atomic) { unsafeAtomicAdd(xf, v0); unsafeAtomicAdd(xf + 1, v1); unsafeAtomicAdd(xf + 2, v2); unsafeAtomicAdd(xf + 3, v3); }
                                else { float4 x = *(float4*)xf; x.x += v0; x.y += v1; x.z += v2; x.w += v3; *(float4*)xf = x; }
                            } else if (EPI == EPI_SSM_IN) {
                                const uint2 pk = make_uint2(pack2(v0, v1), pack2(v2, v3));
                                if (col < DI) *(uint2*)((bf16_t*)(ws_ + B_R3) + (size_t)row * DI + col) = pk;
                                else if (col < DI + CONVD) *(uint2*)((bf16_t*)(ws_ + B_R4) + (size_t)row * CONVD + (col - DI)) = pk;
                                else if (col < SSM_IN) *(float4*)((float*)(ws_ + B_DT) + (size_t)row * 32 + (col - DI - CONVD)) = make_float4(v0, v1, v2, v3);
                            } else if (EPI == EPI_GLA_IN) {
                                if (col < 3072) *(uint2*)((bf16_t*)(ws_ + B_R4) + (size_t)row * 3072 + col) = make_uint2(pack2(v0, v1), pack2(v2, v3));
                                else if (col < GLA_IN) *(float4*)((float*)(ws_ + B_GLOW) + (size_t)row * 16 + (col - 3072)) = make_float4(v0, v1, v2, v3);
                            } else {
                                *(uint2*)((bf16_t*)(ws_ + B_R4) + (size_t)row * QKVD + col) = make_uint2(pack2(v0, v1), pack2(v2, v3));
                            }
                        }
                }
            }
        }
    }
    __syncthreads();
}

DEVI void ssm_conv_phase(const Params& p, int j) {
    int z_; asm volatile("s_mov_b32 %0, 0" : "=s"(z_)); unsigned char* ws_ = p.ws + z_; float* out_ = p.out + z_; (void)ws_; (void)out_;
    const bf16_t* raw = (const bf16_t*)(ws_ + B_R4);
    bf16_t* act = (bf16_t*)(ws_ + B_R5);
    const float* cw = p.in[14] + (size_t)j * 4 * CONVD; const float* cb = p.in[15] + (size_t)j * CONVD;
    const float* sbuf = p.in[3] + (size_t)j * 32 * 3 * CONVD;
    float* convp = out_ + O_CONVP + (size_t)j * 2 * 3 * CONVD; float* convs = out_ + O_CONVS + (size_t)j * 32 * 3 * CONVD;
    const size_t gtid = (size_t)bidx() * 256 + tidx(), gsz = (size_t)VGRID * 256;
    const size_t tot = (size_t)T * (CONVD / 8);
    for (size_t it = gtid; it < tot; it += gsz) {
        const int t = (int)(it / (CONVD / 8)), c8 = (int)(it % (CONVD / 8)) * 8;
        int pos, sb = 0; bool samp = t >= TP;
        if (samp) { sb = (t - TP) >> 2; pos = (t - TP) & 3; } else pos = t & (SEQ - 1);
        float accv[8], xr[4][8];
#pragma unroll
        for (int e = 0; e < 8; ++e) accv[e] = cb[c8 + e];
#pragma unroll
        for (int d = 0; d < 4; ++d) {
            if (pos - d >= 0) unpack8(*(const uint4*)(raw + (size_t)(t - d) * CONVD + c8), xr[d]);
            else if (samp) {
                const float* bp = sbuf + ((size_t)sb * 3 + (3 + pos - d)) * CONVD + c8;
#pragma unroll
                for (int e = 0; e < 8; ++e) xr[d][e] = bp[e];
            } else {
#pragma unroll
                for (int e = 0; e < 8; ++e) xr[d][e] = 0.f;
            }
            const float* wp = cw + (size_t)(3 - d) * CONVD + c8;
#pragma unroll
            for (int e = 0; e < 8; ++e) accv[e] += xr[d][e] * wp[e];
        }
        unsigned w[4];
#pragma unroll
        for (int e = 0; e < 4; ++e) w[e] = pack2(silu_f(accv[2 * e]), silu_f(accv[2 * e + 1]));
        *(uint4*)(act + (size_t)t * CONVD + c8) = make_uint4(w[0], w[1], w[2], w[3]);
        if (!samp && pos >= SEQ - 3) {
            float* o = convp + ((size_t)(t >> 13) * 3 + (pos - (SEQ - 3))) * CONVD + c8;
#pragma unroll
            for (int e = 0; e < 8; ++e) o[e] = xr[0][e];
        }
        if (samp && pos >= 1) {
            float* o = convs + ((size_t)sb * 3 + (pos - 1)) * CONVD + c8;
#pragma unroll
            for (int e = 0; e < 8; ++e) o[e] = xr[0][e];
        }
    }
    const float* DT = (const float*)(ws_ + B_DT); float* DTS = (float*)(ws_ + B_DTS); float* ACS = (float*)(ws_ + B_ACS);
    const float* dtb = p.in[16] + j * 32; const float* alog = p.in[17] + j * 32;
    {
        const int lane = tidx() & 63, wv = (bidx() * 256 + tidx()) >> 6, nw = VGRID * 4;
        for (int it = wv; it < 128 * 32; it += nw) {
            const int c = it >> 5, h = it & 31;
            const float Ah = -__expf(alog[h]), bh = dtb[h];
            float carry = 0.f;
#pragma unroll
            for (int ps = 0; ps < 2; ++ps) {
                const size_t o = (size_t)(c * 128 + ps * 64 + lane) * 32 + h;
                const float d = softplus_f(DT[o] + bh); DTS[o] = d;
                float a = Ah * d;
#pragma unroll
                for (int off = 1; off < 64; off <<= 1) { const float t = __shfl_up(a, off); if (lane >= off) a += t; }
                a += carry; ACS[o] = a; carry = __shfl(a, 63);
            }
        }
    }
    for (size_t it = gtid; it < TS * 32; it += gsz) {
        const int r = (int)it, h = r & 31; const size_t o = (size_t)(TP + (r >> 5)) * 32 + h;
        const float d = softplus_f(DT[o] + dtb[h]); DTS[o] = d; ACS[o] = -__expf(alog[h]) * d;
    }
}

constexpr int SST = 136;
DEVI void ssm_state_phase(const Params& p, int j) {
    int z_; asm volatile("s_mov_b32 %0, 0" : "=s"(z_)); unsigned char* ws_ = p.ws + z_; float* out_ = p.out + z_; (void)ws_; (void)out_;
    const bf16_t* act = (const bf16_t*)(ws_ + B_R5);
    const float* DTS = (const float*)(ws_ + B_DTS); const float* ACS = (const float*)(ws_ + B_ACS);
    bf16_t* ST = (bf16_t*)(ws_ + B_R6);
    const int tid = tidx(), lane = tid & 63, wave = tid >> 6, l31 = lane & 31, lh = lane >> 5;
    bf16_t* sBt = (bf16_t*)VSMEM;
    bf16_t* sXt = sBt + 128 * SST;
    float* sw = (float*)(sXt + 64 * SST);
    const int nprompt = 128 * 4, nitems = nprompt + 32 * 4;
    for (int item = bidx(); item < nitems; item += VGRID) {
        if (item < nprompt) {
            const int c = item >> 2, g = item & 3, t0 = c * 128;
            __syncthreads();
            for (int idx = tid; idx < 128 * 16; idx += 256) {
                const int q = idx >> 4, n8 = (idx & 15) * 8;
                const uint4 v = *(const uint4*)(act + (size_t)(t0 + q) * CONVD + DI + g * 128 + n8);
                const unsigned short* s = (const unsigned short*)&v;
#pragma unroll
                for (int e = 0; e < 8; ++e) sBt[(n8 + e) * SST + q] = s[e];
            }
            for (int hh = 0; hh < 8; ++hh) {
                const int h = g * 8 + hh;
                __syncthreads();
                if (tid < 128) sw[tid] = DTS[(size_t)(t0 + tid) * 32 + h] * __expf(ACS[(size_t)(t0 + 127) * 32 + h] - ACS[(size_t)(t0 + tid) * 32 + h]);
                __syncthreads();
                for (int idx = tid; idx < 128 * 8; idx += 256) {
                    const int q = idx >> 3, p8 = (idx & 7) * 8;
                    float f[8]; unpack8(*(const uint4*)(act + (size_t)(t0 + q) * CONVD + h * 64 + p8), f);
                    const float w = sw[q];
#pragma unroll
                    for (int e = 0; e < 8; ++e) sXt[(p8 + e) * SST + q] = f2bf(f[e] * w);
                }
                __syncthreads();
                f32x16 acc[2];
#pragma unroll
                for (int i = 0; i < 2; ++i)
#pragma unroll
                    for (int e = 0; e < 16; ++e) acc[i][e] = 0.f;
#pragma unroll
                for (int ks = 0; ks < 8; ++ks) {
                    const bf16x8 a = ldsfrag(sBt, 32 * wave + l31, SST, ks * 16 + 8 * lh);
#pragma unroll
                    for (int i = 0; i < 2; ++i) acc[i] = mfma32(a, ldsfrag(sXt, 32 * i + l31, SST, ks * 16 + 8 * lh), acc[i]);
                }
#pragma unroll
                for (int i = 0; i < 2; ++i)
#pragma unroll
                    for (int rg = 0; rg < 4; ++rg) {
                        const int n = 32 * wave + 8 * rg + 4 * lh, pp = 32 * i + l31;
                        *(uint2*)(ST + (((size_t)c * 32 + h) * 64 + pp) * 128 + n) = make_uint2(pack2(acc[i][4 * rg], acc[i][4 * rg + 1]), pack2(acc[i][4 * rg + 2], acc[i][4 * rg + 3]));
                    }
            }
        } else {
            const int sb = (item - nprompt) >> 2, g = (item - nprompt) & 3, pp = tid >> 2, nq = tid & 3;
            const float* st_in = p.in[2] + (size_t)j * 32 * 262144; float* st_out = out_ + O_SSMS + (size_t)j * 32 * 262144;
            const bf16_t* Z = (const bf16_t*)(ws_ + B_R3); bf16_t* Y = (bf16_t*)(ws_ + B_R4);
            const float* dsk = p.in[18] + j * 32;
            float* red = (float*)VSMEM;
            float ssq[4] = {0.f, 0.f, 0.f, 0.f};
            __syncthreads();
            for (int hh = 0; hh < 8; ++hh) {
                const int h = g * 8 + hh;
                const size_t sbase = (((size_t)sb * 32 + h) * 64 + pp) * 128;
                float hs[32];
#pragma unroll
                for (int i = 0; i < 8; ++i) { const float4 v = *(const float4*)(st_in + sbase + 4 * nq + 16 * i); hs[4 * i] = v.x; hs[4 * i + 1] = v.y; hs[4 * i + 2] = v.z; hs[4 * i + 3] = v.w; }
                const float Dh = dsk[h];
#pragma unroll
                for (int s = 0; s < 4; ++s) {
                    const int tok = TP + sb * 4 + s;
                    const float dt = DTS[(size_t)tok * 32 + h], dA = __expf(ACS[(size_t)tok * 32 + h]);
                    const float x = bf2f(act[(size_t)tok * CONVD + h * 64 + pp]), xdt = x * dt;
                    float yp = 0.f;
#pragma unroll
                    for (int i = 0; i < 8; ++i) {
                        float bf[4], cf[4];
                        unpack4(*(const uint2*)(act + (size_t)tok * CONVD + DI + g * 128 + 4 * nq + 16 * i), bf);
                        unpack4(*(const uint2*)(act + (size_t)tok * CONVD + DI + 512 + g * 128 + 4 * nq + 16 * i), cf);
#pragma unroll
                        for (int e = 0; e < 4; ++e) { hs[4 * i + e] = dA * hs[4 * i + e] + xdt * bf[e]; yp += hs[4 * i + e] * cf[e]; }
                    }
                    yp += __shfl_xor(yp, 1); yp += __shfl_xor(yp, 2);
                    float y = yp + Dh * x;
                    y *= silu_f(bf2f(Z[(size_t)tok * DI + h * 64 + pp]));
                    if (nq == 0) { ssq[s] += y * y; Y[(size_t)tok * DI + h * 64 + pp] = f2bf(y); }
                }
#pragma unroll
                for (int i = 0; i < 8; ++i) *(float4*)(st_out + sbase + 4 * nq + 16 * i) = make_float4(hs[4 * i], hs[4 * i + 1], hs[4 * i + 2], hs[4 * i + 3]);
            }
#pragma unroll
            for (int s = 0; s < 4; ++s) red[s * 256 + tid] = ssq[s];
            __syncthreads();
            for (int o = 128; o > 0; o >>= 1) {
                if (tid < o) {
#pragma unroll
                    for (int s = 0; s < 4; ++s) red[s * 256 + tid] += red[s * 256 + tid + o];
                }
                __syncthreads();
            }
            if (nq == 0) {
#pragma unroll
                for (int s = 0; s < 4; ++s) {
                    const float inv = rsqrtf(red[s * 256] * (1.f / 512.f) + EPS);
                    const int tok = TP + sb * 4 + s;
                    for (int hh = 0; hh < 8; ++hh) { bf16_t* yp = Y + (size_t)tok * DI + (g * 8 + hh) * 64 + pp; *yp = f2bf(bf2f(*yp) * inv); }
                }
            }
            __syncthreads();
        }
    }
}

DEVI void ssm_scan_phase(const Params& p, int j) {
    int z_; asm volatile("s_mov_b32 %0, 0" : "=s"(z_)); unsigned char* ws_ = p.ws + z_; float* out_ = p.out + z_; (void)ws_; (void)out_;
    bf16_t* ST = (bf16_t*)(ws_ + B_R6);
    const float* ACS = (const float*)(ws_ + B_ACS);
    float* outp = out_ + O_SSMP + (size_t)j * 2 * 262144;
    const int gtid = bidx() * 256 + tidx(), gsz = VGRID * 256;
    for (int it = gtid; it < 2 * 32 * 2048; it += gsz) {
        const int b = it >> 16, h = (it >> 11) & 31, e4 = (it & 2047) * 4;
        float s0 = 0.f, s1 = 0.f, s2 = 0.f, s3 = 0.f;
#pragma unroll 8
        for (int cc = 0; cc < 64; ++cc) {
            const int c = b * 64 + cc;
            uint2* ptr = (uint2*)(ST + ((size_t)c * 32 + h) * 8192 + e4);
            float f[4]; unpack4(*ptr, f);
            *ptr = make_uint2(pack2(s0, s1), pack2(s2, s3));
            const float dec = __expf(ACS[(size_t)(c * 128 + 127) * 32 + h]);
            s0 = dec * s0 + f[0]; s1 = dec * s1 + f[1]; s2 = dec * s2 + f[2]; s3 = dec * s3 + f[3];
        }
        *(float4*)(outp + ((size_t)b * 32 + h) * 8192 + e4) = make_float4(s0, s1, s2, s3);
    }
}

DEVI void ssm_out_phase(const Params& p, int j) {
    int z_; asm volatile("s_mov_b32 %0, 0" : "=s"(z_)); unsigned char* ws_ = p.ws + z_; float* out_ = p.out + z_; (void)ws_; (void)out_;
    const bf16_t* act = (const bf16_t*)(ws_ + B_R5);
    const float* DTS = (const float*)(ws_ + B_DTS); const float* ACS = (const float*)(ws_ + B_ACS);
    const bf16_t* ST = (const bf16_t*)(ws_ + B_R6); const bf16_t* Z = (const bf16_t*)(ws_ + B_R3);
    bf16_t* Y = (bf16_t*)(ws_ + B_R4);
    const float* dsk = p.in[18] + j * 32;
    const int tid = tidx(), lane = tid & 63, wave = tid >> 6, l31 = lane & 31, lh = lane >> 5;
    bf16_t* RA = (bf16_t*)VSMEM;
    bf16_t* RB = RA + 128 * SST;
    float* sacs = (float*)(RB + 128 * SST);
    float* sdts = sacs + 1024;
    for (int item = bidx(); item < 512; item += VGRID) {
        const int c = item >> 2, g = item & 3, t0 = c * 128;
        __syncthreads();
        for (int idx = tid; idx < 128 * 16; idx += 256) {
            const int q = idx >> 4, n8 = (idx & 15) * 8;
            *(uint4*)(RB + q * SST + n8) = *(const uint4*)(act + (size_t)(t0 + q) * CONVD + DI + g * 128 + n8);
            *(uint4*)(RA + q * SST + n8) = *(const uint4*)(act + (size_t)(t0 + q) * CONVD + DI + 512 + g * 128 + n8);
        }
        for (int idx = tid; idx < 1024; idx += 256) {
            const int hh = idx >> 7, q = idx & 127;
            sacs[idx] = ACS[(size_t)(t0 + q) * 32 + g * 8 + hh]; sdts[idx] = DTS[(size_t)(t0 + q) * 32 + g * 8 + hh];
        }
        __syncthreads();
        f32x16 X[4]; bf16x8 cf[8];
#pragma unroll
        for (int st = 0; st < 4; ++st)
#pragma unroll
            for (int e = 0; e < 16; ++e) X[st][e] = 0.f;
#pragma unroll
        for (int ks = 0; ks < 8; ++ks) {
            cf[ks] = ldsfrag(RA, 32 * wave + l31, SST, ks * 16 + 8 * lh);
#pragma unroll
            for (int st = 0; st < 4; ++st) X[st] = mfma32(ldsfrag(RB, 32 * st + l31, SST, ks * 16 + 8 * lh), cf[ks], X[st]);
        }
        const int q = 32 * wave + l31;
        float ssq = 0.f;
        for (int hh = 0; hh < 8; ++hh) {
            const int h = g * 8 + hh;
            __syncthreads();
            for (int idx = tid; idx < 128 * 8; idx += 256) {
                const int s = idx >> 3, p8 = (idx & 7) * 8;
                float f[8]; unpack8(*(const uint4*)(act + (size_t)(t0 + s) * CONVD + h * 64 + p8), f);
                const float w = sdts[hh * 128 + s];
#pragma unroll
                for (int e = 0; e < 8; ++e) RA[(p8 + e) * SST + s] = f2bf(f[e] * w);
            }
            for (int idx = tid; idx < 64 * 16; idx += 256) {
                const int pp = idx >> 4, n8 = (idx & 15) * 8;
                *(uint4*)(RA + (64 + pp) * SST + n8) = *(const uint4*)(ST + (((size_t)c * 32 + h) * 64 + pp) * 128 + n8);
            }
            const float aq = sacs[hh * 128 + q];
#pragma unroll
            for (int st = 0; st < 4; ++st)
#pragma unroll
                for (int rg = 0; rg < 4; ++rg) {
                    const int s0 = 32 * st + 8 * rg + 4 * lh;
                    float m[4];
#pragma unroll
                    for (int e = 0; e < 4; ++e) { const int s = s0 + e; m[e] = (s <= q) ? X[st][4 * rg + e] * __expf(aq - sacs[hh * 128 + s]) : 0.f; }
                    *(uint2*)(RB + q * SST + s0) = make_uint2(pack2(m[0], m[1]), pack2(m[2], m[3]));
                }
            __syncthreads();
            f32x16 ad[2], ao[2];
#pragma unroll
            for (int i = 0; i < 2; ++i)
#pragma unroll
                for (int e = 0; e < 16; ++e) { ad[i][e] = 0.f; ao[i][e] = 0.f; }
#pragma unroll
            for (int ks = 0; ks < 8; ++ks) {
                const bf16x8 mb = ldsfrag(RB, q, SST, ks * 16 + 8 * lh);
#pragma unroll
                for (int i = 0; i < 2; ++i) {
                    ad[i] = mfma32(ldsfrag(RA, 32 * i + l31, SST, ks * 16 + 8 * lh), mb, ad[i]);
                    ao[i] = mfma32(ldsfrag(RA, 64 + 32 * i + l31, SST, ks * 16 + 8 * lh), cf[ks], ao[i]);
                }
            }
            const float eq = __expf(aq), Dh = dsk[h];
            const size_t trow = (size_t)(t0 + q);
#pragma unroll
            for (int i = 0; i < 2; ++i)
#pragma unroll
                for (int rg = 0; rg < 4; ++rg) {
                    const int pc = h * 64 + 32 * i + 8 * rg + 4 * lh;
                    float xf[4], zf[4], y[4];
                    unpack4(*(const uint2*)(act + trow * CONVD + pc), xf);
                    unpack4(*(const uint2*)(Z + trow * DI + pc), zf);
#pragma unroll
                    for (int e = 0; e < 4; ++e) { y[e] = (ad[i][4 * rg + e] + eq * ao[i][4 * rg + e] + Dh * xf[e]) * silu_f(zf[e]); ssq += y[e] * y[e]; }
                    *(uint2*)(Y + trow * DI + pc) = make_uint2(pack2(y[0], y[1]), pack2(y[2], y[3]));
                }
        }
        ssq += __shfl_xor(ssq, 32);
        const float inv = rsqrtf(ssq * (1.f / 512.f) + EPS);
        const size_t trow = (size_t)(t0 + q);
        for (int hh = 0; hh < 8; ++hh)
#pragma unroll
            for (int i = 0; i < 2; ++i)
#pragma unroll
                for (int rg = 0; rg < 4; ++rg) {
                    uint2* yp = (uint2*)(Y + trow * DI + (g * 8 + hh) * 64 + 32 * i + 8 * rg + 4 * lh);
                    float f[4]; unpack4(*yp, f);
                    *yp = make_uint2(pack2(f[0] * inv, f[1] * inv), pack2(f[2] * inv, f[3] * inv));
                }
    }
}

constexpr int GCH = 64;
DEVI void gla_gate_phase(const Params& p) {
    int z_; asm volatile("s_mov_b32 %0, 0" : "=s"(z_)); unsigned char* ws_ = p.ws + z_; float* out_ = p.out + z_; (void)ws_; (void)out_;
    const float* GLOW = (const float*)(ws_ + B_GLOW); float* BC = (float*)(ws_ + B_HB);
    const float* wg = p.in[22]; const float* gb = p.in[23];
    const int tid = tidx();
    const int nitems = TP / GCH + 32;
    for (int item = bidx(); item < nitems; item += VGRID) {
        int t0, len;
        if (item < TP / GCH) { t0 = item * GCH; len = GCH; } else { t0 = TP + (item - TP / GCH) * 4; len = 4; }
        float w0[16], w1[16];
#pragma unroll
        for (int r = 0; r < 16; ++r) { w0[r] = wg[r * 512 + tid]; w1[r] = wg[r * 512 + 256 + tid]; }
        const float b0 = gb[tid], b1 = gb[256 + tid];
        float r0 = 0.f, r1 = 0.f;
        for (int q = 0; q < len; ++q) {
            const float* gl = GLOW + (size_t)(t0 + q) * 16;
            float a0 = b0, a1 = b1;
#pragma unroll
            for (int r = 0; r < 16; ++r) { const float gv = gl[r]; a0 += gv * w0[r]; a1 += gv * w1[r]; }
            r0 += logsigmoid_f(a0) * (1.f / 16.f); r1 += logsigmoid_f(a1) * (1.f / 16.f);
            BC[(size_t)(t0 + q) * 512 + tid] = r0; BC[(size_t)(t0 + q) * 512 + 256 + tid] = r1;
        }
    }
}

constexpr int QST = 72;
DEVI void gla_state_phase(const Params& p) {
    int z_; asm volatile("s_mov_b32 %0, 0" : "=s"(z_)); unsigned char* ws_ = p.ws + z_; float* out_ = p.out + z_; (void)ws_; (void)out_;
    const bf16_t* QK = (const bf16_t*)(ws_ + B_R4);
    const float* BC = (const float*)(ws_ + B_HB);
    bf16_t* U = (bf16_t*)(ws_ + B_R6);
    const int tid = tidx(), lane = tid & 63, wave = tid >> 6, l31 = lane & 31, lh = lane >> 5;
    bf16_t* sVt = (bf16_t*)VSMEM;
    bf16_t* sKt = sVt + 256 * QST;
    const int nprompt = (TP / GCH) * 4, nitems = nprompt + 128;
    for (int item = bidx(); item < nitems; item += VGRID) {
        __syncthreads();
        if (item < nprompt) {
            const int c = item >> 2, h = item & 3, t0 = c * GCH;
            for (int idx = tid; idx < GCH * 32; idx += 256) {
                const int q = idx >> 5, v8 = (idx & 31) * 8;
                const uint4 v = *(const uint4*)(QK + (size_t)(t0 + q) * 3072 + 1024 + h * 256 + v8);
                const unsigned short* s = (const unsigned short*)&v;
#pragma unroll
                for (int e = 0; e < 8; ++e) sVt[(v8 + e) * QST + q] = s[e];
            }
            for (int idx = tid; idx < GCH * 16; idx += 256) {
                const int q = idx >> 4, k8 = (idx & 15) * 8;
                float f[8]; unpack8(*(const uint4*)(QK + (size_t)(t0 + q) * 3072 + 512 + h * 128 + k8), f);
                const float* bl = BC + (size_t)(t0 + GCH - 1) * 512 + h * 128 + k8; const float* bq = BC + (size_t)(t0 + q) * 512 + h * 128 + k8;
#pragma unroll
                for (int e = 0; e < 8; ++e) sKt[(k8 + e) * QST + q] = f2bf(f[e] * __expf(bl[e] - bq[e]));
            }
            __syncthreads();
            f32x16 acc[2][4];
#pragma unroll
            for (int i = 0; i < 2; ++i)
#pragma unroll
                for (int kk = 0; kk < 4; ++kk)
#pragma unroll
                    for (int e = 0; e < 16; ++e) acc[i][kk][e] = 0.f;
#pragma unroll
            for (int ks = 0; ks < 4; ++ks) {
                bf16x8 vb[2];
#pragma unroll
                for (int i = 0; i < 2; ++i) vb[i] = ldsfrag(sVt, 64 * wave + 32 * i + l31, QST, ks * 16 + 8 * lh);
#pragma unroll
                for (int kk = 0; kk < 4; ++kk) {
                    const bf16x8 ka = ldsfrag(sKt, 32 * kk + l31, QST, ks * 16 + 8 * lh);
#pragma unroll
                    for (int i = 0; i < 2; ++i) acc[i][kk] = mfma32(ka, vb[i], acc[i][kk]);
                }
            }
#pragma unroll
            for (int i = 0; i < 2; ++i)
#pragma unroll
                for (int kk = 0; kk < 4; ++kk)
#pragma unroll
                    for (int rg = 0; rg < 4; ++rg) {
                        const int v = 64 * wave + 32 * i + l31, k = 32 * kk + 8 * rg + 4 * lh;
                        *(uint2*)(U + (((size_t)c * 4 + h) * 256 + v) * 128 + k) = make_uint2(pack2(acc[i][kk][4 * rg], acc[i][kk][4 * rg + 1]), pack2(acc[i][kk][4 * rg + 2], acc[i][kk][4 * rg + 3]));
                    }
        } else {
            const int sb = (item - nprompt) >> 2, h = (item - nprompt) & 3, v = tid;
            const float* s_in = p.in[4] + ((size_t)sb * 4 + h) * 32768; float* s_out = out_ + O_GLAS + ((size_t)sb * 4 + h) * 32768;
            bf16_t* OG = (bf16_t*)(ws_ + B_R3);
            float* sq = (float*)VSMEM; float* sk = sq + 128; float* sa = sk + 128; float* red = sa + 128;
            float S[128];
#pragma unroll
            for (int k = 0; k < 128; ++k) S[k] = s_in[(size_t)k * 256 + v];
            for (int s = 0; s < 4; ++s) {
                const int tok = TP + sb * 4 + s;
                __syncthreads();
                if (tid < 128) {
                    sq[tid] = bf2f(QK[(size_t)tok * 3072 + h * 128 + tid]) * 0.08838834764831845f;
                    sk[tid] = bf2f(QK[(size_t)tok * 3072 + 512 + h * 128 + tid]);
                    const float bcur = BC[(size_t)tok * 512 + h * 128 + tid], bprev = s ? BC[(size_t)(tok - 1) * 512 + h * 128 + tid] : 0.f;
                    sa[tid] = __expf(bcur - bprev);
                }
                __syncthreads();
                const float vv = bf2f(QK[(size_t)tok * 3072 + 1024 + h * 256 + v]);
                float o = 0.f;
#pragma unroll
                for (int k = 0; k < 128; ++k) { S[k] = sa[k] * S[k] + sk[k] * vv; o += sq[k] * S[k]; }
                red[tid] = o * o;
                __syncthreads();
                for (int st = 128; st > 0; st >>= 1) { if (tid < st) red[tid] += red[tid + st]; __syncthreads(); }
                const float inv = rsqrtf(red[0] * (1.f / 256.f) + EPS);
                const float r = bf2f(QK[(size_t)tok * 3072 + 2048 + h * 256 + v]);
                OG[(size_t)tok * D + h * 256 + v] = f2bf(o * inv * silu_f(r));
            }
#pragma unroll
            for (int k = 0; k < 128; ++k) s_out[(size_t)k * 256 + v] = S[k];
        }
    }
}

DEVI void gla_scan_phase(const Params& p) {
    int z_; asm volatile("s_mov_b32 %0, 0" : "=s"(z_)); unsigned char* ws_ = p.ws + z_; float* out_ = p.out + z_; (void)ws_; (void)out_;
    bf16_t* U = (bf16_t*)(ws_ + B_R6);
    const float* BC = (const float*)(ws_ + B_HB);
    float* outp = out_ + O_GLAP;
    const int gtid = bidx() * 256 + tidx(), gsz = VGRID * 256;
    for (int it = gtid; it < 2 * 4 * 8192; it += gsz) {
        const int b = it >> 15, h = (it >> 13) & 3, v = (it >> 5) & 255, k4 = (it & 31) * 4;
        float s0 = 0.f, s1 = 0.f, s2 = 0.f, s3 = 0.f;
#pragma unroll 8
        for (int cc = 0; cc < SEQ / GCH; ++cc) {
            const int c = b * (SEQ / GCH) + cc;
            uint2* ptr = (uint2*)(U + (((size_t)c * 4 + h) * 256 + v) * 128 + k4);
            float f[4]; unpack4(*ptr, f);
            *ptr = make_uint2(pack2(s0, s1), pack2(s2, s3));
            const float4 bl = *(const float4*)(BC + (size_t)(c * GCH + GCH - 1) * 512 + h * 128 + k4);
            s0 = __expf(bl.x) * s0 + f[0]; s1 = __expf(bl.y) * s1 + f[1]; s2 = __expf(bl.z) * s2 + f[2]; s3 = __expf(bl.w) * s3 + f[3];
        }
        float* o = outp + (((size_t)b * 4 + h) * 128 + k4) * 256 + v;
        o[0] = s0; o[256] = s1; o[512] = s2; o[768] = s3;
    }
}

DEVI void gla_out_phase(const Params& p) {
    int z_; asm volatile("s_mov_b32 %0, 0" : "=s"(z_)); unsigned char* ws_ = p.ws + z_; float* out_ = p.out + z_; (void)ws_; (void)out_;
    const bf16_t* QK = (const bf16_t*)(ws_ + B_R4);
    const float* BC = (const float*)(ws_ + B_HB);
    const bf16_t* U = (const bf16_t*)(ws_ + B_R6);
    bf16_t* OG = (bf16_t*)(ws_ + B_R3);
    const int tid = tidx(), lane = tid & 63, wave = tid >> 6, l31 = lane & 31, lh = lane >> 5;
    bf16_t* sQ = (bf16_t*)VSMEM;
    bf16_t* sK = sQ + 64 * SST;
    bf16_t* sVt = sK + 64 * SST;
    float* sred = (float*)(sVt + 256 * QST);
    const int nitems = (TP / GCH) * 4;
    for (int item = bidx(); item < nitems; item += VGRID) {
        const int c = item >> 2, h = item & 3, t0 = c * GCH;
        __syncthreads();
        for (int idx = tid; idx < GCH * 16; idx += 256) {
            const int q = idx >> 4, k8 = (idx & 15) * 8;
            float fq[8], fk[8];
            unpack8(*(const uint4*)(QK + (size_t)(t0 + q) * 3072 + h * 128 + k8), fq);
            unpack8(*(const uint4*)(QK + (size_t)(t0 + q) * 3072 + 512 + h * 128 + k8), fk);
            const float* bq = BC + (size_t)(t0 + q) * 512 + h * 128 + k8;
            unsigned wq[4], wk[4];
#pragma unroll
            for (int e = 0; e < 4; ++e) {
                const float e0 = __expf(bq[2 * e]), e1 = __expf(bq[2 * e + 1]);
                wq[e] = pack2(fq[2 * e] * e0 * 0.08838834764831845f, fq[2 * e + 1] * e1 * 0.08838834764831845f);
                wk[e] = pack2(fk[2 * e] / e0, fk[2 * e + 1] / e1);
            }
            *(uint4*)(sQ + q * SST + k8) = make_uint4(wq[0], wq[1], wq[2], wq[3]);
            *(uint4*)(sK + q * SST + k8) = make_uint4(wk[0], wk[1], wk[2], wk[3]);
        }
        for (int idx = tid; idx < GCH * 32; idx += 256) {
            const int q = idx >> 5, v8 = (idx & 31) * 8;
            const uint4 v = *(const uint4*)(QK + (size_t)(t0 + q) * 3072 + 1024 + h * 256 + v8);
            const unsigned short* s = (const unsigned short*)&v;
#pragma unroll
            for (int e = 0; e < 8; ++e) sVt[(v8 + e) * QST + q] = s[e];
        }
        __syncthreads();
        const int qt = wave & 1, stl = wave >> 1;
        f32x16 at;
#pragma unroll
        for (int e = 0; e < 16; ++e) at[e] = 0.f;
#pragma unroll
        for (int ks = 0; ks < 8; ++ks) at = mfma32(ldsfrag(sK, 32 * stl + l31, SST, ks * 16 + 8 * lh), ldsfrag(sQ, 32 * qt + l31, SST, ks * 16 + 8 * lh), at);
        f32x16 acc[2][2];
#pragma unroll
        for (int i = 0; i < 2; ++i)
#pragma unroll
            for (int jq = 0; jq < 2; ++jq)
#pragma unroll
                for (int e = 0; e < 16; ++e) acc[i][jq][e] = 0.f;
        const bf16_t* Uc = U + ((size_t)c * 4 + h) * 32768;
#pragma unroll
        for (int ks = 0; ks < 8; ++ks) {
            bf16x8 qb[2];
#pragma unroll
            for (int jq = 0; jq < 2; ++jq) qb[jq] = ldsfrag(sQ, 32 * jq + l31, SST, ks * 16 + 8 * lh);
#pragma unroll
            for (int i = 0; i < 2; ++i) {
                const bf16x8 sa = *(const bf16x8*)(Uc + (size_t)(64 * wave + 32 * i + l31) * 128 + ks * 16 + 8 * lh);
#pragma unroll
                for (int jq = 0; jq < 2; ++jq) acc[i][jq] = mfma32(sa, qb[jq], acc[i][jq]);
            }
        }
        __syncthreads();
        bf16_t* sP = sK;
        {
            const int q = 32 * qt + l31;
#pragma unroll
            for (int rg = 0; rg < 4; ++rg) {
                const int s0 = 32 * stl + 8 * rg + 4 * lh;
                float m[4];
#pragma unroll
                for (int e = 0; e < 4; ++e) m[e] = (s0 + e <= q) ? at[4 * rg + e] : 0.f;
                *(uint2*)(sP + q * QST + s0) = make_uint2(pack2(m[0], m[1]), pack2(m[2], m[3]));
            }
        }
        __syncthreads();
#pragma unroll
        for (int ks = 0; ks < 4; ++ks) {
            bf16x8 pb[2];
#pragma unroll
            for (int jq = 0; jq < 2; ++jq) pb[jq] = ldsfrag(sP, 32 * jq + l31, QST, ks * 16 + 8 * lh);
#pragma unroll
            for (int i = 0; i < 2; ++i) {
                const bf16x8 va = ldsfrag(sVt, 64 * wave + 32 * i + l31, QST, ks * 16 + 8 * lh);
#pragma unroll
                for (int jq = 0; jq < 2; ++jq) acc[i][jq] = mfma32(va, pb[jq], acc[i][jq]);
            }
        }
        float ss[2] = {0.f, 0.f};
#pragma unroll
        for (int jq = 0; jq < 2; ++jq)
#pragma unroll
            for (int i = 0; i < 2; ++i)
#pragma unroll
                for (int e = 0; e < 16; ++e) ss[jq] += acc[i][jq][e] * acc[i][jq][e];
#pragma unroll
        for (int jq = 0; jq < 2; ++jq) { ss[jq] += __shfl_xor(ss[jq], 32); if (lh == 0) sred[wave * 64 + 32 * jq + l31] = ss[jq]; }
        __syncthreads();
#pragma unroll
        for (int jq = 0; jq < 2; ++jq) {
            const int q = 32 * jq + l31;
            const float tot = sred[q] + sred[64 + q] + sred[128 + q] + sred[192 + q];
            const float inv = rsqrtf(tot * (1.f / 256.f) + EPS);
            const size_t trow = (size_t)(t0 + q);
#pragma unroll
            for (int i = 0; i < 2; ++i)
#pragma unroll
                for (int rg = 0; rg < 4; ++rg) {
                    const int vc = h * 256 + 64 * wave + 32 * i + 8 * rg + 4 * lh;
                    float rf[4]; unpack4(*(const uint2*)(QK + trow * 3072 + 2048 + vc), rf);
                    float o[4];
#pragma unroll
                    for (int e = 0; e < 4; ++e) o[e] = acc[i][jq][4 * rg + e] * inv * silu_f(rf[e]);
                    *(uint2*)(OG + trow * D + vc) = make_uint2(pack2(o[0], o[1]), pack2(o[2], o[3]));
                }
        }
    }
}

DEVI void att_rope_phase(const Params& p) {
    int z_; asm volatile("s_mov_b32 %0, 0" : "=s"(z_)); unsigned char* ws_ = p.ws + z_; float* out_ = p.out + z_; (void)ws_; (void)out_;
    bf16_t* QKV = (bf16_t*)(ws_ + B_R4);
    const int gtid = bidx() * 256 + tidx(), gsz = VGRID * 256;
    const int Ws[3] = {128, 512, 2048};
    const size_t op[3] = {O_KV0P, O_KV1P, O_KV2P}, os[3] = {O_KV0S, O_KV1S, O_KV2S};
    for (int it = gtid; it < T * 12; it += gsz) {
        const int t = it / 12, hd = it % 12, g = hd >> 2, hg = hd & 3;
        const bool samp = t >= TP;
        const int pos = samp ? SEQ + ((t - TP) & 3) : (t & (SEQ - 1));
        float cs[8], sn[8];
#pragma unroll
        for (int i = 0; i < 8; ++i) { const float fr = powf(500000.f, -(float)i * 0.125f); sincosf((float)pos * fr, &sn[i], &cs[i]); }
        bf16_t* qp = QKV + (size_t)t * QKVD + hd * 64; bf16_t* kp = qp + 768; const bf16_t* vp = qp + 1536;
        float kf[64];
        {
            float f[16];
            unpack8(*(const uint4*)qp, f); unpack8(*(const uint4*)(qp + 8), f + 8);
            unsigned w[8];
#pragma unroll
            for (int i = 0; i < 4; ++i) {
                w[i] = pack2(f[2 * i] * cs[2 * i] - f[2 * i + 8] * sn[2 * i], f[2 * i + 1] * cs[2 * i + 1] - f[2 * i + 9] * sn[2 * i + 1]);
                w[4 + i] = pack2(f[2 * i + 8] * cs[2 * i] + f[2 * i] * sn[2 * i], f[2 * i + 9] * cs[2 * i + 1] + f[2 * i + 1] * sn[2 * i + 1]);
            }
            *(uint4*)qp = make_uint4(w[0], w[1], w[2], w[3]); *(uint4*)(qp + 8) = make_uint4(w[4], w[5], w[6], w[7]);
        }
#pragma unroll
        for (int i = 0; i < 8; ++i) unpack8(*(const uint4*)(kp + 8 * i), kf + 8 * i);
        {
            float r[16];
#pragma unroll
            for (int i = 0; i < 8; ++i) { r[i] = kf[i] * cs[i] - kf[i + 8] * sn[i]; r[i + 8] = kf[i + 8] * cs[i] + kf[i] * sn[i]; }
            unsigned w[8];
#pragma unroll
            for (int i = 0; i < 8; ++i) { w[i] = pack2(r[2 * i], r[2 * i + 1]); kf[2 * i] = bf2f(f2bf(r[2 * i])); kf[2 * i + 1] = bf2f(f2bf(r[2 * i + 1])); }
            *(uint4*)kp = make_uint4(w[0], w[1], w[2], w[3]); *(uint4*)(kp + 8) = make_uint4(w[4], w[5], w[6], w[7]);
        }
        const int W = Ws[g];
        float* dst = nullptr;
        if (!samp) { const int b = t >> 13, tp = t & (SEQ - 1); if (tp >= SEQ - W) dst = out_ + op[g] + (((size_t)b * W + (tp - (SEQ - W))) * 2) * 256 + hg * 64; }
        else { const int sb = (t - TP) >> 2, s = (t - TP) & 3; dst = out_ + os[g] + (((size_t)sb * W + (W - 4 + s)) * 2) * 256 + hg * 64; }
        if (dst) {
#pragma unroll
            for (int i = 0; i < 16; ++i) ((float4*)dst)[i] = make_float4(kf[4 * i], kf[4 * i + 1], kf[4 * i + 2], kf[4 * i + 3]);
#pragma unroll
            for (int i = 0; i < 8; ++i) { float f[8]; unpack8(*(const uint4*)(vp + 8 * i), f); ((float4*)(dst + 256))[2 * i] = make_float4(f[0], f[1], f[2], f[3]); ((float4*)(dst + 256))[2 * i + 1] = make_float4(f[4], f[5], f[6], f[7]); }
        }
    }
}

DEVI void att_phase(const Params& p) {
    int z_; asm volatile("s_mov_b32 %0, 0" : "=s"(z_)); unsigned char* ws_ = p.ws + z_; float* out_ = p.out + z_; (void)ws_; (void)out_;
    const bf16_t* QKV = (const bf16_t*)(ws_ + B_R4);
    bf16_t* AO = (bf16_t*)(ws_ + B_R3);
    const int lane = tidx() & 63, wib = tidx() >> 6;
    const int wv = (bidx() * 256 + tidx()) >> 6, nw = (VGRID * 256) >> 6;
    float* sq = (float*)VSMEM + wib * 256;
    float* sp = sq + 64;
    const int dil[3] = {1, 4, 16}, Ws[3] = {128, 512, 2048};
    for (int it = TP * 4 + wv; it < T * 4; it += nw) {
        const int t = it >> 2, hg = it & 3;
        const bool samp = t >= TP;
        const int sb = samp ? (t - TP) >> 2 : 0, s = samp ? (t - TP) & 3 : 0, tp = t & (SEQ - 1);
        float o[3], lse[3];
#pragma unroll
        for (int g = 0; g < 3; ++g) {
            const int hd = g * 4 + hg, d = dil[g], W = Ws[g];
            sq[lane] = bf2f(QKV[(size_t)t * QKVD + hd * 64 + lane]) * 0.125f;
            const float* cache = p.in[5 + g];
            float sc[3];
#pragma unroll
            for (int r = 0; r < 3; ++r) {
                const int jj = r * 64 + lane;
                float v = -INFINITY;
                if (jj <= 128) {
                    if (!samp) {
                        const int kt = tp - jj * d;
                        if (kt >= 0) {
                            const bf16_t* kp = QKV + (size_t)(t - jj * d) * QKVD + 768 + hd * 64;
                            float a = 0.f;
#pragma unroll
                            for (int i = 0; i < 8; ++i) { float f[8]; unpack8(*(const uint4*)(kp + 8 * i), f);
#pragma unroll
                                for (int e = 0; e < 8; ++e) a += f[e] * sq[8 * i + e]; }
                            v = a;
                        }
                    } else {
                        const int idx = W + s - jj * d;
                        float a = 0.f;
                        if (idx >= W) {
                            const bf16_t* kp = QKV + (size_t)(TP + sb * 4 + (idx - W)) * QKVD + 768 + hd * 64;
#pragma unroll
                            for (int i = 0; i < 8; ++i) { float f[8]; unpack8(*(const uint4*)(kp + 8 * i), f);
#pragma unroll
                                for (int e = 0; e < 8; ++e) a += f[e] * sq[8 * i + e]; }
                        } else {
                            const float4* kp = (const float4*)(cache + (((size_t)sb * W + idx) * 2) * 256 + hg * 64);
#pragma unroll
                            for (int i = 0; i < 16; ++i) { const float4 f = kp[i]; a += f.x * sq[4 * i] + f.y * sq[4 * i + 1] + f.z * sq[4 * i + 2] + f.w * sq[4 * i + 3]; }
                        }
                        v = a;
                    }
                }
                sc[r] = v;
            }
            const float mx = wave_max(fmaxf(sc[0], fmaxf(sc[1], sc[2])));
            float ps = 0.f;
#pragma unroll
            for (int r = 0; r < 3; ++r) { const float e = (sc[r] == -INFINITY) ? 0.f : __expf(sc[r] - mx); sp[r * 64 + lane] = e; ps += e; }
            const float den = wave_sum(ps);
            lse[g] = mx + __logf(den);
            float a = 0.f;
            const int nj = samp ? 129 : min(129, tp / d + 1);
            if (!samp) {
                const bf16_t* vp = QKV + (size_t)t * QKVD + 1536 + hd * 64 + lane;
#pragma unroll 4
                for (int jj = 0; jj < nj; ++jj) a += sp[jj] * bf2f(vp[-(ptrdiff_t)jj * d * QKVD]);
            } else {
                for (int jj = 0; jj < nj; ++jj) {
                    const int idx = W + s - jj * d;
                    const float vv = idx >= W ? bf2f(QKV[(size_t)(TP + sb * 4 + (idx - W)) * QKVD + 1536 + hd * 64 + lane]) : cache[(((size_t)sb * W + idx) * 2 + 1) * 256 + hg * 64 + lane];
                    a += sp[jj] * vv;
                }
            }
            o[g] = a / den;
        }
        const float ml = fmaxf(lse[0], fmaxf(lse[1], lse[2]));
        const float e0 = __expf(lse[0] - ml), e1 = __expf(lse[1] - ml), e2 = __expf(lse[2] - ml), rs = 1.f / (e0 + e1 + e2);
        AO[(size_t)t * ATTD + (0 * 4 + hg) * 64 + lane] = f2bf(o[0] * e0 * rs);
        AO[(size_t)t * ATTD + (1 * 4 + hg) * 64 + lane] = f2bf(o[1] * e1 * rs);
        AO[(size_t)t * ATTD + (2 * 4 + hg) * 64 + lane] = f2bf(o[2] * e2 * rs);
    }
}


constexpr int VST = 264;
DEVI void att_prompt_phase(const Params& p) {
    int z_; asm volatile("s_mov_b32 %0, 0" : "=s"(z_)); unsigned char* ws_ = p.ws + z_; float* out_ = p.out + z_; (void)ws_; (void)out_;
    const bf16_t* QKV = (const bf16_t*)(ws_ + B_R4);
    bf16_t* AO = (bf16_t*)(ws_ + B_R3);
    float* LSE = (float*)(ws_ + B_DT);
    const int tid = tidx(), lane = tid & 63, wave = tid >> 6, l31 = lane & 31, lh = lane >> 5;
    bf16_t* sK = (bf16_t*)VSMEM;
    bf16_t* sVt = sK + 256 * GST;
    for (int item = bidx(); item < 2 * 12 * 64; item += VGRID) {
        const int b = item / 768, hd = (item / 64) % 12, blk = item & 63, g = hd >> 2;
        const int d = (g == 0) ? 1 : (g == 1 ? 4 : 16), nbr = (SEQ / d) / 128, r = blk / nbr, u0 = (blk % nbr) * 128;
        const size_t tb = (size_t)b * SEQ + r;
        __syncthreads();
        for (int idx = tid; idx < 256 * 8; idx += 256) {
            const int kj = idx >> 3, c8 = (idx & 7) * 8, u = u0 - 128 + kj;
            u32x4 kv = {0u, 0u, 0u, 0u}, vv = {0u, 0u, 0u, 0u};
            if (u >= 0) { const bf16_t* src = QKV + (tb + (size_t)u * d) * QKVD + 768 + hd * 64 + c8; kv = *(const u32x4*)src; vv = *(const u32x4*)(src + 768); }
            *(u32x4*)(sK + kj * GST + c8) = kv;
#pragma unroll
            for (int e = 0; e < 4; ++e) { sVt[(c8 + 2 * e) * VST + kj] = (bf16_t)(vv[e] & 0xffffu); sVt[(c8 + 2 * e + 1) * VST + kj] = (bf16_t)(vv[e] >> 16); }
        }
        const int qi = 32 * wave + l31;
        const size_t tq = tb + (size_t)(u0 + qi) * d;
        bf16x8 qf[4];
#pragma unroll
        for (int ks = 0; ks < 4; ++ks) qf[ks] = *(const bf16x8*)(QKV + tq * QKVD + hd * 64 + ks * 16 + 8 * lh);
        __syncthreads();
        f32x16 S[5];
#pragma unroll
        for (int tt = 0; tt < 5; ++tt) {
#pragma unroll
            for (int e = 0; e < 16; ++e) S[tt][e] = 0.f;
#pragma unroll
            for (int ks = 0; ks < 4; ++ks) S[tt] = mfma32(ldsfrag(sK, 32 * (wave + tt) + l31, GST, ks * 16 + 8 * lh), qf[ks], S[tt]);
        }
        float mx = -INFINITY;
#pragma unroll
        for (int tt = 0; tt < 5; ++tt)
#pragma unroll
            for (int e = 0; e < 16; ++e) {
                const int kj = 32 * (wave + tt) + (e & 3) + 8 * (e >> 2) + 4 * lh;
                const bool valid = (kj >= qi) && (kj <= qi + 128) && (u0 - 128 + kj >= 0);
                const float sv = valid ? S[tt][e] * 0.125f : -INFINITY;
                S[tt][e] = sv; mx = fmaxf(mx, sv);
            }
        mx = fmaxf(mx, __shfl_xor(mx, 32));
        float den = 0.f;
#pragma unroll
        for (int tt = 0; tt < 5; ++tt)
#pragma unroll
            for (int e = 0; e < 16; ++e) { const float pe = __expf(S[tt][e] - mx); S[tt][e] = pe; den += pe; }
        den += __shfl_xor(den, 32);
        f32x16 O[2];
#pragma unroll
        for (int i = 0; i < 2; ++i)
#pragma unroll
            for (int e = 0; e < 16; ++e) O[i][e] = 0.f;
#pragma unroll
        for (int tt = 0; tt < 5; ++tt)
#pragma unroll
            for (int s2 = 0; s2 < 2; ++s2) {
                union { bf16x8 v; unsigned u[4]; } pb;
#pragma unroll
                for (int e = 0; e < 4; ++e) pb.u[e] = pack2(S[tt][8 * s2 + 2 * e], S[tt][8 * s2 + 2 * e + 1]);
#pragma unroll
                for (int i = 0; i < 2; ++i) {
                    const bf16_t* vp = sVt + (32 * i + l31) * VST + 32 * (wave + tt) + 16 * s2 + 4 * lh;
                    union { bf16x8 v; uint2 h[2]; } va;
                    va.h[0] = *(const uint2*)vp; va.h[1] = *(const uint2*)(vp + 8);
                    O[i] = mfma32(va.v, pb.v, O[i]);
                }
            }
        const float rden = 1.f / den;
#pragma unroll
        for (int i = 0; i < 2; ++i)
#pragma unroll
            for (int rg = 0; rg < 4; ++rg)
                *(uint2*)(AO + tq * ATTD + hd * 64 + 32 * i + 8 * rg + 4 * lh) = make_uint2(pack2(O[i][4 * rg] * rden, O[i][4 * rg + 1] * rden), pack2(O[i][4 * rg + 2] * rden, O[i][4 * rg + 3] * rden));
        if (lh == 0) LSE[tq * 12 + hd] = mx + __logf(den);
    }
}

DEVI void att_mix_phase(const Params& p) {
    int z_; asm volatile("s_mov_b32 %0, 0" : "=s"(z_)); unsigned char* ws_ = p.ws + z_; float* out_ = p.out + z_; (void)ws_; (void)out_;
    bf16_t* AO = (bf16_t*)(ws_ + B_R3);
    const float* LSE = (const float*)(ws_ + B_DT);
    const int gtid = bidx() * 256 + tidx(), gsz = VGRID * 256;
    for (int it = gtid; it < TP * 32; it += gsz) {
        const int t = it >> 5, hg = (it >> 3) & 3, c8 = (it & 7) * 8;
        const float l0 = LSE[(size_t)t * 12 + hg], l1 = LSE[(size_t)t * 12 + 4 + hg], l2 = LSE[(size_t)t * 12 + 8 + hg];
        const float ml = fmaxf(l0, fmaxf(l1, l2));
        float al[3] = {__expf(l0 - ml), __expf(l1 - ml), __expf(l2 - ml)};
        const float rs = 1.f / (al[0] + al[1] + al[2]);
#pragma unroll
        for (int g = 0; g < 3; ++g) {
            u32x4* ptr = (u32x4*)(AO + (size_t)t * ATTD + (g * 4 + hg) * 64 + c8);
            const u32x4 v = *ptr; const float a = al[g] * rs;
            u32x4 o;
#pragma unroll
            for (int e = 0; e < 4; ++e) o[e] = pack2(__uint_as_float(v[e] << 16) * a, __uint_as_float(v[e] & 0xffff0000u) * a);
            *ptr = o;
        }
    }
}

enum { OP_INIT = 0, OP_NORM, OP_FINAL, OP_SSM_IN, OP_SSM_CONV, OP_SSM_STATE, OP_SSM_SCAN, OP_SSM_OUT, OP_SSM_OG, OP_GLA_IN, OP_GLA_GATE, OP_GLA_STATE, OP_GLA_SCAN,
       OP_GLA_OUT, OP_GLA_OG, OP_ATT_IN_, OP_ATT_ROPE, OP_ATT_ATT, OP_ATT_MIX, OP_ATT_OG, OP_FFN_GU, OP_FFN_DN };
constexpr int OP_ATT_IN = OP_ATT_IN_;
DEVI int phase_op(int ph, int& a) {
    int l, q, op; a = 0;
    if (ph == 0) return OP_INIT;
    if (ph <= 10) { l = 0; q = ph - 1; } else if (ph <= 20) { l = 1; q = ph - 11; } else if (ph <= 29) { l = 2; q = ph - 21; } else { l = 3; q = ph - 30; }
    const int nmix = (l == 2) ? 5 : 6;
    if (q < nmix) { op = (l == 1 ? OP_GLA_IN : (l == 2 ? OP_ATT_IN_ : OP_SSM_IN)) + q; a = l / 3; }
    else { const int k = q - nmix; op = (k == 0) ? OP_NORM : (k == 1 ? OP_FFN_GU : (k == 2 ? OP_FFN_DN : (l == 3 ? OP_FINAL : OP_NORM))); a = l; }
    return op;
}
DEVI int phase_op_only(int ph) { int a; return phase_op(ph, a); }
DEVI void run_phase(const Params& p, int ph) {
    const bf16_t* Hb = (const bf16_t*)(p.ws + B_HB);
    int a = 0; int op = phase_op(ph, a);
#ifdef ONLY_OP
    if (op != ONLY_OP) return;
    op = ONLY_OP;
#endif
    switch (op) {
        case OP_INIT: convert_weights(p); copy_caches(p); norm_phase(p, 0); break;
        case OP_NORM: norm_phase(p, 1); break;
        case OP_FINAL: norm_phase(p, 2); break;
        case OP_SSM_IN: gemm_phase<EPI_SSM_IN, D>(p, Hb, (const bf16_t*)(p.ws + W_SSM_IN) + (size_t)a * SSM_INP * D, SSM_INP / 256); break;
        case OP_SSM_CONV: ssm_conv_phase(p, a); break;
        case OP_SSM_STATE: ssm_state_phase(p, a); break;
        case OP_SSM_SCAN: ssm_scan_phase(p, a); break;
        case OP_SSM_OUT: ssm_out_phase(p, a); break;
        case OP_SSM_OG: gemm_phase<EPI_RESADD, DI>(p, (const bf16_t*)(p.ws + B_R4), (const bf16_t*)(p.ws + W_SSM_OUT) + (size_t)a * D * DI, 4); break;
        case OP_GLA_IN: gemm_phase<EPI_GLA_IN, D>(p, Hb, (const bf16_t*)(p.ws + W_GLA_IN), GLA_INP / 256); break;
        case OP_GLA_GATE: gla_gate_phase(p); break;
        case OP_GLA_STATE: gla_state_phase(p); break;
        case OP_GLA_SCAN: gla_scan_phase(p); break;
        case OP_GLA_OUT: gla_out_phase(p); break;
        case OP_GLA_OG: gemm_phase<EPI_RESADD, D>(p, (const bf16_t*)(p.ws + B_R3), (const bf16_t*)(p.ws + W_GLA_OUT), 4); break;
        case OP_ATT_IN: gemm_phase<EPI_ATT_IN, D>(p, Hb, (const bf16_t*)(p.ws + W_ATT_QKV), QKVD / 256); break;
        case OP_ATT_ROPE: att_rope_phase(p); break;
        case OP_ATT_ATT: att_prompt_phase(p); __syncthreads(); att_phase(p); break;
        case OP_ATT_MIX: att_mix_phase(p); break;
        case OP_ATT_OG: gemm_phase<EPI_RESADD, ATTD>(p, (const bf16_t*)(p.ws + B_R3), (const bf16_t*)(p.ws + W_ATT_OUT), 4); break;
        case OP_FFN_GU: gemm_phase<EPI_SWIGLU, D>(p, Hb, (const bf16_t*)(p.ws + W_FFN_GU) + (size_t)a * 2 * DFF * D, 2 * DFF / 256); break;
        case OP_FFN_DN: gemm_phase<EPI_RESADD, DFF>(p, (const bf16_t*)(p.ws + B_R4), (const bf16_t*)(p.ws + W_FFN_DN) + (size_t)a * D * DFF, 4); break;
        default: break;
    }
}

#ifndef REPEAT_OP
#define REPEAT_OP -1
#endif
#ifndef REPEAT_N
#define REPEAT_N 1
#endif
__global__ void __launch_bounds__(512, 2) mega(Params p, int ph_lo, int ph_hi, int coop) {
    __shared__ uint4 xb_words;
    if (threadIdx.x == 0) xb_words = make_uint4(0u, 0u, 0u, 0u);
    __syncthreads();
    XcdBarrier xb = xcd_barrier_post((unsigned*)(p.ws + B_BAR), (volatile LAS unsigned*)&xb_words);
    if (coop < 0) cg::this_grid().sync();
    int rep = 0;
    for (int ph = ph_lo; ph < ph_hi;) {
        run_phase(p, ph);
        if (REPEAT_OP >= 0 && phase_op_only(ph) == REPEAT_OP && rep < REPEAT_N) { ++rep; __syncthreads(); continue; }
        rep = 0;
        if (ph + 1 < ph_hi) xcd_barrier(xb);
        ++ph;
    }
}

extern "C" void kernel_launch(void* const* d_in, const int* in_sizes, int n_in, void* d_out, int out_size, void* d_ws, size_t ws_size, hipStream_t stream) {
    if (ws_size < B_END) { fprintf(stderr, "workspace too small: %zu < %zu\n", ws_size, (size_t)B_END); return; }
    Params p; memset(&p, 0, sizeof(p));
    for (int i = 0; i < 29; ++i) p.in[i] = (const float*)d_in[i];
    p.out = (float*)d_out; p.ws = (unsigned char*)d_ws;
    p.nphase = 40;
    static int grid_blocks = 0;
    if (!grid_blocks) {
        int dev = 0, cus = 0, per_cu = 0;
        hipGetDevice(&dev);
        hipDeviceGetAttribute(&cus, hipDeviceAttributeMultiprocessorCount, dev);
        hipOccupancyMaxActiveBlocksPerMultiprocessor(&per_cu, mega, 512, 0);
        if (per_cu > 1) per_cu = 1;
        if (per_cu < 1) per_cu = 1;
        grid_blocks = cus * per_cu;
    }
#if ONE_LAUNCH
    hipMemsetAsync(p.ws + B_BAR, 0, XCD_BAR_WORDS * 4, stream);
    int lo = 0, hi = p.nphase, coop = 1;
    void* args[] = {&p, &lo, &hi, &coop};
    hipError_t e = hipLaunchCooperativeKernel((void*)mega, dim3(grid_blocks), dim3(512), args, 0, stream);
    if (e != hipSuccess) fprintf(stderr, "cooperative launch failed: %s (grid %d)\n", hipGetErrorString(e), grid_blocks);
#else
    for (int ph = 0; ph < p.nphase; ++ph) mega<<<grid_blocks, 512, 0, stream>>>(p, ph, ph + 1, 0);
#endif
}
```

```cpp
#include <hip/hip_runtime.h>
#include <hip/hip_cooperative_groups.h>
#include <cstdio>
#include <cstring>
namespace cg = cooperative_groups;

#ifndef ONE_LAUNCH
#define ONE_LAUNCH 1
#endif

typedef unsigned short bf16_t;
typedef short bf16x8 __attribute__((ext_vector_type(8)));
typedef float f32x16 __attribute__((ext_vector_type(16)));
typedef float f32x4 __attribute__((ext_vector_type(4)));
typedef unsigned u32x4 __attribute__((ext_vector_type(4)));
#define DEVI __device__ __forceinline__

constexpr int D = 1024, TP = 16384, TS = 128, T = TP + TS, SEQ = 8192, DFF = 2816;
constexpr int SSM_IN = 5152, SSM_INP = 5376, DI = 2048, CONVD = 3072;
constexpr int GLA_IN = 3088, GLA_INP = 3328;
constexpr int QKVD = 2304, ATTD = 768;
constexpr float EPS = 1e-6f;
constexpr int MPAD = 16640;

constexpr size_t O_YP = 0, O_YS = O_YP + (size_t)TP * D, O_SSMP = O_YS + (size_t)TS * D, O_SSMS = O_SSMP + 2ull * 2 * 262144,
                 O_CONVP = O_SSMS + 2ull * 32 * 262144, O_CONVS = O_CONVP + 2ull * 2 * 3 * CONVD, O_GLAP = O_CONVS + 2ull * 32 * 3 * CONVD,
                 O_GLAS = O_GLAP + 2ull * 4 * 32768, O_KV0P = O_GLAS + 32ull * 4 * 32768, O_KV0S = O_KV0P + 2ull * 128 * 512,
                 O_KV1P = O_KV0S + 32ull * 128 * 512, O_KV1S = O_KV1P + 2ull * 512 * 512, O_KV2P = O_KV1S + 32ull * 512 * 512,
                 O_KV2S = O_KV2P + 2ull * 2048 * 512, O_END = O_KV2S + 32ull * 2048 * 512;

constexpr size_t al(size_t x) { return (x + 255) & ~(size_t)255; }
constexpr size_t W_SSM_IN = 0, W_SSM_OUT = W_SSM_IN + 2ull * SSM_INP * D * 2, W_GLA_IN = W_SSM_OUT + 2ull * D * DI * 2,
                 W_GLA_OUT = W_GLA_IN + (size_t)GLA_INP * D * 2, W_ATT_QKV = W_GLA_OUT + (size_t)D * D * 2, W_ATT_OUT = W_ATT_QKV + (size_t)QKVD * D * 2,
                 W_FFN_GU = W_ATT_OUT + (size_t)D * ATTD * 2, W_FFN_DN = W_FFN_GU + 4ull * 2 * DFF * D * 2, W_END = W_FFN_DN + 4ull * D * DFF * 2;
constexpr size_t B_HB = al(W_END), B_R3 = B_HB + (size_t)T * D * 2, B_R4 = B_R3 + (size_t)T * DI * 2, B_R5 = B_R4 + (size_t)T * CONVD * 2,
                 B_R6 = B_R5 + (size_t)T * CONVD * 2, B_DT = B_R6 + 67108864ull, B_DTS = B_DT + (size_t)T * 32 * 4, B_ACS = B_DTS + (size_t)T * 32 * 4,
                 B_GLOW = B_ACS + (size_t)T * 32 * 4, B_BAR = al(B_GLOW + (size_t)T * 16 * 4), B_SSQS = B_BAR + 16384, B_END = B_SSQS + 4096;

struct WDesc { const float* src; const float* gain; bf16_t* dst; int K, N, mode, tile0, gmod; };
struct Params {
    const float* in[29];
    float* out;
    unsigned char* ws;
    int nphase, pad0;
};

constexpr int LDS_BYTES = 79872;
extern __shared__ __attribute__((aligned(16))) unsigned char smem[];
constexpr int DYN_LDS = 2 * LDS_BYTES + 16;

DEVI int rtid() { int t = threadIdx.x; asm volatile("" : "+v"(t)); return t; }
DEVI int rbid() { int b = blockIdx.x; asm volatile("" : "+s"(b)); return b; }
DEVI int vhalf() { return __builtin_amdgcn_readfirstlane(rtid() >> 8); }
DEVI int tidx() { return rtid() & 255; }
DEVI int bidx() { return rbid() * 2 + vhalf(); }
#define VGRID ((int)gridDim.x * 2)
#define CAS4 __attribute__((address_space(4)))
#define KIN_DECL const float* const CAS4* in_ = (const float* const CAS4*)((const CAS4 char*)__builtin_amdgcn_kernarg_segment_ptr() + z_); (void)in_
#define VSMEM (smem + vhalf() * LDS_BYTES)
DEVI unsigned short f2bf(float f) { unsigned u = __float_as_uint(f); u += 0x7fffu + ((u >> 16) & 1u); return (unsigned short)(u >> 16); }
DEVI float bf2f(unsigned short h) { return __uint_as_float(((unsigned)h) << 16); }
DEVI unsigned pack2(float a, float b) { return (unsigned)f2bf(a) | ((unsigned)f2bf(b) << 16); }
DEVI float silu_f(float x) { return x / (1.f + __expf(-x)); }
DEVI float softplus_f(float x) { return x > 20.f ? x : log1pf(__expf(x)); }
DEVI float logsigmoid_f(float x) { return fminf(x, 0.f) - log1pf(__expf(-fabsf(x))); }
DEVI float wave_sum(float v) { for (int o = 32; o > 0; o >>= 1) v += __shfl_xor(v, o); return v; }
DEVI float wave_max(float v) { for (int o = 32; o > 0; o >>= 1) v = fmaxf(v, __shfl_xor(v, o)); return v; }
DEVI bf16x8 ldsfrag(const bf16_t* base, int row, int stride, int k) { return *(const bf16x8*)(base + row * stride + k); }
DEVI f32x16 mfma32(bf16x8 a, bf16x8 b, f32x16 c) { return __builtin_amdgcn_mfma_f32_32x32x16_bf16(a, b, c, 0, 0, 0); }
DEVI void unpack8(uint4 v, float* f) {
    f[0] = __uint_as_float(v.x << 16); f[1] = __uint_as_float(v.x & 0xffff0000u); f[2] = __uint_as_float(v.y << 16); f[3] = __uint_as_float(v.y & 0xffff0000u);
    f[4] = __uint_as_float(v.z << 16); f[5] = __uint_as_float(v.z & 0xffff0000u); f[6] = __uint_as_float(v.w << 16); f[7] = __uint_as_float(v.w & 0xffff0000u);
}
DEVI void unpack4(uint2 v, float* f) {
    f[0] = __uint_as_float(v.x << 16); f[1] = __uint_as_float(v.x & 0xffff0000u); f[2] = __uint_as_float(v.y << 16); f[3] = __uint_as_float(v.y & 0xffff0000u);
}


#define XB_TMO      128
#define XB_XCNT(j)  (256  + 64 * (j))
#define XB_XSUB(j)  (1280 + 64 * (j))
#define XB_XGEN(j)  (2304 + 64 * (j))
#define XB_TOP      3328
#define XB_TOPGEN   3392
#define XCD_BAR_WORDS 3456
#define XB_SPIN_CAP (1u << 22)
#define LAS __attribute__((address_space(3)))
DEVI unsigned xb_ld(unsigned* p)              { return __hip_atomic_load(p, __ATOMIC_RELAXED, __HIP_MEMORY_SCOPE_AGENT); }
DEVI unsigned xb_add(unsigned* p, unsigned v) { return __hip_atomic_fetch_add(p, v, __ATOMIC_RELAXED, __HIP_MEMORY_SCOPE_AGENT); }
DEVI unsigned xb_xcc_id() { return (unsigned)__builtin_amdgcn_s_getreg((3 << 11) | 20) & 0xFu; }
#define XB_SPIN(cond, bar) do { unsigned _sp = 0; while (cond) { __builtin_amdgcn_s_sleep(1); \
    if ((++_sp & 255u) == 0u) { if (xb_ld(&(bar)[XB_TMO])) break; if (_sp > XB_SPIN_CAP) { atomicAdd(&(bar)[XB_TMO], 1u); break; } } } } while (0)
struct XcdBarrier { unsigned* bar; unsigned x; volatile LAS unsigned* st; };
DEVI XcdBarrier xcd_barrier_post(unsigned* bar, volatile LAS unsigned* st) {
    XcdBarrier b; b.bar = bar; b.x = xb_xcc_id(); b.st = st;
    if (threadIdx.x == 0) (void)xb_add(&bar[XB_XCNT(b.x)], 1u);
    return b;
}
DEVI void xcd_barrier_complete(unsigned* bar, unsigned x, unsigned& nloc, unsigned& nx) {
    const unsigned G = gridDim.x * gridDim.y * gridDim.z;
    unsigned sum, cnt, mine, sp = 0u;
    for (;;) {
        sum = 0u; cnt = 0u; mine = 0u;
#pragma unroll
        for (unsigned j = 0; j < 16; ++j) { const unsigned c = xb_ld(&bar[XB_XCNT(j)]); sum += c; cnt += (c > 0u) ? 1u : 0u; mine = (j == x) ? c : mine; }
        if (sum == G) break;
        __builtin_amdgcn_s_sleep(1);
        if ((++sp & 255u) == 0u) { if (xb_ld(&bar[XB_TMO])) break; if (sp > XB_SPIN_CAP) { atomicAdd(&bar[XB_TMO], 1u); break; } }
    }
    nloc = mine > 0u ? mine : 1u; nx = cnt > 0u ? cnt : 1u;
}
DEVI void xcd_barrier(const XcdBarrier& b) {
    asm volatile("s_waitcnt vmcnt(0)" ::: "memory");
    __syncthreads();
    if (threadIdx.x == 0) {
        unsigned* bar = b.bar;
        __builtin_amdgcn_s_waitcnt(0);
        unsigned nloc = b.st[0], nx = b.st[1];
        if (nloc == 0u) { xcd_barrier_complete(bar, b.x, nloc, nx); b.st[0] = nloc; b.st[1] = nx; }
        const unsigned old = xb_add(&bar[XB_XSUB(b.x)], 1u);
        const unsigned gen = old / nloc;
        if (old + 1u == (gen + 1u) * nloc) {
            __builtin_amdgcn_fence(__ATOMIC_RELEASE, "agent");
            asm volatile("s_waitcnt vmcnt(0)" ::: "memory");
            const unsigned og = xb_add(&bar[XB_TOP], 1u);
            const unsigned tg = og / nx;
            if (og + 1u == (tg + 1u) * nx) xb_add(&bar[XB_TOPGEN], 1u);
            else XB_SPIN(xb_ld(&bar[XB_TOPGEN]) == tg, bar);
            __builtin_amdgcn_fence(__ATOMIC_ACQUIRE, "agent");
            xb_add(&bar[XB_XGEN(b.x)], 1u);
            asm volatile("s_waitcnt vmcnt(0)" ::: "memory");
        } else {
            XB_SPIN(xb_ld(&bar[XB_XGEN(b.x)]) == gen, bar);
            __builtin_amdgcn_fence(__ATOMIC_ACQUIRE, "agent");
            asm volatile("s_waitcnt vmcnt(0)" ::: "memory");
        }
    }
    __syncthreads();
}

DEVI void convert_weights(const Params& p) {
    int z_; asm volatile("s_mov_b32 %0, 0" : "=s"(z_)); unsigned char* ws_ = p.ws + z_; float* out_ = p.out + z_; (void)ws_; (void)out_; KIN_DECL;
    float* tile = (float*)VSMEM;
    const int tid = tidx();
    constexpr int T_SI = (SSM_INP / 64) * (D / 64), T_SO = (D / 64) * (DI / 64), T_GI = (GLA_INP / 64) * (D / 64), T_GO = (D / 64) * (D / 64),
                  T_AQ = (QKVD / 64) * (D / 64), T_AO = (D / 64) * (ATTD / 64), T_FF = (DFF / 64) * (D / 64);
    constexpr int P0 = 2 * (T_SI + T_SO), P1 = P0 + T_GI, P2 = P1 + T_GO, P3 = P2 + T_AQ, P4 = P3 + T_AO, WT = P4 + 12 * T_FF;
    auto decode = [&](int it, WDesc& d) {
        d.gain = nullptr; d.mode = 0; d.gmod = 1 << 30;
        if (it < P0) {
            const int j = it / (T_SI + T_SO), r = it - j * (T_SI + T_SO);
            if (r < T_SI) { d.src = in_[13] + (size_t)j * D * SSM_IN; d.gain = in_[8] + j * 3 * D; d.dst = (bf16_t*)(ws_ + W_SSM_IN) + (size_t)j * SSM_INP * D; d.K = D; d.N = SSM_IN; d.tile0 = j * (T_SI + T_SO); }
            else { d.src = in_[20] + (size_t)j * DI * D; d.gain = in_[19] + j * DI; d.dst = (bf16_t*)(ws_ + W_SSM_OUT) + (size_t)j * D * DI; d.K = DI; d.N = D; d.tile0 = j * (T_SI + T_SO) + T_SI; }
        } else if (it < P1) { d.src = in_[21]; d.gain = in_[8] + D; d.dst = (bf16_t*)(ws_ + W_GLA_IN); d.K = D; d.N = GLA_IN; d.tile0 = P0; }
        else if (it < P2) { d.src = in_[25]; d.gain = in_[24]; d.gmod = 256; d.dst = (bf16_t*)(ws_ + W_GLA_OUT); d.K = D; d.N = D; d.tile0 = P1; }
        else if (it < P3) { d.src = in_[26]; d.gain = in_[8] + 2 * D; d.dst = (bf16_t*)(ws_ + W_ATT_QKV); d.K = D; d.N = QKVD; d.tile0 = P2; }
        else if (it < P4) { d.src = in_[27]; d.dst = (bf16_t*)(ws_ + W_ATT_OUT); d.K = ATTD; d.N = D; d.tile0 = P3; }
        else {
            const int q = (it - P4) / T_FF, l = q / 3, w = q - l * 3;
            d.tile0 = P4 + q * T_FF;
            if (w < 2) { d.src = (w == 0 ? in_[10] : in_[11]) + (size_t)l * D * DFF; d.gain = in_[9] + l * D; d.dst = (bf16_t*)(ws_ + W_FFN_GU) + (size_t)l * 2 * DFF * D; d.K = D; d.N = DFF; d.mode = 1 + w; }
            else { d.src = in_[12] + (size_t)l * DFF * D; d.dst = (bf16_t*)(ws_ + W_FFN_DN) + (size_t)l * D * DFF; d.K = DFF; d.N = D; }
        }
    };
    auto load_tile = [&](int it, const WDesc& d, float (&v)[16]) {
        const int lt = it - d.tile0, nkt = d.K / 64, ntile = lt / nkt, ktile = lt - ntile * nkt, n = ntile * 64 + (tid & 63), k0 = ktile * 64;
#pragma unroll
        for (int r = 0; r < 16; ++r) {
            const int kk = (tid >> 6) + 4 * r;
            float x = 0.f;
            if (n < d.N) { x = d.src[(size_t)(k0 + kk) * d.N + n]; if (d.gain) x *= d.gain[(k0 + kk) & (d.gmod - 1)]; }
            v[r] = x;
        }
    };
    int it = bidx(); bool have = it < WT;
    WDesc d; float v[16];
    if (have) { decode(it, d); load_tile(it, d, v); }
    while (have) {
        const int itn = it + VGRID; const bool hn = itn < WT;
        WDesc dn = d; float vn[16];
        if (hn) { decode(itn, dn); load_tile(itn, dn, vn); }
        __syncthreads();
#pragma unroll
        for (int r = 0; r < 16; ++r) tile[((tid >> 6) + 4 * r) * 65 + (tid & 63)] = v[r];
        __syncthreads();
        {
            const int lt = it - d.tile0, nkt = d.K / 64, ntile = lt / nkt, ktile = lt - ntile * nkt, n0 = ntile * 64, k0 = ktile * 64;
            const int r = tid >> 2, seg = tid & 3, n = n0 + r;
            int drow = n;
            if (d.mode) { const int t = n >> 7, c = n & 127; drow = t * 256 + (d.mode == 2 ? 128 : 0) + c; }
            unsigned w[8];
#pragma unroll
            for (int e = 0; e < 8; ++e) w[e] = pack2(tile[(seg * 16 + 2 * e) * 65 + r], tile[(seg * 16 + 2 * e + 1) * 65 + r]);
            uint4* dp = (uint4*)(d.dst + (size_t)drow * d.K + k0 + seg * 16);
            dp[0] = make_uint4(w[0], w[1], w[2], w[3]); dp[1] = make_uint4(w[4], w[5], w[6], w[7]);
        }
        it = itn; have = hn; d = dn;
#pragma unroll
        for (int r = 0; r < 16; ++r) v[r] = vn[r];
    }
}

DEVI void copy_caches(const Params& p) {
    int z_; asm volatile("s_mov_b32 %0, 0" : "=s"(z_)); unsigned char* ws_ = p.ws + z_; float* out_ = p.out + z_; (void)ws_; (void)out_; KIN_DECL;
    const unsigned gtid = (unsigned)(bidx() * 256 + tidx()), gsz = (unsigned)(VGRID * 256);
#pragma unroll
    for (int g = 0; g < 3; ++g) {
        const unsigned W = g == 0 ? 128u : (g == 1 ? 512u : 2048u);
        const unsigned per = (W - 4u) * 128u, tot = 32u * per;
        const f32x4* src = (const f32x4*)(g == 0 ? in_[5] : (g == 1 ? in_[6] : in_[7]));
        f32x4* dst = (f32x4*)(out_ + (g == 0 ? O_KV0S : (g == 1 ? O_KV1S : O_KV2S)));
        for (unsigned base = gtid; base < tot; base += 8u * gsz) {
            f32x4 v[8]; unsigned di[8];
#pragma unroll
            for (int u = 0; u < 8; ++u) {
                const unsigned i = base + (unsigned)u * gsz, ic = i < tot ? i : tot - 1u, sb = ic / per, rem = ic - sb * per;
                di[u] = sb * W * 128u + rem;
                v[u] = __builtin_nontemporal_load(src + (sb * W + 4u) * 128u + rem);
            }
#pragma unroll
            for (int u = 0; u < 8; ++u) if (base + (unsigned)u * gsz < tot) __builtin_nontemporal_store(v[u], dst + di[u]);
        }
    }
}

DEVI void norm_phase(const Params& p, int mode) {
    int z_; asm volatile("s_mov_b32 %0, 0" : "=s"(z_)); unsigned char* ws_ = p.ws + z_; float* out_ = p.out + z_; (void)ws_; (void)out_; KIN_DECL;
    const int lane = tidx() & 63, wv = (bidx() * 256 + tidx()) >> 6, nw = (VGRID * 256) >> 6;
    float* X = out_;
    bf16_t* Hb = (bf16_t*)(ws_ + B_HB);
    for (int r0 = wv; r0 < T; r0 += 2 * nw) {
        const int r1 = r0 + nw; const bool h1 = r1 < T; const int rr[2] = {r0, h1 ? r1 : r0};
        float4 v[2][4]; float ss[2] = {0.f, 0.f};
#pragma unroll
        for (int k = 0; k < 2; ++k) {
            const int r = rr[k];
            const float* src = mode == 0 ? (r < TP ? in_[0] + (size_t)r * D : in_[1] + (size_t)(r - TP) * D) : X + (size_t)r * D;
#pragma unroll
            for (int i = 0; i < 4; ++i) v[k][i] = ((const float4*)src)[i * 64 + lane];
        }
#pragma unroll
        for (int k = 0; k < 2; ++k) {
#pragma unroll
            for (int i = 0; i < 4; ++i) ss[k] += v[k][i].x * v[k][i].x + v[k][i].y * v[k][i].y + v[k][i].z * v[k][i].z + v[k][i].w * v[k][i].w;
            ss[k] = wave_sum(ss[k]);
        }
#pragma unroll
        for (int k = 0; k < 2; ++k) {
            if (k == 1 && !h1) break;
            const int r = rr[k];
            const float inv = rsqrtf(ss[k] * (1.f / D) + EPS);
            if (mode == 2) {
                const float4* g = (const float4*)in_[28];
#pragma unroll
                for (int i = 0; i < 4; ++i) { float4 gg = g[i * 64 + lane]; ((float4*)(X + (size_t)r * D))[i * 64 + lane] = make_float4(v[k][i].x * inv * gg.x, v[k][i].y * inv * gg.y, v[k][i].z * inv * gg.z, v[k][i].w * inv * gg.w); }
            } else {
#pragma unroll
                for (int i = 0; i < 4; ++i) {
                    if (mode == 0) ((float4*)(X + (size_t)r * D))[i * 64 + lane] = v[k][i];
                    ((uint2*)(Hb + (size_t)r * D))[i * 64 + lane] = make_uint2(pack2(v[k][i].x * inv, v[k][i].y * inv), pack2(v[k][i].z * inv, v[k][i].w * inv));
                }
            }
        }
    }
}

enum { EPI_SSM_IN = 0, EPI_GLA_IN = 1, EPI_ATT_IN = 2, EPI_RESADD = 3, EPI_SWIGLU = 4 };
constexpr int GST = 72;
constexpr int GBUF = 2 * 128 * GST;

template <int EPI, int K>
DEVI void gemm_phase(const Params& p, const bf16_t* __restrict__ A, const bf16_t* __restrict__ Bt, int nN, bool only_split = false) {
    int z_; asm volatile("s_mov_b32 %0, 0" : "=s"(z_)); unsigned char* ws_ = p.ws + z_; float* out_ = p.out + z_; (void)ws_; (void)out_; KIN_DECL;
    const int tid = rtid(), lane = tid & 63, wave = tid >> 6, wm = wave >> 2, wn = wave & 3, l31 = lane & 31, lh = lane >> 5;
    constexpr int SBUF = 2 * 256 * GST;
    bf16_t* const s0 = (bf16_t*)smem;
    constexpr int nkfull = K / 64, KCH = 2;
    const int nMt = (EPI == EPI_RESADD) ? 64 : 65;
    const int nfull = nMt * nN, nch = (EPI == EPI_RESADD) ? (nkfull + KCH - 1) / KCH : 0, nunits = nfull + nch * nN;
    const int bid = rbid(), xcd = bid & 7, lb = bid >> 3, nper = (int)gridDim.x >> 3;
    const int u0 = only_split ? nfull : 0;
    for (int rnd = 0; u0 + rnd * (int)gridDim.x < nunits; ++rnd) {
        const int u = u0 + (rnd * 8 + xcd) * nper + lb;
        if (u >= nunits) continue;
        int mt, nt, kt0, kt1; bool atomic = false;
        if (u < nfull) {
            const int per_group = 8 * nN, gm = u / per_group, rem = u - gm * per_group, fm = gm * 8, gsz = (nMt - fm) < 8 ? (nMt - fm) : 8;
            mt = fm + rem % gsz; nt = rem / gsz; kt0 = 0; kt1 = nkfull;
        } else {
            const int v = u - nfull, ch = v / nN; mt = 64; nt = v - ch * nN; kt0 = ch * KCH; kt1 = (kt0 + KCH < nkfull) ? kt0 + KCH : nkfull; atomic = true;
        }
        const int nk = kt1 - kt0;
        const char* Ab = (const char*)A + (size_t)kt0 * 128; const char* Bb = (const char*)(Bt + (size_t)nt * 256 * K) + (size_t)kt0 * 128;
        unsigned aoff[4];
#pragma unroll
        for (int i = 0; i < 4; ++i) { int gr = mt * 256 + (tid >> 3) + 64 * i; gr = gr < T ? gr : T - 1; aoff[i] = (unsigned)gr * (unsigned)(K * 2) + (unsigned)((tid & 7) * 16); }
        const unsigned boff = (unsigned)(tid >> 3) * (unsigned)(K * 2) + (unsigned)((tid & 7) * 16);
        const unsigned lso = (unsigned)((tid >> 3) * GST + (tid & 7) * 8);
        f32x16 acc[4][2];
#pragma unroll
        for (int i = 0; i < 4; ++i)
#pragma unroll
            for (int j = 0; j < 2; ++j)
#pragma unroll
                for (int e = 0; e < 16; ++e) acc[i][j][e] = 0.f;
        u32x4 ra[4], rb[4];
#define G_LOAD(KT) { const int kk_ = (KT) < nk ? (KT) : nk - 1; const char* ab_ = Ab + (size_t)kk_ * 128; const char* bb_ = Bb + (size_t)kk_ * 128; \
            _Pragma("unroll") for (int i = 0; i < 4; ++i) ra[i] = *(const u32x4*)(ab_ + aoff[i]); \
            _Pragma("unroll") for (int i = 0; i < 4; ++i) rb[i] = *(const u32x4*)(bb_ + (size_t)i * 128 * K + boff); }
#define G_STORE(BUF) { bf16_t* sa_ = s0 + (BUF) * SBUF; bf16_t* sb_ = sa_ + 256 * GST; \
            _Pragma("unroll") for (int i = 0; i < 4; ++i) *(u32x4*)(sa_ + lso + i * 64 * GST) = ra[i]; \
            _Pragma("unroll") for (int i = 0; i < 4; ++i) *(u32x4*)(sb_ + lso + i * 64 * GST) = rb[i]; }
        __syncthreads();
        G_LOAD(0); G_STORE(0); G_LOAD(1);
        __syncthreads();
        for (int kt = 0; kt < nk; ++kt) {
            if (kt + 1 < nk) G_STORE((kt + 1) & 1);
            G_LOAD(kt + 2);
            const bf16_t* cA = s0 + (kt & 1) * SBUF; const bf16_t* cB = cA + 256 * GST;
#pragma unroll
            for (int ks = 0; ks < 4; ++ks) {
                bf16x8 a[4], b[2];
#pragma unroll
                for (int i = 0; i < 4; ++i) a[i] = ldsfrag(cA, 128 * wm + 32 * i + l31, GST, ks * 16 + 8 * lh);
#pragma unroll
                for (int j = 0; j < 2; ++j) b[j] = ldsfrag(cB, 64 * wn + 32 * j + l31, GST, ks * 16 + 8 * lh);
#pragma unroll
                for (int i = 0; i < 4; ++i)
#pragma unroll
                    for (int j = 0; j < 2; ++j) acc[i][j] = mfma32(a[i], b[j], acc[i][j]);
            }
            __syncthreads();
        }
        static_assert(EPI == EPI_RESADD, "own GEMM is only used for the residual-add phases");
        if (mt * 256 + 128 * wm < T) {
#pragma unroll
            for (int i = 0; i < 4; ++i)
#pragma unroll
                for (int j = 0; j < 2; ++j)
#pragma unroll
                    for (int e = 0; e < 16; ++e) {
                        const int row = mt * 256 + 128 * wm + 32 * i + (e & 3) + 8 * (e >> 2) + 4 * lh, col = nt * 256 + 64 * wn + 32 * j + l31;
                        if (row < T) {
                            float* xf = out_ + (size_t)row * D + col;
                            if (atomic) unsafeAtomicAdd(xf, acc[i][j][e]); else *xf += acc[i][j][e];
                        }
                    }
        }
    }
    __syncthreads();
}


namespace pg8 {
#define PG8_LAS __attribute__((address_space(3)))
constexpr int BM = 256, BK = 64, HALF = 128, HTB = HALF * BK * 2  , STAGE_BYTES = 8 * HTB, NXCD = 8, WGM = 8;

__host__ __device__ __forceinline__ int lds_byte(int r, int c) { const int st = (r >> 4) * 2 + (c >> 5), rr = r & 15, cc = c & 31, ob = rr * 64 + cc * 2; return st * 1024 + (ob ^ (((ob >> 9) & 1) << 5)); }
__host__ __device__ __forceinline__ void stage_rc(int b, int& R, int& C) { const int st = b / 1024, sb = b % 1024, swz = sb ^ (((sb >> 9) & 1) << 5); R = (st >> 1) * 16 + swz / 64; C = (st & 1) * 32 + (swz % 64) / 2; }
__host__ __device__ __forceinline__ int perm32(int rho) { const int n = rho >> 4, i = rho & 15; return 8 * (i >> 2) + 4 * n + (i & 3); }

struct Unit { int pm, pn; };
struct Gemm { const bf16_t* A; const bf16_t* Bt; int M, N, K; };
struct StaticOrder {
    int nM, nN, nwg, G, c;
    __host__ __device__ void init(int M, int N, int G_, int c_) { nM = M / BM; nN = N / BM; nwg = nM * nN; G = G_; c = c_; }
    __host__ __device__ bool next(int i, Unit& u) const {
        const long L = (long)i * G + c; if (L >= nwg) return false;
        int wgid = (int)L; { const int q = nwg / NXCD, r = nwg % NXCD, xcd = wgid % NXCD, off = wgid / NXCD; wgid = (xcd < r ? xcd * (q + 1) : r * (q + 1) + (xcd - r) * q) + off; }
        const int nig = WGM * nN, gid = wgid / nig, fm = gid * WGM, gsz = (nM - fm) < WGM ? (nM - fm) : WGM;
        u.pm = fm + ((wgid % nig) % gsz); u.pn = (wgid % nig) / gsz; return true;
    }
    __device__ __forceinline__ void a_ready(const Unit&) const {}
    __device__ __forceinline__ void done(const Unit&) const {}
};
template <class Epi, class Sched, bool STAMP = false>
__device__ __forceinline__ void gemm_phase(PG8_LAS unsigned char* lds, const Gemm g, const Sched& S, const Epi& E, unsigned long long* stamps) {
    const int tid = rtid(), wid = __builtin_amdgcn_readfirstlane(tid >> 6), lane = tid & 63, wr = wid >> 2, wc = wid & 3, fr = lane & 15, fq = lane >> 4;
    const int K = g.K, nt = K / BK;
    int ts_lo = 0, ts_hi = 0, nts = 0; const unsigned long long rt_entry = STAMP ? (unsigned long long)0ull : 0ull;
#define PG8_STAMP() do { if (STAMP && wid == 0 && nts < 64) { const unsigned long long _c = (unsigned long long)clock64(); \
        ts_lo = (lane == nts) ? (int)(unsigned)_c : ts_lo; ts_hi = (lane == nts) ? (int)(unsigned)(_c >> 32) : ts_hi; ++nts; } } while (0)
    PG8_STAMP();
    unsigned voffA[2], voffB[2];
#pragma unroll
    for (int i = 0; i < 2; ++i) { int R, C; stage_rc(tid * 16 + i * 8192, R, C); const int Rb = Epi::PERM ? ((R & ~31) + perm32(R & 31)) : R;
        voffA[i] = (unsigned)(R * K + C) * 2u; voffB[i] = (unsigned)(Rb * K + C) * 2u; }
    const size_t kstep = (size_t)(BK * 2);
    const size_t hstep = (size_t)HALF * K * 2;
    const size_t tstep = 2 * hstep;
    const unsigned ldsw = (unsigned)wid * 1024u;
    const int aoff = lds_byte(wr * 64 + fr, fq * 8), boff = lds_byte(wc * 32 + fr, fq * 8);
#define PG8_SA(b, h) (((b) * 2 + (h)) * HTB)
#define PG8_SB(b, h) ((4 + (b) * 2 + (h)) * HTB)
#define PG8_STAGE(bufoff, gbase, voff) do { _Pragma("unroll") for (int _i = 0; _i < 2; ++_i) \
        __builtin_amdgcn_global_load_lds((const unsigned*)((const char*)(gbase) + (voff)[_i]), (PG8_LAS unsigned*)(lds + (bufoff) + ldsw + _i * 8192), 16, 0, 0); } while (0)
#define PG8_LDA(dst, b, h) do { _Pragma("unroll") for (int m = 0; m < 4; ++m) _Pragma("unroll") for (int k = 0; k < 2; ++k) dst[m][k] = *(const PG8_LAS bf16x8*)(lds + PG8_SA(b, h) + aoff + m * 2048 + k * 1024); } while (0)
#define PG8_LDB(dst, b, h) do { _Pragma("unroll") for (int n = 0; n < 2; ++n) _Pragma("unroll") for (int k = 0; k < 2; ++k) dst[n][k] = *(const PG8_LAS bf16x8*)(lds + PG8_SB(b, h) + boff + n * 2048 + k * 1024); } while (0)
#define PG8_MMA(ai, bj, At, Bt) do { __builtin_amdgcn_s_setprio(1); _Pragma("unroll") for (int m = 0; m < 4; ++m) _Pragma("unroll") for (int n = 0; n < 2; ++n) _Pragma("unroll") for (int k = 0; k < 2; ++k) \
        acc[ai][bj][m][n] = __builtin_amdgcn_mfma_f32_16x16x32_bf16(Bt[n][k], At[m][k], acc[ai][bj][m][n], 0, 0, 0); __builtin_amdgcn_s_setprio(0); } while (0)
#define PG8_WAIT_V(n) asm volatile("s_waitcnt vmcnt(" #n ")" ::: "memory")
#define PG8_WAIT_L(n) asm volatile("s_waitcnt lgkmcnt(" #n ")" ::: "memory")
#define PG8_BAR __builtin_amdgcn_s_barrier()
#define PG8_SCHED __builtin_amdgcn_sched_barrier(0)
    Unit cur, nxt; int ui = 0;
    if (!S.next(0, cur)) return;
    f32x4 acc[2][2][4][2];
#pragma unroll
    for (int a = 0; a < 2; ++a)
#pragma unroll
        for (int b = 0; b < 2; ++b)
#pragma unroll
            for (int m = 0; m < 4; ++m)
#pragma unroll
                for (int n = 0; n < 2; ++n) acc[a][b][m][n] = (f32x4){0.f, 0.f, 0.f, 0.f};
    bf16x8 At[4][2], B0[2][2], B1[2][2];
    const char* cA = (const char*)g.A + (size_t)cur.pm * tstep; const char* cB = (const char*)g.Bt + (size_t)cur.pn * tstep;
    S.a_ready(cur);
    PG8_STAGE(PG8_SB(0, 0), cB, voffB); PG8_STAGE(PG8_SA(0, 0), cA, voffA); PG8_STAGE(PG8_SB(0, 1), cB + hstep, voffB); PG8_STAGE(PG8_SA(0, 1), cA + hstep, voffA);
    if (wr == 1) PG8_BAR;
    PG8_WAIT_V(4); PG8_BAR;
    PG8_STAGE(PG8_SB(1, 0), cB + kstep, voffB); PG8_STAGE(PG8_SA(1, 0), cA + kstep, voffA); PG8_STAGE(PG8_SB(1, 1), cB + hstep + kstep, voffB);
    PG8_WAIT_V(6); PG8_BAR;
    PG8_STAMP();
    for (;;) {
        const bool has_next = S.next(ui + 1, nxt);
        const char* nA = has_next ? (const char*)g.A + (size_t)nxt.pm * tstep : cA; const char* nB = has_next ? (const char*)g.Bt + (size_t)nxt.pn * tstep : cB;
        for (int t = 0; t < nt; t += 2) {
            const bool last = (t == nt - 2);
            const char* a1 = cA + (size_t)(t + 1) * kstep;
            const char* a2 = last ? nA : cA + (size_t)(t + 2) * kstep; const char* b2 = last ? nB : cB + (size_t)(t + 2) * kstep;
            const char* a3 = a2 + kstep; const char* b3 = b2 + kstep;
            if (last && has_next) S.a_ready(nxt);
            PG8_LDB(B0, 0, 0); PG8_SCHED; PG8_LDA(At, 0, 0); PG8_STAGE(PG8_SA(1, 1), a1 + hstep, voffA);
            PG8_WAIT_L(8); PG8_BAR; PG8_WAIT_L(0); PG8_MMA(0, 0, At, B0); PG8_BAR; PG8_SCHED;
            PG8_LDB(B1, 0, 1); PG8_STAGE(PG8_SB(0, 0), b2, voffB);
            PG8_BAR; PG8_WAIT_L(0); PG8_MMA(0, 1, At, B1); PG8_BAR;
            PG8_LDA(At, 0, 1); PG8_STAGE(PG8_SA(0, 0), a2, voffA);
            PG8_BAR; PG8_WAIT_L(0); PG8_MMA(1, 0, At, B0); PG8_BAR; PG8_SCHED;
            PG8_STAGE(PG8_SB(0, 1), b2 + hstep, voffB);
            PG8_WAIT_V(6); PG8_BAR; PG8_MMA(1, 1, At, B1); PG8_BAR;
            PG8_LDB(B0, 1, 0); PG8_SCHED; PG8_LDA(At, 1, 0); PG8_STAGE(PG8_SA(0, 1), a2 + hstep, voffA);
            PG8_WAIT_L(8); PG8_BAR; PG8_WAIT_L(0); PG8_MMA(0, 0, At, B0); PG8_BAR; PG8_SCHED;
            PG8_LDB(B1, 1, 1); PG8_STAGE(PG8_SB(1, 0), b3, voffB);
            PG8_BAR; PG8_WAIT_L(0); PG8_MMA(0, 1, At, B1); PG8_BAR;
            PG8_LDA(At, 1, 1); PG8_STAGE(PG8_SA(1, 0), a3, voffA);
            PG8_BAR; PG8_WAIT_L(0); PG8_MMA(1, 0, At, B0); PG8_BAR; PG8_SCHED;
            PG8_STAGE(PG8_SB(1, 1), b3 + hstep, voffB);
            PG8_WAIT_V(6); PG8_BAR; PG8_MMA(1, 1, At, B1); PG8_BAR;
        }
        PG8_STAMP();
        if constexpr (!Epi::AFTER_DRAIN) { E(acc, cur, wr, wc, fr, fq); S.done(cur); }
        PG8_STAMP();
        if (!has_next) break;
#pragma unroll
        for (int a = 0; a < 2; ++a)
#pragma unroll
            for (int b = 0; b < 2; ++b)
#pragma unroll
                for (int m = 0; m < 4; ++m)
#pragma unroll
                    for (int n = 0; n < 2; ++n) acc[a][b][m][n] = (f32x4){0.f, 0.f, 0.f, 0.f};
        cur = nxt; cA = nA; cB = nB; ++ui;
    }
    PG8_WAIT_V(0);
    if (wr == 0) PG8_BAR;
    PG8_BAR;
    if constexpr (Epi::AFTER_DRAIN) { E.fused(acc, cur, wr, wc, fr, fq, lds, wid, lane); S.done(cur); }
    PG8_STAMP();
    if (STAMP && wid == 0) { stamps[lane] = lane < nts ? (((unsigned long long)(unsigned)ts_hi << 32) | (unsigned)ts_lo) : 0ull;
        if (lane == 62) stamps[62] = rt_entry; if (lane == 63) stamps[63] = (unsigned long long)0ull; }
#undef PG8_STAMP
#undef PG8_SA
#undef PG8_SB
#undef PG8_STAGE
#undef PG8_LDA
#undef PG8_LDB
#undef PG8_MMA
#undef PG8_WAIT_V
#undef PG8_WAIT_L
#undef PG8_BAR
#undef PG8_SCHED
}
}

template <int EPI> struct EpiMk {
    static constexpr bool PERM = (EPI == EPI_SSM_IN || EPI == EPI_GLA_IN || EPI == EPI_ATT_IN || EPI == EPI_SWIGLU), AFTER_DRAIN = false;
    unsigned char* ws; float* out;
    DEVI void operator()(const f32x4 (&acc)[2][2][4][2], const pg8::Unit& u, int wr, int wc, int fr, int fq) const {
        const int row0 = u.pm * 256 + wr * 64 + fr, col0 = u.pn * 256 + wc * 32 + 4 * fq;
#pragma unroll
        for (int ai = 0; ai < 2; ++ai)
#pragma unroll
            for (int m = 0; m < 4; ++m) {
                const int row = row0 + ai * 128 + m * 16;
                if (row < T) {
                    if (EPI == EPI_SWIGLU) {
                        const int hc = u.pn * 128 + wc * 32 + 8 * fq;
                        unsigned w[4];
#pragma unroll
                        for (int n = 0; n < 2; ++n) {
                            const f32x4 g = acc[ai][0][m][n], up = acc[ai][1][m][n];
                            float o[4];
#pragma unroll
                            for (int e = 0; e < 4; ++e) o[e] = g[e] * __builtin_amdgcn_rcpf(1.f + __expf(-g[e])) * up[e];
                            w[2 * n] = pack2(o[0], o[1]); w[2 * n + 1] = pack2(o[2], o[3]);
                        }
                        *(uint4*)((bf16_t*)(ws + B_R4) + (size_t)row * DFF + hc) = make_uint4(w[0], w[1], w[2], w[3]);
                    } else
#pragma unroll
                    for (int bj = 0; bj < 2; ++bj) {
                        if (PERM) {
                            const int col = u.pn * 256 + bj * 128 + wc * 32 + 8 * fq;
                            const f32x4 v0 = acc[ai][bj][m][0], v1 = acc[ai][bj][m][1];
                            const uint4 pk = make_uint4(pack2(v0[0], v0[1]), pack2(v0[2], v0[3]), pack2(v1[0], v1[1]), pack2(v1[2], v1[3]));
                            if (EPI == EPI_SSM_IN) {
                                if (col < DI) *(uint4*)((bf16_t*)(ws + B_R3) + (size_t)row * DI + col) = pk;
                                else if (col < DI + CONVD) *(uint4*)((bf16_t*)(ws + B_R4) + (size_t)row * CONVD + (col - DI)) = pk;
                                else if (col < SSM_IN) { float4* dp = (float4*)((float*)(ws + B_DT) + (size_t)row * 32 + (col - DI - CONVD)); dp[0] = make_float4(v0[0], v0[1], v0[2], v0[3]); dp[1] = make_float4(v1[0], v1[1], v1[2], v1[3]); }
                            } else if (EPI == EPI_GLA_IN) {
                                if (col < 3072) *(uint4*)((bf16_t*)(ws + B_R4) + (size_t)row * 3072 + col) = pk;
                                else if (col < GLA_IN) { float4* dp = (float4*)((float*)(ws + B_GLOW) + (size_t)row * 16 + (col - 3072)); dp[0] = make_float4(v0[0], v0[1], v0[2], v0[3]); dp[1] = make_float4(v1[0], v1[1], v1[2], v1[3]); }
                            } else {
                                *(uint4*)((bf16_t*)(ws + B_R4) + (size_t)row * QKVD + col) = pk;
                            }
                        } else if (EPI == EPI_SWIGLU) {
                            const f32x4 g = acc[ai][bj][m][0], up = acc[ai][bj][m][1];
                            const int hc = u.pn * 128 + bj * 64 + wc * 16 + 4 * fq;
                            float o[4];
#pragma unroll
                            for (int e = 0; e < 4; ++e) o[e] = g[e] * __builtin_amdgcn_rcpf(1.f + __expf(-g[e])) * up[e];
                            *(uint2*)((bf16_t*)(ws + B_R4) + (size_t)row * DFF + hc) = make_uint2(pack2(o[0], o[1]), pack2(o[2], o[3]));
                        } else {
#pragma unroll
                            for (int n = 0; n < 2; ++n) {
                                const int col = col0 + bj * 128 + n * 16;
                                const f32x4 v = acc[ai][bj][m][n];
                                if (EPI == EPI_RESADD) {
                                    float4* xp = (float4*)(out + (size_t)row * D + col);
                                    float4 x = *xp; x.x += v[0]; x.y += v[1]; x.z += v[2]; x.w += v[3]; *xp = x;
                                } else if (EPI == EPI_SSM_IN) {
                                    const uint2 pk = make_uint2(pack2(v[0], v[1]), pack2(v[2], v[3]));
                                    if (col < DI) *(uint2*)((bf16_t*)(ws + B_R3) + (size_t)row * DI + col) = pk;
                                    else if (col < DI + CONVD) *(uint2*)((bf16_t*)(ws + B_R4) + (size_t)row * CONVD + (col - DI)) = pk;
                                    else if (col < SSM_IN) *(float4*)((float*)(ws + B_DT) + (size_t)row * 32 + (col - DI - CONVD)) = make_float4(v[0], v[1], v[2], v[3]);
                                } else if (EPI == EPI_GLA_IN) {
                                    if (col < 3072) *(uint2*)((bf16_t*)(ws + B_R4) + (size_t)row * 3072 + col) = make_uint2(pack2(v[0], v[1]), pack2(v[2], v[3]));
                                    else if (col < GLA_IN) *(float4*)((float*)(ws + B_GLOW) + (size_t)row * 16 + (col - 3072)) = make_float4(v[0], v[1], v[2], v[3]);
                                } else {
                                    *(uint2*)((bf16_t*)(ws + B_R4) + (size_t)row * QKVD + col) = make_uint2(pack2(v[0], v[1]), pack2(v[2], v[3]));
                                }
                            }
                        }
                    }
                }
            }
    }
};

template <int EPI>
DEVI void gemm8(const Params& p, const bf16_t* A, const bf16_t* Bt, int Mrows, int N, int K) {
    int z_; asm volatile("s_mov_b32 %0, 0" : "=s"(z_));
    EpiMk<EPI> E; E.ws = p.ws + z_; E.out = p.out + z_;
    pg8::Gemm g; g.A = A + z_; g.Bt = Bt + z_; g.M = Mrows; g.N = N; g.K = K;
    pg8::StaticOrder S; S.init(Mrows, N, (int)gridDim.x, rbid());
    __syncthreads();
    pg8::gemm_phase<EpiMk<EPI>, pg8::StaticOrder, false>((PG8_LAS unsigned char*)smem, g, S, E, nullptr);
    __syncthreads();
}

DEVI void ssm_conv_phase(const Params& p, int j) {
    int z_; asm volatile("s_mov_b32 %0, 0" : "=s"(z_)); unsigned char* ws_ = p.ws + z_; float* out_ = p.out + z_; (void)ws_; (void)out_; KIN_DECL;
    const bf16_t* raw = (const bf16_t*)(ws_ + B_R4);
    bf16_t* act = (bf16_t*)(ws_ + B_R5);
    const float* cw = in_[14] + (size_t)j * 4 * CONVD; const float* cb = in_[15] + (size_t)j * CONVD;
    const float* sbuf = in_[3] + (size_t)j * 32 * 3 * CONVD;
    float* convp = out_ + O_CONVP + (size_t)j * 2 * 3 * CONVD; float* convs = out_ + O_CONVS + (size_t)j * 32 * 3 * CONVD;
    const size_t gtid = (size_t)bidx() * 256 + tidx(), gsz = (size_t)VGRID * 256;
    {
        const size_t totp = (size_t)(TP / 16) * (CONVD / 8);
        for (size_t it = gtid; it < totp; it += gsz) {
            const int run = (int)(it / (CONVD / 8)), c8 = (int)(it % (CONVD / 8)) * 8;
            const int t0 = run * 16, pos0 = t0 & (SEQ - 1);
            float w[4][8], bb[8], x1[8], x2[8], x3[8];
#pragma unroll
            for (int d = 0; d < 4; ++d)
#pragma unroll
                for (int e = 0; e < 8; ++e) w[d][e] = cw[(size_t)d * CONVD + c8 + e];
#pragma unroll
            for (int e = 0; e < 8; ++e) bb[e] = cb[c8 + e];
            if (pos0 >= 3) {
                unpack8(*(const uint4*)(raw + (size_t)(t0 - 1) * CONVD + c8), x1); unpack8(*(const uint4*)(raw + (size_t)(t0 - 2) * CONVD + c8), x2); unpack8(*(const uint4*)(raw + (size_t)(t0 - 3) * CONVD + c8), x3);
            } else {
#pragma unroll
                for (int e = 0; e < 8; ++e) { x1[e] = 0.f; x2[e] = 0.f; x3[e] = 0.f; }
            }
#pragma unroll 4
            for (int r = 0; r < 16; ++r) {
                const int t = t0 + r;
                float x0[8]; unpack8(*(const uint4*)(raw + (size_t)t * CONVD + c8), x0);
                unsigned o[4];
#pragma unroll
                for (int e = 0; e < 4; ++e) {
                    const float a0 = bb[2 * e] + w[3][2 * e] * x0[2 * e] + w[2][2 * e] * x1[2 * e] + w[1][2 * e] * x2[2 * e] + w[0][2 * e] * x3[2 * e];
                    const float a1 = bb[2 * e + 1] + w[3][2 * e + 1] * x0[2 * e + 1] + w[2][2 * e + 1] * x1[2 * e + 1] + w[1][2 * e + 1] * x2[2 * e + 1] + w[0][2 * e + 1] * x3[2 * e + 1];
                    o[e] = pack2(silu_f(a0), silu_f(a1));
                }
                *(uint4*)(act + (size_t)t * CONVD + c8) = make_uint4(o[0], o[1], o[2], o[3]);
                const int pos = pos0 + r;
                if (pos >= SEQ - 3) {
                    float* op = convp + ((size_t)(t >> 13) * 3 + (pos - (SEQ - 3))) * CONVD + c8;
#pragma unroll
                    for (int e = 0; e < 8; ++e) op[e] = x0[e];
                }
#pragma unroll
                for (int e = 0; e < 8; ++e) { x3[e] = x2[e]; x2[e] = x1[e]; x1[e] = x0[e]; }
            }
        }
    }
    const size_t tot = (size_t)TS * (CONVD / 8);
    for (size_t it = gtid; it < tot; it += gsz) {
        const int t = TP + (int)(it / (CONVD / 8)), c8 = (int)(it % (CONVD / 8)) * 8;
        int pos, sb = 0; bool samp = t >= TP;
        if (samp) { sb = (t - TP) >> 2; pos = (t - TP) & 3; } else pos = t & (SEQ - 1);
        float accv[8], xr[4][8];
#pragma unroll
        for (int e = 0; e < 8; ++e) accv[e] = cb[c8 + e];
#pragma unroll
        for (int d = 0; d < 4; ++d) {
            if (pos - d >= 0) unpack8(*(const uint4*)(raw + (size_t)(t - d) * CONVD + c8), xr[d]);
            else if (samp) {
                const float* bp = sbuf + ((size_t)sb * 3 + (3 + pos - d)) * CONVD + c8;
#pragma unroll
                for (int e = 0; e < 8; ++e) xr[d][e] = bp[e];
            } else {
#pragma unroll
                for (int e = 0; e < 8; ++e) xr[d][e] = 0.f;
            }
            const float* wp = cw + (size_t)(3 - d) * CONVD + c8;
#pragma unroll
            for (int e = 0; e < 8; ++e) accv[e] += xr[d][e] * wp[e];
        }
        unsigned w[4];
#pragma unroll
        for (int e = 0; e < 4; ++e) w[e] = pack2(silu_f(accv[2 * e]), silu_f(accv[2 * e + 1]));
        *(uint4*)(act + (size_t)t * CONVD + c8) = make_uint4(w[0], w[1], w[2], w[3]);
        if (!samp && pos >= SEQ - 3) {
            float* o = convp + ((size_t)(t >> 13) * 3 + (pos - (SEQ - 3))) * CONVD + c8;
#pragma unroll
            for (int e = 0; e < 8; ++e) o[e] = xr[0][e];
        }
        if (samp && pos >= 1) {
            float* o = convs + ((size_t)sb * 3 + (pos - 1)) * CONVD + c8;
#pragma unroll
            for (int e = 0; e < 8; ++e) o[e] = xr[0][e];
        }
    }
    const float* DT = (const float*)(ws_ + B_DT); float* DTS = (float*)(ws_ + B_DTS); float* ACS = (float*)(ws_ + B_ACS);
    if (gtid < TS * 4) ((float*)(ws_ + B_SSQS))[gtid] = 0.f;
    const float* dtb = in_[16] + j * 32; const float* alog = in_[17] + j * 32;
    {
        const int lane = tidx() & 63, wv = (bidx() * 256 + tidx()) >> 6, nw = VGRID * 4;
        for (int it = wv; it < 128 * 32; it += nw) {
            const int c = it >> 5, h = it & 31;
            const float Ah = -__expf(alog[h]), bh = dtb[h];
            float carry = 0.f;
#pragma unroll
            for (int ps = 0; ps < 2; ++ps) {
                const size_t o = (size_t)(c * 128 + ps * 64 + lane) * 32 + h;
                const float d = softplus_f(DT[o] + bh); DTS[o] = d;
                float a = Ah * d;
#pragma unroll
                for (int off = 1; off < 64; off <<= 1) { const float t = __shfl_up(a, off); if (lane >= off) a += t; }
                a += carry; ACS[o] = a; carry = __shfl(a, 63);
            }
        }
    }
    for (size_t it = gtid; it < TS * 32; it += gsz) {
        const int r = (int)it, h = r & 31; const size_t o = (size_t)(TP + (r >> 5)) * 32 + h;
        const float d = softplus_f(DT[o] + dtb[h]); DTS[o] = d; ACS[o] = -__expf(alog[h]) * d;
    }
}

constexpr int SST = 136;
DEVI void ssm_state_phase(const Params& p, int j) {
    int z_; asm volatile("s_mov_b32 %0, 0" : "=s"(z_)); unsigned char* ws_ = p.ws + z_; float* out_ = p.out + z_; (void)ws_; (void)out_; KIN_DECL;
    const bf16_t* act = (const bf16_t*)(ws_ + B_R5);
    const float* DTS = (const float*)(ws_ + B_DTS); const float* ACS = (const float*)(ws_ + B_ACS);
    bf16_t* ST = (bf16_t*)(ws_ + B_R6);
    const int tid = tidx(), lane = tid & 63, wave = tid >> 6, l31 = lane & 31, lh = lane >> 5;
    bf16_t* sBt = (bf16_t*)VSMEM;
    bf16_t* sXt = sBt + 128 * SST;
    float* sw = (float*)(sXt + 64 * SST);
    const int nprompt = 128 * 4, nitems = nprompt + 32 * 32;
    for (int item = bidx(); item < nitems; item += VGRID) {
        if (item < nprompt) {
            const int c = item >> 2, g = item & 3, t0 = c * 128;
            __syncthreads();
            for (int idx = tid; idx < 128 * 16; idx += 256) {
                const int q = idx >> 4, n8 = (idx & 15) * 8;
                const uint4 v = *(const uint4*)(act + (size_t)(t0 + q) * CONVD + DI + g * 128 + n8);
                const unsigned short* s = (const unsigned short*)&v;
#pragma unroll
                for (int e = 0; e < 8; ++e) sBt[(n8 + e) * SST + q] = s[e];
            }
            for (int hh = 0; hh < 8; ++hh) {
                const int h = g * 8 + hh;
                __syncthreads();
                if (tid < 128) sw[tid] = DTS[(size_t)(t0 + tid) * 32 + h] * __expf(ACS[(size_t)(t0 + 127) * 32 + h] - ACS[(size_t)(t0 + tid) * 32 + h]);
                __syncthreads();
                for (int idx = tid; idx < 128 * 8; idx += 256) {
                    const int q = idx >> 3, p8 = (idx & 7) * 8;
                    float f[8]; unpack8(*(const uint4*)(act + (size_t)(t0 + q) * CONVD + h * 64 + p8), f);
                    const float w = sw[q];
#pragma unroll
                    for (int e = 0; e < 8; ++e) sXt[(p8 + e) * SST + q] = f2bf(f[e] * w);
                }
                __syncthreads();
                f32x16 acc[2];
#pragma unroll
                for (int i = 0; i < 2; ++i)
#pragma unroll
                    for (int e = 0; e < 16; ++e) acc[i][e] = 0.f;
#pragma unroll
                for (int ks = 0; ks < 8; ++ks) {
                    const bf16x8 a = ldsfrag(sBt, 32 * wave + l31, SST, ks * 16 + 8 * lh);
#pragma unroll
                    for (int i = 0; i < 2; ++i) acc[i] = mfma32(a, ldsfrag(sXt, 32 * i + l31, SST, ks * 16 + 8 * lh), acc[i]);
                }
#pragma unroll
                for (int i = 0; i < 2; ++i)
#pragma unroll
                    for (int rg = 0; rg < 4; ++rg) {
                        const int n = 32 * wave + 8 * rg + 4 * lh, pp = 32 * i + l31;
                        *(uint2*)(ST + (((size_t)c * 32 + h) * 64 + pp) * 128 + n) = make_uint2(pack2(acc[i][4 * rg], acc[i][4 * rg + 1]), pack2(acc[i][4 * rg + 2], acc[i][4 * rg + 3]));
                    }
            }
        } else {
            const int sit = item - nprompt, sb = sit >> 5, h = sit & 31, g = h >> 3, pp = tid >> 2, nq = tid & 3;
            const float* st_in = in_[2] + (size_t)j * 32 * 262144; float* st_out = out_ + O_SSMS + (size_t)j * 32 * 262144;
            const bf16_t* Z = (const bf16_t*)(ws_ + B_R3); bf16_t* Y = (bf16_t*)(ws_ + B_R4);
            float* SSQS = (float*)(ws_ + B_SSQS);
            const size_t sbase = (((size_t)sb * 32 + h) * 64 + pp) * 128;
            float hs[32];
#pragma unroll
            for (int i = 0; i < 8; ++i) { const float4 v = *(const float4*)(st_in + sbase + 4 * nq + 16 * i); hs[4 * i] = v.x; hs[4 * i + 1] = v.y; hs[4 * i + 2] = v.z; hs[4 * i + 3] = v.w; }
            const float Dh = in_[18][j * 32 + h];
#pragma unroll 1
            for (int s = 0; s < 4; ++s) {
                const int tok = TP + sb * 4 + s;
                const float dt = DTS[(size_t)tok * 32 + h], dA = __expf(ACS[(size_t)tok * 32 + h]);
                const float x = bf2f(act[(size_t)tok * CONVD + h * 64 + pp]), xdt = x * dt;
                float yp = 0.f;
#pragma unroll
                for (int i = 0; i < 8; ++i) {
                    float bf[4], cf[4];
                    unpack4(*(const uint2*)(act + (size_t)tok * CONVD + DI + g * 128 + 4 * nq + 16 * i), bf);
                    unpack4(*(const uint2*)(act + (size_t)tok * CONVD + DI + 512 + g * 128 + 4 * nq + 16 * i), cf);
#pragma unroll
                    for (int e = 0; e < 4; ++e) { hs[4 * i + e] = dA * hs[4 * i + e] + xdt * bf[e]; yp += hs[4 * i + e] * cf[e]; }
                }
                yp += __shfl_xor(yp, 1); yp += __shfl_xor(yp, 2);
                const float yv = (yp + Dh * x) * silu_f(bf2f(Z[(size_t)tok * DI + h * 64 + pp]));
                if (nq == 0) Y[(size_t)tok * DI + h * 64 + pp] = f2bf(yv);
                const float tot = wave_sum(nq == 0 ? yv * yv : 0.f);
                if ((tid & 63) == 0) unsafeAtomicAdd(SSQS + (tok - TP) * 4 + g, tot);
            }
#pragma unroll
            for (int i = 0; i < 8; ++i) *(float4*)(st_out + sbase + 4 * nq + 16 * i) = make_float4(hs[4 * i], hs[4 * i + 1], hs[4 * i + 2], hs[4 * i + 3]);
        }
    }
}

DEVI void ssm_scan_phase(const Params& p, int j) {
    int z_; asm volatile("s_mov_b32 %0, 0" : "=s"(z_)); unsigned char* ws_ = p.ws + z_; float* out_ = p.out + z_; (void)ws_; (void)out_; KIN_DECL;
    bf16_t* ST = (bf16_t*)(ws_ + B_R6);
    const float* ACS = (const float*)(ws_ + B_ACS);
    float* outp = out_ + O_SSMP + (size_t)j * 2 * 262144;
    const int gtid = bidx() * 256 + tidx(), gsz = VGRID * 256;
    {
        bf16_t* Y = (bf16_t*)(ws_ + B_R4); const float* SSQS = (const float*)(ws_ + B_SSQS);
        for (int it = gtid; it < TS * 256; it += gsz) {
            const int tk = it >> 8, c8 = (it & 255) * 8;
            const float inv = rsqrtf(SSQS[tk * 4 + (c8 >> 9)] * (1.f / 512.f) + EPS);
            uint4* yp = (uint4*)(Y + (size_t)(TP + tk) * DI + c8);
            float f[8]; unpack8(*yp, f);
            *yp = make_uint4(pack2(f[0] * inv, f[1] * inv), pack2(f[2] * inv, f[3] * inv), pack2(f[4] * inv, f[5] * inv), pack2(f[6] * inv, f[7] * inv));
        }
    }
    for (int it = gtid; it < 2 * 32 * 2048; it += gsz) {
        const int b = it >> 16, h = (it >> 11) & 31, e4 = (it & 2047) * 4;
        float s0 = 0.f, s1 = 0.f, s2 = 0.f, s3 = 0.f;
#pragma unroll 16
        for (int cc = 0; cc < 64; ++cc) {
            const int c = b * 64 + cc;
            uint2* ptr = (uint2*)(ST + ((size_t)c * 32 + h) * 8192 + e4);
            float f[4]; unpack4(*ptr, f);
            *ptr = make_uint2(pack2(s0, s1), pack2(s2, s3));
            const float dec = __expf(ACS[(size_t)(c * 128 + 127) * 32 + h]);
            s0 = dec * s0 + f[0]; s1 = dec * s1 + f[1]; s2 = dec * s2 + f[2]; s3 = dec * s3 + f[3];
        }
        *(float4*)(outp + ((size_t)b * 32 + h) * 8192 + e4) = make_float4(s0, s1, s2, s3);
    }
}

DEVI void ssm_out_phase(const Params& p, int j) {
    int z_; asm volatile("s_mov_b32 %0, 0" : "=s"(z_)); unsigned char* ws_ = p.ws + z_; float* out_ = p.out + z_; (void)ws_; (void)out_; KIN_DECL;
    const bf16_t* act = (const bf16_t*)(ws_ + B_R5);
    const float* DTS = (const float*)(ws_ + B_DTS); const float* ACS = (const float*)(ws_ + B_ACS);
    const bf16_t* ST = (const bf16_t*)(ws_ + B_R6); const bf16_t* Z = (const bf16_t*)(ws_ + B_R3);
    bf16_t* Y = (bf16_t*)(ws_ + B_R4);
    const float* dsk = in_[18] + j * 32;
    const int tid = tidx(), lane = tid & 63, wave = tid >> 6, l31 = lane & 31, lh = lane >> 5;
    bf16_t* RA = (bf16_t*)VSMEM;
    bf16_t* RB = RA + 128 * SST;
    float* sacs = (float*)(RB + 128 * SST);
    float* sdts = sacs + 1024;
    for (int item = bidx(); item < 512; item += VGRID) {
        const int c = item >> 2, g = item & 3, t0 = c * 128;
        __syncthreads();
        for (int idx = tid; idx < 128 * 16; idx += 256) {
            const int q = idx >> 4, n8 = (idx & 15) * 8;
            *(uint4*)(RB + q * SST + n8) = *(const uint4*)(act + (size_t)(t0 + q) * CONVD + DI + g * 128 + n8);
            *(uint4*)(RA + q * SST + n8) = *(const uint4*)(act + (size_t)(t0 + q) * CONVD + DI + 512 + g * 128 + n8);
        }
        for (int idx = tid; idx < 1024; idx += 256) {
            const int hh = idx >> 7, q = idx & 127;
            sacs[idx] = ACS[(size_t)(t0 + q) * 32 + g * 8 + hh]; sdts[idx] = DTS[(size_t)(t0 + q) * 32 + g * 8 + hh];
        }
        __syncthreads();
        f32x16 X[4]; bf16x8 cf[8];
#pragma unroll
        for (int st = 0; st < 4; ++st)
#pragma unroll
            for (int e = 0; e < 16; ++e) X[st][e] = 0.f;
#pragma unroll
        for (int ks = 0; ks < 8; ++ks) {
            cf[ks] = ldsfrag(RA, 32 * wave + l31, SST, ks * 16 + 8 * lh);
#pragma unroll
            for (int st = 0; st < 4; ++st) X[st] = mfma32(ldsfrag(RB, 32 * st + l31, SST, ks * 16 + 8 * lh), cf[ks], X[st]);
        }
        const int q = 32 * wave + l31;
        float ssqk[4] = {0.f, 0.f, 0.f, 0.f};
        for (int hh = 0; hh < 8; ++hh) {
            const int h = g * 8 + hh;
            __syncthreads();
            for (int idx = tid; idx < 128 * 8; idx += 256) {
                const int s = idx >> 3, p8 = (idx & 7) * 8;
                float f[8]; unpack8(*(const uint4*)(act + (size_t)(t0 + s) * CONVD + h * 64 + p8), f);
                const float w = sdts[hh * 128 + s];
#pragma unroll
                for (int e = 0; e < 8; ++e) RA[(p8 + e) * SST + s] = f2bf(f[e] * w);
            }
            for (int idx = tid; idx < 64 * 16; idx += 256) {
                const int pp = idx >> 4, n8 = (idx & 15) * 8;
                *(uint4*)(RA + (64 + pp) * SST + n8) = *(const uint4*)(ST + (((size_t)c * 32 + h) * 64 + pp) * 128 + n8);
            }
            const float aq = sacs[hh * 128 + q];
#pragma unroll
            for (int st = 0; st < 4; ++st)
#pragma unroll
                for (int rg = 0; rg < 4; ++rg) {
                    const int s0 = 32 * st + 8 * rg + 4 * lh;
                    float m[4];
#pragma unroll
                    for (int e = 0; e < 4; ++e) { const int s = s0 + e; m[e] = (s <= q) ? X[st][4 * rg + e] * __expf(aq - sacs[hh * 128 + s]) : 0.f; }
                    *(uint2*)(RB + q * SST + s0) = make_uint2(pack2(m[0], m[1]), pack2(m[2], m[3]));
                }
            __syncthreads();
            f32x16 ad[2], ao[2];
#pragma unroll
            for (int i = 0; i < 2; ++i)
#pragma unroll
                for (int e = 0; e < 16; ++e) { ad[i][e] = 0.f; ao[i][e] = 0.f; }
#pragma unroll
            for (int ks = 0; ks < 8; ++ks) {
                const bf16x8 mb = ldsfrag(RB, q, SST, ks * 16 + 8 * lh);
#pragma unroll
                for (int i = 0; i < 2; ++i) {
                    ad[i] = mfma32(ldsfrag(RA, 32 * i + l31, SST, ks * 16 + 8 * lh), mb, ad[i]);
                    ao[i] = mfma32(ldsfrag(RA, 64 + 32 * i + l31, SST, ks * 16 + 8 * lh), cf[ks], ao[i]);
                }
            }
            const float eq = __expf(aq), Dh = dsk[h];
            float* sYw = (float*)(RB + q * SST);
#pragma unroll
            for (int i = 0; i < 2; ++i)
#pragma unroll
                for (int rg = 0; rg < 4; ++rg) {
                    f32x4 v;
#pragma unroll
                    for (int e = 0; e < 4; ++e) v[e] = ad[i][4 * rg + e] + eq * ao[i][4 * rg + e];
                    *(f32x4*)(sYw + 32 * i + 8 * rg + 4 * lh) = v;
                }
#pragma unroll
            for (int k = 0; k < 4; ++k) {
                const int qr = 32 * wave + (lane >> 3) + 8 * k, c8 = (lane & 7) * 8;
                const float* yr = (const float*)(RB + qr * SST) + c8;
                const f32x4 y0 = *(const f32x4*)yr, y1 = *(const f32x4*)(yr + 4);
                const size_t go = (size_t)(t0 + qr);
                float xf[8], zf[8], y[8];
                unpack8(*(const uint4*)(act + go * CONVD + h * 64 + c8), xf);
                unpack8(*(const uint4*)(Z + go * DI + h * 64 + c8), zf);
                float ps = 0.f;
#pragma unroll
                for (int e = 0; e < 8; ++e) { const float yr_ = e < 4 ? y0[e & 3] : y1[e & 3]; y[e] = (yr_ + Dh * xf[e]) * silu_f(zf[e]); ps += y[e] * y[e]; }
                ps += __shfl_xor(ps, 1); ps += __shfl_xor(ps, 2); ps += __shfl_xor(ps, 4);
                ssqk[k] += ps;
                *(uint4*)(Y + go * DI + h * 64 + c8) = make_uint4(pack2(y[0], y[1]), pack2(y[2], y[3]), pack2(y[4], y[5]), pack2(y[6], y[7]));
                if (k & 1) __builtin_amdgcn_sched_barrier(0);
            }
        }
#pragma unroll
        for (int k = 0; k < 4; ++k) {
            const float inv = rsqrtf(ssqk[k] * (1.f / 512.f) + EPS);
            const int qr = 32 * wave + (lane >> 3) + 8 * k, c8 = (lane & 7) * 8;
            const size_t go = (size_t)(t0 + qr);
            for (int hh = 0; hh < 8; ++hh) {
                uint4* yp = (uint4*)(Y + go * DI + (g * 8 + hh) * 64 + c8);
                float f[8]; unpack8(*yp, f);
                *yp = make_uint4(pack2(f[0] * inv, f[1] * inv), pack2(f[2] * inv, f[3] * inv), pack2(f[4] * inv, f[5] * inv), pack2(f[6] * inv, f[7] * inv));
            }
        }
    }
}

constexpr int GCH = 64;
DEVI void gla_gate_phase(const Params& p) {
    int z_; asm volatile("s_mov_b32 %0, 0" : "=s"(z_)); unsigned char* ws_ = p.ws + z_; float* out_ = p.out + z_; (void)ws_; (void)out_; KIN_DECL;
    const float* GLOW = (const float*)(ws_ + B_GLOW); float* BC = (float*)(ws_ + B_HB);
    const float* wg = in_[22]; const float* gb = in_[23];
    const int tid = tidx();
    const int nitems = TP / GCH + 32;
    for (int item = bidx(); item < nitems; item += VGRID) {
        int t0, len;
        if (item < TP / GCH) { t0 = item * GCH; len = GCH; } else { t0 = TP + (item - TP / GCH) * 4; len = 4; }
        float w0[16], w1[16];
#pragma unroll
        for (int r = 0; r < 16; ++r) { w0[r] = wg[r * 512 + tid]; w1[r] = wg[r * 512 + 256 + tid]; }
        const float b0 = gb[tid], b1 = gb[256 + tid];
        float* sg = (float*)VSMEM;
        __syncthreads();
        if (tid * 4 < len * 16) *(float4*)(sg + tid * 4) = *(const float4*)(GLOW + (size_t)t0 * 16 + tid * 4);
        __syncthreads();
        float r0 = 0.f, r1 = 0.f;
        for (int q = 0; q < len; ++q) {
            const float* gl = sg + q * 16;
            float a0 = b0, a1 = b1;
#pragma unroll
            for (int r = 0; r < 16; ++r) { const float gv = gl[r]; a0 += gv * w0[r]; a1 += gv * w1[r]; }
            r0 += logsigmoid_f(a0) * (1.f / 16.f); r1 += logsigmoid_f(a1) * (1.f / 16.f);
            BC[(size_t)(t0 + q) * 512 + tid] = r0; BC[(size_t)(t0 + q) * 512 + 256 + tid] = r1;
        }
    }
}

constexpr int QST = 72;
DEVI void gla_state_phase(const Params& p) {
    int z_; asm volatile("s_mov_b32 %0, 0" : "=s"(z_)); unsigned char* ws_ = p.ws + z_; float* out_ = p.out + z_; (void)ws_; (void)out_; KIN_DECL;
    const bf16_t* QK = (const bf16_t*)(ws_ + B_R4);
    const float* BC = (const float*)(ws_ + B_HB);
    bf16_t* U = (bf16_t*)(ws_ + B_R6);
    const int tid = tidx(), lane = tid & 63, wave = tid >> 6, l31 = lane & 31, lh = lane >> 5;
    bf16_t* sVt = (bf16_t*)VSMEM;
    bf16_t* sKt = sVt + 256 * QST;
    const int nprompt = (TP / GCH) * 4, nitems = nprompt + 128;
    for (int item = bidx(); item < nitems; item += VGRID) {
        __syncthreads();
        if (item < nprompt) {
            const int c = item >> 2, h = item & 3, t0 = c * GCH;
            for (int idx = tid; idx < GCH * 32; idx += 256) {
                const int q = idx >> 5, v8 = (idx & 31) * 8;
                const uint4 v = *(const uint4*)(QK + (size_t)(t0 + q) * 3072 + 1024 + h * 256 + v8);
                const unsigned short* s = (const unsigned short*)&v;
#pragma unroll
                for (int e = 0; e < 8; ++e) sVt[(v8 + e) * QST + q] = s[e];
            }
            for (int idx = tid; idx < GCH * 16; idx += 256) {
                const int q = idx >> 4, k8 = (idx & 15) * 8;
                float f[8]; unpack8(*(const uint4*)(QK + (size_t)(t0 + q) * 3072 + 512 + h * 128 + k8), f);
                const float* bl = BC + (size_t)(t0 + GCH - 1) * 512 + h * 128 + k8; const float* bq = BC + (size_t)(t0 + q) * 512 + h * 128 + k8;
#pragma unroll
                for (int e = 0; e < 8; ++e) sKt[(k8 + e) * QST + q] = f2bf(f[e] * __expf(bl[e] - bq[e]));
            }
            __syncthreads();
            f32x16 acc[2][4];
#pragma unroll
            for (int i = 0; i < 2; ++i)
#pragma unroll
                for (int kk = 0; kk < 4; ++kk)
#pragma unroll
                    for (int e = 0; e < 16; ++e) acc[i][kk][e] = 0.f;
#pragma unroll
            for (int ks = 0; ks < 4; ++ks) {
                bf16x8 vb[2];
#pragma unroll
                for (int i = 0; i < 2; ++i) vb[i] = ldsfrag(sVt, 64 * wave + 32 * i + l31, QST, ks * 16 + 8 * lh);
#pragma unroll
                for (int kk = 0; kk < 4; ++kk) {
                    const bf16x8 ka = ldsfrag(sKt, 32 * kk + l31, QST, ks * 16 + 8 * lh);
#pragma unroll
                    for (int i = 0; i < 2; ++i) acc[i][kk] = mfma32(ka, vb[i], acc[i][kk]);
                }
            }
#pragma unroll
            for (int i = 0; i < 2; ++i)
#pragma unroll
                for (int kk = 0; kk < 4; ++kk)
#pragma unroll
                    for (int rg = 0; rg < 4; ++rg) {
                        const int v = 64 * wave + 32 * i + l31, k = 32 * kk + 8 * rg + 4 * lh;
                        *(uint2*)(U + (((size_t)c * 4 + h) * 256 + v) * 128 + k) = make_uint2(pack2(acc[i][kk][4 * rg], acc[i][kk][4 * rg + 1]), pack2(acc[i][kk][4 * rg + 2], acc[i][kk][4 * rg + 3]));
                    }
        } else {
            const int sb = (item - nprompt) >> 2, h = (item - nprompt) & 3, v = tid;
            const float* s_in = in_[4] + ((size_t)sb * 4 + h) * 32768; float* s_out = out_ + O_GLAS + ((size_t)sb * 4 + h) * 32768;
            bf16_t* OG = (bf16_t*)(ws_ + B_R3);
            float* sq = (float*)VSMEM; float* sk = sq + 128; float* sa = sk + 128; float* red = sa + 128;
            float S[128];
#pragma unroll
            for (int k = 0; k < 128; ++k) S[k] = s_in[(size_t)k * 256 + v];
            for (int s = 0; s < 4; ++s) {
                const int tok = TP + sb * 4 + s;
                __syncthreads();
                if (tid < 128) {
                    sq[tid] = bf2f(QK[(size_t)tok * 3072 + h * 128 + tid]) * 0.08838834764831845f;
                    sk[tid] = bf2f(QK[(size_t)tok * 3072 + 512 + h * 128 + tid]);
                    const float bcur = BC[(size_t)tok * 512 + h * 128 + tid], bprev = s ? BC[(size_t)(tok - 1) * 512 + h * 128 + tid] : 0.f;
                    sa[tid] = __expf(bcur - bprev);
                }
                __syncthreads();
                const float vv = bf2f(QK[(size_t)tok * 3072 + 1024 + h * 256 + v]);
                float o = 0.f;
#pragma unroll
                for (int k = 0; k < 128; ++k) { S[k] = sa[k] * S[k] + sk[k] * vv; o += sq[k] * S[k]; }
                red[tid] = o * o;
                __syncthreads();
                for (int st = 128; st > 0; st >>= 1) { if (tid < st) red[tid] += red[tid + st]; __syncthreads(); }
                const float inv = rsqrtf(red[0] * (1.f / 256.f) + EPS);
                const float r = bf2f(QK[(size_t)tok * 3072 + 2048 + h * 256 + v]);
                OG[(size_t)tok * D + h * 256 + v] = f2bf(o * inv * silu_f(r));
            }
#pragma unroll
            for (int k = 0; k < 128; ++k) s_out[(size_t)k * 256 + v] = S[k];
        }
    }
}

DEVI void gla_scan_phase(const Params& p) {
    int z_; asm volatile("s_mov_b32 %0, 0" : "=s"(z_)); unsigned char* ws_ = p.ws + z_; float* out_ = p.out + z_; (void)ws_; (void)out_; KIN_DECL;
    bf16_t* U = (bf16_t*)(ws_ + B_R6);
    const float* BC = (const float*)(ws_ + B_HB);
    float* outp = out_ + O_GLAP;
    const int gtid = bidx() * 256 + tidx(), gsz = VGRID * 256;
    for (int it = gtid; it < 2 * 4 * 8192; it += gsz) {
        const int b = it >> 15, h = (it >> 13) & 3, v = (it >> 5) & 255, k4 = (it & 31) * 4;
        float s0 = 0.f, s1 = 0.f, s2 = 0.f, s3 = 0.f;
#pragma unroll 16
        for (int cc = 0; cc < SEQ / GCH; ++cc) {
            const int c = b * (SEQ / GCH) + cc;
            uint2* ptr = (uint2*)(U + (((size_t)c * 4 + h) * 256 + v) * 128 + k4);
            float f[4]; unpack4(*ptr, f);
            *ptr = make_uint2(pack2(s0, s1), pack2(s2, s3));
            const float4 bl = *(const float4*)(BC + (size_t)(c * GCH + GCH - 1) * 512 + h * 128 + k4);
            s0 = __expf(bl.x) * s0 + f[0]; s1 = __expf(bl.y) * s1 + f[1]; s2 = __expf(bl.z) * s2 + f[2]; s3 = __expf(bl.w) * s3 + f[3];
        }
        float* o = outp + (((size_t)b * 4 + h) * 128 + k4) * 256 + v;
        o[0] = s0; o[256] = s1; o[512] = s2; o[768] = s3;
    }
}

DEVI void gla_out_phase(const Params& p) {
    int z_; asm volatile("s_mov_b32 %0, 0" : "=s"(z_)); unsigned char* ws_ = p.ws + z_; float* out_ = p.out + z_; (void)ws_; (void)out_; KIN_DECL;
    const bf16_t* QK = (const bf16_t*)(ws_ + B_R4);
    const float* BC = (const float*)(ws_ + B_HB);
    const bf16_t* U = (const bf16_t*)(ws_ + B_R6);
    bf16_t* OG = (bf16_t*)(ws_ + B_R3);
    const int tid = tidx(), lane = tid & 63, wave = tid >> 6, l31 = lane & 31, lh = lane >> 5;
    bf16_t* sQ = (bf16_t*)VSMEM;
    bf16_t* sK = sQ + 64 * SST;
    bf16_t* sVt = sK + 64 * SST;
    float* sred = (float*)(sVt + 256 * QST);
    const int nitems = (TP / GCH) * 4;
    for (int item = bidx(); item < nitems; item += VGRID) {
        const int c = item >> 2, h = item & 3, t0 = c * GCH;
        __syncthreads();
        for (int idx = tid; idx < GCH * 16; idx += 256) {
            const int q = idx >> 4, k8 = (idx & 15) * 8;
            float fq[8], fk[8];
            unpack8(*(const uint4*)(QK + (size_t)(t0 + q) * 3072 + h * 128 + k8), fq);
            unpack8(*(const uint4*)(QK + (size_t)(t0 + q) * 3072 + 512 + h * 128 + k8), fk);
            const float* bq = BC + (size_t)(t0 + q) * 512 + h * 128 + k8;
            unsigned wq[4], wk[4];
#pragma unroll
            for (int e = 0; e < 4; ++e) {
                const float e0 = __expf(bq[2 * e]), e1 = __expf(bq[2 * e + 1]);
                wq[e] = pack2(fq[2 * e] * e0 * 0.08838834764831845f, fq[2 * e + 1] * e1 * 0.08838834764831845f);
                wk[e] = pack2(fk[2 * e] / e0, fk[2 * e + 1] / e1);
            }
            *(uint4*)(sQ + q * SST + k8) = make_uint4(wq[0], wq[1], wq[2], wq[3]);
            *(uint4*)(sK + q * SST + k8) = make_uint4(wk[0], wk[1], wk[2], wk[3]);
        }
        for (int idx = tid; idx < GCH * 32; idx += 256) {
            const int q = idx >> 5, v8 = (idx & 31) * 8;
            const uint4 v = *(const uint4*)(QK + (size_t)(t0 + q) * 3072 + 1024 + h * 256 + v8);
            const unsigned short* s = (const unsigned short*)&v;
#pragma unroll
            for (int e = 0; e < 8; ++e) sVt[(v8 + e) * QST + q] = s[e];
        }
        __syncthreads();
        const int qt = wave & 1, stl = wave >> 1;
        f32x16 at;
#pragma unroll
        for (int e = 0; e < 16; ++e) at[e] = 0.f;
#pragma unroll
        for (int ks = 0; ks < 8; ++ks) at = mfma32(ldsfrag(sK, 32 * stl + l31, SST, ks * 16 + 8 * lh), ldsfrag(sQ, 32 * qt + l31, SST, ks * 16 + 8 * lh), at);
        f32x16 acc[2][2];
#pragma unroll
        for (int i = 0; i < 2; ++i)
#pragma unroll
            for (int jq = 0; jq < 2; ++jq)
#pragma unroll
                for (int e = 0; e < 16; ++e) acc[i][jq][e] = 0.f;
        const bf16_t* Uc = U + ((size_t)c * 4 + h) * 32768;
#pragma unroll
        for (int ks = 0; ks < 8; ++ks) {
            bf16x8 qb[2];
#pragma unroll
            for (int jq = 0; jq < 2; ++jq) qb[jq] = ldsfrag(sQ, 32 * jq + l31, SST, ks * 16 + 8 * lh);
#pragma unroll
            for (int i = 0; i < 2; ++i) {
                const bf16x8 sa = *(const bf16x8*)(Uc + (size_t)(64 * wave + 32 * i + l31) * 128 + ks * 16 + 8 * lh);
#pragma unroll
                for (int jq = 0; jq < 2; ++jq) acc[i][jq] = mfma32(sa, qb[jq], acc[i][jq]);
            }
        }
        __syncthreads();
        bf16_t* sP = sK;
        {
            const int q = 32 * qt + l31;
#pragma unroll
            for (int rg = 0; rg < 4; ++rg) {
                const int s0 = 32 * stl + 8 * rg + 4 * lh;
                float m[4];
#pragma unroll
                for (int e = 0; e < 4; ++e) m[e] = (s0 + e <= q) ? at[4 * rg + e] : 0.f;
                *(uint2*)(sP + q * QST + s0) = make_uint2(pack2(m[0], m[1]), pack2(m[2], m[3]));
            }
        }
        __syncthreads();
#pragma unroll
        for (int ks = 0; ks < 4; ++ks) {
            bf16x8 pb[2];
#pragma unroll
            for (int jq = 0; jq < 2; ++jq) pb[jq] = ldsfrag(sP, 32 * jq + l31, QST, ks * 16 + 8 * lh);
#pragma unroll
            for (int i = 0; i < 2; ++i) {
                const bf16x8 va = ldsfrag(sVt, 64 * wave + 32 * i + l31, QST, ks * 16 + 8 * lh);
#pragma unroll
                for (int jq = 0; jq < 2; ++jq) acc[i][jq] = mfma32(va, pb[jq], acc[i][jq]);
            }
        }
        float ss[2] = {0.f, 0.f};
#pragma unroll
        for (int jq = 0; jq < 2; ++jq)
#pragma unroll
            for (int i = 0; i < 2; ++i)
#pragma unroll
                for (int e = 0; e < 16; ++e) ss[jq] += acc[i][jq][e] * acc[i][jq][e];
#pragma unroll
        for (int jq = 0; jq < 2; ++jq) { ss[jq] += __shfl_xor(ss[jq], 32); if (lh == 0) sred[wave * 64 + 32 * jq + l31] = ss[jq]; }
        __syncthreads();
#pragma unroll
        for (int jq = 0; jq < 2; ++jq) {
            const int q = 32 * jq + l31;
            const float tot = sred[q] + sred[64 + q] + sred[128 + q] + sred[192 + q];
            const float inv = rsqrtf(tot * (1.f / 256.f) + EPS);
            const size_t trow = (size_t)(t0 + q);
#pragma unroll
            for (int i = 0; i < 2; ++i)
#pragma unroll
                for (int rg = 0; rg < 4; ++rg) {
                    const int vc = h * 256 + 64 * wave + 32 * i + 8 * rg + 4 * lh;
                    float rf[4]; unpack4(*(const uint2*)(QK + trow * 3072 + 2048 + vc), rf);
                    float o[4];
#pragma unroll
                    for (int e = 0; e < 4; ++e) o[e] = acc[i][jq][4 * rg + e] * inv * silu_f(rf[e]);
                    *(uint2*)(OG + trow * D + vc) = make_uint2(pack2(o[0], o[1]), pack2(o[2], o[3]));
                }
        }
    }
}

DEVI void att_rope_phase(const Params& p) {
    int z_; asm volatile("s_mov_b32 %0, 0" : "=s"(z_)); unsigned char* ws_ = p.ws + z_; float* out_ = p.out + z_; (void)ws_; (void)out_; KIN_DECL;
    bf16_t* QKV = (bf16_t*)(ws_ + B_R4);
    const int gtid = bidx() * 256 + tidx(), gsz = VGRID * 256;
    const int Ws[3] = {128, 512, 2048};
    const size_t op[3] = {O_KV0P, O_KV1P, O_KV2P}, os[3] = {O_KV0S, O_KV1S, O_KV2S};
    for (int it = gtid; it < T * 12; it += gsz) {
        const int t = it / 12, hd = it % 12, g = hd >> 2, hg = hd & 3;
        const bool samp = t >= TP;
        const int pos = samp ? SEQ + ((t - TP) & 3) : (t & (SEQ - 1));
        float cs[8], sn[8];
#pragma unroll
        for (int i = 0; i < 8; ++i) { const float fr = powf(500000.f, -(float)i * 0.125f); sincosf((float)pos * fr, &sn[i], &cs[i]); }
        bf16_t* qp = QKV + (size_t)t * QKVD + hd * 64; bf16_t* kp = qp + 768; const bf16_t* vp = qp + 1536;
        float kf[64];
        {
            float f[16];
            unpack8(*(const uint4*)qp, f); unpack8(*(const uint4*)(qp + 8), f + 8);
            unsigned w[8];
#pragma unroll
            for (int i = 0; i < 4; ++i) {
                w[i] = pack2(f[2 * i] * cs[2 * i] - f[2 * i + 8] * sn[2 * i], f[2 * i + 1] * cs[2 * i + 1] - f[2 * i + 9] * sn[2 * i + 1]);
                w[4 + i] = pack2(f[2 * i + 8] * cs[2 * i] + f[2 * i] * sn[2 * i], f[2 * i + 9] * cs[2 * i + 1] + f[2 * i + 1] * sn[2 * i + 1]);
            }
            *(uint4*)qp = make_uint4(w[0], w[1], w[2], w[3]); *(uint4*)(qp + 8) = make_uint4(w[4], w[5], w[6], w[7]);
        }
#pragma unroll
        for (int i = 0; i < 8; ++i) unpack8(*(const uint4*)(kp + 8 * i), kf + 8 * i);
        {
            float r[16];
#pragma unroll
            for (int i = 0; i < 8; ++i) { r[i] = kf[i] * cs[i] - kf[i + 8] * sn[i]; r[i + 8] = kf[i + 8] * cs[i] + kf[i] * sn[i]; }
            unsigned w[8];
#pragma unroll
            for (int i = 0; i < 8; ++i) { w[i] = pack2(r[2 * i], r[2 * i + 1]); kf[2 * i] = bf2f(f2bf(r[2 * i])); kf[2 * i + 1] = bf2f(f2bf(r[2 * i + 1])); }
            *(uint4*)kp = make_uint4(w[0], w[1], w[2], w[3]); *(uint4*)(kp + 8) = make_uint4(w[4], w[5], w[6], w[7]);
        }
        const int W = Ws[g];
        float* dst = nullptr;
        if (!samp) { const int b = t >> 13, tp = t & (SEQ - 1); if (tp >= SEQ - W) dst = out_ + op[g] + (((size_t)b * W + (tp - (SEQ - W))) * 2) * 256 + hg * 64; }
        else { const int sb = (t - TP) >> 2, s = (t - TP) & 3; dst = out_ + os[g] + (((size_t)sb * W + (W - 4 + s)) * 2) * 256 + hg * 64; }
        if (dst) {
#pragma unroll
            for (int i = 0; i < 16; ++i) ((float4*)dst)[i] = make_float4(kf[4 * i], kf[4 * i + 1], kf[4 * i + 2], kf[4 * i + 3]);
#pragma unroll
            for (int i = 0; i < 8; ++i) { float f[8]; unpack8(*(const uint4*)(vp + 8 * i), f); ((float4*)(dst + 256))[2 * i] = make_float4(f[0], f[1], f[2], f[3]); ((float4*)(dst + 256))[2 * i + 1] = make_float4(f[4], f[5], f[6], f[7]); }
        }
    }
}

DEVI void att_phase(const Params& p) {
    int z_; asm volatile("s_mov_b32 %0, 0" : "=s"(z_)); unsigned char* ws_ = p.ws + z_; float* out_ = p.out + z_; (void)ws_; (void)out_; KIN_DECL;
    const bf16_t* QKV = (const bf16_t*)(ws_ + B_R4);
    bf16_t* AO = (bf16_t*)(ws_ + B_R3);
    float* LSE = (float*)(ws_ + B_DT);
    const int lane = tidx() & 63, wib = tidx() >> 6;
    const int wv = (bidx() * 256 + tidx()) >> 6, nw = (VGRID * 256) >> 6;
    float* sq = (float*)VSMEM + wib * 256;
    float* sp = sq + 64;
    for (int it = wv; it < TS * 12; it += nw) {
        const int t = TP + it / 12, hd = it % 12, g = hd >> 2, hg = hd & 3;
        const int sb = (t - TP) >> 2, s = (t - TP) & 3;
        const int d = (g == 0) ? 1 : (g == 1 ? 4 : 16), W = 128 * d;
        const float* cache = (g == 0) ? in_[5] : (g == 1 ? in_[6] : in_[7]);
        sq[lane] = bf2f(QKV[(size_t)t * QKVD + hd * 64 + lane]) * 0.125f;
        float sc[3];
#pragma unroll
        for (int r = 0; r < 3; ++r) {
            const int jj = r * 64 + lane;
            float v = -INFINITY;
            if (jj <= 128) {
                const int idx = W + s - jj * d;
                float a = 0.f;
                if (idx >= W) {
                    const bf16_t* kp = QKV + (size_t)(TP + sb * 4 + (idx - W)) * QKVD + 768 + hd * 64;
#pragma unroll
                    for (int i = 0; i < 8; ++i) { float f[8]; unpack8(*(const uint4*)(kp + 8 * i), f);
#pragma unroll
                        for (int e = 0; e < 8; ++e) a += f[e] * sq[8 * i + e]; }
                } else {
                    const float4* kp = (const float4*)(cache + (((size_t)sb * W + idx) * 2) * 256 + hg * 64);
#pragma unroll
                    for (int i = 0; i < 16; ++i) { const float4 f = kp[i]; a += f.x * sq[4 * i] + f.y * sq[4 * i + 1] + f.z * sq[4 * i + 2] + f.w * sq[4 * i + 3]; }
                }
                v = a;
            }
            sc[r] = v;
        }
        const float mx = wave_max(fmaxf(sc[0], fmaxf(sc[1], sc[2])));
        float ps = 0.f;
#pragma unroll
        for (int r = 0; r < 3; ++r) { const float e = (sc[r] == -INFINITY) ? 0.f : __expf(sc[r] - mx); sp[r * 64 + lane] = e; ps += e; }
        const float den = wave_sum(ps);
        const int jn = s / d;
        float a = 0.f;
        for (int jj = 0; jj <= jn; ++jj) a += sp[jj] * bf2f(QKV[(size_t)(TP + sb * 4 + (s - jj * d)) * QKVD + 1536 + hd * 64 + lane]);
        const float* vb = cache + (((size_t)sb * W) * 2 + 1) * 256 + hg * 64 + lane;
#pragma unroll 8
        for (int jj = jn + 1; jj <= 128; ++jj) a += sp[jj] * vb[(size_t)(W + s - jj * d) * 512];
        AO[(size_t)t * ATTD + hd * 64 + lane] = f2bf(a / den);
        if (lane == 0) LSE[(size_t)t * 12 + hd] = mx + __logf(den);
    }
}

constexpr int VST = 264;
DEVI void att_prompt_phase(const Params& p) {
    int z_; asm volatile("s_mov_b32 %0, 0" : "=s"(z_)); unsigned char* ws_ = p.ws + z_; float* out_ = p.out + z_; (void)ws_; (void)out_; KIN_DECL;
    const bf16_t* QKV = (const bf16_t*)(ws_ + B_R4);
    bf16_t* AO = (bf16_t*)(ws_ + B_R3);
    float* LSE = (float*)(ws_ + B_DT);
    const int tid = tidx(), lane = tid & 63, wave = tid >> 6, l31 = lane & 31, lh = lane >> 5;
    bf16_t* sK = (bf16_t*)VSMEM;
    bf16_t* sVt = sK + 256 * GST;
    for (int item = bidx(); item < 2 * 12 * 64; item += VGRID) {
        const int b = item / 768, hd = (item / 64) % 12, blk = item & 63, g = hd >> 2;
        const int d = (g == 0) ? 1 : (g == 1 ? 4 : 16), nbr = (SEQ / d) / 128, r = blk / nbr, u0 = (blk % nbr) * 128;
        const size_t tb = (size_t)b * SEQ + r;
        __syncthreads();
        for (int idx = tid; idx < 256 * 8; idx += 256) {
            const int kj = idx >> 3, c8 = (idx & 7) * 8, u = u0 - 128 + kj;
            u32x4 kv = {0u, 0u, 0u, 0u}, vv = {0u, 0u, 0u, 0u};
            if (u >= 0) { const bf16_t* src = QKV + (tb + (size_t)u * d) * QKVD + 768 + hd * 64 + c8; kv = *(const u32x4*)src; vv = *(const u32x4*)(src + 768); }
            *(u32x4*)(sK + kj * GST + c8) = kv;
#pragma unroll
            for (int e = 0; e < 4; ++e) { sVt[(c8 + 2 * e) * VST + kj] = (bf16_t)(vv[e] & 0xffffu); sVt[(c8 + 2 * e + 1) * VST + kj] = (bf16_t)(vv[e] >> 16); }
        }
        const int qi = 32 * wave + l31;
        const size_t tq = tb + (size_t)(u0 + qi) * d;
        bf16x8 qf[4];
#pragma unroll
        for (int ks = 0; ks < 4; ++ks) qf[ks] = *(const bf16x8*)(QKV + tq * QKVD + hd * 64 + ks * 16 + 8 * lh);
        __syncthreads();
        f32x16 S[5];
#pragma unroll
        for (int tt = 0; tt < 5; ++tt) {
#pragma unroll
            for (int e = 0; e < 16; ++e) S[tt][e] = 0.f;
#pragma unroll
            for (int ks = 0; ks < 4; ++ks) S[tt] = mfma32(ldsfrag(sK, 32 * (wave + tt) + l31, GST, ks * 16 + 8 * lh), qf[ks], S[tt]);
        }
        float mx = -INFINITY;
#pragma unroll
        for (int tt = 0; tt < 5; ++tt)
#pragma unroll
            for (int e = 0; e < 16; ++e) {
                const int kj = 32 * (wave + tt) + (e & 3) + 8 * (e >> 2) + 4 * lh;
                const bool valid = (kj >= qi) && (kj <= qi + 128) && (u0 - 128 + kj >= 0);
                const float sv = valid ? S[tt][e] * 0.125f : -INFINITY;
                S[tt][e] = sv; mx = fmaxf(mx, sv);
            }
        mx = fmaxf(mx, __shfl_xor(mx, 32));
        float den = 0.f;
#pragma unroll
        for (int tt = 0; tt < 5; ++tt)
#pragma unroll
            for (int e = 0; e < 16; ++e) { const float pe = __expf(S[tt][e] - mx); S[tt][e] = pe; den += pe; }
        den += __shfl_xor(den, 32);
        f32x16 O[2];
#pragma unroll
        for (int i = 0; i < 2; ++i)
#pragma unroll
            for (int e = 0; e < 16; ++e) O[i][e] = 0.f;
#pragma unroll
        for (int tt = 0; tt < 5; ++tt)
#pragma unroll
            for (int s2 = 0; s2 < 2; ++s2) {
                union { bf16x8 v; unsigned u[4]; } pb;
#pragma unroll
                for (int e = 0; e < 4; ++e) pb.u[e] = pack2(S[tt][8 * s2 + 2 * e], S[tt][8 * s2 + 2 * e + 1]);
#pragma unroll
                for (int i = 0; i < 2; ++i) {
                    const bf16_t* vp = sVt + (32 * i + l31) * VST + 32 * (wave + tt) + 16 * s2 + 4 * lh;
                    union { bf16x8 v; uint2 h[2]; } va;
                    va.h[0] = *(const uint2*)vp; va.h[1] = *(const uint2*)(vp + 8);
                    O[i] = mfma32(va.v, pb.v, O[i]);
                }
            }
        const float rden = 1.f / den;
#pragma unroll
        for (int i = 0; i < 2; ++i)
#pragma unroll
            for (int rg = 0; rg < 4; ++rg)
                *(uint2*)(AO + tq * ATTD + hd * 64 + 32 * i + 8 * rg + 4 * lh) = make_uint2(pack2(O[i][4 * rg] * rden, O[i][4 * rg + 1] * rden), pack2(O[i][4 * rg + 2] * rden, O[i][4 * rg + 3] * rden));
        if (lh == 0) LSE[tq * 12 + hd] = mx + __logf(den);
    }
}

DEVI void att_mix_phase(const Params& p) {
    int z_; asm volatile("s_mov_b32 %0, 0" : "=s"(z_)); unsigned char* ws_ = p.ws + z_; float* out_ = p.out + z_; (void)ws_; (void)out_; KIN_DECL;
    bf16_t* AO = (bf16_t*)(ws_ + B_R3);
    const float* LSE = (const float*)(ws_ + B_DT);
    const int gtid = bidx() * 256 + tidx(), gsz = VGRID * 256;
    for (int it = gtid; it < T * 32; it += gsz) {
        const int t = it >> 5, hg = (it >> 3) & 3, c8 = (it & 7) * 8;
        const float l0 = LSE[(size_t)t * 12 + hg], l1 = LSE[(size_t)t * 12 + 4 + hg], l2 = LSE[(size_t)t * 12 + 8 + hg];
        const float ml = fmaxf(l0, fmaxf(l1, l2));
        float al[3] = {__expf(l0 - ml), __expf(l1 - ml), __expf(l2 - ml)};
        const float rs = 1.f / (al[0] + al[1] + al[2]);
#pragma unroll
        for (int g = 0; g < 3; ++g) {
            u32x4* ptr = (u32x4*)(AO + (size_t)t * ATTD + (g * 4 + hg) * 64 + c8);
            const u32x4 v = *ptr; const float a = al[g] * rs;
            u32x4 o;
#pragma unroll
            for (int e = 0; e < 4; ++e) o[e] = pack2(__uint_as_float(v[e] << 16) * a, __uint_as_float(v[e] & 0xffff0000u) * a);
            *ptr = o;
        }
    }
}

enum { OP_INIT = 0, OP_NORM, OP_FINAL, OP_SSM_IN, OP_SSM_CONV, OP_SSM_STATE, OP_SSM_SCAN, OP_SSM_OUT, OP_SSM_OG, OP_GLA_IN, OP_GLA_GATE, OP_GLA_STATE, OP_GLA_SCAN,
       OP_GLA_OUT, OP_GLA_OG, OP_ATT_IN_, OP_ATT_ROPE, OP_ATT_ATT, OP_ATT_MIX, OP_ATT_OG, OP_FFN_GU, OP_FFN_DN };
constexpr int OP_ATT_IN = OP_ATT_IN_;
DEVI int phase_op(int ph, int& a) {
    int l, q, op; a = 0;
    if (ph == 0) return OP_INIT;
    if (ph <= 10) { l = 0; q = ph - 1; } else if (ph <= 20) { l = 1; q = ph - 11; } else if (ph <= 29) { l = 2; q = ph - 21; } else { l = 3; q = ph - 30; }
    const int nmix = (l == 2) ? 5 : 6;
    if (q < nmix) { op = (l == 1 ? OP_GLA_IN : (l == 2 ? OP_ATT_IN_ : OP_SSM_IN)) + q; a = l / 3; }
    else { const int k = q - nmix; op = (k == 0) ? OP_NORM : (k == 1 ? OP_FFN_GU : (k == 2 ? OP_FFN_DN : (l == 3 ? OP_FINAL : OP_NORM))); a = l; }
    return op;
}
DEVI int phase_op_only(int ph) { int a; return phase_op(ph, a); }
DEVI void run_phase(const Params& p, int ph) {
    const bf16_t* Hb = (const bf16_t*)(p.ws + B_HB);
    int a = 0; int op = phase_op(ph, a);
#ifdef ONLY_OP
    if (op != ONLY_OP) return;
    op = ONLY_OP;
#endif
    switch (op) {
        case OP_INIT: if (rbid() & 1) { copy_caches(p); convert_weights(p); } else { convert_weights(p); copy_caches(p); } norm_phase(p, 0); break;
        case OP_NORM: norm_phase(p, 1); break;
        case OP_FINAL: norm_phase(p, 2); break;
        case OP_SSM_IN: gemm8<EPI_SSM_IN>(p, Hb, (const bf16_t*)(p.ws + W_SSM_IN) + (size_t)a * SSM_INP * D, MPAD, SSM_INP, D); break;
        case OP_SSM_CONV: ssm_conv_phase(p, a); break;
        case OP_SSM_STATE: ssm_state_phase(p, a); break;
        case OP_SSM_SCAN: ssm_scan_phase(p, a); break;
        case OP_SSM_OUT: ssm_out_phase(p, a); break;
        case OP_SSM_OG: gemm8<EPI_RESADD>(p, (const bf16_t*)(p.ws + B_R4), (const bf16_t*)(p.ws + W_SSM_OUT) + (size_t)a * D * DI, TP, D, DI); gemm_phase<EPI_RESADD, DI>(p, (const bf16_t*)(p.ws + B_R4), (const bf16_t*)(p.ws + W_SSM_OUT) + (size_t)a * D * DI, 4, true); break;
        case OP_GLA_IN: gemm8<EPI_GLA_IN>(p, Hb, (const bf16_t*)(p.ws + W_GLA_IN), MPAD, GLA_INP, D); break;
        case OP_GLA_GATE: gla_gate_phase(p); break;
        case OP_GLA_STATE: gla_state_phase(p); break;
        case OP_GLA_SCAN: gla_scan_phase(p); break;
        case OP_GLA_OUT: gla_out_phase(p); break;
        case OP_GLA_OG: gemm8<EPI_RESADD>(p, (const bf16_t*)(p.ws + B_R3), (const bf16_t*)(p.ws + W_GLA_OUT), TP, D, D); gemm_phase<EPI_RESADD, D>(p, (const bf16_t*)(p.ws + B_R3), (const bf16_t*)(p.ws + W_GLA_OUT), 4, true); break;
        case OP_ATT_IN: gemm8<EPI_ATT_IN>(p, Hb, (const bf16_t*)(p.ws + W_ATT_QKV), MPAD, QKVD, D); break;
        case OP_ATT_ROPE: att_rope_phase(p); break;
        case OP_ATT_ATT: att_prompt_phase(p); __syncthreads(); att_phase(p); break;
        case OP_ATT_MIX: att_mix_phase(p); break;
        case OP_ATT_OG: gemm8<EPI_RESADD>(p, (const bf16_t*)(p.ws + B_R3), (const bf16_t*)(p.ws + W_ATT_OUT), TP, D, ATTD); gemm_phase<EPI_RESADD, ATTD>(p, (const bf16_t*)(p.ws + B_R3), (const bf16_t*)(p.ws + W_ATT_OUT), 4, true); break;
        case OP_FFN_GU: gemm8<EPI_SWIGLU>(p, Hb, (const bf16_t*)(p.ws + W_FFN_GU) + (size_t)a * 2 * DFF * D, MPAD, 2 * DFF, D); break;
        case OP_FFN_DN: gemm8<EPI_RESADD>(p, (const bf16_t*)(p.ws + B_R4), (const bf16_t*)(p.ws + W_FFN_DN) + (size_t)a * D * DFF, TP, D, DFF); gemm_phase<EPI_RESADD, DFF>(p, (const bf16_t*)(p.ws + B_R4), (const bf16_t*)(p.ws + W_FFN_DN) + (size_t)a * D * DFF, 4, true); break;
        default: break;
    }
}

#ifndef REPEAT_OP
#define REPEAT_OP -1
#endif
#ifndef REPEAT_N
#define REPEAT_N 1
#endif
__global__ void __launch_bounds__(512, 2) mega(Params p, int ph_lo, int ph_hi, int coop) {
    uint4* xb_words = (uint4*)(smem + 2 * LDS_BYTES);
    if (threadIdx.x == 0) *xb_words = make_uint4(0u, 0u, 0u, 0u);
    __syncthreads();
    XcdBarrier xb = xcd_barrier_post((unsigned*)(p.ws + B_BAR), (volatile LAS unsigned*)xb_words);
    if (coop < 0) cg::this_grid().sync();
    int rep = 0;
    for (int ph = ph_lo; ph < ph_hi;) {
        run_phase(p, ph);
        if (REPEAT_OP >= 0 && phase_op_only(ph) == REPEAT_OP && rep < REPEAT_N) { ++rep; __syncthreads(); continue; }
        rep = 0;
        if (ph + 1 < ph_hi) xcd_barrier(xb);
        ++ph;
    }
}

extern "C" void kernel_launch(void* const* d_in, const int* in_sizes, int n_in, void* d_out, int out_size, void* d_ws, size_t ws_size, hipStream_t stream) {
    if (ws_size < B_END) { fprintf(stderr, "workspace too small: %zu < %zu\n", ws_size, (size_t)B_END); return; }
    Params p; memset(&p, 0, sizeof(p));
    for (int i = 0; i < 29; ++i) p.in[i] = (const float*)d_in[i];
    p.out = (float*)d_out; p.ws = (unsigned char*)d_ws;
    p.nphase = 40;
    static int grid_blocks = 0;
    if (!grid_blocks) {
        int dev = 0, cus = 0, per_cu = 0;
        hipGetDevice(&dev);
        hipDeviceGetAttribute(&cus, hipDeviceAttributeMultiprocessorCount, dev);
        hipFuncSetAttribute((const void*)mega, hipFuncAttributeMaxDynamicSharedMemorySize, DYN_LDS);
        hipOccupancyMaxActiveBlocksPerMultiprocessor(&per_cu, mega, 512, DYN_LDS);
        if (per_cu > 1) per_cu = 1;
        if (per_cu < 1) per_cu = 1;
        grid_blocks = cus * per_cu;
    }
#if ONE_LAUNCH
    hipMemsetAsync(p.ws + B_BAR, 0, XCD_BAR_WORDS * 4, stream);
    int lo = 0, hi = p.nphase, coop = 1;
    void* args[] = {&p, &lo, &hi, &coop};
    hipError_t e = hipLaunchCooperativeKernel((void*)mega, dim3(grid_blocks), dim3(512), args, DYN_LDS, stream);
    if (e != hipSuccess) fprintf(stderr, "cooperative launch failed: %s (grid %d)\n", hipGetErrorString(e), grid_blocks);
#else
    for (int ph = 0; ph < p.nphase; ++ph) mega<<<grid_blocks, 512, DYN_LDS, stream>>>(p, ph, ph + 1, 0);
#endif
}
```

```cpp
#include <hip/hip_runtime.h>
#include <hip/hip_cooperative_groups.h>
#include <cstdio>
#include <cstring>
namespace cg = cooperative_groups;

#ifndef ONE_LAUNCH
#define ONE_LAUNCH 1
#endif

typedef unsigned short bf16_t;
typedef short bf16x8 __attribute__((ext_vector_type(8)));
typedef float f32x16 __attribute__((ext_vector_type(16)));
typedef float f32x4 __attribute__((ext_vector_type(4)));
typedef unsigned u32x4 __attribute__((ext_vector_type(4)));
#define DEVI __device__ __forceinline__

constexpr int D = 1024, TP = 16384, TS = 128, T = TP + TS, SEQ = 8192, DFF = 2816;
constexpr int SSM_IN = 5152, SSM_INP = 5376, DI = 2048, CONVD = 3072;
constexpr int GLA_IN = 3088, GLA_INP = 3328;
constexpr int QKVD = 2304, ATTD = 768;
constexpr float EPS = 1e-6f;
constexpr int MPAD = 16640;

constexpr size_t O_YP = 0, O_YS = O_YP + (size_t)TP * D, O_SSMP = O_YS + (size_t)TS * D, O_SSMS = O_SSMP + 2ull * 2 * 262144,
                 O_CONVP = O_SSMS + 2ull * 32 * 262144, O_CONVS = O_CONVP + 2ull * 2 * 3 * CONVD, O_GLAP = O_CONVS + 2ull * 32 * 3 * CONVD,
                 O_GLAS = O_GLAP + 2ull * 4 * 32768, O_KV0P = O_GLAS + 32ull * 4 * 32768, O_KV0S = O_KV0P + 2ull * 128 * 512,
                 O_KV1P = O_KV0S + 32ull * 128 * 512, O_KV1S = O_KV1P + 2ull * 512 * 512, O_KV2P = O_KV1S + 32ull * 512 * 512,
                 O_KV2S = O_KV2P + 2ull * 2048 * 512, O_END = O_KV2S + 32ull * 2048 * 512;

constexpr size_t al(size_t x) { return (x + 255) & ~(size_t)255; }
constexpr size_t W_SSM_IN = 0, W_SSM_OUT = W_SSM_IN + 2ull * SSM_INP * D * 2, W_GLA_IN = W_SSM_OUT + 2ull * D * DI * 2,
                 W_GLA_OUT = W_GLA_IN + (size_t)GLA_INP * D * 2, W_ATT_QKV = W_GLA_OUT + (size_t)D * D * 2, W_ATT_OUT = W_ATT_QKV + (size_t)QKVD * D * 2,
                 W_FFN_GU = W_ATT_OUT + (size_t)D * ATTD * 2, W_FFN_DN = W_FFN_GU + 4ull * 2 * DFF * D * 2, W_END = W_FFN_DN + 4ull * D * DFF * 2;
constexpr size_t B_HB = al(W_END), B_R3 = B_HB + (size_t)T * D * 2, B_R4 = B_R3 + (size_t)T * DI * 2, B_R5 = B_R4 + (size_t)T * CONVD * 2,
                 B_R6 = B_R5 + (size_t)T * CONVD * 2, B_DT = B_R6 + 67108864ull, B_DTS = B_DT + (size_t)T * 32 * 4, B_ACS = B_DTS + (size_t)T * 32 * 4,
                 B_GLOW = B_ACS + (size_t)T * 32 * 4, B_BAR = al(B_GLOW + (size_t)T * 16 * 4), B_SSQS = B_BAR + 16384, B_ROPE = B_SSQS + 4096, B_END = B_ROPE + 8196ull * 16 * 4;

struct WDesc { const float* src; const float* gain; bf16_t* dst; int K, N, mode, tile0, gmod; };
struct Params {
    const float* in[29];
    float* out;
    unsigned char* ws;
    int nphase, pad0;
};

constexpr int LDS_BYTES = 79872;
extern __shared__ __attribute__((aligned(16))) unsigned char smem[];
constexpr int DYN_LDS = 2 * LDS_BYTES + 16;

DEVI int rtid() { int t = threadIdx.x; asm volatile("" : "+v"(t)); return t; }
DEVI int rbid() { int b = blockIdx.x; asm volatile("" : "+s"(b)); return b; }
DEVI int vhalf() { return __builtin_amdgcn_readfirstlane(rtid() >> 8); }
DEVI int tidx() { return rtid() & 255; }
DEVI int bidx() { return rbid() * 2 + vhalf(); }
#define VGRID ((int)gridDim.x * 2)
#define CAS4 __attribute__((address_space(4)))
#define KIN_DECL const float* const CAS4* in_ = (const float* const CAS4*)((const CAS4 char*)__builtin_amdgcn_kernarg_segment_ptr() + z_); (void)in_
#define VSMEM (smem + vhalf() * LDS_BYTES)
DEVI unsigned short f2bf(float f) { unsigned u = __float_as_uint(f); u += 0x7fffu + ((u >> 16) & 1u); return (unsigned short)(u >> 16); }
DEVI float bf2f(unsigned short h) { return __uint_as_float(((unsigned)h) << 16); }
DEVI unsigned pack2(float a, float b) { return (unsigned)f2bf(a) | ((unsigned)f2bf(b) << 16); }
DEVI float silu_f(float x) { return x / (1.f + __expf(-x)); }
DEVI float softplus_f(float x) { return x > 20.f ? x : log1pf(__expf(x)); }
DEVI float logsigmoid_f(float x) { return fminf(x, 0.f) - log1pf(__expf(-fabsf(x))); }
DEVI float wave_sum(float v) { for (int o = 32; o > 0; o >>= 1) v += __shfl_xor(v, o); return v; }
DEVI float wave_max(float v) { for (int o = 32; o > 0; o >>= 1) v = fmaxf(v, __shfl_xor(v, o)); return v; }
DEVI bf16x8 ldsfrag(const bf16_t* base, int row, int stride, int k) { return *(const bf16x8*)(base + row * stride + k); }
DEVI f32x16 mfma32(bf16x8 a, bf16x8 b, f32x16 c) { return __builtin_amdgcn_mfma_f32_32x32x16_bf16(a, b, c, 0, 0, 0); }
DEVI void unpack8(uint4 v, float* f) {
    f[0] = __uint_as_float(v.x << 16); f[1] = __uint_as_float(v.x & 0xffff0000u); f[2] = __uint_as_float(v.y << 16); f[3] = __uint_as_float(v.y & 0xffff0000u);
    f[4] = __uint_as_float(v.z << 16); f[5] = __uint_as_float(v.z & 0xffff0000u); f[6] = __uint_as_float(v.w << 16); f[7] = __uint_as_float(v.w & 0xffff0000u);
}
DEVI void unpack4(uint2 v, float* f) {
    f[0] = __uint_as_float(v.x << 16); f[1] = __uint_as_float(v.x & 0xffff0000u); f[2] = __uint_as_float(v.y << 16); f[3] = __uint_as_float(v.y & 0xffff0000u);
}


#define XB_TMO      128
#define XB_XCNT(j)  (256  + 64 * (j))
#define XB_XSUB(j)  (1280 + 64 * (j))
#define XB_XGEN(j)  (2304 + 64 * (j))
#define XB_TOP      3328
#define XB_TOPGEN   3392
#define XCD_BAR_WORDS 3456
#define XB_SPIN_CAP (1u << 22)
#define LAS __attribute__((address_space(3)))
DEVI unsigned xb_ld(unsigned* p)              { return __hip_atomic_load(p, __ATOMIC_RELAXED, __HIP_MEMORY_SCOPE_AGENT); }
DEVI unsigned xb_add(unsigned* p, unsigned v) { return __hip_atomic_fetch_add(p, v, __ATOMIC_RELAXED, __HIP_MEMORY_SCOPE_AGENT); }
DEVI unsigned xb_xcc_id() { return (unsigned)__builtin_amdgcn_s_getreg((3 << 11) | 20) & 0xFu; }
#define XB_SPIN(cond, bar) do { unsigned _sp = 0; while (cond) { __builtin_amdgcn_s_sleep(1); \
    if ((++_sp & 255u) == 0u) { if (xb_ld(&(bar)[XB_TMO])) break; if (_sp > XB_SPIN_CAP) { atomicAdd(&(bar)[XB_TMO], 1u); break; } } } } while (0)
struct XcdBarrier { unsigned* bar; unsigned x; volatile LAS unsigned* st; };
DEVI XcdBarrier xcd_barrier_post(unsigned* bar, volatile LAS unsigned* st) {
    XcdBarrier b; b.bar = bar; b.x = xb_xcc_id(); b.st = st;
    if (threadIdx.x == 0) (void)xb_add(&bar[XB_XCNT(b.x)], 1u);
    return b;
}
DEVI void xcd_barrier_complete(unsigned* bar, unsigned x, unsigned& nloc, unsigned& nx) {
    const unsigned G = gridDim.x * gridDim.y * gridDim.z;
    unsigned sum, cnt, mine, sp = 0u;
    for (;;) {
        sum = 0u; cnt = 0u; mine = 0u;
#pragma unroll
        for (unsigned j = 0; j < 16; ++j) { const unsigned c = xb_ld(&bar[XB_XCNT(j)]); sum += c; cnt += (c > 0u) ? 1u : 0u; mine = (j == x) ? c : mine; }
        if (sum == G) break;
        __builtin_amdgcn_s_sleep(1);
        if ((++sp & 255u) == 0u) { if (xb_ld(&bar[XB_TMO])) break; if (sp > XB_SPIN_CAP) { atomicAdd(&bar[XB_TMO], 1u); break; } }
    }
    nloc = mine > 0u ? mine : 1u; nx = cnt > 0u ? cnt : 1u;
}
DEVI void xcd_barrier(const XcdBarrier& b) {
    asm volatile("s_waitcnt vmcnt(0)" ::: "memory");
    __syncthreads();
    if (threadIdx.x == 0) {
        unsigned* bar = b.bar;
        __builtin_amdgcn_s_waitcnt(0);
        unsigned nloc = b.st[0], nx = b.st[1];
        if (nloc == 0u) { xcd_barrier_complete(bar, b.x, nloc, nx); b.st[0] = nloc; b.st[1] = nx; }
        const unsigned old = xb_add(&bar[XB_XSUB(b.x)], 1u);
        const unsigned gen = old / nloc;
        if (old + 1u == (gen + 1u) * nloc) {
            __builtin_amdgcn_fence(__ATOMIC_RELEASE, "agent");
            asm volatile("s_waitcnt vmcnt(0)" ::: "memory");
            const unsigned og = xb_add(&bar[XB_TOP], 1u);
            const unsigned tg = og / nx;
            if (og + 1u == (tg + 1u) * nx) xb_add(&bar[XB_TOPGEN], 1u);
            else XB_SPIN(xb_ld(&bar[XB_TOPGEN]) == tg, bar);
            __builtin_amdgcn_fence(__ATOMIC_ACQUIRE, "agent");
            xb_add(&bar[XB_XGEN(b.x)], 1u);
            asm volatile("s_waitcnt vmcnt(0)" ::: "memory");
        } else {
            XB_SPIN(xb_ld(&bar[XB_XGEN(b.x)]) == gen, bar);
            __builtin_amdgcn_fence(__ATOMIC_ACQUIRE, "agent");
            asm volatile("s_waitcnt vmcnt(0)" ::: "memory");
        }
    }
    __syncthreads();
}

DEVI void convert_weights(const Params& p) {
    int z_; asm volatile("s_mov_b32 %0, 0" : "=s"(z_)); unsigned char* ws_ = p.ws + z_; float* out_ = p.out + z_; (void)ws_; (void)out_; KIN_DECL;
    float* tile = (float*)VSMEM;
    const int tid = tidx();
    constexpr int T_SI = (SSM_INP / 64) * (D / 64), T_SO = (D / 64) * (DI / 64), T_GI = (GLA_INP / 64) * (D / 64), T_GO = (D / 64) * (D / 64),
                  T_AQ = (QKVD / 64) * (D / 64), T_AO = (D / 64) * (ATTD / 64), T_FF = (DFF / 64) * (D / 64);
    constexpr int P0 = 2 * (T_SI + T_SO), P1 = P0 + T_GI, P2 = P1 + T_GO, P3 = P2 + T_AQ, P4 = P3 + T_AO, WT = P4 + 12 * T_FF;
    auto decode = [&](int it, WDesc& d) {
        d.gain = nullptr; d.mode = 0; d.gmod = 1 << 30;
        if (it < P0) {
            const int j = it / (T_SI + T_SO), r = it - j * (T_SI + T_SO);
            if (r < T_SI) { d.src = in_[13] + (size_t)j * D * SSM_IN; d.gain = in_[8] + j * 3 * D; d.dst = (bf16_t*)(ws_ + W_SSM_IN) + (size_t)j * SSM_INP * D; d.K = D; d.N = SSM_IN; d.tile0 = j * (T_SI + T_SO); }
            else { d.src = in_[20] + (size_t)j * DI * D; d.gain = in_[19] + j * DI; d.dst = (bf16_t*)(ws_ + W_SSM_OUT) + (size_t)j * D * DI; d.K = DI; d.N = D; d.tile0 = j * (T_SI + T_SO) + T_SI; }
        } else if (it < P1) { d.src = in_[21]; d.gain = in_[8] + D; d.dst = (bf16_t*)(ws_ + W_GLA_IN); d.K = D; d.N = GLA_IN; d.tile0 = P0; }
        else if (it < P2) { d.src = in_[25]; d.gain = in_[24]; d.gmod = 256; d.dst = (bf16_t*)(ws_ + W_GLA_OUT); d.K = D; d.N = D; d.tile0 = P1; }
        else if (it < P3) { d.src = in_[26]; d.gain = in_[8] + 2 * D; d.dst = (bf16_t*)(ws_ + W_ATT_QKV); d.K = D; d.N = QKVD; d.tile0 = P2; }
        else if (it < P4) { d.src = in_[27]; d.dst = (bf16_t*)(ws_ + W_ATT_OUT); d.K = ATTD; d.N = D; d.tile0 = P3; }
        else {
            const int q = (it - P4) / T_FF, l = q / 3, w = q - l * 3;
            d.tile0 = P4 + q * T_FF;
            if (w < 2) { d.src = (w == 0 ? in_[10] : in_[11]) + (size_t)l * D * DFF; d.gain = in_[9] + l * D; d.dst = (bf16_t*)(ws_ + W_FFN_GU) + (size_t)l * 2 * DFF * D; d.K = D; d.N = DFF; d.mode = 1 + w; }
            else { d.src = in_[12] + (size_t)l * DFF * D; d.dst = (bf16_t*)(ws_ + W_FFN_DN) + (size_t)l * D * DFF; d.K = DFF; d.N = D; }
        }
    };
    auto load_tile = [&](int it, const WDesc& d, float (&v)[16]) {
        const int lt = it - d.tile0, nkt = d.K / 64, ntile = lt / nkt, ktile = lt - ntile * nkt, n = ntile * 64 + (tid & 63), k0 = ktile * 64;
#pragma unroll
        for (int r = 0; r < 16; ++r) {
            const int kk = (tid >> 6) + 4 * r;
            float x = 0.f;
            if (n < d.N) { x = d.src[(size_t)(k0 + kk) * d.N + n]; if (d.gain) x *= d.gain[(k0 + kk) & (d.gmod - 1)]; }
            v[r] = x;
        }
    };
    int it = bidx(); bool have = it < WT;
    WDesc d; float v[16];
    if (have) { decode(it, d); load_tile(it, d, v); }
    while (have) {
        const int itn = it + VGRID; const bool hn = itn < WT;
        WDesc dn = d; float vn[16];
        if (hn) { decode(itn, dn); load_tile(itn, dn, vn); }
        __syncthreads();
#pragma unroll
        for (int r = 0; r < 16; ++r) tile[((tid >> 6) + 4 * r) * 65 + (tid & 63)] = v[r];
        __syncthreads();
        {
            const int lt = it - d.tile0, nkt = d.K / 64, ntile = lt / nkt, ktile = lt - ntile * nkt, n0 = ntile * 64, k0 = ktile * 64;
            const int r = tid >> 2, seg = tid & 3, n = n0 + r;
            int drow = n;
            if (d.mode) { const int t = n >> 7, c = n & 127; drow = t * 256 + (d.mode == 2 ? 128 : 0) + c; }
            unsigned w[8];
#pragma unroll
            for (int e = 0; e < 8; ++e) w[e] = pack2(tile[(seg * 16 + 2 * e) * 65 + r], tile[(seg * 16 + 2 * e + 1) * 65 + r]);
            uint4* dp = (uint4*)(d.dst + (size_t)drow * d.K + k0 + seg * 16);
            dp[0] = make_uint4(w[0], w[1], w[2], w[3]); dp[1] = make_uint4(w[4], w[5], w[6], w[7]);
        }
        it = itn; have = hn; d = dn;
#pragma unroll
        for (int r = 0; r < 16; ++r) v[r] = vn[r];
    }
}

DEVI void copy_caches(const Params& p) {
    int z_; asm volatile("s_mov_b32 %0, 0" : "=s"(z_)); unsigned char* ws_ = p.ws + z_; float* out_ = p.out + z_; (void)ws_; (void)out_; KIN_DECL;
    const unsigned gtid = (unsigned)(bidx() * 256 + tidx()), gsz = (unsigned)(VGRID * 256);
#pragma unroll
    for (int g = 0; g < 3; ++g) {
        const unsigned W = g == 0 ? 128u : (g == 1 ? 512u : 2048u);
        const unsigned per = (W - 4u) * 128u, tot = 32u * per;
        const f32x4* src = (const f32x4*)(g == 0 ? in_[5] : (g == 1 ? in_[6] : in_[7]));
        f32x4* dst = (f32x4*)(out_ + (g == 0 ? O_KV0S : (g == 1 ? O_KV1S : O_KV2S)));
        for (unsigned base = gtid; base < tot; base += 8u * gsz) {
            f32x4 v[8]; unsigned di[8];
#pragma unroll
            for (int u = 0; u < 8; ++u) {
                const unsigned i = base + (unsigned)u * gsz, ic = i < tot ? i : tot - 1u, sb = ic / per, rem = ic - sb * per;
                di[u] = sb * W * 128u + rem;
                v[u] = __builtin_nontemporal_load(src + (sb * W + 4u) * 128u + rem);
            }
#pragma unroll
            for (int u = 0; u < 8; ++u) if (base + (unsigned)u * gsz < tot) __builtin_nontemporal_store(v[u], dst + di[u]);
        }
    }
}

DEVI void norm_phase(const Params& p, int mode) {
    int z_; asm volatile("s_mov_b32 %0, 0" : "=s"(z_)); unsigned char* ws_ = p.ws + z_; float* out_ = p.out + z_; (void)ws_; (void)out_; KIN_DECL;
    const int lane = tidx() & 63, wv = (bidx() * 256 + tidx()) >> 6, nw = (VGRID * 256) >> 6;
    float* X = out_;
    bf16_t* Hb = (bf16_t*)(ws_ + B_HB);
    for (int r0 = wv; r0 < T; r0 += 2 * nw) {
        const int r1 = r0 + nw; const bool h1 = r1 < T; const int rr[2] = {r0, h1 ? r1 : r0};
        float4 v[2][4]; float ss[2] = {0.f, 0.f};
#pragma unroll
        for (int k = 0; k < 2; ++k) {
            const int r = rr[k];
            const float* src = mode == 0 ? (r < TP ? in_[0] + (size_t)r * D : in_[1] + (size_t)(r - TP) * D) : X + (size_t)r * D;
#pragma unroll
            for (int i = 0; i < 4; ++i) v[k][i] = ((const float4*)src)[i * 64 + lane];
        }
#pragma unroll
        for (int k = 0; k < 2; ++k) {
#pragma unroll
            for (int i = 0; i < 4; ++i) ss[k] += v[k][i].x * v[k][i].x + v[k][i].y * v[k][i].y + v[k][i].z * v[k][i].z + v[k][i].w * v[k][i].w;
            ss[k] = wave_sum(ss[k]);
        }
#pragma unroll
        for (int k = 0; k < 2; ++k) {
            if (k == 1 && !h1) break;
            const int r = rr[k];
            const float inv = rsqrtf(ss[k] * (1.f / D) + EPS);
            if (mode == 2) {
                const float4* g = (const float4*)in_[28];
#pragma unroll
                for (int i = 0; i < 4; ++i) { float4 gg = g[i * 64 + lane]; ((float4*)(X + (size_t)r * D))[i * 64 + lane] = make_float4(v[k][i].x * inv * gg.x, v[k][i].y * inv * gg.y, v[k][i].z * inv * gg.z, v[k][i].w * inv * gg.w); }
            } else {
#pragma unroll
                for (int i = 0; i < 4; ++i) {
                    if (mode == 0) ((float4*)(X + (size_t)r * D))[i * 64 + lane] = v[k][i];
                    ((uint2*)(Hb + (size_t)r * D))[i * 64 + lane] = make_uint2(pack2(v[k][i].x * inv, v[k][i].y * inv), pack2(v[k][i].z * inv, v[k][i].w * inv));
                }
            }
        }
    }
}

enum { EPI_SSM_IN = 0, EPI_GLA_IN = 1, EPI_ATT_IN = 2, EPI_RESADD = 3, EPI_SWIGLU = 4 };
constexpr int GST = 72;
constexpr int GBUF = 2 * 128 * GST;

template <int EPI, int K>
DEVI void gemm_phase(const Params& p, const bf16_t* __restrict__ A, const bf16_t* __restrict__ Bt, int nN, bool only_split = false) {
    int z_; asm volatile("s_mov_b32 %0, 0" : "=s"(z_)); unsigned char* ws_ = p.ws + z_; float* out_ = p.out + z_; (void)ws_; (void)out_; KIN_DECL;
    const int tid = rtid(), lane = tid & 63, wave = tid >> 6, wm = wave >> 2, wn = wave & 3, l31 = lane & 31, lh = lane >> 5;
    constexpr int SBUF = 2 * 256 * GST;
    bf16_t* const s0 = (bf16_t*)smem;
    constexpr int nkfull = K / 64, KCH = 2;
    const int nMt = (EPI == EPI_RESADD) ? 64 : 65;
    const int nfull = nMt * nN, nch = (EPI == EPI_RESADD) ? (nkfull + KCH - 1) / KCH : 0, nunits = nfull + nch * nN;
    const int bid = rbid(), xcd = bid & 7, lb = bid >> 3, nper = (int)gridDim.x >> 3;
    const int u0 = only_split ? nfull : 0;
    for (int rnd = 0; u0 + rnd * (int)gridDim.x < nunits; ++rnd) {
        const int u = u0 + (rnd * 8 + xcd) * nper + lb;
        if (u >= nunits) continue;
        int mt, nt, kt0, kt1; bool atomic = false;
        if (u < nfull) {
            const int per_group = 8 * nN, gm = u / per_group, rem = u - gm * per_group, fm = gm * 8, gsz = (nMt - fm) < 8 ? (nMt - fm) : 8;
            mt = fm + rem % gsz; nt = rem / gsz; kt0 = 0; kt1 = nkfull;
        } else {
            const int v = u - nfull, ch = v / nN; mt = 64; nt = v - ch * nN; kt0 = ch * KCH; kt1 = (kt0 + KCH < nkfull) ? kt0 + KCH : nkfull; atomic = true;
        }
        const int nk = kt1 - kt0;
        const char* Ab = (const char*)A + (size_t)kt0 * 128; const char* Bb = (const char*)(Bt + (size_t)nt * 256 * K) + (size_t)kt0 * 128;
        unsigned aoff[4];
#pragma unroll
        for (int i = 0; i < 4; ++i) { int gr = mt * 256 + (tid >> 3) + 64 * i; gr = gr < T ? gr : T - 1; aoff[i] = (unsigned)gr * (unsigned)(K * 2) + (unsigned)((tid & 7) * 16); }
        const unsigned boff = (unsigned)(tid >> 3) * (unsigned)(K * 2) + (unsigned)((tid & 7) * 16);
        const unsigned lso = (unsigned)((tid >> 3) * GST + (tid & 7) * 8);
        f32x16 acc[4][2];
#pragma unroll
        for (int i = 0; i < 4; ++i)
#pragma unroll
            for (int j = 0; j < 2; ++j)
#pragma unroll
                for (int e = 0; e < 16; ++e) acc[i][j][e] = 0.f;
        u32x4 ra[4], rb[4];
#define G_LOAD(KT) { const int kk_ = (KT) < nk ? (KT) : nk - 1; const char* ab_ = Ab + (size_t)kk_ * 128; const char* bb_ = Bb + (size_t)kk_ * 128; \
            _Pragma("unroll") for (int i = 0; i < 4; ++i) ra[i] = *(const u32x4*)(ab_ + aoff[i]); \
            _Pragma("unroll") for (int i = 0; i < 4; ++i) rb[i] = *(const u32x4*)(bb_ + (size_t)i * 128 * K + boff); }
#define G_STORE(BUF) { bf16_t* sa_ = s0 + (BUF) * SBUF; bf16_t* sb_ = sa_ + 256 * GST; \
            _Pragma("unroll") for (int i = 0; i < 4; ++i) *(u32x4*)(sa_ + lso + i * 64 * GST) = ra[i]; \
            _Pragma("unroll") for (int i = 0; i < 4; ++i) *(u32x4*)(sb_ + lso + i * 64 * GST) = rb[i]; }
        __syncthreads();
        G_LOAD(0); G_STORE(0); G_LOAD(1);
        __syncthreads();
        for (int kt = 0; kt < nk; ++kt) {
            if (kt + 1 < nk) G_STORE((kt + 1) & 1);
            G_LOAD(kt + 2);
            const bf16_t* cA = s0 + (kt & 1) * SBUF; const bf16_t* cB = cA + 256 * GST;
#pragma unroll
            for (int ks = 0; ks < 4; ++ks) {
                bf16x8 a[4], b[2];
#pragma unroll
                for (int i = 0; i < 4; ++i) a[i] = ldsfrag(cA, 128 * wm + 32 * i + l31, GST, ks * 16 + 8 * lh);
#pragma unroll
                for (int j = 0; j < 2; ++j) b[j] = ldsfrag(cB, 64 * wn + 32 * j + l31, GST, ks * 16 + 8 * lh);
#pragma unroll
                for (int i = 0; i < 4; ++i)
#pragma unroll
                    for (int j = 0; j < 2; ++j) acc[i][j] = mfma32(a[i], b[j], acc[i][j]);
            }
            __syncthreads();
        }
        static_assert(EPI == EPI_RESADD, "own GEMM is only used for the residual-add phases");
        if (mt * 256 + 128 * wm < T) {
#pragma unroll
            for (int i = 0; i < 4; ++i)
#pragma unroll
                for (int j = 0; j < 2; ++j)
#pragma unroll
                    for (int e = 0; e < 16; ++e) {
                        const int row = mt * 256 + 128 * wm + 32 * i + (e & 3) + 8 * (e >> 2) + 4 * lh, col = nt * 256 + 64 * wn + 32 * j + l31;
                        if (row < T) {
                            float* xf = out_ + (size_t)row * D + col;
                            if (atomic) unsafeAtomicAdd(xf, acc[i][j][e]); else *xf += acc[i][j][e];
                        }
                    }
        }
    }
    __syncthreads();
}


namespace pg8 {
#define PG8_LAS __attribute__((address_space(3)))
constexpr int BM = 256, BK = 64, HALF = 128, HTB = HALF * BK * 2  , STAGE_BYTES = 8 * HTB, NXCD = 8, WGM = 8;

__host__ __device__ __forceinline__ int lds_byte(int r, int c) { const int st = (r >> 4) * 2 + (c >> 5), rr = r & 15, cc = c & 31, ob = rr * 64 + cc * 2; return st * 1024 + (ob ^ (((ob >> 9) & 1) << 5)); }
__host__ __device__ __forceinline__ void stage_rc(int b, int& R, int& C) { const int st = b / 1024, sb = b % 1024, swz = sb ^ (((sb >> 9) & 1) << 5); R = (st >> 1) * 16 + swz / 64; C = (st & 1) * 32 + (swz % 64) / 2; }
__host__ __device__ __forceinline__ int perm32(int rho) { const int n = rho >> 4, i = rho & 15; return 8 * (i >> 2) + 4 * n + (i & 3); }

struct Unit { int pm, pn; };
struct Gemm { const bf16_t* A; const bf16_t* Bt; int M, N, K; };
struct StaticOrder {
    int nM, nN, nwg, G, c;
    __host__ __device__ void init(int M, int N, int G_, int c_) { nM = M / BM; nN = N / BM; nwg = nM * nN; G = G_; c = c_; }
    __host__ __device__ bool next(int i, Unit& u) const {
        const long L = (long)i * G + c; if (L >= nwg) return false;
        int wgid = (int)L; { const int q = nwg / NXCD, r = nwg % NXCD, xcd = wgid % NXCD, off = wgid / NXCD; wgid = (xcd < r ? xcd * (q + 1) : r * (q + 1) + (xcd - r) * q) + off; }
        const int nig = WGM * nN, gid = wgid / nig, fm = gid * WGM, gsz = (nM - fm) < WGM ? (nM - fm) : WGM;
        u.pm = fm + ((wgid % nig) % gsz); u.pn = (wgid % nig) / gsz; return true;
    }
    __device__ __forceinline__ void a_ready(const Unit&) const {}
    __device__ __forceinline__ void done(const Unit&) const {}
};
template <class Epi, class Sched, bool STAMP = false>
__device__ __forceinline__ void gemm_phase(PG8_LAS unsigned char* lds, const Gemm g, const Sched& S, const Epi& E, unsigned long long* stamps) {
    const int tid = rtid(), wid = __builtin_amdgcn_readfirstlane(tid >> 6), lane = tid & 63, wr = wid >> 2, wc = wid & 3, fr = lane & 15, fq = lane >> 4;
    const int K = g.K, nt = K / BK;
    int ts_lo = 0, ts_hi = 0, nts = 0; const unsigned long long rt_entry = STAMP ? (unsigned long long)0ull : 0ull;
#define PG8_STAMP() do { if (STAMP && wid == 0 && nts < 64) { const unsigned long long _c = (unsigned long long)clock64(); \
        ts_lo = (lane == nts) ? (int)(unsigned)_c : ts_lo; ts_hi = (lane == nts) ? (int)(unsigned)(_c >> 32) : ts_hi; ++nts; } } while (0)
    PG8_STAMP();
    unsigned voffA[2], voffB[2];
#pragma unroll
    for (int i = 0; i < 2; ++i) { int R, C; stage_rc(tid * 16 + i * 8192, R, C); const int Rb = Epi::PERM ? ((R & ~31) + perm32(R & 31)) : R;
        voffA[i] = (unsigned)(R * K + C) * 2u; voffB[i] = (unsigned)(Rb * K + C) * 2u; }
    const size_t kstep = (size_t)(BK * 2);
    const size_t hstep = (size_t)HALF * K * 2;
    const size_t tstep = 2 * hstep;
    const unsigned ldsw = (unsigned)wid * 1024u;
    const int aoff = lds_byte(wr * 64 + fr, fq * 8), boff = lds_byte(wc * 32 + fr, fq * 8);
#define PG8_SA(b, h) (((b) * 2 + (h)) * HTB)
#define PG8_SB(b, h) ((4 + (b) * 2 + (h)) * HTB)
#define PG8_STAGE(bufoff, gbase, voff) do { _Pragma("unroll") for (int _i = 0; _i < 2; ++_i) \
        __builtin_amdgcn_global_load_lds((const unsigned*)((const char*)(gbase) + (voff)[_i]), (PG8_LAS unsigned*)(lds + (bufoff) + ldsw + _i * 8192), 16, 0, 0); } while (0)
#define PG8_LDA(dst, b, h) do { _Pragma("unroll") for (int m = 0; m < 4; ++m) _Pragma("unroll") for (int k = 0; k < 2; ++k) dst[m][k] = *(const PG8_LAS bf16x8*)(lds + PG8_SA(b, h) + aoff + m * 2048 + k * 1024); } while (0)
#define PG8_LDB(dst, b, h) do { _Pragma("unroll") for (int n = 0; n < 2; ++n) _Pragma("unroll") for (int k = 0; k < 2; ++k) dst[n][k] = *(const PG8_LAS bf16x8*)(lds + PG8_SB(b, h) + boff + n * 2048 + k * 1024); } while (0)
#define PG8_MMA(ai, bj, At, Bt) do { __builtin_amdgcn_s_setprio(1); _Pragma("unroll") for (int m = 0; m < 4; ++m) _Pragma("unroll") for (int n = 0; n < 2; ++n) _Pragma("unroll") for (int k = 0; k < 2; ++k) \
        acc[ai][bj][m][n] = __builtin_amdgcn_mfma_f32_16x16x32_bf16(Bt[n][k], At[m][k], acc[ai][bj][m][n], 0, 0, 0); __builtin_amdgcn_s_setprio(0); } while (0)
#define PG8_WAIT_V(n) asm volatile("s_waitcnt vmcnt(" #n ")" ::: "memory")
#define PG8_WAIT_L(n) asm volatile("s_waitcnt lgkmcnt(" #n ")" ::: "memory")
#define PG8_BAR __builtin_amdgcn_s_barrier()
#define PG8_SCHED __builtin_amdgcn_sched_barrier(0)
    Unit cur, nxt; int ui = 0;
    if (!S.next(0, cur)) return;
    f32x4 acc[2][2][4][2];
#pragma unroll
    for (int a = 0; a < 2; ++a)
#pragma unroll
        for (int b = 0; b < 2; ++b)
#pragma unroll
            for (int m = 0; m < 4; ++m)
#pragma unroll
                for (int n = 0; n < 2; ++n) acc[a][b][m][n] = (f32x4){0.f, 0.f, 0.f, 0.f};
    bf16x8 At[4][2], B0[2][2], B1[2][2];
    const char* cA = (const char*)g.A + (size_t)cur.pm * tstep; const char* cB = (const char*)g.Bt + (size_t)cur.pn * tstep;
    S.a_ready(cur);
    PG8_STAGE(PG8_SB(0, 0), cB, voffB); PG8_STAGE(PG8_SA(0, 0), cA, voffA); PG8_STAGE(PG8_SB(0, 1), cB + hstep, voffB); PG8_STAGE(PG8_SA(0, 1), cA + hstep, voffA);
    if (wr == 1) PG8_BAR;
    PG8_WAIT_V(4); PG8_BAR;
    PG8_STAGE(PG8_SB(1, 0), cB + kstep, voffB); PG8_STAGE(PG8_SA(1, 0), cA + kstep, voffA); PG8_STAGE(PG8_SB(1, 1), cB + hstep + kstep, voffB);
    PG8_WAIT_V(6); PG8_BAR;
    PG8_STAMP();
    for (;;) {
        const bool has_next = S.next(ui + 1, nxt);
        const char* nA = has_next ? (const char*)g.A + (size_t)nxt.pm * tstep : cA; const char* nB = has_next ? (const char*)g.Bt + (size_t)nxt.pn * tstep : cB;
        for (int t = 0; t < nt; t += 2) {
            const bool last = (t == nt - 2);
            const char* a1 = cA + (size_t)(t + 1) * kstep;
            const char* a2 = last ? nA : cA + (size_t)(t + 2) * kstep; const char* b2 = last ? nB : cB + (size_t)(t + 2) * kstep;
            const char* a3 = a2 + kstep; const char* b3 = b2 + kstep;
            if (last && has_next) S.a_ready(nxt);
            PG8_LDB(B0, 0, 0); PG8_SCHED; PG8_LDA(At, 0, 0); PG8_STAGE(PG8_SA(1, 1), a1 + hstep, voffA);
            PG8_WAIT_L(8); PG8_BAR; PG8_WAIT_L(0); PG8_MMA(0, 0, At, B0); PG8_BAR; PG8_SCHED;
            PG8_LDB(B1, 0, 1); PG8_STAGE(PG8_SB(0, 0), b2, voffB);
            PG8_BAR; PG8_WAIT_L(0); PG8_MMA(0, 1, At, B1); PG8_BAR;
            PG8_LDA(At, 0, 1); PG8_STAGE(PG8_SA(0, 0), a2, voffA);
            PG8_BAR; PG8_WAIT_L(0); PG8_MMA(1, 0, At, B0); PG8_BAR; PG8_SCHED;
            PG8_STAGE(PG8_SB(0, 1), b2 + hstep, voffB);
            PG8_WAIT_V(6); PG8_BAR; PG8_MMA(1, 1, At, B1); PG8_BAR;
            PG8_LDB(B0, 1, 0); PG8_SCHED; PG8_LDA(At, 1, 0); PG8_STAGE(PG8_SA(0, 1), a2 + hstep, voffA);
            PG8_WAIT_L(8); PG8_BAR; PG8_WAIT_L(0); PG8_MMA(0, 0, At, B0); PG8_BAR; PG8_SCHED;
            PG8_LDB(B1, 1, 1); PG8_STAGE(PG8_SB(1, 0), b3, voffB);
            PG8_BAR; PG8_WAIT_L(0); PG8_MMA(0, 1, At, B1); PG8_BAR;
            PG8_LDA(At, 1, 1); PG8_STAGE(PG8_SA(1, 0), a3, voffA);
            PG8_BAR; PG8_WAIT_L(0); PG8_MMA(1, 0, At, B0); PG8_BAR; PG8_SCHED;
            PG8_STAGE(PG8_SB(1, 1), b3 + hstep, voffB);
            PG8_WAIT_V(6); PG8_BAR; PG8_MMA(1, 1, At, B1); PG8_BAR;
        }
        PG8_STAMP();
        if constexpr (!Epi::AFTER_DRAIN) { E(acc, cur, wr, wc, fr, fq); S.done(cur); }
        PG8_STAMP();
        if (!has_next) break;
#pragma unroll
        for (int a = 0; a < 2; ++a)
#pragma unroll
            for (int b = 0; b < 2; ++b)
#pragma unroll
                for (int m = 0; m < 4; ++m)
#pragma unroll
                    for (int n = 0; n < 2; ++n) acc[a][b][m][n] = (f32x4){0.f, 0.f, 0.f, 0.f};
        cur = nxt; cA = nA; cB = nB; ++ui;
    }
    PG8_WAIT_V(0);
    if (wr == 0) PG8_BAR;
    PG8_BAR;
    if constexpr (Epi::AFTER_DRAIN) { E.fused(acc, cur, wr, wc, fr, fq, lds, wid, lane); S.done(cur); }
    PG8_STAMP();
    if (STAMP && wid == 0) { stamps[lane] = lane < nts ? (((unsigned long long)(unsigned)ts_hi << 32) | (unsigned)ts_lo) : 0ull;
        if (lane == 62) stamps[62] = rt_entry; if (lane == 63) stamps[63] = (unsigned long long)0ull; }
#undef PG8_STAMP
#undef PG8_SA
#undef PG8_SB
#undef PG8_STAGE
#undef PG8_LDA
#undef PG8_LDB
#undef PG8_MMA
#undef PG8_WAIT_V
#undef PG8_WAIT_L
#undef PG8_BAR
#undef PG8_SCHED
}
}

template <int EPI> struct EpiMk {
    static constexpr bool PERM = (EPI == EPI_SSM_IN || EPI == EPI_GLA_IN || EPI == EPI_ATT_IN || EPI == EPI_SWIGLU), AFTER_DRAIN = false;
    unsigned char* ws; float* out;
    DEVI void operator()(const f32x4 (&acc)[2][2][4][2], const pg8::Unit& u, int wr, int wc, int fr, int fq) const {
        const int row0 = u.pm * 256 + wr * 64 + fr, col0 = u.pn * 256 + wc * 32 + 4 * fq;
#pragma unroll
        for (int ai = 0; ai < 2; ++ai)
#pragma unroll
            for (int m = 0; m < 4; ++m) {
                const int row = row0 + ai * 128 + m * 16;
                if (row < T) {
                    if (EPI == EPI_SWIGLU) {
                        const int hc = u.pn * 128 + wc * 32 + 8 * fq;
                        unsigned w[4];
#pragma unroll
                        for (int n = 0; n < 2; ++n) {
                            const f32x4 g = acc[ai][0][m][n], up = acc[ai][1][m][n];
                            float o[4];
#pragma unroll
                            for (int e = 0; e < 4; ++e) o[e] = g[e] * __builtin_amdgcn_rcpf(1.f + __expf(-g[e])) * up[e];
                            w[2 * n] = pack2(o[0], o[1]); w[2 * n + 1] = pack2(o[2], o[3]);
                        }
                        *(uint4*)((bf16_t*)(ws + B_R4) + (size_t)row * DFF + hc) = make_uint4(w[0], w[1], w[2], w[3]);
                    } else
#pragma unroll
                    for (int bj = 0; bj < 2; ++bj) {
                        if (PERM) {
                            const int col = u.pn * 256 + bj * 128 + wc * 32 + 8 * fq;
                            const f32x4 v0 = acc[ai][bj][m][0], v1 = acc[ai][bj][m][1];
                            const uint4 pk = make_uint4(pack2(v0[0], v0[1]), pack2(v0[2], v0[3]), pack2(v1[0], v1[1]), pack2(v1[2], v1[3]));
                            if (EPI == EPI_SSM_IN) {
                                if (col < DI) *(uint4*)((bf16_t*)(ws + B_R3) + (size_t)row * DI + col) = pk;
                                else if (col < DI + CONVD) *(uint4*)((bf16_t*)(ws + B_R4) + (size_t)row * CONVD + (col - DI)) = pk;
                                else if (col < SSM_IN) { float4* dp = (float4*)((float*)(ws + B_DT) + (size_t)row * 32 + (col - DI - CONVD)); dp[0] = make_float4(v0[0], v0[1], v0[2], v0[3]); dp[1] = make_float4(v1[0], v1[1], v1[2], v1[3]); }
                            } else if (EPI == EPI_GLA_IN) {
                                if (col < 3072) *(uint4*)((bf16_t*)(ws + B_R4) + (size_t)row * 3072 + col) = pk;
                                else if (col < GLA_IN) { float4* dp = (float4*)((float*)(ws + B_GLOW) + (size_t)row * 16 + (col - 3072)); dp[0] = make_float4(v0[0], v0[1], v0[2], v0[3]); dp[1] = make_float4(v1[0], v1[1], v1[2], v1[3]); }
                            } else {
                                *(uint4*)((bf16_t*)(ws + B_R4) + (size_t)row * QKVD + col) = pk;
                            }
                        } else if (EPI == EPI_SWIGLU) {
                            const f32x4 g = acc[ai][bj][m][0], up = acc[ai][bj][m][1];
                            const int hc = u.pn * 128 + bj * 64 + wc * 16 + 4 * fq;
                            float o[4];
#pragma unroll
                            for (int e = 0; e < 4; ++e) o[e] = g[e] * __builtin_amdgcn_rcpf(1.f + __expf(-g[e])) * up[e];
                            *(uint2*)((bf16_t*)(ws + B_R4) + (size_t)row * DFF + hc) = make_uint2(pack2(o[0], o[1]), pack2(o[2], o[3]));
                        } else {
#pragma unroll
                            for (int n = 0; n < 2; ++n) {
                                const int col = col0 + bj * 128 + n * 16;
                                const f32x4 v = acc[ai][bj][m][n];
                                if (EPI == EPI_RESADD) {
                                    float4* xp = (float4*)(out + (size_t)row * D + col);
                                    float4 x = *xp; x.x += v[0]; x.y += v[1]; x.z += v[2]; x.w += v[3]; *xp = x;
                                } else if (EPI == EPI_SSM_IN) {
                                    const uint2 pk = make_uint2(pack2(v[0], v[1]), pack2(v[2], v[3]));
                                    if (col < DI) *(uint2*)((bf16_t*)(ws + B_R3) + (size_t)row * DI + col) = pk;
                                    else if (col < DI + CONVD) *(uint2*)((bf16_t*)(ws + B_R4) + (size_t)row * CONVD + (col - DI)) = pk;
                                    else if (col < SSM_IN) *(float4*)((float*)(ws + B_DT) + (size_t)row * 32 + (col - DI - CONVD)) = make_float4(v[0], v[1], v[2], v[3]);
                                } else if (EPI == EPI_GLA_IN) {
                                    if (col < 3072) *(uint2*)((bf16_t*)(ws + B_R4) + (size_t)row * 3072 + col) = make_uint2(pack2(v[0], v[1]), pack2(v[2], v[3]));
                                    else if (col < GLA_IN) *(float4*)((float*)(ws + B_GLOW) + (size_t)row * 16 + (col - 3072)) = make_float4(v[0], v[1], v[2], v[3]);
                                } else {
                                    *(uint2*)((bf16_t*)(ws + B_R4) + (size_t)row * QKVD + col) = make_uint2(pack2(v[0], v[1]), pack2(v[2], v[3]));
                                }
                            }
                        }
                    }
                }
            }
    }
};

template <int EPI>
DEVI void gemm8(const Params& p, const bf16_t* A, const bf16_t* Bt, int Mrows, int N, int K) {
    int z_; asm volatile("s_mov_b32 %0, 0" : "=s"(z_));
    EpiMk<EPI> E; E.ws = p.ws + z_; E.out = p.out + z_;
    pg8::Gemm g; g.A = A + z_; g.Bt = Bt + z_; g.M = Mrows; g.N = N; g.K = K;
    pg8::StaticOrder S; S.init(Mrows, N, (int)gridDim.x, rbid());
    __syncthreads();
    pg8::gemm_phase<EpiMk<EPI>, pg8::StaticOrder, false>((PG8_LAS unsigned char*)smem, g, S, E, nullptr);
    __syncthreads();
}

DEVI void ssm_conv_phase(const Params& p, int j) {
    int z_; asm volatile("s_mov_b32 %0, 0" : "=s"(z_)); unsigned char* ws_ = p.ws + z_; float* out_ = p.out + z_; (void)ws_; (void)out_; KIN_DECL;
    const bf16_t* raw = (const bf16_t*)(ws_ + B_R4);
    bf16_t* act = (bf16_t*)(ws_ + B_R5);
    const float* cw = in_[14] + (size_t)j * 4 * CONVD; const float* cb = in_[15] + (size_t)j * CONVD;
    const float* sbuf = in_[3] + (size_t)j * 32 * 3 * CONVD;
    float* convp = out_ + O_CONVP + (size_t)j * 2 * 3 * CONVD; float* convs = out_ + O_CONVS + (size_t)j * 32 * 3 * CONVD;
    const size_t gtid = (size_t)bidx() * 256 + tidx(), gsz = (size_t)VGRID * 256;
    {
        const size_t totp = (size_t)(TP / 16) * (CONVD / 8);
        for (size_t it = gtid; it < totp; it += gsz) {
            const int run = (int)(it / (CONVD / 8)), c8 = (int)(it % (CONVD / 8)) * 8;
            const int t0 = run * 16, pos0 = t0 & (SEQ - 1);
            float w[4][8], bb[8], x1[8], x2[8], x3[8];
#pragma unroll
            for (int d = 0; d < 4; ++d)
#pragma unroll
                for (int e = 0; e < 8; ++e) w[d][e] = cw[(size_t)d * CONVD + c8 + e];
#pragma unroll
            for (int e = 0; e < 8; ++e) bb[e] = cb[c8 + e];
            if (pos0 >= 3) {
                unpack8(*(const uint4*)(raw + (size_t)(t0 - 1) * CONVD + c8), x1); unpack8(*(const uint4*)(raw + (size_t)(t0 - 2) * CONVD + c8), x2); unpack8(*(const uint4*)(raw + (size_t)(t0 - 3) * CONVD + c8), x3);
            } else {
#pragma unroll
                for (int e = 0; e < 8; ++e) { x1[e] = 0.f; x2[e] = 0.f; x3[e] = 0.f; }
            }
#pragma unroll 4
            for (int r = 0; r < 16; ++r) {
                const int t = t0 + r;
                float x0[8]; unpack8(*(const uint4*)(raw + (size_t)t * CONVD + c8), x0);
                unsigned o[4];
#pragma unroll
                for (int e = 0; e < 4; ++e) {
                    const float a0 = bb[2 * e] + w[3][2 * e] * x0[2 * e] + w[2][2 * e] * x1[2 * e] + w[1][2 * e] * x2[2 * e] + w[0][2 * e] * x3[2 * e];
                    const float a1 = bb[2 * e + 1] + w[3][2 * e + 1] * x0[2 * e + 1] + w[2][2 * e + 1] * x1[2 * e + 1] + w[1][2 * e + 1] * x2[2 * e + 1] + w[0][2 * e + 1] * x3[2 * e + 1];
                    o[e] = pack2(silu_f(a0), silu_f(a1));
                }
                *(uint4*)(act + (size_t)t * CONVD + c8) = make_uint4(o[0], o[1], o[2], o[3]);
                const int pos = pos0 + r;
                if (pos >= SEQ - 3) {
                    float* op = convp + ((size_t)(t >> 13) * 3 + (pos - (SEQ - 3))) * CONVD + c8;
#pragma unroll
                    for (int e = 0; e < 8; ++e) op[e] = x0[e];
                }
#pragma unroll
                for (int e = 0; e < 8; ++e) { x3[e] = x2[e]; x2[e] = x1[e]; x1[e] = x0[e]; }
            }
        }
    }
    const size_t tot = (size_t)TS * (CONVD / 8);
    for (size_t it = gtid; it < tot; it += gsz) {
        const int t = TP + (int)(it / (CONVD / 8)), c8 = (int)(it % (CONVD / 8)) * 8;
        int pos, sb = 0; bool samp = t >= TP;
        if (samp) { sb = (t - TP) >> 2; pos = (t - TP) & 3; } else pos = t & (SEQ - 1);
        float accv[8], xr[4][8];
#pragma unroll
        for (int e = 0; e < 8; ++e) accv[e] = cb[c8 + e];
#pragma unroll
        for (int d = 0; d < 4; ++d) {
            if (pos - d >= 0) unpack8(*(const uint4*)(raw + (size_t)(t - d) * CONVD + c8), xr[d]);
            else if (samp) {
                const float* bp = sbuf + ((size_t)sb * 3 + (3 + pos - d)) * CONVD + c8;
#pragma unroll
                for (int e = 0; e < 8; ++e) xr[d][e] = bp[e];
            } else {
#pragma unroll
                for (int e = 0; e < 8; ++e) xr[d][e] = 0.f;
            }
            const float* wp = cw + (size_t)(3 - d) * CONVD + c8;
#pragma unroll
            for (int e = 0; e < 8; ++e) accv[e] += xr[d][e] * wp[e];
        }
        unsigned w[4];
#pragma unroll
        for (int e = 0; e < 4; ++e) w[e] = pack2(silu_f(accv[2 * e]), silu_f(accv[2 * e + 1]));
        *(uint4*)(act + (size_t)t * CONVD + c8) = make_uint4(w[0], w[1], w[2], w[3]);
        if (!samp && pos >= SEQ - 3) {
            float* o = convp + ((size_t)(t >> 13) * 3 + (pos - (SEQ - 3))) * CONVD + c8;
#pragma unroll
            for (int e = 0; e < 8; ++e) o[e] = xr[0][e];
        }
        if (samp && pos >= 1) {
            float* o = convs + ((size_t)sb * 3 + (pos - 1)) * CONVD + c8;
#pragma unroll
            for (int e = 0; e < 8; ++e) o[e] = xr[0][e];
        }
    }
    const float* DT = (const float*)(ws_ + B_DT); float* DTS = (float*)(ws_ + B_DTS); float* ACS = (float*)(ws_ + B_ACS);
    if (gtid < TS * 4) ((float*)(ws_ + B_SSQS))[gtid] = 0.f;
    const float* dtb = in_[16] + j * 32; const float* alog = in_[17] + j * 32;
    {
        const int lane = tidx() & 63, wv = (bidx() * 256 + tidx()) >> 6, nw = VGRID * 4;
        for (int it = wv; it < 128 * 32; it += nw) {
            const int c = it >> 5, h = it & 31;
            const float Ah = -__expf(alog[h]), bh = dtb[h];
            float carry = 0.f;
#pragma unroll
            for (int ps = 0; ps < 2; ++ps) {
                const size_t o = (size_t)(c * 128 + ps * 64 + lane) * 32 + h;
                const float d = softplus_f(DT[o] + bh); DTS[o] = d;
                float a = Ah * d;
#pragma unroll
                for (int off = 1; off < 64; off <<= 1) { const float t = __shfl_up(a, off); if (lane >= off) a += t; }
                a += carry; ACS[o] = a; carry = __shfl(a, 63);
            }
        }
    }
    for (size_t it = gtid; it < TS * 32; it += gsz) {
        const int r = (int)it, h = r & 31; const size_t o = (size_t)(TP + (r >> 5)) * 32 + h;
        const float d = softplus_f(DT[o] + dtb[h]); DTS[o] = d; ACS[o] = -__expf(alog[h]) * d;
    }
}

constexpr int SST = 136;
DEVI void ssm_state_phase(const Params& p, int j) {
    int z_; asm volatile("s_mov_b32 %0, 0" : "=s"(z_)); unsigned char* ws_ = p.ws + z_; float* out_ = p.out + z_; (void)ws_; (void)out_; KIN_DECL;
    const bf16_t* act = (const bf16_t*)(ws_ + B_R5);
    const float* DTS = (const float*)(ws_ + B_DTS); const float* ACS = (const float*)(ws_ + B_ACS);
    bf16_t* ST = (bf16_t*)(ws_ + B_R6);
    const int tid = tidx(), lane = tid & 63, wave = tid >> 6, l31 = lane & 31, lh = lane >> 5;
    bf16_t* sBt = (bf16_t*)VSMEM;
    bf16_t* sXt = sBt + 128 * SST;
    float* sw = (float*)(sXt + 64 * SST);
    const int nprompt = 128 * 4, nitems = nprompt + 32 * 32;
    for (int item = bidx(); item < nitems; item += VGRID) {
        if (item < nprompt) {
            const int c = item >> 2, g = item & 3, t0 = c * 128;
            __syncthreads();
            for (int idx = tid; idx < 128 * 16; idx += 256) {
                const int q = idx >> 4, n8 = (idx & 15) * 8;
                const uint4 v = *(const uint4*)(act + (size_t)(t0 + q) * CONVD + DI + g * 128 + n8);
                const unsigned short* s = (const unsigned short*)&v;
#pragma unroll
                for (int e = 0; e < 8; ++e) sBt[(n8 + e) * SST + q] = s[e];
            }
            for (int hh = 0; hh < 8; ++hh) {
                const int h = g * 8 + hh;
                __syncthreads();
                if (tid < 128) sw[tid] = DTS[(size_t)(t0 + tid) * 32 + h] * __expf(ACS[(size_t)(t0 + 127) * 32 + h] - ACS[(size_t)(t0 + tid) * 32 + h]);
                __syncthreads();
                for (int idx = tid; idx < 128 * 8; idx += 256) {
                    const int q = idx >> 3, p8 = (idx & 7) * 8;
                    float f[8]; unpack8(*(const uint4*)(act + (size_t)(t0 + q) * CONVD + h * 64 + p8), f);
                    const float w = sw[q];
#pragma unroll
                    for (int e = 0; e < 8; ++e) sXt[(p8 + e) * SST + q] = f2bf(f[e] * w);
                }
                __syncthreads();
                f32x16 acc[2];
#pragma unroll
                for (int i = 0; i < 2; ++i)
#pragma unroll
                    for (int e = 0; e < 16; ++e) acc[i][e] = 0.f;
#pragma unroll
                for (int ks = 0; ks < 8; ++ks) {
                    const bf16x8 a = ldsfrag(sBt, 32 * wave + l31, SST, ks * 16 + 8 * lh);
#pragma unroll
                    for (int i = 0; i < 2; ++i) acc[i] = mfma32(a, ldsfrag(sXt, 32 * i + l31, SST, ks * 16 + 8 * lh), acc[i]);
                }
#pragma unroll
                for (int i = 0; i < 2; ++i)
#pragma unroll
                    for (int rg = 0; rg < 4; ++rg) {
                        const int n = 32 * wave + 8 * rg + 4 * lh, pp = 32 * i + l31;
                        *(uint2*)(ST + (((size_t)c * 32 + h) * 64 + pp) * 128 + n) = make_uint2(pack2(acc[i][4 * rg], acc[i][4 * rg + 1]), pack2(acc[i][4 * rg + 2], acc[i][4 * rg + 3]));
                    }
            }
        } else {
            const int sit = item - nprompt, sb = sit >> 5, h = sit & 31, g = h >> 3, pp = tid >> 2, nq = tid & 3;
            const float* st_in = in_[2] + (size_t)j * 32 * 262144; float* st_out = out_ + O_SSMS + (size_t)j * 32 * 262144;
            const bf16_t* Z = (const bf16_t*)(ws_ + B_R3); bf16_t* Y = (bf16_t*)(ws_ + B_R4);
            float* SSQS = (float*)(ws_ + B_SSQS);
            const size_t sbase = (((size_t)sb * 32 + h) * 64 + pp) * 128;
            float hs[32];
#pragma unroll
            for (int i = 0; i < 8; ++i) { const float4 v = *(const float4*)(st_in + sbase + 4 * nq + 16 * i); hs[4 * i] = v.x; hs[4 * i + 1] = v.y; hs[4 * i + 2] = v.z; hs[4 * i + 3] = v.w; }
            const float Dh = in_[18][j * 32 + h];
#pragma unroll 1
            for (int s = 0; s < 4; ++s) {
                const int tok = TP + sb * 4 + s;
                const float dt = DTS[(size_t)tok * 32 + h], dA = __expf(ACS[(size_t)tok * 32 + h]);
                const float x = bf2f(act[(size_t)tok * CONVD + h * 64 + pp]), xdt = x * dt;
                float yp = 0.f;
#pragma unroll
                for (int i = 0; i < 8; ++i) {
                    float bf[4], cf[4];
                    unpack4(*(const uint2*)(act + (size_t)tok * CONVD + DI + g * 128 + 4 * nq + 16 * i), bf);
                    unpack4(*(const uint2*)(act + (size_t)tok * CONVD + DI + 512 + g * 128 + 4 * nq + 16 * i), cf);
#pragma unroll
                    for (int e = 0; e < 4; ++e) { hs[4 * i + e] = dA * hs[4 * i + e] + xdt * bf[e]; yp += hs[4 * i + e] * cf[e]; }
                }
                yp += __shfl_xor(yp, 1); yp += __shfl_xor(yp, 2);
                const float yv = (yp + Dh * x) * silu_f(bf2f(Z[(size_t)tok * DI + h * 64 + pp]));
                if (nq == 0) Y[(size_t)tok * DI + h * 64 + pp] = f2bf(yv);
                const float tot = wave_sum(nq == 0 ? yv * yv : 0.f);
                if ((tid & 63) == 0) unsafeAtomicAdd(SSQS + (tok - TP) * 4 + g, tot);
            }
#pragma unroll
            for (int i = 0; i < 8; ++i) *(float4*)(st_out + sbase + 4 * nq + 16 * i) = make_float4(hs[4 * i], hs[4 * i + 1], hs[4 * i + 2], hs[4 * i + 3]);
        }
    }
}

DEVI void ssm_scan_phase(const Params& p, int j) {
    int z_; asm volatile("s_mov_b32 %0, 0" : "=s"(z_)); unsigned char* ws_ = p.ws + z_; float* out_ = p.out + z_; (void)ws_; (void)out_; KIN_DECL;
    bf16_t* ST = (bf16_t*)(ws_ + B_R6);
    const float* ACS = (const float*)(ws_ + B_ACS);
    float* outp = out_ + O_SSMP + (size_t)j * 2 * 262144;
    const int gtid = bidx() * 256 + tidx(), gsz = VGRID * 256;
    {
        bf16_t* Y = (bf16_t*)(ws_ + B_R4); const float* SSQS = (const float*)(ws_ + B_SSQS);
        for (int it = gtid; it < TS * 256; it += gsz) {
            const int tk = it >> 8, c8 = (it & 255) * 8;
            const float inv = rsqrtf(SSQS[tk * 4 + (c8 >> 9)] * (1.f / 512.f) + EPS);
            uint4* yp = (uint4*)(Y + (size_t)(TP + tk) * DI + c8);
            float f[8]; unpack8(*yp, f);
            *yp = make_uint4(pack2(f[0] * inv, f[1] * inv), pack2(f[2] * inv, f[3] * inv), pack2(f[4] * inv, f[5] * inv), pack2(f[6] * inv, f[7] * inv));
        }
    }
    for (int it = gtid; it < 2 * 32 * 2048; it += gsz) {
        const int b = it >> 16, h = (it >> 11) & 31, e4 = (it & 2047) * 4;
        float s0 = 0.f, s1 = 0.f, s2 = 0.f, s3 = 0.f;
#pragma unroll 16
        for (int cc = 0; cc < 64; ++cc) {
            const int c = b * 64 + cc;
            uint2* ptr = (uint2*)(ST + ((size_t)c * 32 + h) * 8192 + e4);
            float f[4]; unpack4(*ptr, f);
            *ptr = make_uint2(pack2(s0, s1), pack2(s2, s3));
            const float dec = __expf(ACS[(size_t)(c * 128 + 127) * 32 + h]);
            s0 = dec * s0 + f[0]; s1 = dec * s1 + f[1]; s2 = dec * s2 + f[2]; s3 = dec * s3 + f[3];
        }
        *(float4*)(outp + ((size_t)b * 32 + h) * 8192 + e4) = make_float4(s0, s1, s2, s3);
    }
}

DEVI void ssm_out_phase(const Params& p, int j) {
    int z_; asm volatile("s_mov_b32 %0, 0" : "=s"(z_)); unsigned char* ws_ = p.ws + z_; float* out_ = p.out + z_; (void)ws_; (void)out_; KIN_DECL;
    const bf16_t* act = (const bf16_t*)(ws_ + B_R5);
    const float* DTS = (const float*)(ws_ + B_DTS); const float* ACS = (const float*)(ws_ + B_ACS);
    const bf16_t* ST = (const bf16_t*)(ws_ + B_R6); const bf16_t* Z = (const bf16_t*)(ws_ + B_R3);
    bf16_t* Y = (bf16_t*)(ws_ + B_R4);
    const float* dsk = in_[18] + j * 32;
    const int tid = tidx(), lane = tid & 63, wave = tid >> 6, l31 = lane & 31, lh = lane >> 5;
    bf16_t* RA = (bf16_t*)VSMEM;
    bf16_t* RB = RA + 128 * SST;
    float* sacs = (float*)(RB + 128 * SST);
    float* sdts = sacs + 1024;
    for (int item = bidx(); item < 512; item += VGRID) {
        const int c = item >> 2, g = item & 3, t0 = c * 128;
        __syncthreads();
        for (int idx = tid; idx < 128 * 16; idx += 256) {
            const int q = idx >> 4, n8 = (idx & 15) * 8;
            *(uint4*)(RB + q * SST + n8) = *(const uint4*)(act + (size_t)(t0 + q) * CONVD + DI + g * 128 + n8);
            *(uint4*)(RA + q * SST + n8) = *(const uint4*)(act + (size_t)(t0 + q) * CONVD + DI + 512 + g * 128 + n8);
        }
        for (int idx = tid; idx < 1024; idx += 256) {
            const int hh = idx >> 7, q = idx & 127;
            sacs[idx] = ACS[(size_t)(t0 + q) * 32 + g * 8 + hh]; sdts[idx] = DTS[(size_t)(t0 + q) * 32 + g * 8 + hh];
        }
        __syncthreads();
        f32x16 X[4]; bf16x8 cf[8];
#pragma unroll
        for (int st = 0; st < 4; ++st)
#pragma unroll
            for (int e = 0; e < 16; ++e) X[st][e] = 0.f;
#pragma unroll
        for (int ks = 0; ks < 8; ++ks) {
            cf[ks] = ldsfrag(RA, 32 * wave + l31, SST, ks * 16 + 8 * lh);
#pragma unroll
            for (int st = 0; st < 4; ++st) X[st] = mfma32(ldsfrag(RB, 32 * st + l31, SST, ks * 16 + 8 * lh), cf[ks], X[st]);
        }
        const int q = 32 * wave + l31;
        float ssqk[4] = {0.f, 0.f, 0.f, 0.f};
        for (int hh = 0; hh < 8; ++hh) {
            const int h = g * 8 + hh;
            __syncthreads();
            for (int idx = tid; idx < 128 * 8; idx += 256) {
                const int s = idx >> 3, p8 = (idx & 7) * 8;
                float f[8]; unpack8(*(const uint4*)(act + (size_t)(t0 + s) * CONVD + h * 64 + p8), f);
                const float w = sdts[hh * 128 + s];
#pragma unroll
                for (int e = 0; e < 8; ++e) RA[(p8 + e) * SST + s] = f2bf(f[e] * w);
            }
            for (int idx = tid; idx < 64 * 16; idx += 256) {
                const int pp = idx >> 4, n8 = (idx & 15) * 8;
                *(uint4*)(RA + (64 + pp) * SST + n8) = *(const uint4*)(ST + (((size_t)c * 32 + h) * 64 + pp) * 128 + n8);
            }
            const float aq = sacs[hh * 128 + q];
#pragma unroll
            for (int st = 0; st < 4; ++st)
#pragma unroll
                for (int rg = 0; rg < 4; ++rg) {
                    const int s0 = 32 * st + 8 * rg + 4 * lh;
                    float m[4];
#pragma unroll
                    for (int e = 0; e < 4; ++e) { const int s = s0 + e; m[e] = (s <= q) ? X[st][4 * rg + e] * __expf(aq - sacs[hh * 128 + s]) : 0.f; }
                    *(uint2*)(RB + q * SST + s0) = make_uint2(pack2(m[0], m[1]), pack2(m[2], m[3]));
                }
            __syncthreads();
            f32x16 ad[2], ao[2];
#pragma unroll
            for (int i = 0; i < 2; ++i)
#pragma unroll
                for (int e = 0; e < 16; ++e) { ad[i][e] = 0.f; ao[i][e] = 0.f; }
#pragma unroll
            for (int ks = 0; ks < 8; ++ks) {
                const bf16x8 mb = ldsfrag(RB, q, SST, ks * 16 + 8 * lh);
#pragma unroll
                for (int i = 0; i < 2; ++i) {
                    ad[i] = mfma32(ldsfrag(RA, 32 * i + l31, SST, ks * 16 + 8 * lh), mb, ad[i]);
                    ao[i] = mfma32(ldsfrag(RA, 64 + 32 * i + l31, SST, ks * 16 + 8 * lh), cf[ks], ao[i]);
                }
            }
            const float eq = __expf(aq), Dh = dsk[h];
            float* sYw = (float*)(RB + q * SST);
#pragma unroll
            for (int i = 0; i < 2; ++i)
#pragma unroll
                for (int rg = 0; rg < 4; ++rg) {
                    f32x4 v;
#pragma unroll
                    for (int e = 0; e < 4; ++e) v[e] = ad[i][4 * rg + e] + eq * ao[i][4 * rg + e];
                    *(f32x4*)(sYw + 32 * i + 8 * rg + 4 * lh) = v;
                }
#pragma unroll
            for (int k = 0; k < 4; ++k) {
                const int qr = 32 * wave + (lane >> 3) + 8 * k, c8 = (lane & 7) * 8;
                const float* yr = (const float*)(RB + qr * SST) + c8;
                const f32x4 y0 = *(const f32x4*)yr, y1 = *(const f32x4*)(yr + 4);
                const size_t go = (size_t)(t0 + qr);
                float xf[8], zf[8], y[8];
                unpack8(*(const uint4*)(act + go * CONVD + h * 64 + c8), xf);
                unpack8(*(const uint4*)(Z + go * DI + h * 64 + c8), zf);
                float ps = 0.f;
#pragma unroll
                for (int e = 0; e < 8; ++e) { const float yr_ = e < 4 ? y0[e & 3] : y1[e & 3]; y[e] = (yr_ + Dh * xf[e]) * silu_f(zf[e]); ps += y[e] * y[e]; }
                ps += __shfl_xor(ps, 1); ps += __shfl_xor(ps, 2); ps += __shfl_xor(ps, 4);
                ssqk[k] += ps;
                *(uint4*)(Y + go * DI + h * 64 + c8) = make_uint4(pack2(y[0], y[1]), pack2(y[2], y[3]), pack2(y[4], y[5]), pack2(y[6], y[7]));
                if (k & 1) __builtin_amdgcn_sched_barrier(0);
            }
        }
#pragma unroll
        for (int k = 0; k < 4; ++k) {
            const float inv = rsqrtf(ssqk[k] * (1.f / 512.f) + EPS);
            const int qr = 32 * wave + (lane >> 3) + 8 * k, c8 = (lane & 7) * 8;
            const size_t go = (size_t)(t0 + qr);
            for (int hh = 0; hh < 8; ++hh) {
                uint4* yp = (uint4*)(Y + go * DI + (g * 8 + hh) * 64 + c8);
                float f[8]; unpack8(*yp, f);
                *yp = make_uint4(pack2(f[0] * inv, f[1] * inv), pack2(f[2] * inv, f[3] * inv), pack2(f[4] * inv, f[5] * inv), pack2(f[6] * inv, f[7] * inv));
            }
        }
    }
}

constexpr int GCH = 64;
DEVI void gla_gate_phase(const Params& p) {
    int z_; asm volatile("s_mov_b32 %0, 0" : "=s"(z_)); unsigned char* ws_ = p.ws + z_; float* out_ = p.out + z_; (void)ws_; (void)out_; KIN_DECL;
    const float* GLOW = (const float*)(ws_ + B_GLOW); float* BC = (float*)(ws_ + B_HB);
    const float* wg = in_[22]; const float* gb = in_[23];
    const int tid = tidx();
    const int nitems = TP / GCH + 32;
    for (int item = bidx(); item < nitems; item += VGRID) {
        int t0, len;
        if (item < TP / GCH) { t0 = item * GCH; len = GCH; } else { t0 = TP + (item - TP / GCH) * 4; len = 4; }
        float w0[16], w1[16];
#pragma unroll
        for (int r = 0; r < 16; ++r) { w0[r] = wg[r * 512 + tid]; w1[r] = wg[r * 512 + 256 + tid]; }
        const float b0 = gb[tid], b1 = gb[256 + tid];
        float* sg = (float*)VSMEM;
        __syncthreads();
        if (tid * 4 < len * 16) *(float4*)(sg + tid * 4) = *(const float4*)(GLOW + (size_t)t0 * 16 + tid * 4);
        __syncthreads();
        float r0 = 0.f, r1 = 0.f;
        for (int q = 0; q < len; ++q) {
            const float* gl = sg + q * 16;
            float a0 = b0, a1 = b1;
#pragma unroll
            for (int r = 0; r < 16; ++r) { const float gv = gl[r]; a0 += gv * w0[r]; a1 += gv * w1[r]; }
            r0 += logsigmoid_f(a0) * (1.f / 16.f); r1 += logsigmoid_f(a1) * (1.f / 16.f);
            BC[(size_t)(t0 + q) * 512 + tid] = r0; BC[(size_t)(t0 + q) * 512 + 256 + tid] = r1;
        }
    }
}

constexpr int QST = 72;
DEVI void gla_state_phase(const Params& p) {
    int z_; asm volatile("s_mov_b32 %0, 0" : "=s"(z_)); unsigned char* ws_ = p.ws + z_; float* out_ = p.out + z_; (void)ws_; (void)out_; KIN_DECL;
    const bf16_t* QK = (const bf16_t*)(ws_ + B_R4);
    const float* BC = (const float*)(ws_ + B_HB);
    bf16_t* U = (bf16_t*)(ws_ + B_R6);
    const int tid = tidx(), lane = tid & 63, wave = tid >> 6, l31 = lane & 31, lh = lane >> 5;
    bf16_t* sVt = (bf16_t*)VSMEM;
    bf16_t* sKt = sVt + 256 * QST;
    const int nprompt = (TP / GCH) * 4, nitems = nprompt + 128;
    for (int item = bidx(); item < nitems; item += VGRID) {
        __syncthreads();
        if (item < nprompt) {
            const int c = item >> 2, h = item & 3, t0 = c * GCH;
            for (int idx = tid; idx < GCH * 32; idx += 256) {
                const int q = idx >> 5, v8 = (idx & 31) * 8;
                const uint4 v = *(const uint4*)(QK + (size_t)(t0 + q) * 3072 + 1024 + h * 256 + v8);
                const unsigned short* s = (const unsigned short*)&v;
#pragma unroll
                for (int e = 0; e < 8; ++e) sVt[(v8 + e) * QST + q] = s[e];
            }
            for (int idx = tid; idx < GCH * 16; idx += 256) {
                const int q = idx >> 4, k8 = (idx & 15) * 8;
                float f[8]; unpack8(*(const uint4*)(QK + (size_t)(t0 + q) * 3072 + 512 + h * 128 + k8), f);
                const float* bl = BC + (size_t)(t0 + GCH - 1) * 512 + h * 128 + k8; const float* bq = BC + (size_t)(t0 + q) * 512 + h * 128 + k8;
#pragma unroll
                for (int e = 0; e < 8; ++e) sKt[(k8 + e) * QST + q] = f2bf(f[e] * __expf(bl[e] - bq[e]));
            }
            __syncthreads();
            f32x16 acc[2][4];
#pragma unroll
            for (int i = 0; i < 2; ++i)
#pragma unroll
                for (int kk = 0; kk < 4; ++kk)
#pragma unroll
                    for (int e = 0; e < 16; ++e) acc[i][kk][e] = 0.f;
#pragma unroll
            for (int ks = 0; ks < 4; ++ks) {
                bf16x8 vb[2];
#pragma unroll
                for (int i = 0; i < 2; ++i) vb[i] = ldsfrag(sVt, 64 * wave + 32 * i + l31, QST, ks * 16 + 8 * lh);
#pragma unroll
                for (int kk = 0; kk < 4; ++kk) {
                    const bf16x8 ka = ldsfrag(sKt, 32 * kk + l31, QST, ks * 16 + 8 * lh);
#pragma unroll
                    for (int i = 0; i < 2; ++i) acc[i][kk] = mfma32(ka, vb[i], acc[i][kk]);
                }
            }
#pragma unroll
            for (int i = 0; i < 2; ++i)
#pragma unroll
                for (int kk = 0; kk < 4; ++kk)
#pragma unroll
                    for (int rg = 0; rg < 4; ++rg) {
                        const int v = 64 * wave + 32 * i + l31, k = 32 * kk + 8 * rg + 4 * lh;
                        *(uint2*)(U + (((size_t)c * 4 + h) * 256 + v) * 128 + k) = make_uint2(pack2(acc[i][kk][4 * rg], acc[i][kk][4 * rg + 1]), pack2(acc[i][kk][4 * rg + 2], acc[i][kk][4 * rg + 3]));
                    }
        } else {
            const int sb = (item - nprompt) >> 2, h = (item - nprompt) & 3, v = tid;
            const float* s_in = in_[4] + ((size_t)sb * 4 + h) * 32768; float* s_out = out_ + O_GLAS + ((size_t)sb * 4 + h) * 32768;
            bf16_t* OG = (bf16_t*)(ws_ + B_R3);
            float* sq = (float*)VSMEM; float* sk = sq + 128; float* sa = sk + 128; float* red = sa + 128;
            float S[128];
#pragma unroll
            for (int k = 0; k < 128; ++k) S[k] = s_in[(size_t)k * 256 + v];
            for (int s = 0; s < 4; ++s) {
                const int tok = TP + sb * 4 + s;
                __syncthreads();
                if (tid < 128) {
                    sq[tid] = bf2f(QK[(size_t)tok * 3072 + h * 128 + tid]) * 0.08838834764831845f;
                    sk[tid] = bf2f(QK[(size_t)tok * 3072 + 512 + h * 128 + tid]);
                    const float bcur = BC[(size_t)tok * 512 + h * 128 + tid], bprev = s ? BC[(size_t)(tok - 1) * 512 + h * 128 + tid] : 0.f;
                    sa[tid] = __expf(bcur - bprev);
                }
                __syncthreads();
                const float vv = bf2f(QK[(size_t)tok * 3072 + 1024 + h * 256 + v]);
                float o = 0.f;
#pragma unroll
                for (int k = 0; k < 128; ++k) { S[k] = sa[k] * S[k] + sk[k] * vv; o += sq[k] * S[k]; }
                red[tid] = o * o;
                __syncthreads();
                for (int st = 128; st > 0; st >>= 1) { if (tid < st) red[tid] += red[tid + st]; __syncthreads(); }
                const float inv = rsqrtf(red[0] * (1.f / 256.f) + EPS);
                const float r = bf2f(QK[(size_t)tok * 3072 + 2048 + h * 256 + v]);
                OG[(size_t)tok * D + h * 256 + v] = f2bf(o * inv * silu_f(r));
            }
#pragma unroll
            for (int k = 0; k < 128; ++k) s_out[(size_t)k * 256 + v] = S[k];
        }
    }
}

DEVI void gla_scan_phase(const Params& p) {
    int z_; asm volatile("s_mov_b32 %0, 0" : "=s"(z_)); unsigned char* ws_ = p.ws + z_; float* out_ = p.out + z_; (void)ws_; (void)out_; KIN_DECL;
    bf16_t* U = (bf16_t*)(ws_ + B_R6);
    const float* BC = (const float*)(ws_ + B_HB);
    float* outp = out_ + O_GLAP;
    const int gtid = bidx() * 256 + tidx(), gsz = VGRID * 256;
    for (int it = gtid; it < 2 * 4 * 8192; it += gsz) {
        const int b = it >> 15, h = (it >> 13) & 3, v = (it >> 5) & 255, k4 = (it & 31) * 4;
        float s0 = 0.f, s1 = 0.f, s2 = 0.f, s3 = 0.f;
#pragma unroll 16
        for (int cc = 0; cc < SEQ / GCH; ++cc) {
            const int c = b * (SEQ / GCH) + cc;
            uint2* ptr = (uint2*)(U + (((size_t)c * 4 + h) * 256 + v) * 128 + k4);
            float f[4]; unpack4(*ptr, f);
            *ptr = make_uint2(pack2(s0, s1), pack2(s2, s3));
            const float4 bl = *(const float4*)(BC + (size_t)(c * GCH + GCH - 1) * 512 + h * 128 + k4);
            s0 = __expf(bl.x) * s0 + f[0]; s1 = __expf(bl.y) * s1 + f[1]; s2 = __expf(bl.z) * s2 + f[2]; s3 = __expf(bl.w) * s3 + f[3];
        }
        float* o = outp + (((size_t)b * 4 + h) * 128 + k4) * 256 + v;
        o[0] = s0; o[256] = s1; o[512] = s2; o[768] = s3;
    }
}

DEVI void gla_out_phase(const Params& p) {
    int z_; asm volatile("s_mov_b32 %0, 0" : "=s"(z_)); unsigned char* ws_ = p.ws + z_; float* out_ = p.out + z_; (void)ws_; (void)out_; KIN_DECL;
    const bf16_t* QK = (const bf16_t*)(ws_ + B_R4);
    const float* BC = (const float*)(ws_ + B_HB);
    const bf16_t* U = (const bf16_t*)(ws_ + B_R6);
    bf16_t* OG = (bf16_t*)(ws_ + B_R3);
    const int tid = tidx(), lane = tid & 63, wave = tid >> 6, l31 = lane & 31, lh = lane >> 5;
    bf16_t* sQ = (bf16_t*)VSMEM;
    bf16_t* sK = sQ + 64 * SST;
    bf16_t* sVt = sK + 64 * SST;
    float* sred = (float*)(sVt + 256 * QST);
    const int nitems = (TP / GCH) * 4;
    for (int item = bidx(); item < nitems; item += VGRID) {
        const int c = item >> 2, h = item & 3, t0 = c * GCH;
        __syncthreads();
        for (int idx = tid; idx < GCH * 16; idx += 256) {
            const int q = idx >> 4, k8 = (idx & 15) * 8;
            float fq[8], fk[8];
            unpack8(*(const uint4*)(QK + (size_t)(t0 + q) * 3072 + h * 128 + k8), fq);
            unpack8(*(const uint4*)(QK + (size_t)(t0 + q) * 3072 + 512 + h * 128 + k8), fk);
            const float* bq = BC + (size_t)(t0 + q) * 512 + h * 128 + k8;
            unsigned wq[4], wk[4];
#pragma unroll
            for (int e = 0; e < 4; ++e) {
                const float e0 = __expf(bq[2 * e]), e1 = __expf(bq[2 * e + 1]);
                wq[e] = pack2(fq[2 * e] * e0 * 0.08838834764831845f, fq[2 * e + 1] * e1 * 0.08838834764831845f);
                wk[e] = pack2(fk[2 * e] / e0, fk[2 * e + 1] / e1);
            }
            *(uint4*)(sQ + q * SST + k8) = make_uint4(wq[0], wq[1], wq[2], wq[3]);
            *(uint4*)(sK + q * SST + k8) = make_uint4(wk[0], wk[1], wk[2], wk[3]);
        }
        for (int idx = tid; idx < GCH * 32; idx += 256) {
            const int q = idx >> 5, v8 = (idx & 31) * 8;
            const uint4 v = *(const uint4*)(QK + (size_t)(t0 + q) * 3072 + 1024 + h * 256 + v8);
            const unsigned short* s = (const unsigned short*)&v;
#pragma unroll
            for (int e = 0; e < 8; ++e) sVt[(v8 + e) * QST + q] = s[e];
        }
        __syncthreads();
        const int qt = wave & 1, stl = wave >> 1;
        f32x16 at;
#pragma unroll
        for (int e = 0; e < 16; ++e) at[e] = 0.f;
#pragma unroll
        for (int ks = 0; ks < 8; ++ks) at = mfma32(ldsfrag(sK, 32 * stl + l31, SST, ks * 16 + 8 * lh), ldsfrag(sQ, 32 * qt + l31, SST, ks * 16 + 8 * lh), at);
        f32x16 acc[2][2];
#pragma unroll
        for (int i = 0; i < 2; ++i)
#pragma unroll
            for (int jq = 0; jq < 2; ++jq)
#pragma unroll
                for (int e = 0; e < 16; ++e) acc[i][jq][e] = 0.f;
        const bf16_t* Uc = U + ((size_t)c * 4 + h) * 32768;
#pragma unroll
        for (int ks = 0; ks < 8; ++ks) {
            bf16x8 qb[2];
#pragma unroll
            for (int jq = 0; jq < 2; ++jq) qb[jq] = ldsfrag(sQ, 32 * jq + l31, SST, ks * 16 + 8 * lh);
#pragma unroll
            for (int i = 0; i < 2; ++i) {
                const bf16x8 sa = *(const bf16x8*)(Uc + (size_t)(64 * wave + 32 * i + l31) * 128 + ks * 16 + 8 * lh);
#pragma unroll
                for (int jq = 0; jq < 2; ++jq) acc[i][jq] = mfma32(sa, qb[jq], acc[i][jq]);
            }
        }
        __syncthreads();
        bf16_t* sP = sK;
        {
            const int q = 32 * qt + l31;
#pragma unroll
            for (int rg = 0; rg < 4; ++rg) {
                const int s0 = 32 * stl + 8 * rg + 4 * lh;
                float m[4];
#pragma unroll
                for (int e = 0; e < 4; ++e) m[e] = (s0 + e <= q) ? at[4 * rg + e] : 0.f;
                *(uint2*)(sP + q * QST + s0) = make_uint2(pack2(m[0], m[1]), pack2(m[2], m[3]));
            }
        }
        __syncthreads();
#pragma unroll
        for (int ks = 0; ks < 4; ++ks) {
            bf16x8 pb[2];
#pragma unroll
            for (int jq = 0; jq < 2; ++jq) pb[jq] = ldsfrag(sP, 32 * jq + l31, QST, ks * 16 + 8 * lh);
#pragma unroll
            for (int i = 0; i < 2; ++i) {
                const bf16x8 va = ldsfrag(sVt, 64 * wave + 32 * i + l31, QST, ks * 16 + 8 * lh);
#pragma unroll
                for (int jq = 0; jq < 2; ++jq) acc[i][jq] = mfma32(va, pb[jq], acc[i][jq]);
            }
        }
        float ss[2] = {0.f, 0.f};
#pragma unroll
        for (int jq = 0; jq < 2; ++jq)
#pragma unroll
            for (int i = 0; i < 2; ++i)
#pragma unroll
                for (int e = 0; e < 16; ++e) ss[jq] += acc[i][jq][e] * acc[i][jq][e];
#pragma unroll
        for (int jq = 0; jq < 2; ++jq) { ss[jq] += __shfl_xor(ss[jq], 32); if (lh == 0) sred[wave * 64 + 32 * jq + l31] = ss[jq]; }
        __syncthreads();
#pragma unroll
        for (int jq = 0; jq < 2; ++jq) {
            const int q = 32 * jq + l31;
            const float tot = sred[q] + sred[64 + q] + sred[128 + q] + sred[192 + q];
            const float inv = rsqrtf(tot * (1.f / 256.f) + EPS);
            const size_t trow = (size_t)(t0 + q);
#pragma unroll
            for (int i = 0; i < 2; ++i)
#pragma unroll
                for (int rg = 0; rg < 4; ++rg) {
                    const int vc = h * 256 + 64 * wave + 32 * i + 8 * rg + 4 * lh;
                    float rf[4]; unpack4(*(const uint2*)(QK + trow * 3072 + 2048 + vc), rf);
                    float o[4];
#pragma unroll
                    for (int e = 0; e < 4; ++e) o[e] = acc[i][jq][4 * rg + e] * inv * silu_f(rf[e]);
                    *(uint2*)(OG + trow * D + vc) = make_uint2(pack2(o[0], o[1]), pack2(o[2], o[3]));
                }
        }
    }
}

DEVI void rope_table(const Params& p) {
    int z_; asm volatile("s_mov_b32 %0, 0" : "=s"(z_)); unsigned char* ws_ = p.ws + z_;
    float* CS = (float*)(ws_ + B_ROPE);
    const int gtid = bidx() * 256 + tidx(), gsz = VGRID * 256;
    for (int it = gtid; it < (SEQ + 4) * 8; it += gsz) {
        const int pos = it >> 3, i = it & 7;
        const float fr = powf(500000.f, -(float)i * 0.125f);
        float sv, cv; sincosf((float)pos * fr, &sv, &cv);
        CS[(size_t)pos * 16 + i] = cv; CS[(size_t)pos * 16 + 8 + i] = sv;
    }
}

DEVI void att_rope_phase(const Params& p) {
    int z_; asm volatile("s_mov_b32 %0, 0" : "=s"(z_)); unsigned char* ws_ = p.ws + z_; float* out_ = p.out + z_; (void)ws_; (void)out_; KIN_DECL;
    bf16_t* QKV = (bf16_t*)(ws_ + B_R4);
    const float* CS = (const float*)(ws_ + B_ROPE);
    const int gtid = bidx() * 256 + tidx(), gsz = VGRID * 256;
    for (int it = gtid; it < T * 96; it += gsz) {
        const int t = it / 96, rem = it - t * 96, hd = rem >> 3, l8 = rem & 7, g = hd >> 2, hg = hd & 3;
        const bool samp = t >= TP;
        const int pos = samp ? SEQ + ((t - TP) & 3) : (t & (SEQ - 1));
        bf16_t* qp = QKV + (size_t)t * QKVD + hd * 64 + 8 * l8; bf16_t* kp = qp + 768; const bf16_t* vp = qp + 1536;
        float cs[8], sn[8], qf[8], kf[8], vf[8];
        unpack8(*(const uint4*)kp, kf); unpack8(*(const uint4*)vp, vf);
        if (l8 < 2) {
            unpack8(*(const uint4*)qp, qf);
            const float4* cp = (const float4*)(CS + (size_t)pos * 16);
            const float4 c0 = cp[0], c1 = cp[1], s0 = cp[2], s1 = cp[3];
            cs[0] = c0.x; cs[1] = c0.y; cs[2] = c0.z; cs[3] = c0.w; cs[4] = c1.x; cs[5] = c1.y; cs[6] = c1.z; cs[7] = c1.w;
            sn[0] = s0.x; sn[1] = s0.y; sn[2] = s0.z; sn[3] = s0.w; sn[4] = s1.x; sn[5] = s1.y; sn[6] = s1.z; sn[7] = s1.w;
        } else {
#pragma unroll
            for (int e = 0; e < 8; ++e) { qf[e] = 0.f; cs[e] = 1.f; sn[e] = 0.f; }
        }
#pragma unroll
        for (int e = 0; e < 8; ++e) {
            const float qo = __shfl_xor(qf[e], 1), ko = __shfl_xor(kf[e], 1);
            if (l8 == 0) { qf[e] = qf[e] * cs[e] - qo * sn[e]; kf[e] = kf[e] * cs[e] - ko * sn[e]; }
            else if (l8 == 1) { qf[e] = qf[e] * cs[e] + qo * sn[e]; kf[e] = kf[e] * cs[e] + ko * sn[e]; }
        }
        if (l8 < 2) {
            *(uint4*)qp = make_uint4(pack2(qf[0], qf[1]), pack2(qf[2], qf[3]), pack2(qf[4], qf[5]), pack2(qf[6], qf[7]));
            const uint4 kw = make_uint4(pack2(kf[0], kf[1]), pack2(kf[2], kf[3]), pack2(kf[4], kf[5]), pack2(kf[6], kf[7]));
            *(uint4*)kp = kw; unpack8(kw, kf);
        }
        const int W = 128 << (2 * g);
        float* dst = nullptr;
        if (!samp) { const int b = t >> 13, tp = t & (SEQ - 1); if (tp >= SEQ - W) dst = out_ + (g == 0 ? O_KV0P : (g == 1 ? O_KV1P : O_KV2P)) + (((size_t)b * W + (tp - (SEQ - W))) * 2) * 256 + hg * 64 + 8 * l8; }
        else { const int sb = (t - TP) >> 2, sq = (t - TP) & 3; dst = out_ + (g == 0 ? O_KV0S : (g == 1 ? O_KV1S : O_KV2S)) + (((size_t)sb * W + (W - 4 + sq)) * 2) * 256 + hg * 64 + 8 * l8; }
        if (dst) {
            ((float4*)dst)[0] = make_float4(kf[0], kf[1], kf[2], kf[3]); ((float4*)dst)[1] = make_float4(kf[4], kf[5], kf[6], kf[7]);
            ((float4*)(dst + 256))[0] = make_float4(vf[0], vf[1], vf[2], vf[3]); ((float4*)(dst + 256))[1] = make_float4(vf[4], vf[5], vf[6], vf[7]);
        }
    }
}

DEVI void att_phase(const Params& p) {
    int z_; asm volatile("s_mov_b32 %0, 0" : "=s"(z_)); unsigned char* ws_ = p.ws + z_; float* out_ = p.out + z_; (void)ws_; (void)out_; KIN_DECL;
    const bf16_t* QKV = (const bf16_t*)(ws_ + B_R4);
    bf16_t* AO = (bf16_t*)(ws_ + B_R3);
    float* LSE = (float*)(ws_ + B_DT);
    const int lane = tidx() & 63, wib = tidx() >> 6;
    const int wv = (bidx() * 256 + tidx()) >> 6, nw = (VGRID * 256) >> 6;
    float* sq = (float*)VSMEM + wib * 256;
    float* sp = sq + 64;
    for (int it = wv; it < TS * 12; it += nw) {
        const int t = TP + it / 12, hd = it % 12, g = hd >> 2, hg = hd & 3;
        const int sb = (t - TP) >> 2, s = (t - TP) & 3;
        const int d = (g == 0) ? 1 : (g == 1 ? 4 : 16), W = 128 * d;
        const float* cache = (g == 0) ? in_[5] : (g == 1 ? in_[6] : in_[7]);
        sq[lane] = bf2f(QKV[(size_t)t * QKVD + hd * 64 + lane]) * 0.125f;
        float sc[3];
#pragma unroll
        for (int r = 0; r < 3; ++r) {
            const int jj = r * 64 + lane;
            float v = -INFINITY;
            if (jj <= 128) {
                const int idx = W + s - jj * d;
                float a = 0.f;
                if (idx >= W) {
                    const bf16_t* kp = QKV + (size_t)(TP + sb * 4 + (idx - W)) * QKVD + 768 + hd * 64;
#pragma unroll
                    for (int i = 0; i < 8; ++i) { float f[8]; unpack8(*(const uint4*)(kp + 8 * i), f);
#pragma unroll
                        for (int e = 0; e < 8; ++e) a += f[e] * sq[8 * i + e]; }
                } else {
                    const float4* kp = (const float4*)(cache + (((size_t)sb * W + idx) * 2) * 256 + hg * 64);
#pragma unroll
                    for (int i = 0; i < 16; ++i) { const float4 f = kp[i]; a += f.x * sq[4 * i] + f.y * sq[4 * i + 1] + f.z * sq[4 * i + 2] + f.w * sq[4 * i + 3]; }
                }
                v = a;
            }
            sc[r] = v;
        }
        const float mx = wave_max(fmaxf(sc[0], fmaxf(sc[1], sc[2])));
        float ps = 0.f;
#pragma unroll
        for (int r = 0; r < 3; ++r) { const float e = (sc[r] == -INFINITY) ? 0.f : __expf(sc[r] - mx); sp[r * 64 + lane] = e; ps += e; }
        const float den = wave_sum(ps);
        const int jn = s / d;
        float a = 0.f;
        for (int jj = 0; jj <= jn; ++jj) a += sp[jj] * bf2f(QKV[(size_t)(TP + sb * 4 + (s - jj * d)) * QKVD + 1536 + hd * 64 + lane]);
        const float* vb = cache + (((size_t)sb * W) * 2 + 1) * 256 + hg * 64 + lane;
#pragma unroll 8
        for (int jj = jn + 1; jj <= 128; ++jj) a += sp[jj] * vb[(size_t)(W + s - jj * d) * 512];
        AO[(size_t)t * ATTD + hd * 64 + lane] = f2bf(a / den);
        if (lane == 0) LSE[(size_t)t * 12 + hd] = mx + __logf(den);
    }
}

constexpr int VST = 264;
DEVI void att_prompt_phase(const Params& p) {
    int z_; asm volatile("s_mov_b32 %0, 0" : "=s"(z_)); unsigned char* ws_ = p.ws + z_; float* out_ = p.out + z_; (void)ws_; (void)out_; KIN_DECL;
    const bf16_t* QKV = (const bf16_t*)(ws_ + B_R4);
    bf16_t* AO = (bf16_t*)(ws_ + B_R3);
    float* LSE = (float*)(ws_ + B_DT);
    const int tid = tidx(), lane = tid & 63, wave = tid >> 6, l31 = lane & 31, lh = lane >> 5;
    bf16_t* sK = (bf16_t*)VSMEM;
    bf16_t* sVt = sK + 256 * GST;
    for (int item = bidx(); item < 2 * 12 * 64; item += VGRID) {
        const int b = item / 768, hd = (item / 64) % 12, blk = item & 63, g = hd >> 2;
        const int d = (g == 0) ? 1 : (g == 1 ? 4 : 16), nbr = (SEQ / d) / 128, r = blk / nbr, u0 = (blk % nbr) * 128;
        const size_t tb = (size_t)b * SEQ + r;
        __syncthreads();
        for (int idx = tid; idx < 256 * 8; idx += 256) {
            const int kj = idx >> 3, c8 = (idx & 7) * 8, u = u0 - 128 + kj;
            u32x4 kv = {0u, 0u, 0u, 0u}, vv = {0u, 0u, 0u, 0u};
            if (u >= 0) { const bf16_t* src = QKV + (tb + (size_t)u * d) * QKVD + 768 + hd * 64 + c8; kv = *(const u32x4*)src; vv = *(const u32x4*)(src + 768); }
            *(u32x4*)(sK + kj * GST + c8) = kv;
#pragma unroll
            for (int e = 0; e < 4; ++e) { sVt[(c8 + 2 * e) * VST + kj] = (bf16_t)(vv[e] & 0xffffu); sVt[(c8 + 2 * e + 1) * VST + kj] = (bf16_t)(vv[e] >> 16); }
        }
        const int qi = 32 * wave + l31;
        const size_t tq = tb + (size_t)(u0 + qi) * d;
        bf16x8 qf[4];
#pragma unroll
        for (int ks = 0; ks < 4; ++ks) qf[ks] = *(const bf16x8*)(QKV + tq * QKVD + hd * 64 + ks * 16 + 8 * lh);
        __syncthreads();
        f32x16 S[5];
#pragma unroll
        for (int tt = 0; tt < 5; ++tt) {
#pragma unroll
            for (int e = 0; e < 16; ++e) S[tt][e] = 0.f;
#pragma unroll
            for (int ks = 0; ks < 4; ++ks) S[tt] = mfma32(ldsfrag(sK, 32 * (wave + tt) + l31, GST, ks * 16 + 8 * lh), qf[ks], S[tt]);
        }
        float mx = -INFINITY;
#pragma unroll
        for (int tt = 0; tt < 5; ++tt)
#pragma unroll
            for (int e = 0; e < 16; ++e) {
                const int kj = 32 * (wave + tt) + (e & 3) + 8 * (e >> 2) + 4 * lh;
                const bool valid = (kj >= qi) && (kj <= qi + 128) && (u0 - 128 + kj >= 0);
                const float sv = valid ? S[tt][e] * 0.125f : -INFINITY;
                S[tt][e] = sv; mx = fmaxf(mx, sv);
            }
        mx = fmaxf(mx, __shfl_xor(mx, 32));
        float den = 0.f;
#pragma unroll
        for (int tt = 0; tt < 5; ++tt)
#pragma unroll
            for (int e = 0; e < 16; ++e) { const float pe = __expf(S[tt][e] - mx); S[tt][e] = pe; den += pe; }
        den += __shfl_xor(den, 32);
        f32x16 O[2];
#pragma unroll
        for (int i = 0; i < 2; ++i)
#pragma unroll
            for (int e = 0; e < 16; ++e) O[i][e] = 0.f;
#pragma unroll
        for (int tt = 0; tt < 5; ++tt)
#pragma unroll
            for (int s2 = 0; s2 < 2; ++s2) {
                union { bf16x8 v; unsigned u[4]; } pb;
#pragma unroll
                for (int e = 0; e < 4; ++e) pb.u[e] = pack2(S[tt][8 * s2 + 2 * e], S[tt][8 * s2 + 2 * e + 1]);
#pragma unroll
                for (int i = 0; i < 2; ++i) {
                    const bf16_t* vp = sVt + (32 * i + l31) * VST + 32 * (wave + tt) + 16 * s2 + 4 * lh;
                    union { bf16x8 v; uint2 h[2]; } va;
                    va.h[0] = *(const uint2*)vp; va.h[1] = *(const uint2*)(vp + 8);
                    O[i] = mfma32(va.v, pb.v, O[i]);
                }
            }
        const float rden = 1.f / den;
#pragma unroll
        for (int i = 0; i < 2; ++i)
#pragma unroll
            for (int rg = 0; rg < 4; ++rg)
                *(uint2*)(AO + tq * ATTD + hd * 64 + 32 * i + 8 * rg + 4 * lh) = make_uint2(pack2(O[i][4 * rg] * rden, O[i][4 * rg + 1] * rden), pack2(O[i][4 * rg + 2] * rden, O[i][4 * rg + 3] * rden));
        if (lh == 0) LSE[tq * 12 + hd] = mx + __logf(den);
    }
}

DEVI void att_mix_phase(const Params& p) {
    int z_; asm volatile("s_mov_b32 %0, 0" : "=s"(z_)); unsigned char* ws_ = p.ws + z_; float* out_ = p.out + z_; (void)ws_; (void)out_; KIN_DECL;
    bf16_t* AO = (bf16_t*)(ws_ + B_R3);
    const float* LSE = (const float*)(ws_ + B_DT);
    const int gtid = bidx() * 256 + tidx(), gsz = VGRID * 256;
    for (int it = gtid; it < T * 32; it += gsz) {
        const int t = it >> 5, hg = (it >> 3) & 3, c8 = (it & 7) * 8;
        const float l0 = LSE[(size_t)t * 12 + hg], l1 = LSE[(size_t)t * 12 + 4 + hg], l2 = LSE[(size_t)t * 12 + 8 + hg];
        const float ml = fmaxf(l0, fmaxf(l1, l2));
        float al[3] = {__expf(l0 - ml), __expf(l1 - ml), __expf(l2 - ml)};
        const float rs = 1.f / (al[0] + al[1] + al[2]);
#pragma unroll
        for (int g = 0; g < 3; ++g) {
            u32x4* ptr = (u32x4*)(AO + (size_t)t * ATTD + (g * 4 + hg) * 64 + c8);
            const u32x4 v = *ptr; const float a = al[g] * rs;
            u32x4 o;
#pragma unroll
            for (int e = 0; e < 4; ++e) o[e] = pack2(__uint_as_float(v[e] << 16) * a, __uint_as_float(v[e] & 0xffff0000u) * a);
            *ptr = o;
        }
    }
}

enum { OP_INIT = 0, OP_NORM, OP_FINAL, OP_SSM_IN, OP_SSM_CONV, OP_SSM_STATE, OP_SSM_SCAN, OP_SSM_OUT, OP_SSM_OG, OP_GLA_IN, OP_GLA_GATE, OP_GLA_STATE, OP_GLA_SCAN,
       OP_GLA_OUT, OP_GLA_OG, OP_ATT_IN_, OP_ATT_ROPE, OP_ATT_ATT, OP_ATT_MIX, OP_ATT_OG, OP_FFN_GU, OP_FFN_DN };
constexpr int OP_ATT_IN = OP_ATT_IN_;
DEVI int phase_op(int ph, int& a) {
    int l, q, op; a = 0;
    if (ph == 0) return OP_INIT;
    if (ph <= 10) { l = 0; q = ph - 1; } else if (ph <= 20) { l = 1; q = ph - 11; } else if (ph <= 29) { l = 2; q = ph - 21; } else { l = 3; q = ph - 30; }
    const int nmix = (l == 2) ? 5 : 6;
    if (q < nmix) { op = (l == 1 ? OP_GLA_IN : (l == 2 ? OP_ATT_IN_ : OP_SSM_IN)) + q; a = l / 3; }
    else { const int k = q - nmix; op = (k == 0) ? OP_NORM : (k == 1 ? OP_FFN_GU : (k == 2 ? OP_FFN_DN : (l == 3 ? OP_FINAL : OP_NORM))); a = l; }
    return op;
}
DEVI int phase_op_only(int ph) { int a; return phase_op(ph, a); }
DEVI void run_phase(const Params& p, int ph) {
    const bf16_t* Hb = (const bf16_t*)(p.ws + B_HB);
    int a = 0; int op = phase_op(ph, a);
#ifdef ONLY_OP
    if (op != ONLY_OP) return;
    op = ONLY_OP;
#endif
    switch (op) {
        case OP_INIT: if (rbid() & 1) { copy_caches(p); convert_weights(p); } else { convert_weights(p); copy_caches(p); } rope_table(p); norm_phase(p, 0); break;
        case OP_NORM: norm_phase(p, 1); break;
        case OP_FINAL: norm_phase(p, 2); break;
        case OP_SSM_IN: gemm8<EPI_SSM_IN>(p, Hb, (const bf16_t*)(p.ws + W_SSM_IN) + (size_t)a * SSM_INP * D, MPAD, SSM_INP, D); break;
        case OP_SSM_CONV: ssm_conv_phase(p, a); break;
        case OP_SSM_STATE: ssm_state_phase(p, a); break;
        case OP_SSM_SCAN: ssm_scan_phase(p, a); break;
        case OP_SSM_OUT: ssm_out_phase(p, a); break;
        case OP_SSM_OG: gemm8<EPI_RESADD>(p, (const bf16_t*)(p.ws + B_R4), (const bf16_t*)(p.ws + W_SSM_OUT) + (size_t)a * D * DI, TP, D, DI); gemm_phase<EPI_RESADD, DI>(p, (const bf16_t*)(p.ws + B_R4), (const bf16_t*)(p.ws + W_SSM_OUT) + (size_t)a * D * DI, 4, true); break;
        case OP_GLA_IN: gemm8<EPI_GLA_IN>(p, Hb, (const bf16_t*)(p.ws + W_GLA_IN), MPAD, GLA_INP, D); break;
        case OP_GLA_GATE: gla_gate_phase(p); break;
        case OP_GLA_STATE: gla_state_phase(p); break;
        case OP_GLA_SCAN: gla_scan_phase(p); break;
        case OP_GLA_OUT: gla_out_phase(p); break;
        case OP_GLA_OG: gemm8<EPI_RESADD>(p, (const bf16_t*)(p.ws + B_R3), (const bf16_t*)(p.ws + W_GLA_OUT), TP, D, D); gemm_phase<EPI_RESADD, D>(p, (const bf16_t*)(p.ws + B_R3), (const bf16_t*)(p.ws + W_GLA_OUT), 4, true); break;
        case OP_ATT_IN: gemm8<EPI_ATT_IN>(p, Hb, (const bf16_t*)(p.ws + W_ATT_QKV), MPAD, QKVD, D); break;
        case OP_ATT_ROPE: att_rope_phase(p); break;
        case OP_ATT_ATT: att_prompt_phase(p); __syncthreads(); att_phase(p); break;
        case OP_ATT_MIX: att_mix_phase(p); break;
        case OP_ATT_OG: gemm8<EPI_RESADD>(p, (const bf16_t*)(p.ws + B_R3), (const bf16_t*)(p.ws + W_ATT_OUT), TP, D, ATTD); gemm_phase<EPI_RESADD, ATTD>(p, (const bf16_t*)(p.ws + B_R3), (const bf16_t*)(p.ws + W_ATT_OUT), 4, true); break;
        case OP_FFN_GU: gemm8<EPI_SWIGLU>(p, Hb, (const bf16_t*)(p.ws + W_FFN_GU) + (size_t)a * 2 * DFF * D, MPAD, 2 * DFF, D); break;
        case OP_FFN_DN: gemm8<EPI_RESADD>(p, (const bf16_t*)(p.ws + B_R4), (const bf16_t*)(p.ws + W_FFN_DN) + (size_t)a * D * DFF, TP, D, DFF); gemm_phase<EPI_RESADD, DFF>(p, (const bf16_t*)(p.ws + B_R4), (const bf16_t*)(p.ws + W_FFN_DN) + (size_t)a * D * DFF, 4, true); break;
        default: break;
    }
}

#ifndef REPEAT_OP
#define REPEAT_OP -1
#endif
#ifndef REPEAT_N
#define REPEAT_N 1
#endif
__global__ void __launch_bounds__(512, 2) mega(Params p, int ph_lo, int ph_hi, int coop) {
    uint4* xb_words = (uint4*)(smem + 2 * LDS_BYTES);
    if (threadIdx.x == 0) *xb_words = make_uint4(0u, 0u, 0u, 0u);
    __syncthreads();
    XcdBarrier xb = xcd_barrier_post((unsigned*)(p.ws + B_BAR), (volatile LAS unsigned*)xb_words);
    if (coop < 0) cg::this_grid().sync();
    int rep = 0;
    for (int ph = ph_lo; ph < ph_hi;) {
        run_phase(p, ph);
        if (REPEAT_OP >= 0 && phase_op_only(ph) == REPEAT_OP && rep < REPEAT_N) { ++rep; __syncthreads(); continue; }
        rep = 0;
        if (ph + 1 < ph_hi) xcd_barrier(xb);
        ++ph;
    }
}

extern "C" void kernel_launch(void* const* d_in, const int* in_sizes, int n_in, void* d_out, int out_size, void* d_ws, size_t ws_size, hipStream_t stream) {
    if (ws_size < B_END) { fprintf(stderr, "workspace too small: %zu < %zu\n", ws_size, (size_t)B_END); return; }
    Params p; memset(&p, 0, sizeof(p));
    for (int i = 0; i < 29; ++i) p.in[i] = (const float*)d_in[i];
    p.out = (float*)d_out; p.ws = (unsigned char*)d_ws;
    p.nphase = 40;
    static int grid_blocks = 0;
    if (!grid_blocks) {
        int dev = 0, cus = 0, per_cu = 0;
        hipGetDevice(&dev);
        hipDeviceGetAttribute(&cus, hipDeviceAttributeMultiprocessorCount, dev);
        hipFuncSetAttribute((const void*)mega, hipFuncAttributeMaxDynamicSharedMemorySize, DYN_LDS);
        hipOccupancyMaxActiveBlocksPerMultiprocessor(&per_cu, mega, 512, DYN_LDS);
        if (per_cu > 1) per_cu = 1;
        if (per_cu < 1) per_cu = 1;
        grid_blocks = cus * per_cu;
    }
#if ONE_LAUNCH
    hipMemsetAsync(p.ws + B_BAR, 0, XCD_BAR_WORDS * 4, stream);
    int lo = 0, hi = p.nphase, coop = 1;
    void* args[] = {&p, &lo, &hi, &coop};
    hipError_t e = hipLaunchCooperativeKernel((void*)mega, dim3(grid_blocks), dim3(512), args, DYN_LDS, stream);
    if (e != hipSuccess) fprintf(stderr, "cooperative launch failed: %s (grid %d)\n", hipGetErrorString(e), grid_blocks);
#else
    for (int ph = 0; ph < p.nphase; ++ph) mega<<<grid_blocks, 512, DYN_LDS, stream>>>(p, ph, ph + 1, 0);
#endif
}
```

```cpp
#include <hip/hip_runtime.h>
#include <hip/hip_cooperative_groups.h>
#include <cstdio>
#include <cstring>
namespace cg = cooperative_groups;

#ifndef ONE_LAUNCH
#define ONE_LAUNCH 1
#endif

typedef unsigned short bf16_t;
typedef short bf16x8 __attribute__((ext_vector_type(8)));
typedef float f32x16 __attribute__((ext_vector_type(16)));
typedef float f32x4 __attribute__((ext_vector_type(4)));
typedef unsigned u32x4 __attribute__((ext_vector_type(4)));
#define DEVI __device__ __forceinline__

constexpr int D = 1024, TP = 16384, TS = 128, T = TP + TS, SEQ = 8192, DFF = 2816;
constexpr int SSM_IN = 5152, SSM_INP = 5376, DI = 2048, CONVD = 3072;
constexpr int GLA_IN = 3088, GLA_INP = 3328;
constexpr int QKVD = 2304, ATTD = 768;
constexpr float EPS = 1e-6f;
constexpr int MPAD = 16640;

constexpr size_t O_YP = 0, O_YS = O_YP + (size_t)TP * D, O_SSMP = O_YS + (size_t)TS * D, O_SSMS = O_SSMP + 2ull * 2 * 262144,
                 O_CONVP = O_SSMS + 2ull * 32 * 262144, O_CONVS = O_CONVP + 2ull * 2 * 3 * CONVD, O_GLAP = O_CONVS + 2ull * 32 * 3 * CONVD,
                 O_GLAS = O_GLAP + 2ull * 4 * 32768, O_KV0P = O_GLAS + 32ull * 4 * 32768, O_KV0S = O_KV0P + 2ull * 128 * 512,
                 O_KV1P = O_KV0S + 32ull * 128 * 512, O_KV1S = O_KV1P + 2ull * 512 * 512, O_KV2P = O_KV1S + 32ull * 512 * 512,
                 O_KV2S = O_KV2P + 2ull * 2048 * 512, O_END = O_KV2S + 32ull * 2048 * 512;

constexpr size_t al(size_t x) { return (x + 255) & ~(size_t)255; }
constexpr size_t W_SSM_IN = 0, W_SSM_OUT = W_SSM_IN + 2ull * SSM_INP * D * 2, W_GLA_IN = W_SSM_OUT + 2ull * D * DI * 2,
                 W_GLA_OUT = W_GLA_IN + (size_t)GLA_INP * D * 2, W_ATT_QKV = W_GLA_OUT + (size_t)D * D * 2, W_ATT_OUT = W_ATT_QKV + (size_t)QKVD * D * 2,
                 W_FFN_GU = W_ATT_OUT + (size_t)D * ATTD * 2, W_FFN_DN = W_FFN_GU + 4ull * 2 * DFF * D * 2, W_END = W_FFN_DN + 4ull * D * DFF * 2;
constexpr size_t B_HB = al(W_END), B_R3 = B_HB + (size_t)T * D * 2, B_R4 = B_R3 + (size_t)T * DI * 2, B_R5 = B_R4 + (size_t)T * CONVD * 2,
                 B_R6 = B_R5 + (size_t)T * CONVD * 2, B_DT = B_R6 + 67108864ull, B_DTS = B_DT + (size_t)T * 32 * 4, B_ACS = B_DTS + (size_t)T * 32 * 4,
                 B_GLOW = B_ACS + (size_t)T * 32 * 4, B_BAR = al(B_GLOW + (size_t)T * 16 * 4), B_SSQS = B_BAR + 16384, B_ROPE = B_SSQS + 4096, B_END = B_ROPE + 8196ull * 16 * 4;

struct WDesc { const float* src; const float* gain; bf16_t* dst; int K, N, mode, tile0, gmod; };
struct Params {
    const float* in[29];
    float* out;
    unsigned char* ws;
    int nphase, pad0;
};

constexpr int LDS_BYTES = 79872;
extern __shared__ __attribute__((aligned(16))) unsigned char smem[];
constexpr int DYN_LDS = 2 * LDS_BYTES + 16;

DEVI int rtid() { int t = threadIdx.x; asm volatile("" : "+v"(t)); return t; }
DEVI int rbid() { int b = blockIdx.x; asm volatile("" : "+s"(b)); return b; }
DEVI int vhalf() { return __builtin_amdgcn_readfirstlane(rtid() >> 8); }
DEVI int tidx() { return rtid() & 255; }
DEVI int bidx() { return rbid() * 2 + vhalf(); }
#define VGRID ((int)gridDim.x * 2)
#define CAS4 __attribute__((address_space(4)))
#define KIN_DECL const float* const CAS4* in_ = (const float* const CAS4*)((const CAS4 char*)__builtin_amdgcn_kernarg_segment_ptr() + z_); (void)in_
#define VSMEM (smem + vhalf() * LDS_BYTES)
DEVI unsigned short f2bf(float f) { unsigned u = __float_as_uint(f); u += 0x7fffu + ((u >> 16) & 1u); return (unsigned short)(u >> 16); }
DEVI float bf2f(unsigned short h) { return __uint_as_float(((unsigned)h) << 16); }
DEVI unsigned pack2(float a, float b) { return (unsigned)f2bf(a) | ((unsigned)f2bf(b) << 16); }
DEVI float silu_f(float x) { return x / (1.f + __expf(-x)); }
DEVI float softplus_f(float x) { return x > 20.f ? x : log1pf(__expf(x)); }
DEVI float logsigmoid_f(float x) { return fminf(x, 0.f) - log1pf(__expf(-fabsf(x))); }
DEVI float wave_sum(float v) { for (int o = 32; o > 0; o >>= 1) v += __shfl_xor(v, o); return v; }
DEVI float wave_max(float v) { for (int o = 32; o > 0; o >>= 1) v = fmaxf(v, __shfl_xor(v, o)); return v; }
DEVI bf16x8 ldsfrag(const bf16_t* base, int row, int stride, int k) { return *(const bf16x8*)(base + row * stride + k); }
DEVI f32x16 mfma32(bf16x8 a, bf16x8 b, f32x16 c) { return __builtin_amdgcn_mfma_f32_32x32x16_bf16(a, b, c, 0, 0, 0); }
DEVI void unpack8(uint4 v, float* f) {
    f[0] = __uint_as_float(v.x << 16); f[1] = __uint_as_float(v.x & 0xffff0000u); f[2] = __uint_as_float(v.y << 16); f[3] = __uint_as_float(v.y & 0xffff0000u);
    f[4] = __uint_as_float(v.z << 16); f[5] = __uint_as_float(v.z & 0xffff0000u); f[6] = __uint_as_float(v.w << 16); f[7] = __uint_as_float(v.w & 0xffff0000u);
}
DEVI void unpack4(uint2 v, float* f) {
    f[0] = __uint_as_float(v.x << 16); f[1] = __uint_as_float(v.x & 0xffff0000u); f[2] = __uint_as_float(v.y << 16); f[3] = __uint_as_float(v.y & 0xffff0000u);
}


#define XB_TMO      128
#define XB_XCNT(j)  (256  + 64 * (j))
#define XB_XSUB(j)  (1280 + 64 * (j))
#define XB_XGEN(j)  (2304 + 64 * (j))
#define XB_TOP      3328
#define XB_TOPGEN   3392
#define XCD_BAR_WORDS 3456
#define XB_SPIN_CAP (1u << 22)
#define LAS __attribute__((address_space(3)))
DEVI unsigned xb_ld(unsigned* p)              { return __hip_atomic_load(p, __ATOMIC_RELAXED, __HIP_MEMORY_SCOPE_AGENT); }
DEVI unsigned xb_add(unsigned* p, unsigned v) { return __hip_atomic_fetch_add(p, v, __ATOMIC_RELAXED, __HIP_MEMORY_SCOPE_AGENT); }
DEVI unsigned xb_xcc_id() { return (unsigned)__builtin_amdgcn_s_getreg((3 << 11) | 20) & 0xFu; }
#define XB_SPIN(cond, bar) do { unsigned _sp = 0; while (cond) { __builtin_amdgcn_s_sleep(1); \
    if ((++_sp & 255u) == 0u) { if (xb_ld(&(bar)[XB_TMO])) break; if (_sp > XB_SPIN_CAP) { atomicAdd(&(bar)[XB_TMO], 1u); break; } } } } while (0)
struct XcdBarrier { unsigned* bar; unsigned x; volatile LAS unsigned* st; };
DEVI XcdBarrier xcd_barrier_post(unsigned* bar, volatile LAS unsigned* st) {
    XcdBarrier b; b.bar = bar; b.x = xb_xcc_id(); b.st = st;
    if (threadIdx.x == 0) (void)xb_add(&bar[XB_XCNT(b.x)], 1u);
    return b;
}
DEVI void xcd_barrier_complete(unsigned* bar, unsigned x, unsigned& nloc, unsigned& nx) {
    const unsigned G = gridDim.x * gridDim.y * gridDim.z;
    unsigned sum, cnt, mine, sp = 0u;
    for (;;) {
        sum = 0u; cnt = 0u; mine = 0u;
#pragma unroll
        for (unsigned j = 0; j < 16; ++j) { const unsigned c = xb_ld(&bar[XB_XCNT(j)]); sum += c; cnt += (c > 0u) ? 1u : 0u; mine = (j == x) ? c : mine; }
        if (sum == G) break;
        __builtin_amdgcn_s_sleep(1);
        if ((++sp & 255u) == 0u) { if (xb_ld(&bar[XB_TMO])) break; if (sp > XB_SPIN_CAP) { atomicAdd(&bar[XB_TMO], 1u); break; } }
    }
    nloc = mine > 0u ? mine : 1u; nx = cnt > 0u ? cnt : 1u;
}
DEVI void xcd_barrier(const XcdBarrier& b) {
    asm volatile("s_waitcnt vmcnt(0)" ::: "memory");
    __syncthreads();
    if (threadIdx.x == 0) {
        unsigned* bar = b.bar;
        __builtin_amdgcn_s_waitcnt(0);
        unsigned nloc = b.st[0], nx = b.st[1];
        if (nloc == 0u) { xcd_barrier_complete(bar, b.x, nloc, nx); b.st[0] = nloc; b.st[1] = nx; }
        const unsigned old = xb_add(&bar[XB_XSUB(b.x)], 1u);
        const unsigned gen = old / nloc;
        if (old + 1u == (gen + 1u) * nloc) {
            __builtin_amdgcn_fence(__ATOMIC_RELEASE, "agent");
            asm volatile("s_waitcnt vmcnt(0)" ::: "memory");
            const unsigned og = xb_add(&bar[XB_TOP], 1u);
            const unsigned tg = og / nx;
            if (og + 1u == (tg + 1u) * nx) xb_add(&bar[XB_TOPGEN], 1u);
            else XB_SPIN(xb_ld(&bar[XB_TOPGEN]) == tg, bar);
            __builtin_amdgcn_fence(__ATOMIC_ACQUIRE, "agent");
            xb_add(&bar[XB_XGEN(b.x)], 1u);
            asm volatile("s_waitcnt vmcnt(0)" ::: "memory");
        } else {
            XB_SPIN(xb_ld(&bar[XB_XGEN(b.x)]) == gen, bar);
            __builtin_amdgcn_fence(__ATOMIC_ACQUIRE, "agent");
            asm volatile("s_waitcnt vmcnt(0)" ::: "memory");
        }
    }
    __syncthreads();
}

DEVI void convert_weights(const Params& p) {
    int z_; asm volatile("s_mov_b32 %0, 0" : "=s"(z_)); unsigned char* ws_ = p.ws + z_; float* out_ = p.out + z_; (void)ws_; (void)out_; KIN_DECL;
    float* tile = (float*)VSMEM;
    const int tid = tidx();
    constexpr int T_SI = (SSM_INP / 64) * (D / 64), T_SO = (D / 64) * (DI / 64), T_GI = (GLA_INP / 64) * (D / 64), T_GO = (D / 64) * (D / 64),
                  T_AQ = (QKVD / 64) * (D / 64), T_AO = (D / 64) * (ATTD / 64), T_FF = (DFF / 64) * (D / 64);
    constexpr int P0 = 2 * (T_SI + T_SO), P1 = P0 + T_GI, P2 = P1 + T_GO, P3 = P2 + T_AQ, P4 = P3 + T_AO, WT = P4 + 12 * T_FF;
    auto decode = [&](int it, WDesc& d) {
        d.gain = nullptr; d.mode = 0; d.gmod = 1 << 30;
        if (it < P0) {
            const int j = it / (T_SI + T_SO), r = it - j * (T_SI + T_SO);
            if (r < T_SI) { d.src = in_[13] + (size_t)j * D * SSM_IN; d.gain = in_[8] + j * 3 * D; d.dst = (bf16_t*)(ws_ + W_SSM_IN) + (size_t)j * SSM_INP * D; d.K = D; d.N = SSM_IN; d.tile0 = j * (T_SI + T_SO); }
            else { d.src = in_[20] + (size_t)j * DI * D; d.gain = in_[19] + j * DI; d.dst = (bf16_t*)(ws_ + W_SSM_OUT) + (size_t)j * D * DI; d.K = DI; d.N = D; d.tile0 = j * (T_SI + T_SO) + T_SI; }
        } else if (it < P1) { d.src = in_[21]; d.gain = in_[8] + D; d.dst = (bf16_t*)(ws_ + W_GLA_IN); d.K = D; d.N = GLA_IN; d.tile0 = P0; }
        else if (it < P2) { d.src = in_[25]; d.gain = in_[24]; d.gmod = 256; d.dst = (bf16_t*)(ws_ + W_GLA_OUT); d.K = D; d.N = D; d.tile0 = P1; }
        else if (it < P3) { d.src = in_[26]; d.gain = in_[8] + 2 * D; d.dst = (bf16_t*)(ws_ + W_ATT_QKV); d.K = D; d.N = QKVD; d.tile0 = P2; }
        else if (it < P4) { d.src = in_[27]; d.dst = (bf16_t*)(ws_ + W_ATT_OUT); d.K = ATTD; d.N = D; d.tile0 = P3; }
        else {
            const int q = (it - P4) / T_FF, l = q / 3, w = q - l * 3;
            d.tile0 = P4 + q * T_FF;
            if (w < 2) { d.src = (w == 0 ? in_[10] : in_[11]) + (size_t)l * D * DFF; d.gain = in_[9] + l * D; d.dst = (bf16_t*)(ws_ + W_FFN_GU) + (size_t)l * 2 * DFF * D; d.K = D; d.N = DFF; d.mode = 1 + w; }
            else { d.src = in_[12] + (size_t)l * DFF * D; d.dst = (bf16_t*)(ws_ + W_FFN_DN) + (size_t)l * D * DFF; d.K = DFF; d.N = D; }
        }
    };
    auto load_tile = [&](int it, const WDesc& d, float (&v)[16]) {
        const int lt = it - d.tile0, nkt = d.K / 64, ntile = lt / nkt, ktile = lt - ntile * nkt, n = ntile * 64 + (tid & 63), k0 = ktile * 64;
#pragma unroll
        for (int r = 0; r < 16; ++r) {
            const int kk = (tid >> 6) + 4 * r;
            float x = 0.f;
            if (n < d.N) { x = __builtin_nontemporal_load(d.src + (size_t)(k0 + kk) * d.N + n); if (d.gain) x *= d.gain[(k0 + kk) & (d.gmod - 1)]; }
            v[r] = x;
        }
    };
    int it = bidx(); bool have = it < WT;
    WDesc d; float v[16];
    if (have) { decode(it, d); load_tile(it, d, v); }
    while (have) {
        const int itn = it + VGRID; const bool hn = itn < WT;
        WDesc dn = d; float vn[16];
        if (hn) { decode(itn, dn); load_tile(itn, dn, vn); }
        __syncthreads();
#pragma unroll
        for (int r = 0; r < 16; ++r) tile[((tid >> 6) + 4 * r) * 65 + (tid & 63)] = v[r];
        __syncthreads();
        {
            const int lt = it - d.tile0, nkt = d.K / 64, ntile = lt / nkt, ktile = lt - ntile * nkt, n0 = ntile * 64, k0 = ktile * 64;
            const int r = tid >> 2, seg = tid & 3, n = n0 + r;
            int drow = n;
            if (d.mode) { const int t = n >> 7, c = n & 127; drow = t * 256 + (d.mode == 2 ? 128 : 0) + c; }
            unsigned w[8];
#pragma unroll
            for (int e = 0; e < 8; ++e) w[e] = pack2(tile[(seg * 16 + 2 * e) * 65 + r], tile[(seg * 16 + 2 * e + 1) * 65 + r]);
            uint4* dp = (uint4*)(d.dst + (size_t)drow * d.K + k0 + seg * 16);
            dp[0] = make_uint4(w[0], w[1], w[2], w[3]); dp[1] = make_uint4(w[4], w[5], w[6], w[7]);
        }
        it = itn; have = hn; d = dn;
#pragma unroll
        for (int r = 0; r < 16; ++r) v[r] = vn[r];
    }
}

DEVI void copy_caches(const Params& p) {
    int z_; asm volatile("s_mov_b32 %0, 0" : "=s"(z_)); unsigned char* ws_ = p.ws + z_; float* out_ = p.out + z_; (void)ws_; (void)out_; KIN_DECL;
    const unsigned gtid = (unsigned)(bidx() * 256 + tidx()), gsz = (unsigned)(VGRID * 256);
#pragma unroll
    for (int g = 0; g < 3; ++g) {
        const unsigned W = g == 0 ? 128u : (g == 1 ? 512u : 2048u);
        const unsigned per = (W - 4u) * 128u, tot = 32u * per;
        const f32x4* src = (const f32x4*)(g == 0 ? in_[5] : (g == 1 ? in_[6] : in_[7]));
        f32x4* dst = (f32x4*)(out_ + (g == 0 ? O_KV0S : (g == 1 ? O_KV1S : O_KV2S)));
        for (unsigned base = gtid; base < tot; base += 8u * gsz) {
            f32x4 v[8]; unsigned di[8];
#pragma unroll
            for (int u = 0; u < 8; ++u) {
                const unsigned i = base + (unsigned)u * gsz, ic = i < tot ? i : tot - 1u, sb = ic / per, rem = ic - sb * per;
                di[u] = sb * W * 128u + rem;
                v[u] = __builtin_nontemporal_load(src + (sb * W + 4u) * 128u + rem);
            }
#pragma unroll
            for (int u = 0; u < 8; ++u) if (base + (unsigned)u * gsz < tot) __builtin_nontemporal_store(v[u], dst + di[u]);
        }
    }
}

DEVI void norm_phase(const Params& p, int mode) {
    int z_; asm volatile("s_mov_b32 %0, 0" : "=s"(z_)); unsigned char* ws_ = p.ws + z_; float* out_ = p.out + z_; (void)ws_; (void)out_; KIN_DECL;
    const int lane = tidx() & 63, wv = (bidx() * 256 + tidx()) >> 6, nw = (VGRID * 256) >> 6;
    float* X = out_;
    bf16_t* Hb = (bf16_t*)(ws_ + B_HB);
    for (int r0 = wv; r0 < T; r0 += 2 * nw) {
        const int r1 = r0 + nw; const bool h1 = r1 < T; const int rr[2] = {r0, h1 ? r1 : r0};
        float4 v[2][4]; float ss[2] = {0.f, 0.f};
#pragma unroll
        for (int k = 0; k < 2; ++k) {
            const int r = rr[k];
            const float* src = mode == 0 ? (r < TP ? in_[0] + (size_t)r * D : in_[1] + (size_t)(r - TP) * D) : X + (size_t)r * D;
#pragma unroll
            for (int i = 0; i < 4; ++i) v[k][i] = ((const float4*)src)[i * 64 + lane];
        }
#pragma unroll
        for (int k = 0; k < 2; ++k) {
#pragma unroll
            for (int i = 0; i < 4; ++i) ss[k] += v[k][i].x * v[k][i].x + v[k][i].y * v[k][i].y + v[k][i].z * v[k][i].z + v[k][i].w * v[k][i].w;
            ss[k] = wave_sum(ss[k]);
        }
#pragma unroll
        for (int k = 0; k < 2; ++k) {
            if (k == 1 && !h1) break;
            const int r = rr[k];
            const float inv = rsqrtf(ss[k] * (1.f / D) + EPS);
            if (mode == 2) {
                const float4* g = (const float4*)in_[28];
#pragma unroll
                for (int i = 0; i < 4; ++i) { float4 gg = g[i * 64 + lane]; ((float4*)(X + (size_t)r * D))[i * 64 + lane] = make_float4(v[k][i].x * inv * gg.x, v[k][i].y * inv * gg.y, v[k][i].z * inv * gg.z, v[k][i].w * inv * gg.w); }
            } else {
#pragma unroll
                for (int i = 0; i < 4; ++i) {
                    if (mode == 0 && r >= TP) ((float4*)(X + (size_t)r * D))[i * 64 + lane] = v[k][i];
                    ((uint2*)(Hb + (size_t)r * D))[i * 64 + lane] = make_uint2(pack2(v[k][i].x * inv, v[k][i].y * inv), pack2(v[k][i].z * inv, v[k][i].w * inv));
                }
            }
        }
    }
}

enum { EPI_SSM_IN = 0, EPI_GLA_IN = 1, EPI_ATT_IN = 2, EPI_RESADD = 3, EPI_SWIGLU = 4 };
constexpr int GST = 72;
constexpr int GBUF = 2 * 128 * GST;

template <int EPI, int K>
DEVI void gemm_phase(const Params& p, const bf16_t* __restrict__ A, const bf16_t* __restrict__ Bt, int nN, bool only_split = false) {
    int z_; asm volatile("s_mov_b32 %0, 0" : "=s"(z_)); unsigned char* ws_ = p.ws + z_; float* out_ = p.out + z_; (void)ws_; (void)out_; KIN_DECL;
    const int tid = rtid(), lane = tid & 63, wave = tid >> 6, wm = wave >> 2, wn = wave & 3, l31 = lane & 31, lh = lane >> 5;
    constexpr int SBUF = 2 * 256 * GST;
    bf16_t* const s0 = (bf16_t*)smem;
    constexpr int nkfull = K / 64, KCH = 2;
    const int nMt = (EPI == EPI_RESADD) ? 64 : 65;
    const int nfull = nMt * nN, nch = (EPI == EPI_RESADD) ? (nkfull + KCH - 1) / KCH : 0, nunits = nfull + nch * nN;
    const int bid = rbid(), xcd = bid & 7, lb = bid >> 3, nper = (int)gridDim.x >> 3;
    const int u0 = only_split ? nfull : 0;
    for (int rnd = 0; u0 + rnd * (int)gridDim.x < nunits; ++rnd) {
        const int u = u0 + (rnd * 8 + xcd) * nper + lb;
        if (u >= nunits) continue;
        int mt, nt, kt0, kt1; bool atomic = false;
        if (u < nfull) {
            const int per_group = 8 * nN, gm = u / per_group, rem = u - gm * per_group, fm = gm * 8, gsz = (nMt - fm) < 8 ? (nMt - fm) : 8;
            mt = fm + rem % gsz; nt = rem / gsz; kt0 = 0; kt1 = nkfull;
        } else {
            const int v = u - nfull, ch = v / nN; mt = 64; nt = v - ch * nN; kt0 = ch * KCH; kt1 = (kt0 + KCH < nkfull) ? kt0 + KCH : nkfull; atomic = true;
        }
        const int nk = kt1 - kt0;
        const char* Ab = (const char*)A + (size_t)kt0 * 128; const char* Bb = (const char*)(Bt + (size_t)nt * 256 * K) + (size_t)kt0 * 128;
        unsigned aoff[4];
#pragma unroll
        for (int i = 0; i < 4; ++i) { int gr = mt * 256 + (tid >> 3) + 64 * i; gr = gr < T ? gr : T - 1; aoff[i] = (unsigned)gr * (unsigned)(K * 2) + (unsigned)((tid & 7) * 16); }
        const unsigned boff = (unsigned)(tid >> 3) * (unsigned)(K * 2) + (unsigned)((tid & 7) * 16);
        const unsigned lso = (unsigned)((tid >> 3) * GST + (tid & 7) * 8);
        f32x16 acc[4][2];
#pragma unroll
        for (int i = 0; i < 4; ++i)
#pragma unroll
            for (int j = 0; j < 2; ++j)
#pragma unroll
                for (int e = 0; e < 16; ++e) acc[i][j][e] = 0.f;
        u32x4 ra[4], rb[4];
#define G_LOAD(KT) { const int kk_ = (KT) < nk ? (KT) : nk - 1; const char* ab_ = Ab + (size_t)kk_ * 128; const char* bb_ = Bb + (size_t)kk_ * 128; \
            _Pragma("unroll") for (int i = 0; i < 4; ++i) ra[i] = *(const u32x4*)(ab_ + aoff[i]); \
            _Pragma("unroll") for (int i = 0; i < 4; ++i) rb[i] = *(const u32x4*)(bb_ + (size_t)i * 128 * K + boff); }
#define G_STORE(BUF) { bf16_t* sa_ = s0 + (BUF) * SBUF; bf16_t* sb_ = sa_ + 256 * GST; \
            _Pragma("unroll") for (int i = 0; i < 4; ++i) *(u32x4*)(sa_ + lso + i * 64 * GST) = ra[i]; \
            _Pragma("unroll") for (int i = 0; i < 4; ++i) *(u32x4*)(sb_ + lso + i * 64 * GST) = rb[i]; }
        __syncthreads();
        G_LOAD(0); G_STORE(0); G_LOAD(1);
        __syncthreads();
        for (int kt = 0; kt < nk; ++kt) {
            if (kt + 1 < nk) G_STORE((kt + 1) & 1);
            G_LOAD(kt + 2);
            const bf16_t* cA = s0 + (kt & 1) * SBUF; const bf16_t* cB = cA + 256 * GST;
#pragma unroll
            for (int ks = 0; ks < 4; ++ks) {
                bf16x8 a[4], b[2];
#pragma unroll
                for (int i = 0; i < 4; ++i) a[i] = ldsfrag(cA, 128 * wm + 32 * i + l31, GST, ks * 16 + 8 * lh);
#pragma unroll
                for (int j = 0; j < 2; ++j) b[j] = ldsfrag(cB, 64 * wn + 32 * j + l31, GST, ks * 16 + 8 * lh);
#pragma unroll
                for (int i = 0; i < 4; ++i)
#pragma unroll
                    for (int j = 0; j < 2; ++j) acc[i][j] = mfma32(a[i], b[j], acc[i][j]);
            }
            __syncthreads();
        }
        static_assert(EPI == EPI_RESADD, "own GEMM is only used for the residual-add phases");
        if (mt * 256 + 128 * wm < T) {
#pragma unroll
            for (int i = 0; i < 4; ++i)
#pragma unroll
                for (int j = 0; j < 2; ++j)
#pragma unroll
                    for (int e = 0; e < 16; ++e) {
                        const int row = mt * 256 + 128 * wm + 32 * i + (e & 3) + 8 * (e >> 2) + 4 * lh, col = nt * 256 + 64 * wn + 32 * j + l31;
                        if (row < T) {
                            float* xf = out_ + (size_t)row * D + col;
                            if (atomic) unsafeAtomicAdd(xf, acc[i][j][e]); else *xf += acc[i][j][e];
                        }
                    }
        }
    }
    __syncthreads();
}


namespace pg8 {
#define PG8_LAS __attribute__((address_space(3)))
constexpr int BM = 256, BK = 64, HALF = 128, HTB = HALF * BK * 2  , STAGE_BYTES = 8 * HTB, NXCD = 8, WGM = 8;

__host__ __device__ __forceinline__ int lds_byte(int r, int c) { const int st = (r >> 4) * 2 + (c >> 5), rr = r & 15, cc = c & 31, ob = rr * 64 + cc * 2; return st * 1024 + (ob ^ (((ob >> 9) & 1) << 5)); }
__host__ __device__ __forceinline__ void stage_rc(int b, int& R, int& C) { const int st = b / 1024, sb = b % 1024, swz = sb ^ (((sb >> 9) & 1) << 5); R = (st >> 1) * 16 + swz / 64; C = (st & 1) * 32 + (swz % 64) / 2; }
__host__ __device__ __forceinline__ int perm32(int rho) { const int n = rho >> 4, i = rho & 15; return 8 * (i >> 2) + 4 * n + (i & 3); }

struct Unit { int pm, pn; };
struct Gemm { const bf16_t* A; const bf16_t* Bt; int M, N, K; };
struct StaticOrder {
    int nM, nN, nwg, G, c;
    __host__ __device__ void init(int M, int N, int G_, int c_) { nM = M / BM; nN = N / BM; nwg = nM * nN; G = G_; c = c_; }
    __host__ __device__ bool next(int i, Unit& u) const {
        const long L = (long)i * G + c; if (L >= nwg) return false;
        int wgid = (int)L; { const int q = nwg / NXCD, r = nwg % NXCD, xcd = wgid % NXCD, off = wgid / NXCD; wgid = (xcd < r ? xcd * (q + 1) : r * (q + 1) + (xcd - r) * q) + off; }
        const int nig = WGM * nN, gid = wgid / nig, fm = gid * WGM, gsz = (nM - fm) < WGM ? (nM - fm) : WGM;
        u.pm = fm + ((wgid % nig) % gsz); u.pn = (wgid % nig) / gsz; return true;
    }
    __device__ __forceinline__ void a_ready(const Unit&) const {}
    __device__ __forceinline__ void done(const Unit&) const {}
};
template <class Epi, class Sched, bool STAMP = false>
__device__ __forceinline__ void gemm_phase(PG8_LAS unsigned char* lds, const Gemm g, const Sched& S, const Epi& E, unsigned long long* stamps) {
    const int tid = rtid(), wid = __builtin_amdgcn_readfirstlane(tid >> 6), lane = tid & 63, wr = wid >> 2, wc = wid & 3, fr = lane & 15, fq = lane >> 4;
    const int K = g.K, nt = K / BK;
    int ts_lo = 0, ts_hi = 0, nts = 0; const unsigned long long rt_entry = STAMP ? (unsigned long long)0ull : 0ull;
#define PG8_STAMP() do { if (STAMP && wid == 0 && nts < 64) { const unsigned long long _c = (unsigned long long)clock64(); \
        ts_lo = (lane == nts) ? (int)(unsigned)_c : ts_lo; ts_hi = (lane == nts) ? (int)(unsigned)(_c >> 32) : ts_hi; ++nts; } } while (0)
    PG8_STAMP();
    unsigned voffA[2], voffB[2];
#pragma unroll
    for (int i = 0; i < 2; ++i) { int R, C; stage_rc(tid * 16 + i * 8192, R, C); const int Rb = Epi::PERM ? ((R & ~31) + perm32(R & 31)) : R;
        voffA[i] = (unsigned)(R * K + C) * 2u; voffB[i] = (unsigned)(Rb * K + C) * 2u; }
    const size_t kstep = (size_t)(BK * 2);
    const size_t hstep = (size_t)HALF * K * 2;
    const size_t tstep = 2 * hstep;
    const unsigned ldsw = (unsigned)wid * 1024u;
    const int aoff = lds_byte(wr * 64 + fr, fq * 8), boff = lds_byte(wc * 32 + fr, fq * 8);
#define PG8_SA(b, h) (((b) * 2 + (h)) * HTB)
#define PG8_SB(b, h) ((4 + (b) * 2 + (h)) * HTB)
#define PG8_STAGE(bufoff, gbase, voff) do { _Pragma("unroll") for (int _i = 0; _i < 2; ++_i) \
        __builtin_amdgcn_global_load_lds((const unsigned*)((const char*)(gbase) + (voff)[_i]), (PG8_LAS unsigned*)(lds + (bufoff) + ldsw + _i * 8192), 16, 0, 0); } while (0)
#define PG8_LDA(dst, b, h) do { _Pragma("unroll") for (int m = 0; m < 4; ++m) _Pragma("unroll") for (int k = 0; k < 2; ++k) dst[m][k] = *(const PG8_LAS bf16x8*)(lds + PG8_SA(b, h) + aoff + m * 2048 + k * 1024); } while (0)
#define PG8_LDB(dst, b, h) do { _Pragma("unroll") for (int n = 0; n < 2; ++n) _Pragma("unroll") for (int k = 0; k < 2; ++k) dst[n][k] = *(const PG8_LAS bf16x8*)(lds + PG8_SB(b, h) + boff + n * 2048 + k * 1024); } while (0)
#define PG8_MMA(ai, bj, At, Bt) do { __builtin_amdgcn_s_setprio(1); _Pragma("unroll") for (int m = 0; m < 4; ++m) _Pragma("unroll") for (int n = 0; n < 2; ++n) _Pragma("unroll") for (int k = 0; k < 2; ++k) \
        acc[ai][bj][m][n] = __builtin_amdgcn_mfma_f32_16x16x32_bf16(Bt[n][k], At[m][k], acc[ai][bj][m][n], 0, 0, 0); __builtin_amdgcn_s_setprio(0); } while (0)
#define PG8_WAIT_V(n) asm volatile("s_waitcnt vmcnt(" #n ")" ::: "memory")
#define PG8_WAIT_L(n) asm volatile("s_waitcnt lgkmcnt(" #n ")" ::: "memory")
#define PG8_BAR __builtin_amdgcn_s_barrier()
#define PG8_SCHED __builtin_amdgcn_sched_barrier(0)
    Unit cur, nxt; int ui = 0;
    if (!S.next(0, cur)) return;
    f32x4 acc[2][2][4][2];
#pragma unroll
    for (int a = 0; a < 2; ++a)
#pragma unroll
        for (int b = 0; b < 2; ++b)
#pragma unroll
            for (int m = 0; m < 4; ++m)
#pragma unroll
                for (int n = 0; n < 2; ++n) acc[a][b][m][n] = (f32x4){0.f, 0.f, 0.f, 0.f};
    bf16x8 At[4][2], B0[2][2], B1[2][2];
    const char* cA = (const char*)g.A + (size_t)cur.pm * tstep; const char* cB = (const char*)g.Bt + (size_t)cur.pn * tstep;
    S.a_ready(cur);
    PG8_STAGE(PG8_SB(0, 0), cB, voffB); PG8_STAGE(PG8_SA(0, 0), cA, voffA); PG8_STAGE(PG8_SB(0, 1), cB + hstep, voffB); PG8_STAGE(PG8_SA(0, 1), cA + hstep, voffA);
    if (wr == 1) PG8_BAR;
    PG8_WAIT_V(4); PG8_BAR;
    PG8_STAGE(PG8_SB(1, 0), cB + kstep, voffB); PG8_STAGE(PG8_SA(1, 0), cA + kstep, voffA); PG8_STAGE(PG8_SB(1, 1), cB + hstep + kstep, voffB);
    PG8_WAIT_V(6); PG8_BAR;
    PG8_STAMP();
    for (;;) {
        const bool has_next = S.next(ui + 1, nxt);
        const char* nA = has_next ? (const char*)g.A + (size_t)nxt.pm * tstep : cA; const char* nB = has_next ? (const char*)g.Bt + (size_t)nxt.pn * tstep : cB;
        for (int t = 0; t < nt; t += 2) {
            const bool last = (t == nt - 2);
            const char* a1 = cA + (size_t)(t + 1) * kstep;
            const char* a2 = last ? nA : cA + (size_t)(t + 2) * kstep; const char* b2 = last ? nB : cB + (size_t)(t + 2) * kstep;
            const char* a3 = a2 + kstep; const char* b3 = b2 + kstep;
            if (last && has_next) S.a_ready(nxt);
            PG8_LDB(B0, 0, 0); PG8_SCHED; PG8_LDA(At, 0, 0); PG8_STAGE(PG8_SA(1, 1), a1 + hstep, voffA);
            PG8_WAIT_L(8); PG8_BAR; PG8_WAIT_L(0); PG8_MMA(0, 0, At, B0); PG8_BAR; PG8_SCHED;
            PG8_LDB(B1, 0, 1); PG8_STAGE(PG8_SB(0, 0), b2, voffB);
            PG8_BAR; PG8_WAIT_L(0); PG8_MMA(0, 1, At, B1); PG8_BAR;
            PG8_LDA(At, 0, 1); PG8_STAGE(PG8_SA(0, 0), a2, voffA);
            PG8_BAR; PG8_WAIT_L(0); PG8_MMA(1, 0, At, B0); PG8_BAR; PG8_SCHED;
            PG8_STAGE(PG8_SB(0, 1), b2 + hstep, voffB);
            PG8_WAIT_V(6); PG8_BAR; PG8_MMA(1, 1, At, B1); PG8_BAR;
            PG8_LDB(B0, 1, 0); PG8_SCHED; PG8_LDA(At, 1, 0); PG8_STAGE(PG8_SA(0, 1), a2 + hstep, voffA);
            PG8_WAIT_L(8); PG8_BAR; PG8_WAIT_L(0); PG8_MMA(0, 0, At, B0); PG8_BAR; PG8_SCHED;
            PG8_LDB(B1, 1, 1); PG8_STAGE(PG8_SB(1, 0), b3, voffB);
            PG8_BAR; PG8_WAIT_L(0); PG8_MMA(0, 1, At, B1); PG8_BAR;
            PG8_LDA(At, 1, 1); PG8_STAGE(PG8_SA(1, 0), a3, voffA);
            PG8_BAR; PG8_WAIT_L(0); PG8_MMA(1, 0, At, B0); PG8_BAR; PG8_SCHED;
            PG8_STAGE(PG8_SB(1, 1), b3 + hstep, voffB);
            PG8_WAIT_V(6); PG8_BAR; PG8_MMA(1, 1, At, B1); PG8_BAR;
        }
        PG8_STAMP();
        if constexpr (!Epi::AFTER_DRAIN) { E(acc, cur, wr, wc, fr, fq); S.done(cur); }
        PG8_STAMP();
        if (!has_next) break;
#pragma unroll
        for (int a = 0; a < 2; ++a)
#pragma unroll
            for (int b = 0; b < 2; ++b)
#pragma unroll
                for (int m = 0; m < 4; ++m)
#pragma unroll
                    for (int n = 0; n < 2; ++n) acc[a][b][m][n] = (f32x4){0.f, 0.f, 0.f, 0.f};
        cur = nxt; cA = nA; cB = nB; ++ui;
    }
    PG8_WAIT_V(0);
    if (wr == 0) PG8_BAR;
    PG8_BAR;
    if constexpr (Epi::AFTER_DRAIN) { E.fused(acc, cur, wr, wc, fr, fq, lds, wid, lane); S.done(cur); }
    PG8_STAMP();
    if (STAMP && wid == 0) { stamps[lane] = lane < nts ? (((unsigned long long)(unsigned)ts_hi << 32) | (unsigned)ts_lo) : 0ull;
        if (lane == 62) stamps[62] = rt_entry; if (lane == 63) stamps[63] = (unsigned long long)0ull; }
#undef PG8_STAMP
#undef PG8_SA
#undef PG8_SB
#undef PG8_STAGE
#undef PG8_LDA
#undef PG8_LDB
#undef PG8_MMA
#undef PG8_WAIT_V
#undef PG8_WAIT_L
#undef PG8_BAR
#undef PG8_SCHED
}
}

template <int EPI> struct EpiMk {
    static constexpr bool PERM = (EPI == EPI_SSM_IN || EPI == EPI_GLA_IN || EPI == EPI_ATT_IN || EPI == EPI_SWIGLU), AFTER_DRAIN = false;
    unsigned char* ws; float* out; const float* xin;
    DEVI void operator()(const f32x4 (&acc)[2][2][4][2], const pg8::Unit& u, int wr, int wc, int fr, int fq) const {
        const int row0 = u.pm * 256 + wr * 64 + fr, col0 = u.pn * 256 + wc * 32 + 4 * fq;
#pragma unroll
        for (int ai = 0; ai < 2; ++ai)
#pragma unroll
            for (int m = 0; m < 4; ++m) {
                const int row = row0 + ai * 128 + m * 16;
                if (row < T) {
                    if (EPI == EPI_SWIGLU) {
                        const int hc = u.pn * 128 + wc * 32 + 8 * fq;
                        unsigned w[4];
#pragma unroll
                        for (int n = 0; n < 2; ++n) {
                            const f32x4 g = acc[ai][0][m][n], up = acc[ai][1][m][n];
                            float o[4];
#pragma unroll
                            for (int e = 0; e < 4; ++e) o[e] = g[e] * __builtin_amdgcn_rcpf(1.f + __expf(-g[e])) * up[e];
                            w[2 * n] = pack2(o[0], o[1]); w[2 * n + 1] = pack2(o[2], o[3]);
                        }
                        *(uint4*)((bf16_t*)(ws + B_R4) + (size_t)row * DFF + hc) = make_uint4(w[0], w[1], w[2], w[3]);
                    } else
#pragma unroll
                    for (int bj = 0; bj < 2; ++bj) {
                        if (PERM) {
                            const int col = u.pn * 256 + bj * 128 + wc * 32 + 8 * fq;
                            const f32x4 v0 = acc[ai][bj][m][0], v1 = acc[ai][bj][m][1];
                            const uint4 pk = make_uint4(pack2(v0[0], v0[1]), pack2(v0[2], v0[3]), pack2(v1[0], v1[1]), pack2(v1[2], v1[3]));
                            if (EPI == EPI_SSM_IN) {
                                if (col < DI) *(uint4*)((bf16_t*)(ws + B_R3) + (size_t)row * DI + col) = pk;
                                else if (col < DI + CONVD) *(uint4*)((bf16_t*)(ws + B_R4) + (size_t)row * CONVD + (col - DI)) = pk;
                                else if (col < SSM_IN) { float4* dp = (float4*)((float*)(ws + B_DT) + (size_t)row * 32 + (col - DI - CONVD)); dp[0] = make_float4(v0[0], v0[1], v0[2], v0[3]); dp[1] = make_float4(v1[0], v1[1], v1[2], v1[3]); }
                            } else if (EPI == EPI_GLA_IN) {
                                if (col < 3072) *(uint4*)((bf16_t*)(ws + B_R4) + (size_t)row * 3072 + col) = pk;
                                else if (col < GLA_IN) { float4* dp = (float4*)((float*)(ws + B_GLOW) + (size_t)row * 16 + (col - 3072)); dp[0] = make_float4(v0[0], v0[1], v0[2], v0[3]); dp[1] = make_float4(v1[0], v1[1], v1[2], v1[3]); }
                            } else {
                                *(uint4*)((bf16_t*)(ws + B_R4) + (size_t)row * QKVD + col) = pk;
                            }
                        } else if (EPI == EPI_SWIGLU) {
                            const f32x4 g = acc[ai][bj][m][0], up = acc[ai][bj][m][1];
                            const int hc = u.pn * 128 + bj * 64 + wc * 16 + 4 * fq;
                            float o[4];
#pragma unroll
                            for (int e = 0; e < 4; ++e) o[e] = g[e] * __builtin_amdgcn_rcpf(1.f + __expf(-g[e])) * up[e];
                            *(uint2*)((bf16_t*)(ws + B_R4) + (size_t)row * DFF + hc) = make_uint2(pack2(o[0], o[1]), pack2(o[2], o[3]));
                        } else {
#pragma unroll
                            for (int n = 0; n < 2; ++n) {
                                const int col = col0 + bj * 128 + n * 16;
                                const f32x4 v = acc[ai][bj][m][n];
                                if (EPI == EPI_RESADD) {
                                    float4* xp = (float4*)(out + (size_t)row * D + col);
                                    float4 x = xin ? *(const float4*)(xin + (size_t)row * D + col) : *xp; x.x += v[0]; x.y += v[1]; x.z += v[2]; x.w += v[3]; *xp = x;
                                } else if (EPI == EPI_SSM_IN) {
                                    const uint2 pk = make_uint2(pack2(v[0], v[1]), pack2(v[2], v[3]));
                                    if (col < DI) *(uint2*)((bf16_t*)(ws + B_R3) + (size_t)row * DI + col) = pk;
                                    else if (col < DI + CONVD) *(uint2*)((bf16_t*)(ws + B_R4) + (size_t)row * CONVD + (col - DI)) = pk;
                                    else if (col < SSM_IN) *(float4*)((float*)(ws + B_DT) + (size_t)row * 32 + (col - DI - CONVD)) = make_float4(v[0], v[1], v[2], v[3]);
                                } else if (EPI == EPI_GLA_IN) {
                                    if (col < 3072) *(uint2*)((bf16_t*)(ws + B_R4) + (size_t)row * 3072 + col) = make_uint2(pack2(v[0], v[1]), pack2(v[2], v[3]));
                                    else if (col < GLA_IN) *(float4*)((float*)(ws + B_GLOW) + (size_t)row * 16 + (col - 3072)) = make_float4(v[0], v[1], v[2], v[3]);
                                } else {
                                    *(uint2*)((bf16_t*)(ws + B_R4) + (size_t)row * QKVD + col) = make_uint2(pack2(v[0], v[1]), pack2(v[2], v[3]));
                                }
                            }
                        }
                    }
                }
            }
    }
};

template <int EPI>
DEVI void gemm8(const Params& p, const bf16_t* A, const bf16_t* Bt, int Mrows, int N, int K, const float* xin = nullptr) {
    int z_; asm volatile("s_mov_b32 %0, 0" : "=s"(z_));
    EpiMk<EPI> E; E.ws = p.ws + z_; E.out = p.out + z_; E.xin = xin;
    pg8::Gemm g; g.A = A + z_; g.Bt = Bt + z_; g.M = Mrows; g.N = N; g.K = K;
    pg8::StaticOrder S; S.init(Mrows, N, (int)gridDim.x, rbid());
    __syncthreads();
    pg8::gemm_phase<EpiMk<EPI>, pg8::StaticOrder, false>((PG8_LAS unsigned char*)smem, g, S, E, nullptr);
    __syncthreads();
}

DEVI void ssm_conv_phase(const Params& p, int j) {
    int z_; asm volatile("s_mov_b32 %0, 0" : "=s"(z_)); unsigned char* ws_ = p.ws + z_; float* out_ = p.out + z_; (void)ws_; (void)out_; KIN_DECL;
    const bf16_t* raw = (const bf16_t*)(ws_ + B_R4);
    bf16_t* act = (bf16_t*)(ws_ + B_R5);
    const float* cw = in_[14] + (size_t)j * 4 * CONVD; const float* cb = in_[15] + (size_t)j * CONVD;
    const float* sbuf = in_[3] + (size_t)j * 32 * 3 * CONVD;
    float* convp = out_ + O_CONVP + (size_t)j * 2 * 3 * CONVD; float* convs = out_ + O_CONVS + (size_t)j * 32 * 3 * CONVD;
    const size_t gtid = (size_t)bidx() * 256 + tidx(), gsz = (size_t)VGRID * 256;
    {
        const size_t totp = (size_t)(TP / 16) * (CONVD / 8);
        for (size_t it = gtid; it < totp; it += gsz) {
            const int run = (int)(it / (CONVD / 8)), c8 = (int)(it % (CONVD / 8)) * 8;
            const int t0 = run * 16, pos0 = t0 & (SEQ - 1);
            float w[4][8], bb[8], x1[8], x2[8], x3[8];
#pragma unroll
            for (int d = 0; d < 4; ++d)
#pragma unroll
                for (int e = 0; e < 8; ++e) w[d][e] = cw[(size_t)d * CONVD + c8 + e];
#pragma unroll
            for (int e = 0; e < 8; ++e) bb[e] = cb[c8 + e];
            if (pos0 >= 3) {
                unpack8(*(const uint4*)(raw + (size_t)(t0 - 1) * CONVD + c8), x1); unpack8(*(const uint4*)(raw + (size_t)(t0 - 2) * CONVD + c8), x2); unpack8(*(const uint4*)(raw + (size_t)(t0 - 3) * CONVD + c8), x3);
            } else {
#pragma unroll
                for (int e = 0; e < 8; ++e) { x1[e] = 0.f; x2[e] = 0.f; x3[e] = 0.f; }
            }
#pragma unroll 4
            for (int r = 0; r < 16; ++r) {
                const int t = t0 + r;
                float x0[8]; unpack8(*(const uint4*)(raw + (size_t)t * CONVD + c8), x0);
                unsigned o[4];
#pragma unroll
                for (int e = 0; e < 4; ++e) {
                    const float a0 = bb[2 * e] + w[3][2 * e] * x0[2 * e] + w[2][2 * e] * x1[2 * e] + w[1][2 * e] * x2[2 * e] + w[0][2 * e] * x3[2 * e];
                    const float a1 = bb[2 * e + 1] + w[3][2 * e + 1] * x0[2 * e + 1] + w[2][2 * e + 1] * x1[2 * e + 1] + w[1][2 * e + 1] * x2[2 * e + 1] + w[0][2 * e + 1] * x3[2 * e + 1];
                    o[e] = pack2(silu_f(a0), silu_f(a1));
                }
                *(uint4*)(act + (size_t)t * CONVD + c8) = make_uint4(o[0], o[1], o[2], o[3]);
                const int pos = pos0 + r;
                if (pos >= SEQ - 3) {
                    float* op = convp + ((size_t)(t >> 13) * 3 + (pos - (SEQ - 3))) * CONVD + c8;
#pragma unroll
                    for (int e = 0; e < 8; ++e) op[e] = x0[e];
                }
#pragma unroll
                for (int e = 0; e < 8; ++e) { x3[e] = x2[e]; x2[e] = x1[e]; x1[e] = x0[e]; }
            }
        }
    }
    const size_t tot = (size_t)TS * (CONVD / 8);
    for (size_t it = gtid; it < tot; it += gsz) {
        const int t = TP + (int)(it / (CONVD / 8)), c8 = (int)(it % (CONVD / 8)) * 8;
        int pos, sb = 0; bool samp = t >= TP;
        if (samp) { sb = (t - TP) >> 2; pos = (t - TP) & 3; } else pos = t & (SEQ - 1);
        float accv[8], xr[4][8];
#pragma unroll
        for (int e = 0; e < 8; ++e) accv[e] = cb[c8 + e];
#pragma unroll
        for (int d = 0; d < 4; ++d) {
            if (pos - d >= 0) unpack8(*(const uint4*)(raw + (size_t)(t - d) * CONVD + c8), xr[d]);
            else if (samp) {
                const float* bp = sbuf + ((size_t)sb * 3 + (3 + pos - d)) * CONVD + c8;
#pragma unroll
                for (int e = 0; e < 8; ++e) xr[d][e] = bp[e];
            } else {
#pragma unroll
                for (int e = 0; e < 8; ++e) xr[d][e] = 0.f;
            }
            const float* wp = cw + (size_t)(3 - d) * CONVD + c8;
#pragma unroll
            for (int e = 0; e < 8; ++e) accv[e] += xr[d][e] * wp[e];
        }
        unsigned w[4];
#pragma unroll
        for (int e = 0; e < 4; ++e) w[e] = pack2(silu_f(accv[2 * e]), silu_f(accv[2 * e + 1]));
        *(uint4*)(act + (size_t)t * CONVD + c8) = make_uint4(w[0], w[1], w[2], w[3]);
        if (!samp && pos >= SEQ - 3) {
            float* o = convp + ((size_t)(t >> 13) * 3 + (pos - (SEQ - 3))) * CONVD + c8;
#pragma unroll
            for (int e = 0; e < 8; ++e) o[e] = xr[0][e];
        }
        if (samp && pos >= 1) {
            float* o = convs + ((size_t)sb * 3 + (pos - 1)) * CONVD + c8;
#pragma unroll
            for (int e = 0; e < 8; ++e) o[e] = xr[0][e];
        }
    }
    const float* DT = (const float*)(ws_ + B_DT); float* DTS = (float*)(ws_ + B_DTS); float* ACS = (float*)(ws_ + B_ACS);
    if (gtid < TS * 4) ((float*)(ws_ + B_SSQS))[gtid] = 0.f;
    const float* dtb = in_[16] + j * 32; const float* alog = in_[17] + j * 32;
    {
        const int lane = tidx() & 63, wv = (bidx() * 256 + tidx()) >> 6, nw = VGRID * 4;
        for (int it = wv; it < 128 * 32; it += nw) {
            const int c = it >> 5, h = it & 31;
            const float Ah = -__expf(alog[h]), bh = dtb[h];
            float carry = 0.f;
#pragma unroll
            for (int ps = 0; ps < 2; ++ps) {
                const size_t o = (size_t)(c * 128 + ps * 64 + lane) * 32 + h;
                const float d = softplus_f(DT[o] + bh); DTS[o] = d;
                float a = Ah * d;
#pragma unroll
                for (int off = 1; off < 64; off <<= 1) { const float t = __shfl_up(a, off); if (lane >= off) a += t; }
                a += carry; ACS[o] = a; carry = __shfl(a, 63);
            }
        }
    }
    for (size_t it = gtid; it < TS * 32; it += gsz) {
        const int r = (int)it, h = r & 31; const size_t o = (size_t)(TP + (r >> 5)) * 32 + h;
        const float d = softplus_f(DT[o] + dtb[h]); DTS[o] = d; ACS[o] = -__expf(alog[h]) * d;
    }
}

constexpr int SST = 136;
DEVI void ssm_state_phase(const Params& p, int j) {
    int z_; asm volatile("s_mov_b32 %0, 0" : "=s"(z_)); unsigned char* ws_ = p.ws + z_; float* out_ = p.out + z_; (void)ws_; (void)out_; KIN_DECL;
    const bf16_t* act = (const bf16_t*)(ws_ + B_R5);
    const float* DTS = (const float*)(ws_ + B_DTS); const float* ACS = (const float*)(ws_ + B_ACS);
    bf16_t* ST = (bf16_t*)(ws_ + B_R6);
    const int tid = tidx(), lane = tid & 63, wave = tid >> 6, l31 = lane & 31, lh = lane >> 5;
    bf16_t* sBt = (bf16_t*)VSMEM;
    bf16_t* sXt = sBt + 128 * SST;
    float* sw = (float*)(sXt + 64 * SST);
    const int nprompt = 128 * 4, nitems = nprompt + 32 * 32;
    for (int item = bidx(); item < nitems; item += VGRID) {
        if (item < nprompt) {
            const int c = item >> 2, g = item & 3, t0 = c * 128;
            __syncthreads();
            for (int idx = tid; idx < 128 * 16; idx += 256) {
                const int q = idx >> 4, n8 = (idx & 15) * 8;
                const uint4 v = *(const uint4*)(act + (size_t)(t0 + q) * CONVD + DI + g * 128 + n8);
                const unsigned short* s = (const unsigned short*)&v;
#pragma unroll
                for (int e = 0; e < 8; ++e) sBt[(n8 + e) * SST + q] = s[e];
            }
            for (int hh = 0; hh < 8; ++hh) {
                const int h = g * 8 + hh;
                __syncthreads();
                if (tid < 128) sw[tid] = DTS[(size_t)(t0 + tid) * 32 + h] * __expf(ACS[(size_t)(t0 + 127) * 32 + h] - ACS[(size_t)(t0 + tid) * 32 + h]);
                __syncthreads();
                for (int idx = tid; idx < 128 * 8; idx += 256) {
                    const int q = idx >> 3, p8 = (idx & 7) * 8;
                    float f[8]; unpack8(*(const uint4*)(act + (size_t)(t0 + q) * CONVD + h * 64 + p8), f);
                    const float w = sw[q];
#pragma unroll
                    for (int e = 0; e < 8; ++e) sXt[(p8 + e) * SST + q] = f2bf(f[e] * w);
                }
                __syncthreads();
                f32x16 acc[2];
#pragma unroll
                for (int i = 0; i < 2; ++i)
#pragma unroll
                    for (int e = 0; e < 16; ++e) acc[i][e] = 0.f;
#pragma unroll
                for (int ks = 0; ks < 8; ++ks) {
                    const bf16x8 a = ldsfrag(sBt, 32 * wave + l31, SST, ks * 16 + 8 * lh);
#pragma unroll
                    for (int i = 0; i < 2; ++i) acc[i] = mfma32(a, ldsfrag(sXt, 32 * i + l31, SST, ks * 16 + 8 * lh), acc[i]);
                }
#pragma unroll
                for (int i = 0; i < 2; ++i)
#pragma unroll
                    for (int rg = 0; rg < 4; ++rg) {
                        const int n = 32 * wave + 8 * rg + 4 * lh, pp = 32 * i + l31;
                        *(uint2*)(ST + (((size_t)c * 32 + h) * 64 + pp) * 128 + n) = make_uint2(pack2(acc[i][4 * rg], acc[i][4 * rg + 1]), pack2(acc[i][4 * rg + 2], acc[i][4 * rg + 3]));
                    }
            }
        } else {
            const int sit = item - nprompt, sb = sit >> 5, h = sit & 31, g = h >> 3, pp = tid >> 2, nq = tid & 3;
            const float* st_in = in_[2] + (size_t)j * 32 * 262144; float* st_out = out_ + O_SSMS + (size_t)j * 32 * 262144;
            const bf16_t* Z = (const bf16_t*)(ws_ + B_R3); bf16_t* Y = (bf16_t*)(ws_ + B_R4);
            float* SSQS = (float*)(ws_ + B_SSQS);
            const size_t sbase = (((size_t)sb * 32 + h) * 64 + pp) * 128;
            float hs[32];
#pragma unroll
            for (int i = 0; i < 8; ++i) { const float4 v = *(const float4*)(st_in + sbase + 4 * nq + 16 * i); hs[4 * i] = v.x; hs[4 * i + 1] = v.y; hs[4 * i + 2] = v.z; hs[4 * i + 3] = v.w; }
            const float Dh = in_[18][j * 32 + h];
#pragma unroll 1
            for (int s = 0; s < 4; ++s) {
                const int tok = TP + sb * 4 + s;
                const float dt = DTS[(size_t)tok * 32 + h], dA = __expf(ACS[(size_t)tok * 32 + h]);
                const float x = bf2f(act[(size_t)tok * CONVD + h * 64 + pp]), xdt = x * dt;
                float yp = 0.f;
#pragma unroll
                for (int i = 0; i < 8; ++i) {
                    float bf[4], cf[4];
                    unpack4(*(const uint2*)(act + (size_t)tok * CONVD + DI + g * 128 + 4 * nq + 16 * i), bf);
                    unpack4(*(const uint2*)(act + (size_t)tok * CONVD + DI + 512 + g * 128 + 4 * nq + 16 * i), cf);
#pragma unroll
                    for (int e = 0; e < 4; ++e) { hs[4 * i + e] = dA * hs[4 * i + e] + xdt * bf[e]; yp += hs[4 * i + e] * cf[e]; }
                }
                yp += __shfl_xor(yp, 1); yp += __shfl_xor(yp, 2);
                const float yv = (yp + Dh * x) * silu_f(bf2f(Z[(size_t)tok * DI + h * 64 + pp]));
                if (nq == 0) Y[(size_t)tok * DI + h * 64 + pp] = f2bf(yv);
                const float tot = wave_sum(nq == 0 ? yv * yv : 0.f);
                if ((tid & 63) == 0) unsafeAtomicAdd(SSQS + (tok - TP) * 4 + g, tot);
            }
#pragma unroll
            for (int i = 0; i < 8; ++i) *(float4*)(st_out + sbase + 4 * nq + 16 * i) = make_float4(hs[4 * i], hs[4 * i + 1], hs[4 * i + 2], hs[4 * i + 3]);
        }
    }
}

DEVI void ssm_scan_phase(const Params& p, int j) {
    int z_; asm volatile("s_mov_b32 %0, 0" : "=s"(z_)); unsigned char* ws_ = p.ws + z_; float* out_ = p.out + z_; (void)ws_; (void)out_; KIN_DECL;
    bf16_t* ST = (bf16_t*)(ws_ + B_R6);
    const float* ACS = (const float*)(ws_ + B_ACS);
    float* outp = out_ + O_SSMP + (size_t)j * 2 * 262144;
    const int gtid = bidx() * 256 + tidx(), gsz = VGRID * 256;
    {
        bf16_t* Y = (bf16_t*)(ws_ + B_R4); const float* SSQS = (const float*)(ws_ + B_SSQS);
        for (int it = gtid; it < TS * 256; it += gsz) {
            const int tk = it >> 8, c8 = (it & 255) * 8;
            const float inv = rsqrtf(SSQS[tk * 4 + (c8 >> 9)] * (1.f / 512.f) + EPS);
            uint4* yp = (uint4*)(Y + (size_t)(TP + tk) * DI + c8);
            float f[8]; unpack8(*yp, f);
            *yp = make_uint4(pack2(f[0] * inv, f[1] * inv), pack2(f[2] * inv, f[3] * inv), pack2(f[4] * inv, f[5] * inv), pack2(f[6] * inv, f[7] * inv));
        }
    }
    for (int it = gtid; it < 2 * 32 * 2048; it += gsz) {
        const int b = it >> 16, h = (it >> 11) & 31, e4 = (it & 2047) * 4;
        float s0 = 0.f, s1 = 0.f, s2 = 0.f, s3 = 0.f;
#pragma unroll 16
        for (int cc = 0; cc < 64; ++cc) {
            const int c = b * 64 + cc;
            uint2* ptr = (uint2*)(ST + ((size_t)c * 32 + h) * 8192 + e4);
            float f[4]; unpack4(*ptr, f);
            *ptr = make_uint2(pack2(s0, s1), pack2(s2, s3));
            const float dec = __expf(ACS[(size_t)(c * 128 + 127) * 32 + h]);
            s0 = dec * s0 + f[0]; s1 = dec * s1 + f[1]; s2 = dec * s2 + f[2]; s3 = dec * s3 + f[3];
        }
        *(float4*)(outp + ((size_t)b * 32 + h) * 8192 + e4) = make_float4(s0, s1, s2, s3);
    }
}

DEVI void ssm_out_phase(const Params& p, int j) {
    int z_; asm volatile("s_mov_b32 %0, 0" : "=s"(z_)); unsigned char* ws_ = p.ws + z_; float* out_ = p.out + z_; (void)ws_; (void)out_; KIN_DECL;
    const bf16_t* act = (const bf16_t*)(ws_ + B_R5);
    const float* DTS = (const float*)(ws_ + B_DTS); const float* ACS = (const float*)(ws_ + B_ACS);
    const bf16_t* ST = (const bf16_t*)(ws_ + B_R6); const bf16_t* Z = (const bf16_t*)(ws_ + B_R3);
    bf16_t* Y = (bf16_t*)(ws_ + B_R4);
    const float* dsk = in_[18] + j * 32;
    const int tid = tidx(), lane = tid & 63, wave = tid >> 6, l31 = lane & 31, lh = lane >> 5;
    bf16_t* RA = (bf16_t*)VSMEM;
    bf16_t* RB = RA + 128 * SST;
    float* sacs = (float*)(RB + 128 * SST);
    float* sdts = sacs + 1024;
    for (int item = bidx(); item < 512; item += VGRID) {
        const int c = item >> 2, g = item & 3, t0 = c * 128;
        __syncthreads();
        for (int idx = tid; idx < 128 * 16; idx += 256) {
            const int q = idx >> 4, n8 = (idx & 15) * 8;
            *(uint4*)(RB + q * SST + n8) = *(const uint4*)(act + (size_t)(t0 + q) * CONVD + DI + g * 128 + n8);
            *(uint4*)(RA + q * SST + n8) = *(const uint4*)(act + (size_t)(t0 + q) * CONVD + DI + 512 + g * 128 + n8);
        }
        for (int idx = tid; idx < 1024; idx += 256) {
            const int hh = idx >> 7, q = idx & 127;
            sacs[idx] = ACS[(size_t)(t0 + q) * 32 + g * 8 + hh]; sdts[idx] = DTS[(size_t)(t0 + q) * 32 + g * 8 + hh];
        }
        __syncthreads();
        f32x16 X[4]; bf16x8 cf[8];
#pragma unroll
        for (int st = 0; st < 4; ++st)
#pragma unroll
            for (int e = 0; e < 16; ++e) X[st][e] = 0.f;
#pragma unroll
        for (int ks = 0; ks < 8; ++ks) {
            cf[ks] = ldsfrag(RA, 32 * wave + l31, SST, ks * 16 + 8 * lh);
#pragma unroll
            for (int st = 0; st < 4; ++st) X[st] = mfma32(ldsfrag(RB, 32 * st + l31, SST, ks * 16 + 8 * lh), cf[ks], X[st]);
        }
        const int q = 32 * wave + l31;
        float ssqk[4] = {0.f, 0.f, 0.f, 0.f};
        for (int hh = 0; hh < 8; ++hh) {
            const int h = g * 8 + hh;
            __syncthreads();
            for (int idx = tid; idx < 128 * 8; idx += 256) {
                const int s = idx >> 3, p8 = (idx & 7) * 8;
                float f[8]; unpack8(*(const uint4*)(act + (size_t)(t0 + s) * CONVD + h * 64 + p8), f);
                const float w = sdts[hh * 128 + s];
#pragma unroll
                for (int e = 0; e < 8; ++e) RA[(p8 + e) * SST + s] = f2bf(f[e] * w);
            }
            for (int idx = tid; idx < 64 * 16; idx += 256) {
                const int pp = idx >> 4, n8 = (idx & 15) * 8;
                *(uint4*)(RA + (64 + pp) * SST + n8) = *(const uint4*)(ST + (((size_t)c * 32 + h) * 64 + pp) * 128 + n8);
            }
            const float aq = sacs[hh * 128 + q];
#pragma unroll
            for (int st = 0; st < 4; ++st)
#pragma unroll
                for (int rg = 0; rg < 4; ++rg) {
                    const int s0 = 32 * st + 8 * rg + 4 * lh;
                    float m[4];
#pragma unroll
                    for (int e = 0; e < 4; ++e) { const int s = s0 + e; m[e] = (s <= q) ? X[st][4 * rg + e] * __expf(aq - sacs[hh * 128 + s]) : 0.f; }
                    *(uint2*)(RB + q * SST + s0) = make_uint2(pack2(m[0], m[1]), pack2(m[2], m[3]));
                }
            __syncthreads();
            f32x16 ad[2], ao[2];
#pragma unroll
            for (int i = 0; i < 2; ++i)
#pragma unroll
                for (int e = 0; e < 16; ++e) { ad[i][e] = 0.f; ao[i][e] = 0.f; }
#pragma unroll
            for (int ks = 0; ks < 8; ++ks) {
                const bf16x8 mb = ldsfrag(RB, q, SST, ks * 16 + 8 * lh);
#pragma unroll
                for (int i = 0; i < 2; ++i) {
                    ad[i] = mfma32(ldsfrag(RA, 32 * i + l31, SST, ks * 16 + 8 * lh), mb, ad[i]);
                    ao[i] = mfma32(ldsfrag(RA, 64 + 32 * i + l31, SST, ks * 16 + 8 * lh), cf[ks], ao[i]);
                }
            }
            const float eq = __expf(aq), Dh = dsk[h];
            float* sYw = (float*)(RB + q * SST);
#pragma unroll
            for (int i = 0; i < 2; ++i)
#pragma unroll
                for (int rg = 0; rg < 4; ++rg) {
                    f32x4 v;
#pragma unroll
                    for (int e = 0; e < 4; ++e) v[e] = ad[i][4 * rg + e] + eq * ao[i][4 * rg + e];
                    *(f32x4*)(sYw + 32 * i + 8 * rg + 4 * lh) = v;
                }
#pragma unroll
            for (int k = 0; k < 4; ++k) {
                const int qr = 32 * wave + (lane >> 3) + 8 * k, c8 = (lane & 7) * 8;
                const float* yr = (const float*)(RB + qr * SST) + c8;
                const f32x4 y0 = *(const f32x4*)yr, y1 = *(const f32x4*)(yr + 4);
                const size_t go = (size_t)(t0 + qr);
                float xf[8], zf[8], y[8];
                unpack8(*(const uint4*)(act + go * CONVD + h * 64 + c8), xf);
                unpack8(*(const uint4*)(Z + go * DI + h * 64 + c8), zf);
                float ps = 0.f;
#pragma unroll
                for (int e = 0; e < 8; ++e) { const float yr_ = e < 4 ? y0[e & 3] : y1[e & 3]; y[e] = (yr_ + Dh * xf[e]) * silu_f(zf[e]); ps += y[e] * y[e]; }
                ps += __shfl_xor(ps, 1); ps += __shfl_xor(ps, 2); ps += __shfl_xor(ps, 4);
                ssqk[k] += ps;
                *(uint4*)(Y + go * DI + h * 64 + c8) = make_uint4(pack2(y[0], y[1]), pack2(y[2], y[3]), pack2(y[4], y[5]), pack2(y[6], y[7]));
                if (k & 1) __builtin_amdgcn_sched_barrier(0);
            }
        }
#pragma unroll
        for (int k = 0; k < 4; ++k) {
            const float inv = rsqrtf(ssqk[k] * (1.f / 512.f) + EPS);
            const int qr = 32 * wave + (lane >> 3) + 8 * k, c8 = (lane & 7) * 8;
            const size_t go = (size_t)(t0 + qr);
            for (int hh = 0; hh < 8; ++hh) {
                uint4* yp = (uint4*)(Y + go * DI + (g * 8 + hh) * 64 + c8);
                float f[8]; unpack8(*yp, f);
                *yp = make_uint4(pack2(f[0] * inv, f[1] * inv), pack2(f[2] * inv, f[3] * inv), pack2(f[4] * inv, f[5] * inv), pack2(f[6] * inv, f[7] * inv));
            }
        }
    }
}

constexpr int GCH = 64;
DEVI void gla_gate_phase(const Params& p) {
    int z_; asm volatile("s_mov_b32 %0, 0" : "=s"(z_)); unsigned char* ws_ = p.ws + z_; float* out_ = p.out + z_; (void)ws_; (void)out_; KIN_DECL;
    const float* GLOW = (const float*)(ws_ + B_GLOW); float* BC = (float*)(ws_ + B_HB);
    const float* wg = in_[22]; const float* gb = in_[23];
    const int tid = tidx();
    const int nitems = TP / GCH + 32;
    for (int item = bidx(); item < nitems; item += VGRID) {
        int t0, len;
        if (item < TP / GCH) { t0 = item * GCH; len = GCH; } else { t0 = TP + (item - TP / GCH) * 4; len = 4; }
        float w0[16], w1[16];
#pragma unroll
        for (int r = 0; r < 16; ++r) { w0[r] = wg[r * 512 + tid]; w1[r] = wg[r * 512 + 256 + tid]; }
        const float b0 = gb[tid], b1 = gb[256 + tid];
        float* sg = (float*)VSMEM;
        __syncthreads();
        if (tid * 4 < len * 16) *(float4*)(sg + tid * 4) = *(const float4*)(GLOW + (size_t)t0 * 16 + tid * 4);
        __syncthreads();
        float r0 = 0.f, r1 = 0.f;
        for (int q = 0; q < len; ++q) {
            const float* gl = sg + q * 16;
            float a0 = b0, a1 = b1;
#pragma unroll
            for (int r = 0; r < 16; ++r) { const float gv = gl[r]; a0 += gv * w0[r]; a1 += gv * w1[r]; }
            r0 += logsigmoid_f(a0) * (1.f / 16.f); r1 += logsigmoid_f(a1) * (1.f / 16.f);
            BC[(size_t)(t0 + q) * 512 + tid] = r0; BC[(size_t)(t0 + q) * 512 + 256 + tid] = r1;
        }
    }
}

constexpr int QST = 72;
DEVI void gla_state_phase(const Params& p) {
    int z_; asm volatile("s_mov_b32 %0, 0" : "=s"(z_)); unsigned char* ws_ = p.ws + z_; float* out_ = p.out + z_; (void)ws_; (void)out_; KIN_DECL;
    const bf16_t* QK = (const bf16_t*)(ws_ + B_R4);
    const float* BC = (const float*)(ws_ + B_HB);
    bf16_t* U = (bf16_t*)(ws_ + B_R6);
    const int tid = tidx(), lane = tid & 63, wave = tid >> 6, l31 = lane & 31, lh = lane >> 5;
    bf16_t* sVt = (bf16_t*)VSMEM;
    bf16_t* sKt = sVt + 256 * QST;
    const int nprompt = (TP / GCH) * 4, nitems = nprompt + 128;
    for (int item = bidx(); item < nitems; item += VGRID) {
        __syncthreads();
        if (item < nprompt) {
            const int c = item >> 2, h = item & 3, t0 = c * GCH;
            for (int idx = tid; idx < GCH * 32; idx += 256) {
                const int q = idx >> 5, v8 = (idx & 31) * 8;
                const uint4 v = *(const uint4*)(QK + (size_t)(t0 + q) * 3072 + 1024 + h * 256 + v8);
                const unsigned short* s = (const unsigned short*)&v;
#pragma unroll
                for (int e = 0; e < 8; ++e) sVt[(v8 + e) * QST + q] = s[e];
            }
            for (int idx = tid; idx < GCH * 16; idx += 256) {
                const int q = idx >> 4, k8 = (idx & 15) * 8;
                float f[8]; unpack8(*(const uint4*)(QK + (size_t)(t0 + q) * 3072 + 512 + h * 128 + k8), f);
                const float* bl = BC + (size_t)(t0 + GCH - 1) * 512 + h * 128 + k8; const float* bq = BC + (size_t)(t0 + q) * 512 + h * 128 + k8;
#pragma unroll
                for (int e = 0; e < 8; ++e) sKt[(k8 + e) * QST + q] = f2bf(f[e] * __expf(bl[e] - bq[e]));
            }
            __syncthreads();
            f32x16 acc[2][4];
#pragma unroll
            for (int i = 0; i < 2; ++i)
#pragma unroll
                for (int kk = 0; kk < 4; ++kk)
#pragma unroll
                    for (int e = 0; e < 16; ++e) acc[i][kk][e] = 0.f;
#pragma unroll
            for (int ks = 0; ks < 4; ++ks) {
                bf16x8 vb[2];
#pragma unroll
                for (int i = 0; i < 2; ++i) vb[i] = ldsfrag(sVt, 64 * wave + 32 * i + l31, QST, ks * 16 + 8 * lh);
#pragma unroll
                for (int kk = 0; kk < 4; ++kk) {
                    const bf16x8 ka = ldsfrag(sKt, 32 * kk + l31, QST, ks * 16 + 8 * lh);
#pragma unroll
                    for (int i = 0; i < 2; ++i) acc[i][kk] = mfma32(ka, vb[i], acc[i][kk]);
                }
            }
#pragma unroll
            for (int i = 0; i < 2; ++i)
#pragma unroll
                for (int kk = 0; kk < 4; ++kk)
#pragma unroll
                    for (int rg = 0; rg < 4; ++rg) {
                        const int v = 64 * wave + 32 * i + l31, k = 32 * kk + 8 * rg + 4 * lh;
                        *(uint2*)(U + (((size_t)c * 4 + h) * 256 + v) * 128 + k) = make_uint2(pack2(acc[i][kk][4 * rg], acc[i][kk][4 * rg + 1]), pack2(acc[i][kk][4 * rg + 2], acc[i][kk][4 * rg + 3]));
                    }
        } else {
            const int sb = (item - nprompt) >> 2, h = (item - nprompt) & 3, v = tid;
            const float* s_in = in_[4] + ((size_t)sb * 4 + h) * 32768; float* s_out = out_ + O_GLAS + ((size_t)sb * 4 + h) * 32768;
            bf16_t* OG = (bf16_t*)(ws_ + B_R3);
            float* sq = (float*)VSMEM; float* sk = sq + 128; float* sa = sk + 128; float* red = sa + 128;
            float S[128];
#pragma unroll
            for (int k = 0; k < 128; ++k) S[k] = s_in[(size_t)k * 256 + v];
            for (int s = 0; s < 4; ++s) {
                const int tok = TP + sb * 4 + s;
                __syncthreads();
                if (tid < 128) {
                    sq[tid] = bf2f(QK[(size_t)tok * 3072 + h * 128 + tid]) * 0.08838834764831845f;
                    sk[tid] = bf2f(QK[(size_t)tok * 3072 + 512 + h * 128 + tid]);
                    const float bcur = BC[(size_t)tok * 512 + h * 128 + tid], bprev = s ? BC[(size_t)(tok - 1) * 512 + h * 128 + tid] : 0.f;
                    sa[tid] = __expf(bcur - bprev);
                }
                __syncthreads();
                const float vv = bf2f(QK[(size_t)tok * 3072 + 1024 + h * 256 + v]);
                float o = 0.f;
#pragma unroll
                for (int k = 0; k < 128; ++k) { S[k] = sa[k] * S[k] + sk[k] * vv; o += sq[k] * S[k]; }
                red[tid] = o * o;
                __syncthreads();
                for (int st = 128; st > 0; st >>= 1) { if (tid < st) red[tid] += red[tid + st]; __syncthreads(); }
                const float inv = rsqrtf(red[0] * (1.f / 256.f) + EPS);
                const float r = bf2f(QK[(size_t)tok * 3072 + 2048 + h * 256 + v]);
                OG[(size_t)tok * D + h * 256 + v] = f2bf(o * inv * silu_f(r));
            }
#pragma unroll
            for (int k = 0; k < 128; ++k) s_out[(size_t)k * 256 + v] = S[k];
        }
    }
}

DEVI void gla_scan_phase(const Params& p) {
    int z_; asm volatile("s_mov_b32 %0, 0" : "=s"(z_)); unsigned char* ws_ = p.ws + z_; float* out_ = p.out + z_; (void)ws_; (void)out_; KIN_DECL;
    bf16_t* U = (bf16_t*)(ws_ + B_R6);
    const float* BC = (const float*)(ws_ + B_HB);
    float* outp = out_ + O_GLAP;
    const int gtid = bidx() * 256 + tidx(), gsz = VGRID * 256;
    for (int it = gtid; it < 2 * 4 * 8192; it += gsz) {
        const int b = it >> 15, h = (it >> 13) & 3, v = (it >> 5) & 255, k4 = (it & 31) * 4;
        float s0 = 0.f, s1 = 0.f, s2 = 0.f, s3 = 0.f;
#pragma unroll 16
        for (int cc = 0; cc < SEQ / GCH; ++cc) {
            const int c = b * (SEQ / GCH) + cc;
            uint2* ptr = (uint2*)(U + (((size_t)c * 4 + h) * 256 + v) * 128 + k4);
            float f[4]; unpack4(*ptr, f);
            *ptr = make_uint2(pack2(s0, s1), pack2(s2, s3));
            const float4 bl = *(const float4*)(BC + (size_t)(c * GCH + GCH - 1) * 512 + h * 128 + k4);
            s0 = __expf(bl.x) * s0 + f[0]; s1 = __expf(bl.y) * s1 + f[1]; s2 = __expf(bl.z) * s2 + f[2]; s3 = __expf(bl.w) * s3 + f[3];
        }
        float* o = outp + (((size_t)b * 4 + h) * 128 + k4) * 256 + v;
        o[0] = s0; o[256] = s1; o[512] = s2; o[768] = s3;
    }
}

DEVI void gla_out_phase(const Params& p) {
    int z_; asm volatile("s_mov_b32 %0, 0" : "=s"(z_)); unsigned char* ws_ = p.ws + z_; float* out_ = p.out + z_; (void)ws_; (void)out_; KIN_DECL;
    const bf16_t* QK = (const bf16_t*)(ws_ + B_R4);
    const float* BC = (const float*)(ws_ + B_HB);
    const bf16_t* U = (const bf16_t*)(ws_ + B_R6);
    bf16_t* OG = (bf16_t*)(ws_ + B_R3);
    const int tid = tidx(), lane = tid & 63, wave = tid >> 6, l31 = lane & 31, lh = lane >> 5;
    bf16_t* sQ = (bf16_t*)VSMEM;
    bf16_t* sK = sQ + 64 * SST;
    bf16_t* sVt = sK + 64 * SST;
    float* sred = (float*)(sVt + 256 * QST);
    const int nitems = (TP / GCH) * 4;
    for (int item = bidx(); item < nitems; item += VGRID) {
        const int c = item >> 2, h = item & 3, t0 = c * GCH;
        __syncthreads();
        for (int idx = tid; idx < GCH * 16; idx += 256) {
            const int q = idx >> 4, k8 = (idx & 15) * 8;
            float fq[8], fk[8];
            unpack8(*(const uint4*)(QK + (size_t)(t0 + q) * 3072 + h * 128 + k8), fq);
            unpack8(*(const uint4*)(QK + (size_t)(t0 + q) * 3072 + 512 + h * 128 + k8), fk);
            const float* bq = BC + (size_t)(t0 + q) * 512 + h * 128 + k8;
            unsigned wq[4], wk[4];
#pragma unroll
            for (int e = 0; e < 4; ++e) {
                const float e0 = __expf(bq[2 * e]), e1 = __expf(bq[2 * e + 1]);
                wq[e] = pack2(fq[2 * e] * e0 * 0.08838834764831845f, fq[2 * e + 1] * e1 * 0.08838834764831845f);
                wk[e] = pack2(fk[2 * e] / e0, fk[2 * e + 1] / e1);
            }
            *(uint4*)(sQ + q * SST + k8) = make_uint4(wq[0], wq[1], wq[2], wq[3]);
            *(uint4*)(sK + q * SST + k8) = make_uint4(wk[0], wk[1], wk[2], wk[3]);
        }
        for (int idx = tid; idx < GCH * 32; idx += 256) {
            const int q = idx >> 5, v8 = (idx & 31) * 8;
            const uint4 v = *(const uint4*)(QK + (size_t)(t0 + q) * 3072 + 1024 + h * 256 + v8);
            const unsigned short* s = (const unsigned short*)&v;
#pragma unroll
            for (int e = 0; e < 8; ++e) sVt[(v8 + e) * QST + q] = s[e];
        }
        __syncthreads();
        const int qt = wave & 1, stl = wave >> 1;
        f32x16 at;
#pragma unroll
        for (int e = 0; e < 16; ++e) at[e] = 0.f;
#pragma unroll
        for (int ks = 0; ks < 8; ++ks) at = mfma32(ldsfrag(sK, 32 * stl + l31, SST, ks * 16 + 8 * lh), ldsfrag(sQ, 32 * qt + l31, SST, ks * 16 + 8 * lh), at);
        f32x16 acc[2][2];
#pragma unroll
        for (int i = 0; i < 2; ++i)
#pragma unroll
            for (int jq = 0; jq < 2; ++jq)
#pragma unroll
                for (int e = 0; e < 16; ++e) acc[i][jq][e] = 0.f;
        const bf16_t* Uc = U + ((size_t)c * 4 + h) * 32768;
#pragma unroll
        for (int ks = 0; ks < 8; ++ks) {
            bf16x8 qb[2];
#pragma unroll
            for (int jq = 0; jq < 2; ++jq) qb[jq] = ldsfrag(sQ, 32 * jq + l31, SST, ks * 16 + 8 * lh);
#pragma unroll
            for (int i = 0; i < 2; ++i) {
                const bf16x8 sa = *(const bf16x8*)(Uc + (size_t)(64 * wave + 32 * i + l31) * 128 + ks * 16 + 8 * lh);
#pragma unroll
                for (int jq = 0; jq < 2; ++jq) acc[i][jq] = mfma32(sa, qb[jq], acc[i][jq]);
            }
        }
        __syncthreads();
        bf16_t* sP = sK;
        {
            const int q = 32 * qt + l31;
#pragma unroll
            for (int rg = 0; rg < 4; ++rg) {
                const int s0 = 32 * stl + 8 * rg + 4 * lh;
                float m[4];
#pragma unroll
                for (int e = 0; e < 4; ++e) m[e] = (s0 + e <= q) ? at[4 * rg + e] : 0.f;
                *(uint2*)(sP + q * QST + s0) = make_uint2(pack2(m[0], m[1]), pack2(m[2], m[3]));
            }
        }
        __syncthreads();
#pragma unroll
        for (int ks = 0; ks < 4; ++ks) {
            bf16x8 pb[2];
#pragma unroll
            for (int jq = 0; jq < 2; ++jq) pb[jq] = ldsfrag(sP, 32 * jq + l31, QST, ks * 16 + 8 * lh);
#pragma unroll
            for (int i = 0; i < 2; ++i) {
                const bf16x8 va = ldsfrag(sVt, 64 * wave + 32 * i + l31, QST, ks * 16 + 8 * lh);
#pragma unroll
                for (int jq = 0; jq < 2; ++jq) acc[i][jq] = mfma32(va, pb[jq], acc[i][jq]);
            }
        }
        float ss[2] = {0.f, 0.f};
#pragma unroll
        for (int jq = 0; jq < 2; ++jq)
#pragma unroll
            for (int i = 0; i < 2; ++i)
#pragma unroll
                for (int e = 0; e < 16; ++e) ss[jq] += acc[i][jq][e] * acc[i][jq][e];
#pragma unroll
        for (int jq = 0; jq < 2; ++jq) { ss[jq] += __shfl_xor(ss[jq], 32); if (lh == 0) sred[wave * 64 + 32 * jq + l31] = ss[jq]; }
        __syncthreads();
#pragma unroll
        for (int jq = 0; jq < 2; ++jq) {
            const int q = 32 * jq + l31;
            const float tot = sred[q] + sred[64 + q] + sred[128 + q] + sred[192 + q];
            const float inv = rsqrtf(tot * (1.f / 256.f) + EPS);
            const size_t trow = (size_t)(t0 + q);
#pragma unroll
            for (int i = 0; i < 2; ++i)
#pragma unroll
                for (int rg = 0; rg < 4; ++rg) {
                    const int vc = h * 256 + 64 * wave + 32 * i + 8 * rg + 4 * lh;
                    float rf[4]; unpack4(*(const uint2*)(QK + trow * 3072 + 2048 + vc), rf);
                    float o[4];
#pragma unroll
                    for (int e = 0; e < 4; ++e) o[e] = acc[i][jq][4 * rg + e] * inv * silu_f(rf[e]);
                    *(uint2*)(OG + trow * D + vc) = make_uint2(pack2(o[0], o[1]), pack2(o[2], o[3]));
                }
        }
    }
}

DEVI void rope_table(const Params& p) {
    int z_; asm volatile("s_mov_b32 %0, 0" : "=s"(z_)); unsigned char* ws_ = p.ws + z_;
    float* CS = (float*)(ws_ + B_ROPE);
    const int gtid = bidx() * 256 + tidx(), gsz = VGRID * 256;
    for (int it = gtid; it < (SEQ + 4) * 8; it += gsz) {
        const int pos = it >> 3, i = it & 7;
        const float fr = powf(500000.f, -(float)i * 0.125f);
        float sv, cv; sincosf((float)pos * fr, &sv, &cv);
        CS[(size_t)pos * 16 + i] = cv; CS[(size_t)pos * 16 + 8 + i] = sv;
    }
}

DEVI void att_rope_phase(const Params& p) {
    int z_; asm volatile("s_mov_b32 %0, 0" : "=s"(z_)); unsigned char* ws_ = p.ws + z_; float* out_ = p.out + z_; (void)ws_; (void)out_; KIN_DECL;
    bf16_t* QKV = (bf16_t*)(ws_ + B_R4);
    const float* CS = (const float*)(ws_ + B_ROPE);
    const int gtid = bidx() * 256 + tidx(), gsz = VGRID * 256;
    for (int it = gtid; it < T * 96; it += gsz) {
        const int t = it / 96, rem = it - t * 96, hd = rem >> 3, l8 = rem & 7, g = hd >> 2, hg = hd & 3;
        const bool samp = t >= TP;
        const int pos = samp ? SEQ + ((t - TP) & 3) : (t & (SEQ - 1));
        bf16_t* qp = QKV + (size_t)t * QKVD + hd * 64 + 8 * l8; bf16_t* kp = qp + 768; const bf16_t* vp = qp + 1536;
        float cs[8], sn[8], qf[8], kf[8], vf[8];
        unpack8(*(const uint4*)kp, kf); unpack8(*(const uint4*)vp, vf);
        if (l8 < 2) {
            unpack8(*(const uint4*)qp, qf);
            const float4* cp = (const float4*)(CS + (size_t)pos * 16);
            const float4 c0 = cp[0], c1 = cp[1], s0 = cp[2], s1 = cp[3];
            cs[0] = c0.x; cs[1] = c0.y; cs[2] = c0.z; cs[3] = c0.w; cs[4] = c1.x; cs[5] = c1.y; cs[6] = c1.z; cs[7] = c1.w;
            sn[0] = s0.x; sn[1] = s0.y; sn[2] = s0.z; sn[3] = s0.w; sn[4] = s1.x; sn[5] = s1.y; sn[6] = s1.z; sn[7] = s1.w;
        } else {
#pragma unroll
            for (int e = 0; e < 8; ++e) { qf[e] = 0.f; cs[e] = 1.f; sn[e] = 0.f; }
        }
#pragma unroll
        for (int e = 0; e < 8; ++e) {
            const float qo = __shfl_xor(qf[e], 1), ko = __shfl_xor(kf[e], 1);
            if (l8 == 0) { qf[e] = qf[e] * cs[e] - qo * sn[e]; kf[e] = kf[e] * cs[e] - ko * sn[e]; }
            else if (l8 == 1) { qf[e] = qf[e] * cs[e] + qo * sn[e]; kf[e] = kf[e] * cs[e] + ko * sn[e]; }
        }
        if (l8 < 2) {
            *(uint4*)qp = make_uint4(pack2(qf[0], qf[1]), pack2(qf[2], qf[3]), pack2(qf[4], qf[5]), pack2(qf[6], qf[7]));
            const uint4 kw = make_uint4(pack2(kf[0], kf[1]), pack2(kf[2], kf[3]), pack2(kf[4], kf[5]), pack2(kf[6], kf[7]));
            *(uint4*)kp = kw; unpack8(kw, kf);
        }
        const int W = 128 << (2 * g);
        float* dst = nullptr;
        if (!samp) { const int b = t >> 13, tp = t & (SEQ - 1); if (tp >= SEQ - W) dst = out_ + (g == 0 ? O_KV0P : (g == 1 ? O_KV1P : O_KV2P)) + (((size_t)b * W + (tp - (SEQ - W))) * 2) * 256 + hg * 64 + 8 * l8; }
        else { const int sb = (t - TP) >> 2, sq = (t - TP) & 3; dst = out_ + (g == 0 ? O_KV0S : (g == 1 ? O_KV1S : O_KV2S)) + (((size_t)sb * W + (W - 4 + sq)) * 2) * 256 + hg * 64 + 8 * l8; }
        if (dst) {
            ((float4*)dst)[0] = make_float4(kf[0], kf[1], kf[2], kf[3]); ((float4*)dst)[1] = make_float4(kf[4], kf[5], kf[6], kf[7]);
            ((float4*)(dst + 256))[0] = make_float4(vf[0], vf[1], vf[2], vf[3]); ((float4*)(dst + 256))[1] = make_float4(vf[4], vf[5], vf[6], vf[7]);
        }
    }
}

DEVI void att_phase(const Params& p) {
    int z_; asm volatile("s_mov_b32 %0, 0" : "=s"(z_)); unsigned char* ws_ = p.ws + z_; float* out_ = p.out + z_; (void)ws_; (void)out_; KIN_DECL;
    const bf16_t* QKV = (const bf16_t*)(ws_ + B_R4);
    bf16_t* AO = (bf16_t*)(ws_ + B_R3);
    float* LSE = (float*)(ws_ + B_DT);
    const int lane = tidx() & 63, wib = tidx() >> 6;
    const int wv = (bidx() * 256 + tidx()) >> 6, nw = (VGRID * 256) >> 6;
    float* sq = (float*)VSMEM + wib * 256;
    float* sp = sq + 64;
    for (int it = wv; it < TS * 12; it += nw) {
        const int t = TP + it / 12, hd = it % 12, g = hd >> 2, hg = hd & 3;
        const int sb = (t - TP) >> 2, s = (t - TP) & 3;
        const int d = (g == 0) ? 1 : (g == 1 ? 4 : 16), W = 128 * d;
        const float* cache = (g == 0) ? in_[5] : (g == 1 ? in_[6] : in_[7]);
        sq[lane] = bf2f(QKV[(size_t)t * QKVD + hd * 64 + lane]) * 0.125f;
        float sc[3];
#pragma unroll
        for (int r = 0; r < 3; ++r) {
            const int jj = r * 64 + lane;
            float v = -INFINITY;
            if (jj <= 128) {
                const int idx = W + s - jj * d;
                float a = 0.f;
                if (idx >= W) {
                    const bf16_t* kp = QKV + (size_t)(TP + sb * 4 + (idx - W)) * QKVD + 768 + hd * 64;
#pragma unroll
                    for (int i = 0; i < 8; ++i) { float f[8]; unpack8(*(const uint4*)(kp + 8 * i), f);
#pragma unroll
                        for (int e = 0; e < 8; ++e) a += f[e] * sq[8 * i + e]; }
                } else {
                    const float4* kp = (const float4*)(cache + (((size_t)sb * W + idx) * 2) * 256 + hg * 64);
#pragma unroll
                    for (int i = 0; i < 16; ++i) { const float4 f = kp[i]; a += f.x * sq[4 * i] + f.y * sq[4 * i + 1] + f.z * sq[4 * i + 2] + f.w * sq[4 * i + 3]; }
                }
                v = a;
            }
            sc[r] = v;
        }
        const float mx = wave_max(fmaxf(sc[0], fmaxf(sc[1], sc[2])));
        float ps = 0.f;
#pragma unroll
        for (int r = 0; r < 3; ++r) { const float e = (sc[r] == -INFINITY) ? 0.f : __expf(sc[r] - mx); sp[r * 64 + lane] = e; ps += e; }
        const float den = wave_sum(ps);
        const int jn = s / d;
        float a = 0.f;
        for (int jj = 0; jj <= jn; ++jj) a += sp[jj] * bf2f(QKV[(size_t)(TP + sb * 4 + (s - jj * d)) * QKVD + 1536 + hd * 64 + lane]);
        const float* vb = cache + (((size_t)sb * W) * 2 + 1) * 256 + hg * 64 + lane;
#pragma unroll 8
        for (int jj = jn + 1; jj <= 128; ++jj) a += sp[jj] * vb[(size_t)(W + s - jj * d) * 512];
        AO[(size_t)t * ATTD + hd * 64 + lane] = f2bf(a / den);
        if (lane == 0) LSE[(size_t)t * 12 + hd] = mx + __logf(den);
    }
}

constexpr int VST = 264;
DEVI void att_prompt_phase(const Params& p) {
    int z_; asm volatile("s_mov_b32 %0, 0" : "=s"(z_)); unsigned char* ws_ = p.ws + z_; float* out_ = p.out + z_; (void)ws_; (void)out_; KIN_DECL;
    const bf16_t* QKV = (const bf16_t*)(ws_ + B_R4);
    bf16_t* AO = (bf16_t*)(ws_ + B_R3);
    float* LSE = (float*)(ws_ + B_DT);
    const int tid = tidx(), lane = tid & 63, wave = tid >> 6, l31 = lane & 31, lh = lane >> 5;
    bf16_t* sK = (bf16_t*)VSMEM;
    bf16_t* sVt = sK + 256 * GST;
    for (int item = bidx(); item < 2 * 12 * 64; item += VGRID) {
        const int b = item / 768, hd = (item / 64) % 12, blk = item & 63, g = hd >> 2;
        const int d = (g == 0) ? 1 : (g == 1 ? 4 : 16), nbr = (SEQ / d) / 128, r = blk / nbr, u0 = (blk % nbr) * 128;
        const size_t tb = (size_t)b * SEQ + r;
        __syncthreads();
        for (int idx = tid; idx < 256 * 8; idx += 256) {
            const int kj = idx >> 3, c8 = (idx & 7) * 8, u = u0 - 128 + kj;
            u32x4 kv = {0u, 0u, 0u, 0u}, vv = {0u, 0u, 0u, 0u};
            if (u >= 0) { const bf16_t* src = QKV + (tb + (size_t)u * d) * QKVD + 768 + hd * 64 + c8; kv = *(const u32x4*)src; vv = *(const u32x4*)(src + 768); }
            *(u32x4*)(sK + kj * GST + c8) = kv;
#pragma unroll
            for (int e = 0; e < 4; ++e) { sVt[(c8 + 2 * e) * VST + kj] = (bf16_t)(vv[e] & 0xffffu); sVt[(c8 + 2 * e + 1) * VST + kj] = (bf16_t)(vv[e] >> 16); }
        }
        const int qi = 32 * wave + l31;
        const size_t tq = tb + (size_t)(u0 + qi) * d;
        bf16x8 qf[4];
#pragma unroll
        for (int ks = 0; ks < 4; ++ks) qf[ks] = *(const bf16x8*)(QKV + tq * QKVD + hd * 64 + ks * 16 + 8 * lh);
        __syncthreads();
        f32x16 S[5];
#pragma unroll
        for (int tt = 0; tt < 5; ++tt) {
#pragma unroll
            for (int e = 0; e < 16; ++e) S[tt][e] = 0.f;
#pragma unroll
            for (int ks = 0; ks < 4; ++ks) S[tt] = mfma32(ldsfrag(sK, 32 * (wave + tt) + l31, GST, ks * 16 + 8 * lh), qf[ks], S[tt]);
        }
        float mx = -INFINITY;
#pragma unroll
        for (int tt = 0; tt < 5; ++tt)
#pragma unroll
            for (int e = 0; e < 16; ++e) {
                const int kj = 32 * (wave + tt) + (e & 3) + 8 * (e >> 2) + 4 * lh;
                const bool valid = (kj >= qi) && (kj <= qi + 128) && (u0 - 128 + kj >= 0);
                const float sv = valid ? S[tt][e] * 0.125f : -INFINITY;
                S[tt][e] = sv; mx = fmaxf(mx, sv);
            }
        mx = fmaxf(mx, __shfl_xor(mx, 32));
        float den = 0.f;
#pragma unroll
        for (int tt = 0; tt < 5; ++tt)
#pragma unroll
            for (int e = 0; e < 16; ++e) { const float pe = __expf(S[tt][e] - mx); S[tt][e] = pe; den += pe; }
        den += __shfl_xor(den, 32);
        f32x16 O[2];
#pragma unroll
        for (int i = 0; i < 2; ++i)
#pragma unroll
            for (int e = 0; e < 16; ++e) O[i][e] = 0.f;
#pragma unroll
        for (int tt = 0; tt < 5; ++tt)
#pragma unroll
            for (int s2 = 0; s2 < 2; ++s2) {
                union { bf16x8 v; unsigned u[4]; } pb;
#pragma unroll
                for (int e = 0; e < 4; ++e) pb.u[e] = pack2(S[tt][8 * s2 + 2 * e], S[tt][8 * s2 + 2 * e + 1]);
#pragma unroll
                for (int i = 0; i < 2; ++i) {
                    const bf16_t* vp = sVt + (32 * i + l31) * VST + 32 * (wave + tt) + 16 * s2 + 4 * lh;
                    union { bf16x8 v; uint2 h[2]; } va;
                    va.h[0] = *(const uint2*)vp; va.h[1] = *(const uint2*)(vp + 8);
                    O[i] = mfma32(va.v, pb.v, O[i]);
                }
            }
        const float rden = 1.f / den;
#pragma unroll
        for (int i = 0; i < 2; ++i)
#pragma unroll
            for (int rg = 0; rg < 4; ++rg)
                *(uint2*)(AO + tq * ATTD + hd * 64 + 32 * i + 8 * rg + 4 * lh) = make_uint2(pack2(O[i][4 * rg] * rden, O[i][4 * rg + 1] * rden), pack2(O[i][4 * rg + 2] * rden, O[i][4 * rg + 3] * rden));
        if (lh == 0) LSE[tq * 12 + hd] = mx + __logf(den);
    }
}

DEVI void att_mix_phase(const Params& p) {
    int z_; asm volatile("s_mov_b32 %0, 0" : "=s"(z_)); unsigned char* ws_ = p.ws + z_; float* out_ = p.out + z_; (void)ws_; (void)out_; KIN_DECL;
    bf16_t* AO = (bf16_t*)(ws_ + B_R3);
    const float* LSE = (const float*)(ws_ + B_DT);
    const int gtid = bidx() * 256 + tidx(), gsz = VGRID * 256;
    for (int it = gtid; it < T * 32; it += gsz) {
        const int t = it >> 5, hg = (it >> 3) & 3, c8 = (it & 7) * 8;
        const float l0 = LSE[(size_t)t * 12 + hg], l1 = LSE[(size_t)t * 12 + 4 + hg], l2 = LSE[(size_t)t * 12 + 8 + hg];
        const float ml = fmaxf(l0, fmaxf(l1, l2));
        float al[3] = {__expf(l0 - ml), __expf(l1 - ml), __expf(l2 - ml)};
        const float rs = 1.f / (al[0] + al[1] + al[2]);
#pragma unroll
        for (int g = 0; g < 3; ++g) {
            u32x4* ptr = (u32x4*)(AO + (size_t)t * ATTD + (g * 4 + hg) * 64 + c8);
            const u32x4 v = *ptr; const float a = al[g] * rs;
            u32x4 o;
#pragma unroll
            for (int e = 0; e < 4; ++e) o[e] = pack2(__uint_as_float(v[e] << 16) * a, __uint_as_float(v[e] & 0xffff0000u) * a);
            *ptr = o;
        }
    }
}

enum { OP_INIT = 0, OP_NORM, OP_FINAL, OP_SSM_IN, OP_SSM_CONV, OP_SSM_STATE, OP_SSM_SCAN, OP_SSM_OUT, OP_SSM_OG, OP_GLA_IN, OP_GLA_GATE, OP_GLA_STATE, OP_GLA_SCAN,
       OP_GLA_OUT, OP_GLA_OG, OP_ATT_IN_, OP_ATT_ROPE, OP_ATT_ATT, OP_ATT_MIX, OP_ATT_OG, OP_FFN_GU, OP_FFN_DN };
constexpr int OP_ATT_IN = OP_ATT_IN_;
DEVI int phase_op(int ph, int& a) {
    int l, q, op; a = 0;
    if (ph == 0) return OP_INIT;
    if (ph <= 10) { l = 0; q = ph - 1; } else if (ph <= 20) { l = 1; q = ph - 11; } else if (ph <= 29) { l = 2; q = ph - 21; } else { l = 3; q = ph - 30; }
    const int nmix = (l == 2) ? 5 : 6;
    if (q < nmix) { op = (l == 1 ? OP_GLA_IN : (l == 2 ? OP_ATT_IN_ : OP_SSM_IN)) + q; a = l / 3; }
    else { const int k = q - nmix; op = (k == 0) ? OP_NORM : (k == 1 ? OP_FFN_GU : (k == 2 ? OP_FFN_DN : (l == 3 ? OP_FINAL : OP_NORM))); a = l; }
    return op;
}
DEVI int phase_op_only(int ph) { int a; return phase_op(ph, a); }
DEVI void run_phase(const Params& p, int ph) {
    const bf16_t* Hb = (const bf16_t*)(p.ws + B_HB);
    int a = 0; int op = phase_op(ph, a);
#ifdef ONLY_OP
    if (op != ONLY_OP) return;
    op = ONLY_OP;
#endif
    switch (op) {
        case OP_INIT: if (rbid() & 1) { copy_caches(p); convert_weights(p); } else { convert_weights(p); copy_caches(p); } rope_table(p); norm_phase(p, 0); break;
        case OP_NORM: norm_phase(p, 1); break;
        case OP_FINAL: norm_phase(p, 2); break;
        case OP_SSM_IN: gemm8<EPI_SSM_IN>(p, Hb, (const bf16_t*)(p.ws + W_SSM_IN) + (size_t)a * SSM_INP * D, MPAD, SSM_INP, D); break;
        case OP_SSM_CONV: ssm_conv_phase(p, a); break;
        case OP_SSM_STATE: ssm_state_phase(p, a); break;
        case OP_SSM_SCAN: ssm_scan_phase(p, a); break;
        case OP_SSM_OUT: ssm_out_phase(p, a); break;
        case OP_SSM_OG: gemm8<EPI_RESADD>(p, (const bf16_t*)(p.ws + B_R4), (const bf16_t*)(p.ws + W_SSM_OUT) + (size_t)a * D * DI, TP, D, DI, a == 0 ? p.in[0] : nullptr); gemm_phase<EPI_RESADD, DI>(p, (const bf16_t*)(p.ws + B_R4), (const bf16_t*)(p.ws + W_SSM_OUT) + (size_t)a * D * DI, 4, true); break;
        case OP_GLA_IN: gemm8<EPI_GLA_IN>(p, Hb, (const bf16_t*)(p.ws + W_GLA_IN), MPAD, GLA_INP, D); break;
        case OP_GLA_GATE: gla_gate_phase(p); break;
        case OP_GLA_STATE: gla_state_phase(p); break;
        case OP_GLA_SCAN: gla_scan_phase(p); break;
        case OP_GLA_OUT: gla_out_phase(p); break;
        case OP_GLA_OG: gemm8<EPI_RESADD>(p, (const bf16_t*)(p.ws + B_R3), (const bf16_t*)(p.ws + W_GLA_OUT), TP, D, D); gemm_phase<EPI_RESADD, D>(p, (const bf16_t*)(p.ws + B_R3), (const bf16_t*)(p.ws + W_GLA_OUT), 4, true); break;
        case OP_ATT_IN: gemm8<EPI_ATT_IN>(p, Hb, (const bf16_t*)(p.ws + W_ATT_QKV), MPAD, QKVD, D); break;
        case OP_ATT_ROPE: att_rope_phase(p); break;
        case OP_ATT_ATT: att_prompt_phase(p); __syncthreads(); att_phase(p); break;
        case OP_ATT_MIX: att_mix_phase(p); break;
        case OP_ATT_OG: gemm8<EPI_RESADD>(p, (const bf16_t*)(p.ws + B_R3), (const bf16_t*)(p.ws + W_ATT_OUT), TP, D, ATTD); gemm_phase<EPI_RESADD, ATTD>(p, (const bf16_t*)(p.ws + B_R3), (const bf16_t*)(p.ws + W_ATT_OUT), 4, true); break;
        case OP_FFN_GU: gemm8<EPI_SWIGLU>(p, Hb, (const bf16_t*)(p.ws + W_FFN_GU) + (size_t)a * 2 * DFF * D, MPAD, 2 * DFF, D); break;
        case OP_FFN_DN: gemm8<EPI_RESADD>(p, (const bf16_t*)(p.ws + B_R4), (const bf16_t*)(p.ws + W_FFN_DN) + (size_t)a * D * DFF, TP, D, DFF); gemm_phase<EPI_RESADD, DFF>(p, (const bf16_t*)(p.ws + B_R4), (const bf16_t*)(p.ws + W_FFN_DN) + (size_t)a * D * DFF, 4, true); break;
        default: break;
    }
}

#ifndef REPEAT_OP
#define REPEAT_OP -1
#endif
#ifndef REPEAT_N
#define REPEAT_N 1
#endif
__global__ void __launch_bounds__(512, 2) mega(Params p, int ph_lo, int ph_hi, int coop) {
    uint4* xb_words = (uint4*)(smem + 2 * LDS_BYTES);
    if (threadIdx.x == 0) *xb_words = make_uint4(0u, 0u, 0u, 0u);
    __syncthreads();
    XcdBarrier xb = xcd_barrier_post((unsigned*)(p.ws + B_BAR), (volatile LAS unsigned*)xb_words);
    if (coop < 0) cg::this_grid().sync();
    int rep = 0;
    for (int ph = ph_lo; ph < ph_hi;) {
        run_phase(p, ph);
        if (REPEAT_OP >= 0 && phase_op_only(ph) == REPEAT_OP && rep < REPEAT_N) { ++rep; __syncthreads(); continue; }
        rep = 0;
        if (ph + 1 < ph_hi) xcd_barrier(xb);
        ++ph;
    }
}

extern "C" void kernel_launch(void* const* d_in, const int* in_sizes, int n_in, void* d_out, int out_size, void* d_ws, size_t ws_size, hipStream_t stream) {
    if (ws_size < B_END) { fprintf(stderr, "workspace too small: %zu < %zu\n", ws_size, (size_t)B_END); return; }
    Params p; memset(&p, 0, sizeof(p));
    for (int i = 0; i < 29; ++i) p.in[i] = (const float*)d_in[i];
    p.out = (float*)d_out; p.ws = (unsigned char*)d_ws;
    p.nphase = 40;
    static int grid_blocks = 0;
    if (!grid_blocks) {
        int dev = 0, cus = 0, per_cu = 0;
        hipGetDevice(&dev);
        hipDeviceGetAttribute(&cus, hipDeviceAttributeMultiprocessorCount, dev);
        hipFuncSetAttribute((const void*)mega, hipFuncAttributeMaxDynamicSharedMemorySize, DYN_LDS);
        hipOccupancyMaxActiveBlocksPerMultiprocessor(&per_cu, mega, 512, DYN_LDS);
        if (per_cu > 1) per_cu = 1;
        if (per_cu < 1) per_cu = 1;
        grid_blocks = cus * per_cu;
    }
#if ONE_LAUNCH
    hipMemsetAsync(p.ws + B_BAR, 0, XCD_BAR_WORDS * 4, stream);
    int lo = 0, hi = p.nphase, coop = 1;
    void* args[] = {&p, &lo, &hi, &coop};
    hipError_t e = hipLaunchCooperativeKernel((void*)mega, dim3(grid_blocks), dim3(512), args, DYN_LDS, stream);
    if (e != hipSuccess) fprintf(stderr, "cooperative launch failed: %s (grid %d)\n", hipGetErrorString(e), grid_blocks);
#else
    for (int ph = 0; ph < p.nphase; ++ph) mega<<<grid_blocks, 512, DYN_LDS, stream>>>(p, ph, ph + 1, 0);
#endif
}
```

```cpp
#include <hip/hip_runtime.h>
#include <hip/hip_cooperative_groups.h>
#include <cstdio>
#include <cstring>
namespace cg = cooperative_groups;

#ifndef ONE_LAUNCH
#define ONE_LAUNCH 1
#endif

typedef unsigned short bf16_t;
typedef short bf16x8 __attribute__((ext_vector_type(8)));
typedef float f32x16 __attribute__((ext_vector_type(16)));
typedef float f32x4 __attribute__((ext_vector_type(4)));
typedef unsigned u32x4 __attribute__((ext_vector_type(4)));
#define DEVI __device__ __forceinline__

constexpr int D = 1024, TP = 16384, TS = 128, T = TP + TS, SEQ = 8192, DFF = 2816;
constexpr int SSM_IN = 5152, SSM_INP = 5376, DI = 2048, CONVD = 3072;
constexpr int GLA_IN = 3088, GLA_INP = 3328;
constexpr int QKVD = 2304, ATTD = 768;
constexpr float EPS = 1e-6f;
constexpr int MPAD = 16640;

constexpr size_t O_YP = 0, O_YS = O_YP + (size_t)TP * D, O_SSMP = O_YS + (size_t)TS * D, O_SSMS = O_SSMP + 2ull * 2 * 262144,
                 O_CONVP = O_SSMS + 2ull * 32 * 262144, O_CONVS = O_CONVP + 2ull * 2 * 3 * CONVD, O_GLAP = O_CONVS + 2ull * 32 * 3 * CONVD,
                 O_GLAS = O_GLAP + 2ull * 4 * 32768, O_KV0P = O_GLAS + 32ull * 4 * 32768, O_KV0S = O_KV0P + 2ull * 128 * 512,
                 O_KV1P = O_KV0S + 32ull * 128 * 512, O_KV1S = O_KV1P + 2ull * 512 * 512, O_KV2P = O_KV1S + 32ull * 512 * 512,
                 O_KV2S = O_KV2P + 2ull * 2048 * 512, O_END = O_KV2S + 32ull * 2048 * 512;

constexpr size_t al(size_t x) { return (x + 255) & ~(size_t)255; }
constexpr size_t W_SSM_IN = 0, W_SSM_OUT = W_SSM_IN + 2ull * SSM_INP * D * 2, W_GLA_IN = W_SSM_OUT + 2ull * D * DI * 2,
                 W_GLA_OUT = W_GLA_IN + (size_t)GLA_INP * D * 2, W_ATT_QKV = W_GLA_OUT + (size_t)D * D * 2, W_ATT_OUT = W_ATT_QKV + (size_t)QKVD * D * 2,
                 W_FFN_GU = W_ATT_OUT + (size_t)D * ATTD * 2, W_FFN_DN = W_FFN_GU + 4ull * 2 * DFF * D * 2, W_END = W_FFN_DN + 4ull * D * DFF * 2;
constexpr size_t B_HB = al(W_END), B_R3 = B_HB + (size_t)T * D * 2, B_R4 = B_R3 + (size_t)T * DI * 2, B_R5 = B_R4 + (size_t)T * CONVD * 2,
                 B_R6 = B_R5 + (size_t)T * CONVD * 2, B_DT = B_R6 + 67108864ull, B_DTS = B_DT + (size_t)T * 32 * 4, B_ACS = B_DTS + (size_t)T * 32 * 4,
                 B_GLOW = B_ACS + (size_t)T * 32 * 4, B_BAR = al(B_GLOW + (size_t)T * 16 * 4), B_SSQS = B_BAR + 16384, B_ROPE = B_SSQS + 4096, B_END = B_ROPE + 8196ull * 16 * 4;

struct WDesc { const float* src; const float* gain; bf16_t* dst; int K, N, mode, tile0, gmod; };
struct Params {
    const float* in[29];
    float* out;
    unsigned char* ws;
    int nphase, pad0;
};

constexpr int LDS_BYTES = 79872;
extern __shared__ __attribute__((aligned(16))) unsigned char smem[];
constexpr int DYN_LDS = 2 * LDS_BYTES + 16;

DEVI int rtid() { int t = threadIdx.x; asm volatile("" : "+v"(t)); return t; }
DEVI int rbid() { int b = blockIdx.x; asm volatile("" : "+s"(b)); return b; }
DEVI int vhalf() { return __builtin_amdgcn_readfirstlane(rtid() >> 8); }
DEVI int tidx() { return rtid() & 255; }
DEVI int bidx() { return rbid() * 2 + vhalf(); }
#define VGRID ((int)gridDim.x * 2)
#define CAS4 __attribute__((address_space(4)))
#define KIN_DECL const float* const CAS4* in_ = (const float* const CAS4*)((const CAS4 char*)__builtin_amdgcn_kernarg_segment_ptr() + z_); (void)in_
#define VSMEM (smem + vhalf() * LDS_BYTES)
DEVI unsigned short f2bf(float f) { unsigned u = __float_as_uint(f); u += 0x7fffu + ((u >> 16) & 1u); return (unsigned short)(u >> 16); }
DEVI float bf2f(unsigned short h) { return __uint_as_float(((unsigned)h) << 16); }
DEVI unsigned pack2(float a, float b) { return (unsigned)f2bf(a) | ((unsigned)f2bf(b) << 16); }
DEVI float silu_f(float x) { return x / (1.f + __expf(-x)); }
DEVI float softplus_f(float x) { return x > 20.f ? x : log1pf(__expf(x)); }
DEVI float logsigmoid_f(float x) { return fminf(x, 0.f) - log1pf(__expf(-fabsf(x))); }
DEVI float wave_sum(float v) { for (int o = 32; o > 0; o >>= 1) v += __shfl_xor(v, o); return v; }
DEVI float wave_max(float v) { for (int o = 32; o > 0; o >>= 1) v = fmaxf(v, __shfl_xor(v, o)); return v; }
DEVI bf16x8 ldsfrag(const bf16_t* base, int row, int stride, int k) { return *(const bf16x8*)(base + row * stride + k); }
DEVI f32x16 mfma32(bf16x8 a, bf16x8 b, f32x16 c) { return __builtin_amdgcn_mfma_f32_32x32x16_bf16(a, b, c, 0, 0, 0); }
DEVI void unpack8(uint4 v, float* f) {
    f[0] = __uint_as_float(v.x << 16); f[1] = __uint_as_float(v.x & 0xffff0000u); f[2] = __uint_as_float(v.y << 16); f[3] = __uint_as_float(v.y & 0xffff0000u);
    f[4] = __uint_as_float(v.z << 16); f[5] = __uint_as_float(v.z & 0xffff0000u); f[6] = __uint_as_float(v.w << 16); f[7] = __uint_as_float(v.w & 0xffff0000u);
}
DEVI void unpack4(uint2 v, float* f) {
    f[0] = __uint_as_float(v.x << 16); f[1] = __uint_as_float(v.x & 0xffff0000u); f[2] = __uint_as_float(v.y << 16); f[3] = __uint_as_float(v.y & 0xffff0000u);
}


#define XB_TMO      128
#define XB_XCNT(j)  (256  + 64 * (j))
#define XB_XSUB(j)  (1280 + 64 * (j))
#define XB_XGEN(j)  (2304 + 64 * (j))
#define XB_TOP      3328
#define XB_TOPGEN   3392
#define XCD_BAR_WORDS 3456
#define XB_SPIN_CAP (1u << 22)
#define LAS __attribute__((address_space(3)))
DEVI unsigned xb_ld(unsigned* p)              { return __hip_atomic_load(p, __ATOMIC_RELAXED, __HIP_MEMORY_SCOPE_AGENT); }
DEVI unsigned xb_add(unsigned* p, unsigned v) { return __hip_atomic_fetch_add(p, v, __ATOMIC_RELAXED, __HIP_MEMORY_SCOPE_AGENT); }
DEVI unsigned xb_xcc_id() { return (unsigned)__builtin_amdgcn_s_getreg((3 << 11) | 20) & 0xFu; }
#define XB_SPIN(cond, bar) do { unsigned _sp = 0; while (cond) { __builtin_amdgcn_s_sleep(1); \
    if ((++_sp & 255u) == 0u) { if (xb_ld(&(bar)[XB_TMO])) break; if (_sp > XB_SPIN_CAP) { atomicAdd(&(bar)[XB_TMO], 1u); break; } } } } while (0)
struct XcdBarrier { unsigned* bar; unsigned x; volatile LAS unsigned* st; };
DEVI XcdBarrier xcd_barrier_post(unsigned* bar, volatile LAS unsigned* st) {
    XcdBarrier b; b.bar = bar; b.x = xb_xcc_id(); b.st = st;
    if (threadIdx.x == 0) (void)xb_add(&bar[XB_XCNT(b.x)], 1u);
    return b;
}
DEVI void xcd_barrier_complete(unsigned* bar, unsigned x, unsigned& nloc, unsigned& nx) {
    const unsigned G = gridDim.x * gridDim.y * gridDim.z;
    unsigned sum, cnt, mine, sp = 0u;
    for (;;) {
        sum = 0u; cnt = 0u; mine = 0u;
#pragma unroll
        for (unsigned j = 0; j < 16; ++j) { const unsigned c = xb_ld(&bar[XB_XCNT(j)]); sum += c; cnt += (c > 0u) ? 1u : 0u; mine = (j == x) ? c : mine; }
        if (sum == G) break;
        __builtin_amdgcn_s_sleep(1);
        if ((++sp & 255u) == 0u) { if (xb_ld(&bar[XB_TMO])) break; if (sp > XB_SPIN_CAP) { atomicAdd(&bar[XB_TMO], 1u); break; } }
    }
    nloc = mine > 0u ? mine : 1u; nx = cnt > 0u ? cnt : 1u;
}
DEVI void xcd_barrier(const XcdBarrier& b) {
    asm volatile("s_waitcnt vmcnt(0)" ::: "memory");
    __syncthreads();
    if (threadIdx.x == 0) {
        unsigned* bar = b.bar;
        __builtin_amdgcn_s_waitcnt(0);
        unsigned nloc = b.st[0], nx = b.st[1];
        if (nloc == 0u) { xcd_barrier_complete(bar, b.x, nloc, nx); b.st[0] = nloc; b.st[1] = nx; }
        const unsigned old = xb_add(&bar[XB_XSUB(b.x)], 1u);
        const unsigned gen = old / nloc;
        if (old + 1u == (gen + 1u) * nloc) {
            __builtin_amdgcn_fence(__ATOMIC_RELEASE, "agent");
            asm volatile("s_waitcnt vmcnt(0)" ::: "memory");
            const unsigned og = xb_add(&bar[XB_TOP], 1u);
            const unsigned tg = og / nx;
            if (og + 1u == (tg + 1u) * nx) xb_add(&bar[XB_TOPGEN], 1u);
            else XB_SPIN(xb_ld(&bar[XB_TOPGEN]) == tg, bar);
            __builtin_amdgcn_fence(__ATOMIC_ACQUIRE, "agent");
            xb_add(&bar[XB_XGEN(b.x)], 1u);
            asm volatile("s_waitcnt vmcnt(0)" ::: "memory");
        } else {
            XB_SPIN(xb_ld(&bar[XB_XGEN(b.x)]) == gen, bar);
            __builtin_amdgcn_fence(__ATOMIC_ACQUIRE, "agent");
            asm volatile("s_waitcnt vmcnt(0)" ::: "memory");
        }
    }
    __syncthreads();
}

DEVI void convert_weights(const Params& p) {
    int z_; asm volatile("s_mov_b32 %0, 0" : "=s"(z_)); unsigned char* ws_ = p.ws + z_; float* out_ = p.out + z_; (void)ws_; (void)out_; KIN_DECL;
    float* tile = (float*)VSMEM;
    const int tid = tidx();
    constexpr int T_SI = (SSM_INP / 64) * (D / 64), T_SO = (D / 64) * (DI / 64), T_GI = (GLA_INP / 64) * (D / 64), T_GO = (D / 64) * (D / 64),
                  T_AQ = (QKVD / 64) * (D / 64), T_AO = (D / 64) * (ATTD / 64), T_FF = (DFF / 64) * (D / 64);
    constexpr int P0 = 2 * (T_SI + T_SO), P1 = P0 + T_GI, P2 = P1 + T_GO, P3 = P2 + T_AQ, P4 = P3 + T_AO, WT = P4 + 12 * T_FF;
    auto decode = [&](int it, WDesc& d) {
        d.gain = nullptr; d.mode = 0; d.gmod = 1 << 30;
        if (it < P0) {
            const int j = it / (T_SI + T_SO), r = it - j * (T_SI + T_SO);
            if (r < T_SI) { d.src = in_[13] + (size_t)j * D * SSM_IN; d.gain = in_[8] + j * 3 * D; d.dst = (bf16_t*)(ws_ + W_SSM_IN) + (size_t)j * SSM_INP * D; d.K = D; d.N = SSM_IN; d.tile0 = j * (T_SI + T_SO); }
            else { d.src = in_[20] + (size_t)j * DI * D; d.gain = in_[19] + j * DI; d.dst = (bf16_t*)(ws_ + W_SSM_OUT) + (size_t)j * D * DI; d.K = DI; d.N = D; d.tile0 = j * (T_SI + T_SO) + T_SI; }
        } else if (it < P1) { d.src = in_[21]; d.gain = in_[8] + D; d.dst = (bf16_t*)(ws_ + W_GLA_IN); d.K = D; d.N = GLA_IN; d.tile0 = P0; }
        else if (it < P2) { d.src = in_[25]; d.gain = in_[24]; d.gmod = 256; d.dst = (bf16_t*)(ws_ + W_GLA_OUT); d.K = D; d.N = D; d.tile0 = P1; }
        else if (it < P3) { d.src = in_[26]; d.gain = in_[8] + 2 * D; d.dst = (bf16_t*)(ws_ + W_ATT_QKV); d.K = D; d.N = QKVD; d.tile0 = P2; }
        else if (it < P4) { d.src = in_[27]; d.dst = (bf16_t*)(ws_ + W_ATT_OUT); d.K = ATTD; d.N = D; d.tile0 = P3; }
        else {
            const int q = (it - P4) / T_FF, l = q / 3, w = q - l * 3;
            d.tile0 = P4 + q * T_FF;
            if (w < 2) { d.src = (w == 0 ? in_[10] : in_[11]) + (size_t)l * D * DFF; d.gain = in_[9] + l * D; d.dst = (bf16_t*)(ws_ + W_FFN_GU) + (size_t)l * 2 * DFF * D; d.K = D; d.N = DFF; d.mode = 1 + w; }
            else { d.src = in_[12] + (size_t)l * DFF * D; d.dst = (bf16_t*)(ws_ + W_FFN_DN) + (size_t)l * D * DFF; d.K = DFF; d.N = D; }
        }
    };
    auto load_tile = [&](int it, const WDesc& d, float (&v)[16]) {
        const int lt = it - d.tile0, nkt = d.K / 64, ntile = lt / nkt, ktile = lt - ntile * nkt, n = ntile * 64 + (tid & 63), k0 = ktile * 64;
#pragma unroll
        for (int r = 0; r < 16; ++r) {
            const int kk = (tid >> 6) + 4 * r;
            float x = 0.f;
            if (n < d.N) { x = __builtin_nontemporal_load(d.src + (size_t)(k0 + kk) * d.N + n); if (d.gain) x *= d.gain[(k0 + kk) & (d.gmod - 1)]; }
            v[r] = x;
        }
    };
    int it = bidx(); bool have = it < WT;
    WDesc d; float v[16];
    if (have) { decode(it, d); load_tile(it, d, v); }
    while (have) {
        const int itn = it + VGRID; const bool hn = itn < WT;
        WDesc dn = d; float vn[16];
        if (hn) { decode(itn, dn); load_tile(itn, dn, vn); }
        __syncthreads();
#pragma unroll
        for (int r = 0; r < 16; ++r) tile[((tid >> 6) + 4 * r) * 65 + (tid & 63)] = v[r];
        __syncthreads();
        {
            const int lt = it - d.tile0, nkt = d.K / 64, ntile = lt / nkt, ktile = lt - ntile * nkt, n0 = ntile * 64, k0 = ktile * 64;
            const int r = tid >> 2, seg = tid & 3, n = n0 + r;
            int drow = n;
            if (d.mode) { const int t = n >> 7, c = n & 127; drow = t * 256 + (d.mode == 2 ? 128 : 0) + c; }
            unsigned w[8];
#pragma unroll
            for (int e = 0; e < 8; ++e) w[e] = pack2(tile[(seg * 16 + 2 * e) * 65 + r], tile[(seg * 16 + 2 * e + 1) * 65 + r]);
            uint4* dp = (uint4*)(d.dst + (size_t)drow * d.K + k0 + seg * 16);
            dp[0] = make_uint4(w[0], w[1], w[2], w[3]); dp[1] = make_uint4(w[4], w[5], w[6], w[7]);
        }
        it = itn; have = hn; d = dn;
#pragma unroll
        for (int r = 0; r < 16; ++r) v[r] = vn[r];
    }
}

DEVI void copy_caches(const Params& p) {
    int z_; asm volatile("s_mov_b32 %0, 0" : "=s"(z_)); unsigned char* ws_ = p.ws + z_; float* out_ = p.out + z_; (void)ws_; (void)out_; KIN_DECL;
    const unsigned gtid = (unsigned)(bidx() * 256 + tidx()), gsz = (unsigned)(VGRID * 256);
#pragma unroll
    for (int g = 0; g < 3; ++g) {
        const unsigned W = g == 0 ? 128u : (g == 1 ? 512u : 2048u);
        const unsigned per = (W - 4u) * 128u, tot = 32u * per;
        const f32x4* src = (const f32x4*)(g == 0 ? in_[5] : (g == 1 ? in_[6] : in_[7]));
        f32x4* dst = (f32x4*)(out_ + (g == 0 ? O_KV0S : (g == 1 ? O_KV1S : O_KV2S)));
        for (unsigned base = gtid; base < tot; base += 8u * gsz) {
            f32x4 v[8]; unsigned di[8];
#pragma unroll
            for (int u = 0; u < 8; ++u) {
                const unsigned i = base + (unsigned)u * gsz, ic = i < tot ? i : tot - 1u, sb = ic / per, rem = ic - sb * per;
                di[u] = sb * W * 128u + rem;
                v[u] = __builtin_nontemporal_load(src + (sb * W + 4u) * 128u + rem);
            }
#pragma unroll
            for (int u = 0; u < 8; ++u) if (base + (unsigned)u * gsz < tot) __builtin_nontemporal_store(v[u], dst + di[u]);
        }
    }
}

DEVI void norm_phase(const Params& p, int mode) {
    int z_; asm volatile("s_mov_b32 %0, 0" : "=s"(z_)); unsigned char* ws_ = p.ws + z_; float* out_ = p.out + z_; (void)ws_; (void)out_; KIN_DECL;
    const int lane = tidx() & 63, wv = (bidx() * 256 + tidx()) >> 6, nw = (VGRID * 256) >> 6;
    float* X = out_;
    bf16_t* Hb = (bf16_t*)(ws_ + B_HB);
    for (int r0 = wv; r0 < T; r0 += 2 * nw) {
        const int r1 = r0 + nw; const bool h1 = r1 < T; const int rr[2] = {r0, h1 ? r1 : r0};
        float4 v[2][4]; float ss[2] = {0.f, 0.f};
#pragma unroll
        for (int k = 0; k < 2; ++k) {
            const int r = rr[k];
            const float* src = mode == 0 ? (r < TP ? in_[0] + (size_t)r * D : in_[1] + (size_t)(r - TP) * D) : X + (size_t)r * D;
#pragma unroll
            for (int i = 0; i < 4; ++i) v[k][i] = ((const float4*)src)[i * 64 + lane];
        }
#pragma unroll
        for (int k = 0; k < 2; ++k) {
#pragma unroll
            for (int i = 0; i < 4; ++i) ss[k] += v[k][i].x * v[k][i].x + v[k][i].y * v[k][i].y + v[k][i].z * v[k][i].z + v[k][i].w * v[k][i].w;
            ss[k] = wave_sum(ss[k]);
        }
#pragma unroll
        for (int k = 0; k < 2; ++k) {
            if (k == 1 && !h1) break;
            const int r = rr[k];
            const float inv = rsqrtf(ss[k] * (1.f / D) + EPS);
            if (mode == 2) {
                const float4* g = (const float4*)in_[28];
#pragma unroll
                for (int i = 0; i < 4; ++i) { float4 gg = g[i * 64 + lane]; ((float4*)(X + (size_t)r * D))[i * 64 + lane] = make_float4(v[k][i].x * inv * gg.x, v[k][i].y * inv * gg.y, v[k][i].z * inv * gg.z, v[k][i].w * inv * gg.w); }
            } else {
#pragma unroll
                for (int i = 0; i < 4; ++i) {
                    if (mode == 0 && r >= TP) ((float4*)(X + (size_t)r * D))[i * 64 + lane] = v[k][i];
                    ((uint2*)(Hb + (size_t)r * D))[i * 64 + lane] = make_uint2(pack2(v[k][i].x * inv, v[k][i].y * inv), pack2(v[k][i].z * inv, v[k][i].w * inv));
                }
            }
        }
    }
}

enum { EPI_SSM_IN = 0, EPI_GLA_IN = 1, EPI_ATT_IN = 2, EPI_RESADD = 3, EPI_SWIGLU = 4 };
constexpr int GST = 72;
constexpr int GBUF = 2 * 128 * GST;

template <int EPI, int K>
DEVI void gemm_phase(const Params& p, const bf16_t* __restrict__ A, const bf16_t* __restrict__ Bt, int nN, bool only_split = false) {
    int z_; asm volatile("s_mov_b32 %0, 0" : "=s"(z_)); unsigned char* ws_ = p.ws + z_; float* out_ = p.out + z_; (void)ws_; (void)out_; KIN_DECL;
    const int tid = rtid(), lane = tid & 63, wave = tid >> 6, wm = wave >> 2, wn = wave & 3, l31 = lane & 31, lh = lane >> 5;
    constexpr int SBUF = 2 * 256 * GST;
    bf16_t* const s0 = (bf16_t*)smem;
    constexpr int nkfull = K / 64, KCH = 2;
    const int nMt = (EPI == EPI_RESADD) ? 64 : 65;
    const int nfull = nMt * nN, nch = (EPI == EPI_RESADD) ? (nkfull + KCH - 1) / KCH : 0, nunits = nfull + nch * nN;
    const int bid = rbid(), xcd = bid & 7, lb = bid >> 3, nper = (int)gridDim.x >> 3;
    const int u0 = only_split ? nfull : 0;
    for (int rnd = 0; u0 + rnd * (int)gridDim.x < nunits; ++rnd) {
        const int u = u0 + (rnd * 8 + xcd) * nper + lb;
        if (u >= nunits) continue;
        int mt, nt, kt0, kt1; bool atomic = false;
        if (u < nfull) {
            const int per_group = 8 * nN, gm = u / per_group, rem = u - gm * per_group, fm = gm * 8, gsz = (nMt - fm) < 8 ? (nMt - fm) : 8;
            mt = fm + rem % gsz; nt = rem / gsz; kt0 = 0; kt1 = nkfull;
        } else {
            const int v = u - nfull, ch = v / nN; mt = 64; nt = v - ch * nN; kt0 = ch * KCH; kt1 = (kt0 + KCH < nkfull) ? kt0 + KCH : nkfull; atomic = true;
        }
        const int nk = kt1 - kt0;
        const char* Ab = (const char*)A + (size_t)kt0 * 128; const char* Bb = (const char*)(Bt + (size_t)nt * 256 * K) + (size_t)kt0 * 128;
        unsigned aoff[4];
#pragma unroll
        for (int i = 0; i < 4; ++i) { int gr = mt * 256 + (tid >> 3) + 64 * i; gr = gr < T ? gr : T - 1; aoff[i] = (unsigned)gr * (unsigned)(K * 2) + (unsigned)((tid & 7) * 16); }
        const unsigned boff = (unsigned)(tid >> 3) * (unsigned)(K * 2) + (unsigned)((tid & 7) * 16);
        const unsigned lso = (unsigned)((tid >> 3) * GST + (tid & 7) * 8);
        f32x16 acc[4][2];
#pragma unroll
        for (int i = 0; i < 4; ++i)
#pragma unroll
            for (int j = 0; j < 2; ++j)
#pragma unroll
                for (int e = 0; e < 16; ++e) acc[i][j][e] = 0.f;
        u32x4 ra[4], rb[4];
#define G_LOAD(KT) { const int kk_ = (KT) < nk ? (KT) : nk - 1; const char* ab_ = Ab + (size_t)kk_ * 128; const char* bb_ = Bb + (size_t)kk_ * 128; \
            _Pragma("unroll") for (int i = 0; i < 4; ++i) ra[i] = *(const u32x4*)(ab_ + aoff[i]); \
            _Pragma("unroll") for (int i = 0; i < 4; ++i) rb[i] = *(const u32x4*)(bb_ + (size_t)i * 128 * K + boff); }
#define G_STORE(BUF) { bf16_t* sa_ = s0 + (BUF) * SBUF; bf16_t* sb_ = sa_ + 256 * GST; \
            _Pragma("unroll") for (int i = 0; i < 4; ++i) *(u32x4*)(sa_ + lso + i * 64 * GST) = ra[i]; \
            _Pragma("unroll") for (int i = 0; i < 4; ++i) *(u32x4*)(sb_ + lso + i * 64 * GST) = rb[i]; }
        __syncthreads();
        G_LOAD(0); G_STORE(0); G_LOAD(1);
        __syncthreads();
        for (int kt = 0; kt < nk; ++kt) {
            if (kt + 1 < nk) G_STORE((kt + 1) & 1);
            G_LOAD(kt + 2);
            const bf16_t* cA = s0 + (kt & 1) * SBUF; const bf16_t* cB = cA + 256 * GST;
#pragma unroll
            for (int ks = 0; ks < 4; ++ks) {
                bf16x8 a[4], b[2];
#pragma unroll
                for (int i = 0; i < 4; ++i) a[i] = ldsfrag(cA, 128 * wm + 32 * i + l31, GST, ks * 16 + 8 * lh);
#pragma unroll
                for (int j = 0; j < 2; ++j) b[j] = ldsfrag(cB, 64 * wn + 32 * j + l31, GST, ks * 16 + 8 * lh);
#pragma unroll
                for (int i = 0; i < 4; ++i)
#pragma unroll
                    for (int j = 0; j < 2; ++j) acc[i][j] = mfma32(a[i], b[j], acc[i][j]);
            }
            __syncthreads();
        }
        static_assert(EPI == EPI_RESADD, "own GEMM is only used for the residual-add phases");
        if (mt * 256 + 128 * wm < T) {
#pragma unroll
            for (int i = 0; i < 4; ++i)
#pragma unroll
                for (int j = 0; j < 2; ++j)
#pragma unroll
                    for (int e = 0; e < 16; ++e) {
                        const int row = mt * 256 + 128 * wm + 32 * i + (e & 3) + 8 * (e >> 2) + 4 * lh, col = nt * 256 + 64 * wn + 32 * j + l31;
                        if (row < T) {
                            float* xf = out_ + (size_t)row * D + col;
                            if (atomic) unsafeAtomicAdd(xf, acc[i][j][e]); else *xf += acc[i][j][e];
                        }
                    }
        }
    }
    __syncthreads();
}


namespace pg8 {
#define PG8_LAS __attribute__((address_space(3)))
constexpr int BM = 256, BK = 64, HALF = 128, HTB = HALF * BK * 2  , STAGE_BYTES = 8 * HTB, NXCD = 8, WGM = 8;

__host__ __device__ __forceinline__ int lds_byte(int r, int c) { const int st = (r >> 4) * 2 + (c >> 5), rr = r & 15, cc = c & 31, ob = rr * 64 + cc * 2; return st * 1024 + (ob ^ (((ob >> 9) & 1) << 5)); }
__host__ __device__ __forceinline__ void stage_rc(int b, int& R, int& C) { const int st = b / 1024, sb = b % 1024, swz = sb ^ (((sb >> 9) & 1) << 5); R = (st >> 1) * 16 + swz / 64; C = (st & 1) * 32 + (swz % 64) / 2; }
__host__ __device__ __forceinline__ int perm32(int rho) { const int n = rho >> 4, i = rho & 15; return 8 * (i >> 2) + 4 * n + (i & 3); }

struct Unit { int pm, pn; };
struct Gemm { const bf16_t* A; const bf16_t* Bt; int M, N, K; };
struct StaticOrder {
    int nM, nN, nwg, G, c;
    __host__ __device__ void init(int M, int N, int G_, int c_) { nM = M / BM; nN = N / BM; nwg = nM * nN; G = G_; c = c_; }
    __host__ __device__ bool next(int i, Unit& u) const {
        const long L = (long)i * G + c; if (L >= nwg) return false;
        int wgid = (int)L; { const int q = nwg / NXCD, r = nwg % NXCD, xcd = wgid % NXCD, off = wgid / NXCD; wgid = (xcd < r ? xcd * (q + 1) : r * (q + 1) + (xcd - r) * q) + off; }
        const int nig = WGM * nN, gid = wgid / nig, fm = gid * WGM, gsz = (nM - fm) < WGM ? (nM - fm) : WGM;
        u.pm = fm + ((wgid % nig) % gsz); u.pn = (wgid % nig) / gsz; return true;
    }
    __device__ __forceinline__ void a_ready(const Unit&) const {}
    __device__ __forceinline__ void done(const Unit&) const {}
};
template <class Epi, class Sched, bool STAMP = false>
__device__ __forceinline__ void gemm_phase(PG8_LAS unsigned char* lds, const Gemm g, const Sched& S, const Epi& E, unsigned long long* stamps) {
    const int tid = rtid(), wid = __builtin_amdgcn_readfirstlane(tid >> 6), lane = tid & 63, wr = wid >> 2, wc = wid & 3, fr = lane & 15, fq = lane >> 4;
    const int K = g.K, nt = K / BK;
    int ts_lo = 0, ts_hi = 0, nts = 0; const unsigned long long rt_entry = STAMP ? (unsigned long long)0ull : 0ull;
#define PG8_STAMP() do { if (STAMP && wid == 0 && nts < 64) { const unsigned long long _c = (unsigned long long)clock64(); \
        ts_lo = (lane == nts) ? (int)(unsigned)_c : ts_lo; ts_hi = (lane == nts) ? (int)(unsigned)(_c >> 32) : ts_hi; ++nts; } } while (0)
    PG8_STAMP();
    unsigned voffA[2], voffB[2];
#pragma unroll
    for (int i = 0; i < 2; ++i) { int R, C; stage_rc(tid * 16 + i * 8192, R, C); const int Rb = Epi::PERM ? ((R & ~31) + perm32(R & 31)) : R;
        voffA[i] = (unsigned)(R * K + C) * 2u; voffB[i] = (unsigned)(Rb * K + C) * 2u; }
    const size_t kstep = (size_t)(BK * 2);
    const size_t hstep = (size_t)HALF * K * 2;
    const size_t tstep = 2 * hstep;
    const unsigned ldsw = (unsigned)wid * 1024u;
    const int aoff = lds_byte(wr * 64 + fr, fq * 8), boff = lds_byte(wc * 32 + fr, fq * 8);
#define PG8_SA(b, h) (((b) * 2 + (h)) * HTB)
#define PG8_SB(b, h) ((4 + (b) * 2 + (h)) * HTB)
#define PG8_STAGE(bufoff, gbase, voff) do { _Pragma("unroll") for (int _i = 0; _i < 2; ++_i) \
        __builtin_amdgcn_global_load_lds((const unsigned*)((const char*)(gbase) + (voff)[_i]), (PG8_LAS unsigned*)(lds + (bufoff) + ldsw + _i * 8192), 16, 0, 0); } while (0)
#define PG8_LDA(dst, b, h) do { _Pragma("unroll") for (int m = 0; m < 4; ++m) _Pragma("unroll") for (int k = 0; k < 2; ++k) dst[m][k] = *(const PG8_LAS bf16x8*)(lds + PG8_SA(b, h) + aoff + m * 2048 + k * 1024); } while (0)
#define PG8_LDB(dst, b, h) do { _Pragma("unroll") for (int n = 0; n < 2; ++n) _Pragma("unroll") for (int k = 0; k < 2; ++k) dst[n][k] = *(const PG8_LAS bf16x8*)(lds + PG8_SB(b, h) + boff + n * 2048 + k * 1024); } while (0)
#define PG8_MMA(ai, bj, At, Bt) do { __builtin_amdgcn_s_setprio(1); _Pragma("unroll") for (int m = 0; m < 4; ++m) _Pragma("unroll") for (int n = 0; n < 2; ++n) _Pragma("unroll") for (int k = 0; k < 2; ++k) \
        acc[ai][bj][m][n] = __builtin_amdgcn_mfma_f32_16x16x32_bf16(Bt[n][k], At[m][k], acc[ai][bj][m][n], 0, 0, 0); __builtin_amdgcn_s_setprio(0); } while (0)
#define PG8_WAIT_V(n) asm volatile("s_waitcnt vmcnt(" #n ")" ::: "memory")
#define PG8_WAIT_L(n) asm volatile("s_waitcnt lgkmcnt(" #n ")" ::: "memory")
#define PG8_BAR __builtin_amdgcn_s_barrier()
#define PG8_SCHED __builtin_amdgcn_sched_barrier(0)
    Unit cur, nxt; int ui = 0;
    if (!S.next(0, cur)) return;
    f32x4 acc[2][2][4][2];
#pragma unroll
    for (int a = 0; a < 2; ++a)
#pragma unroll
        for (int b = 0; b < 2; ++b)
#pragma unroll
            for (int m = 0; m < 4; ++m)
#pragma unroll
                for (int n = 0; n < 2; ++n) acc[a][b][m][n] = (f32x4){0.f, 0.f, 0.f, 0.f};
    bf16x8 At[4][2], B0[2][2], B1[2][2];
    const char* cA = (const char*)g.A + (size_t)cur.pm * tstep; const char* cB = (const char*)g.Bt + (size_t)cur.pn * tstep;
    S.a_ready(cur);
    PG8_STAGE(PG8_SB(0, 0), cB, voffB); PG8_STAGE(PG8_SA(0, 0), cA, voffA); PG8_STAGE(PG8_SB(0, 1), cB + hstep, voffB); PG8_STAGE(PG8_SA(0, 1), cA + hstep, voffA);
    if (wr == 1) PG8_BAR;
    PG8_WAIT_V(4); PG8_BAR;
    PG8_STAGE(PG8_SB(1, 0), cB + kstep, voffB); PG8_STAGE(PG8_SA(1, 0), cA + kstep, voffA); PG8_STAGE(PG8_SB(1, 1), cB + hstep + kstep, voffB);
    PG8_WAIT_V(6); PG8_BAR;
    PG8_STAMP();
    for (;;) {
        const bool has_next = S.next(ui + 1, nxt);
        const char* nA = has_next ? (const char*)g.A + (size_t)nxt.pm * tstep : cA; const char* nB = has_next ? (const char*)g.Bt + (size_t)nxt.pn * tstep : cB;
        for (int t = 0; t < nt; t += 2) {
            const bool last = (t == nt - 2);
            const char* a1 = cA + (size_t)(t + 1) * kstep;
            const char* a2 = last ? nA : cA + (size_t)(t + 2) * kstep; const char* b2 = last ? nB : cB + (size_t)(t + 2) * kstep;
            const char* a3 = a2 + kstep; const char* b3 = b2 + kstep;
            if (last && has_next) S.a_ready(nxt);
            PG8_LDB(B0, 0, 0); PG8_SCHED; PG8_LDA(At, 0, 0); PG8_STAGE(PG8_SA(1, 1), a1 + hstep, voffA);
            PG8_WAIT_L(8); PG8_BAR; PG8_WAIT_L(0); PG8_MMA(0, 0, At, B0); PG8_BAR; PG8_SCHED;
            PG8_LDB(B1, 0, 1); PG8_STAGE(PG8_SB(0, 0), b2, voffB);
            PG8_BAR; PG8_WAIT_L(0); PG8_MMA(0, 1, At, B1); PG8_BAR;
            PG8_LDA(At, 0, 1); PG8_STAGE(PG8_SA(0, 0), a2, voffA);
            PG8_BAR; PG8_WAIT_L(0); PG8_MMA(1, 0, At, B0); PG8_BAR; PG8_SCHED;
            PG8_STAGE(PG8_SB(0, 1), b2 + hstep, voffB);
            PG8_WAIT_V(6); PG8_BAR; PG8_MMA(1, 1, At, B1); PG8_BAR;
            PG8_LDB(B0, 1, 0); PG8_SCHED; PG8_LDA(At, 1, 0); PG8_STAGE(PG8_SA(0, 1), a2 + hstep, voffA);
            PG8_WAIT_L(8); PG8_BAR; PG8_WAIT_L(0); PG8_MMA(0, 0, At, B0); PG8_BAR; PG8_SCHED;
            PG8_LDB(B1, 1, 1); PG8_STAGE(PG8_SB(1, 0), b3, voffB);
            PG8_BAR; PG8_WAIT_L(0); PG8_MMA(0, 1, At, B1); PG8_BAR;
            PG8_LDA(At, 1, 1); PG8_STAGE(PG8_SA(1, 0), a3, voffA);
            PG8_BAR; PG8_WAIT_L(0); PG8_MMA(1, 0, At, B0); PG8_BAR; PG8_SCHED;
            PG8_STAGE(PG8_SB(1, 1), b3 + hstep, voffB);
            PG8_WAIT_V(6); PG8_BAR; PG8_MMA(1, 1, At, B1); PG8_BAR;
        }
        PG8_STAMP();
        if constexpr (!Epi::AFTER_DRAIN) { E(acc, cur, wr, wc, fr, fq); S.done(cur); }
        PG8_STAMP();
        if (!has_next) break;
#pragma unroll
        for (int a = 0; a < 2; ++a)
#pragma unroll
            for (int b = 0; b < 2; ++b)
#pragma unroll
                for (int m = 0; m < 4; ++m)
#pragma unroll
                    for (int n = 0; n < 2; ++n) acc[a][b][m][n] = (f32x4){0.f, 0.f, 0.f, 0.f};
        cur = nxt; cA = nA; cB = nB; ++ui;
    }
    PG8_WAIT_V(0);
    if (wr == 0) PG8_BAR;
    PG8_BAR;
    if constexpr (Epi::AFTER_DRAIN) { E.fused(acc, cur, wr, wc, fr, fq, lds, wid, lane); S.done(cur); }
    PG8_STAMP();
    if (STAMP && wid == 0) { stamps[lane] = lane < nts ? (((unsigned long long)(unsigned)ts_hi << 32) | (unsigned)ts_lo) : 0ull;
        if (lane == 62) stamps[62] = rt_entry; if (lane == 63) stamps[63] = (unsigned long long)0ull; }
#undef PG8_STAMP
#undef PG8_SA
#undef PG8_SB
#undef PG8_STAGE
#undef PG8_LDA
#undef PG8_LDB
#undef PG8_MMA
#undef PG8_WAIT_V
#undef PG8_WAIT_L
#undef PG8_BAR
#undef PG8_SCHED
}
}

template <int EPI> struct EpiMk {
    static constexpr bool PERM = (EPI == EPI_SSM_IN || EPI == EPI_GLA_IN || EPI == EPI_ATT_IN || EPI == EPI_SWIGLU), AFTER_DRAIN = false;
    unsigned char* ws; float* out; const float* xin;
    DEVI void operator()(const f32x4 (&acc)[2][2][4][2], const pg8::Unit& u, int wr, int wc, int fr, int fq) const {
        const int row0 = u.pm * 256 + wr * 64 + fr, col0 = u.pn * 256 + wc * 32 + 4 * fq;
#pragma unroll
        for (int ai = 0; ai < 2; ++ai)
#pragma unroll
            for (int m = 0; m < 4; ++m) {
                const int row = row0 + ai * 128 + m * 16;
                if (row < T) {
                    if (EPI == EPI_SWIGLU) {
                        const int hc = u.pn * 128 + wc * 32 + 8 * fq;
                        unsigned w[4];
#pragma unroll
                        for (int n = 0; n < 2; ++n) {
                            const f32x4 g = acc[ai][0][m][n], up = acc[ai][1][m][n];
                            float o[4];
#pragma unroll
                            for (int e = 0; e < 4; ++e) o[e] = g[e] * __builtin_amdgcn_rcpf(1.f + __expf(-g[e])) * up[e];
                            w[2 * n] = pack2(o[0], o[1]); w[2 * n + 1] = pack2(o[2], o[3]);
                        }
                        *(uint4*)((bf16_t*)(ws + B_R4) + (size_t)row * DFF + hc) = make_uint4(w[0], w[1], w[2], w[3]);
                    } else
#pragma unroll
                    for (int bj = 0; bj < 2; ++bj) {
                        if (PERM) {
                            const int col = u.pn * 256 + bj * 128 + wc * 32 + 8 * fq;
                            const f32x4 v0 = acc[ai][bj][m][0], v1 = acc[ai][bj][m][1];
                            const uint4 pk = make_uint4(pack2(v0[0], v0[1]), pack2(v0[2], v0[3]), pack2(v1[0], v1[1]), pack2(v1[2], v1[3]));
                            if (EPI == EPI_SSM_IN) {
                                if (col < DI) *(uint4*)((bf16_t*)(ws + B_R3) + (size_t)row * DI + col) = pk;
                                else if (col < DI + CONVD) *(uint4*)((bf16_t*)(ws + B_R4) + (size_t)row * CONVD + (col - DI)) = pk;
                                else if (col < SSM_IN) { float4* dp = (float4*)((float*)(ws + B_DT) + (size_t)row * 32 + (col - DI - CONVD)); dp[0] = make_float4(v0[0], v0[1], v0[2], v0[3]); dp[1] = make_float4(v1[0], v1[1], v1[2], v1[3]); }
                            } else if (EPI == EPI_GLA_IN) {
                                if (col < 3072) *(uint4*)((bf16_t*)(ws + B_R4) + (size_t)row * 3072 + col) = pk;
                                else if (col < GLA_IN) { float4* dp = (float4*)((float*)(ws + B_GLOW) + (size_t)row * 16 + (col - 3072)); dp[0] = make_float4(v0[0], v0[1], v0[2], v0[3]); dp[1] = make_float4(v1[0], v1[1], v1[2], v1[3]); }
                            } else {
                                *(uint4*)((bf16_t*)(ws + B_R4) + (size_t)row * QKVD + col) = pk;
                            }
                        } else if (EPI == EPI_SWIGLU) {
                            const f32x4 g = acc[ai][bj][m][0], up = acc[ai][bj][m][1];
                            const int hc = u.pn * 128 + bj * 64 + wc * 16 + 4 * fq;
                            float o[4];
#pragma unroll
                            for (int e = 0; e < 4; ++e) o[e] = g[e] * __builtin_amdgcn_rcpf(1.f + __expf(-g[e])) * up[e];
                            *(uint2*)((bf16_t*)(ws + B_R4) + (size_t)row * DFF + hc) = make_uint2(pack2(o[0], o[1]), pack2(o[2], o[3]));
                        } else {
#pragma unroll
                            for (int n = 0; n < 2; ++n) {
                                const int col = col0 + bj * 128 + n * 16;
                                const f32x4 v = acc[ai][bj][m][n];
                                if (EPI == EPI_RESADD) {
                                    float4* xp = (float4*)(out + (size_t)row * D + col);
                                    float4 x = xin ? *(const float4*)(xin + (size_t)row * D + col) : *xp; x.x += v[0]; x.y += v[1]; x.z += v[2]; x.w += v[3]; *xp = x;
                                } else if (EPI == EPI_SSM_IN) {
                                    const uint2 pk = make_uint2(pack2(v[0], v[1]), pack2(v[2], v[3]));
                                    if (col < DI) *(uint2*)((bf16_t*)(ws + B_R3) + (size_t)row * DI + col) = pk;
                                    else if (col < DI + CONVD) *(uint2*)((bf16_t*)(ws + B_R4) + (size_t)row * CONVD + (col - DI)) = pk;
                                    else if (col < SSM_IN) *(float4*)((float*)(ws + B_DT) + (size_t)row * 32 + (col - DI - CONVD)) = make_float4(v[0], v[1], v[2], v[3]);
                                } else if (EPI == EPI_GLA_IN) {
                                    if (col < 3072) *(uint2*)((bf16_t*)(ws + B_R4) + (size_t)row * 3072 + col) = make_uint2(pack2(v[0], v[1]), pack2(v[2], v[3]));
                                    else if (col < GLA_IN) *(float4*)((float*)(ws + B_GLOW) + (size_t)row * 16 + (col - 3072)) = make_float4(v[0], v[1], v[2], v[3]);
                                } else {
                                    *(uint2*)((bf16_t*)(ws + B_R4) + (size_t)row * QKVD + col) = make_uint2(pack2(v[0], v[1]), pack2(v[2], v[3]));
                                }
                            }
                        }
                    }
                }
            }
    }
};

template <int EPI>
DEVI void gemm8(const Params& p, const bf16_t* A, const bf16_t* Bt, int Mrows, int N, int K, const float* xin = nullptr) {
    int z_; asm volatile("s_mov_b32 %0, 0" : "=s"(z_));
    EpiMk<EPI> E; E.ws = p.ws + z_; E.out = p.out + z_; E.xin = xin;
    pg8::Gemm g; g.A = A + z_; g.Bt = Bt + z_; g.M = Mrows; g.N = N; g.K = K;
    pg8::StaticOrder S; S.init(Mrows, N, (int)gridDim.x, rbid());
    __syncthreads();
    pg8::gemm_phase<EpiMk<EPI>, pg8::StaticOrder, false>((PG8_LAS unsigned char*)smem, g, S, E, nullptr);
    __syncthreads();
}

DEVI void ssm_conv_phase(const Params& p, int j) {
    int z_; asm volatile("s_mov_b32 %0, 0" : "=s"(z_)); unsigned char* ws_ = p.ws + z_; float* out_ = p.out + z_; (void)ws_; (void)out_; KIN_DECL;
    const bf16_t* raw = (const bf16_t*)(ws_ + B_R4);
    bf16_t* act = (bf16_t*)(ws_ + B_R5);
    const float* cw = in_[14] + (size_t)j * 4 * CONVD; const float* cb = in_[15] + (size_t)j * CONVD;
    const float* sbuf = in_[3] + (size_t)j * 32 * 3 * CONVD;
    float* convp = out_ + O_CONVP + (size_t)j * 2 * 3 * CONVD; float* convs = out_ + O_CONVS + (size_t)j * 32 * 3 * CONVD;
    const size_t gtid = (size_t)bidx() * 256 + tidx(), gsz = (size_t)VGRID * 256;
    {
        const size_t totp = (size_t)(TP / 16) * (CONVD / 8);
        for (size_t it = gtid; it < totp; it += gsz) {
            const int run = (int)(it / (CONVD / 8)), c8 = (int)(it % (CONVD / 8)) * 8;
            const int t0 = run * 16, pos0 = t0 & (SEQ - 1);
            float w[4][8], bb[8], x1[8], x2[8], x3[8];
#pragma unroll
            for (int d = 0; d < 4; ++d)
#pragma unroll
                for (int e = 0; e < 8; ++e) w[d][e] = cw[(size_t)d * CONVD + c8 + e];
#pragma unroll
            for (int e = 0; e < 8; ++e) bb[e] = cb[c8 + e];
            if (pos0 >= 3) {
                unpack8(*(const uint4*)(raw + (size_t)(t0 - 1) * CONVD + c8), x1); unpack8(*(const uint4*)(raw + (size_t)(t0 - 2) * CONVD + c8), x2); unpack8(*(const uint4*)(raw + (size_t)(t0 - 3) * CONVD + c8), x3);
            } else {
#pragma unroll
                for (int e = 0; e < 8; ++e) { x1[e] = 0.f; x2[e] = 0.f; x3[e] = 0.f; }
            }
#pragma unroll 4
            for (int r = 0; r < 16; ++r) {
                const int t = t0 + r;
                float x0[8]; unpack8(*(const uint4*)(raw + (size_t)t * CONVD + c8), x0);
                unsigned o[4];
#pragma unroll
                for (int e = 0; e < 4; ++e) {
                    const float a0 = bb[2 * e] + w[3][2 * e] * x0[2 * e] + w[2][2 * e] * x1[2 * e] + w[1][2 * e] * x2[2 * e] + w[0][2 * e] * x3[2 * e];
                    const float a1 = bb[2 * e + 1] + w[3][2 * e + 1] * x0[2 * e + 1] + w[2][2 * e + 1] * x1[2 * e + 1] + w[1][2 * e + 1] * x2[2 * e + 1] + w[0][2 * e + 1] * x3[2 * e + 1];
                    o[e] = pack2(silu_f(a0), silu_f(a1));
                }
                *(uint4*)(act + (size_t)t * CONVD + c8) = make_uint4(o[0], o[1], o[2], o[3]);
                const int pos = pos0 + r;
                if (pos >= SEQ - 3) {
                    float* op = convp + ((size_t)(t >> 13) * 3 + (pos - (SEQ - 3))) * CONVD + c8;
#pragma unroll
                    for (int e = 0; e < 8; ++e) op[e] = x0[e];
                }
#pragma unroll
                for (int e = 0; e < 8; ++e) { x3[e] = x2[e]; x2[e] = x1[e]; x1[e] = x0[e]; }
            }
        }
    }
    const size_t tot = (size_t)TS * (CONVD / 8);
    for (size_t it = gtid; it < tot; it += gsz) {
        const int t = TP + (int)(it / (CONVD / 8)), c8 = (int)(it % (CONVD / 8)) * 8;
        int pos, sb = 0; bool samp = t >= TP;
        if (samp) { sb = (t - TP) >> 2; pos = (t - TP) & 3; } else pos = t & (SEQ - 1);
        float accv[8], xr[4][8];
#pragma unroll
        for (int e = 0; e < 8; ++e) accv[e] = cb[c8 + e];
#pragma unroll
        for (int d = 0; d < 4; ++d) {
            if (pos - d >= 0) unpack8(*(const uint4*)(raw + (size_t)(t - d) * CONVD + c8), xr[d]);
            else if (samp) {
                const float* bp = sbuf + ((size_t)sb * 3 + (3 + pos - d)) * CONVD + c8;
#pragma unroll
                for (int e = 0; e < 8; ++e) xr[d][e] = bp[e];
            } else {
#pragma unroll
                for (int e = 0; e < 8; ++e) xr[d][e] = 0.f;
            }
            const float* wp = cw + (size_t)(3 - d) * CONVD + c8;
#pragma unroll
            for (int e = 0; e < 8; ++e) accv[e] += xr[d][e] * wp[e];
        }
        unsigned w[4];
#pragma unroll
        for (int e = 0; e < 4; ++e) w[e] = pack2(silu_f(accv[2 * e]), silu_f(accv[2 * e + 1]));
        *(uint4*)(act + (size_t)t * CONVD + c8) = make_uint4(w[0], w[1], w[2], w[3]);
        if (!samp && pos >= SEQ - 3) {
            float* o = convp + ((size_t)(t >> 13) * 3 + (pos - (SEQ - 3))) * CONVD + c8;
#pragma unroll
            for (int e = 0; e < 8; ++e) o[e] = xr[0][e];
        }
        if (samp && pos >= 1) {
            float* o = convs + ((size_t)sb * 3 + (pos - 1)) * CONVD + c8;
#pragma unroll
            for (int e = 0; e < 8; ++e) o[e] = xr[0][e];
        }
    }
    const float* DT = (const float*)(ws_ + B_DT); float* DTS = (float*)(ws_ + B_DTS); float* ACS = (float*)(ws_ + B_ACS);
    if (gtid < TS * 4) ((float*)(ws_ + B_SSQS))[gtid] = 0.f;
    const float* dtb = in_[16] + j * 32; const float* alog = in_[17] + j * 32;
    {
        const int lane = tidx() & 63, wv = (bidx() * 256 + tidx()) >> 6, nw = VGRID * 4;
        for (int it = wv; it < 128 * 32; it += nw) {
            const int c = it >> 5, h = it & 31;
            const float Ah = -__expf(alog[h]), bh = dtb[h];
            float carry = 0.f;
#pragma unroll
            for (int ps = 0; ps < 2; ++ps) {
                const size_t o = (size_t)(c * 128 + ps * 64 + lane) * 32 + h;
                const float d = softplus_f(DT[o] + bh); DTS[o] = d;
                float a = Ah * d;
#pragma unroll
                for (int off = 1; off < 64; off <<= 1) { const float t = __shfl_up(a, off); if (lane >= off) a += t; }
                a += carry; ACS[o] = a; carry = __shfl(a, 63);
            }
        }
    }
    for (size_t it = gtid; it < TS * 32; it += gsz) {
        const int r = (int)it, h = r & 31; const size_t o = (size_t)(TP + (r >> 5)) * 32 + h;
        const float d = softplus_f(DT[o] + dtb[h]); DTS[o] = d; ACS[o] = -__expf(alog[h]) * d;
    }
}

constexpr int SST = 136;
DEVI void ssm_state_phase(const Params& p, int j) {
    int z_; asm volatile("s_mov_b32 %0, 0" : "=s"(z_)); unsigned char* ws_ = p.ws + z_; float* out_ = p.out + z_; (void)ws_; (void)out_; KIN_DECL;
    const bf16_t* act = (const bf16_t*)(ws_ + B_R5);
    const float* DTS = (const float*)(ws_ + B_DTS); const float* ACS = (const float*)(ws_ + B_ACS);
    bf16_t* ST = (bf16_t*)(ws_ + B_R6);
    const int tid = tidx(), lane = tid & 63, wave = tid >> 6, l31 = lane & 31, lh = lane >> 5;
    bf16_t* sBt = (bf16_t*)VSMEM;
    bf16_t* sXt = sBt + 128 * SST;
    float* sw = (float*)(sXt + 64 * SST);
    const int nprompt = 128 * 4, nitems = nprompt + 32 * 32;
    for (int item = bidx(); item < nitems; item += VGRID) {
        if (item < nprompt) {
            const int c = item >> 2, g = item & 3, t0 = c * 128;
            __syncthreads();
            for (int idx = tid; idx < 128 * 16; idx += 256) {
                const int q = idx >> 4, n8 = (idx & 15) * 8;
                const uint4 v = *(const uint4*)(act + (size_t)(t0 + q) * CONVD + DI + g * 128 + n8);
                const unsigned short* s = (const unsigned short*)&v;
#pragma unroll
                for (int e = 0; e < 8; ++e) sBt[(n8 + e) * SST + q] = s[e];
            }
            for (int hh = 0; hh < 8; ++hh) {
                const int h = g * 8 + hh;
                __syncthreads();
                if (tid < 128) sw[tid] = DTS[(size_t)(t0 + tid) * 32 + h] * __expf(ACS[(size_t)(t0 + 127) * 32 + h] - ACS[(size_t)(t0 + tid) * 32 + h]);
                __syncthreads();
                for (int idx = tid; idx < 128 * 8; idx += 256) {
                    const int q = idx >> 3, p8 = (idx & 7) * 8;
                    float f[8]; unpack8(*(const uint4*)(act + (size_t)(t0 + q) * CONVD + h * 64 + p8), f);
                    const float w = sw[q];
#pragma unroll
                    for (int e = 0; e < 8; ++e) sXt[(p8 + e) * SST + q] = f2bf(f[e] * w);
                }
                __syncthreads();
                f32x16 acc[2];
#pragma unroll
                for (int i = 0; i < 2; ++i)
#pragma unroll
                    for (int e = 0; e < 16; ++e) acc[i][e] = 0.f;
#pragma unroll
                for (int ks = 0; ks < 8; ++ks) {
                    const bf16x8 a = ldsfrag(sBt, 32 * wave + l31, SST, ks * 16 + 8 * lh);
#pragma unroll
                    for (int i = 0; i < 2; ++i) acc[i] = mfma32(a, ldsfrag(sXt, 32 * i + l31, SST, ks * 16 + 8 * lh), acc[i]);
                }
#pragma unroll
                for (int i = 0; i < 2; ++i)
#pragma unroll
                    for (int rg = 0; rg < 4; ++rg) {
                        const int n = 32 * wave + 8 * rg + 4 * lh, pp = 32 * i + l31;
                        *(uint2*)(ST + (((size_t)c * 32 + h) * 64 + pp) * 128 + n) = make_uint2(pack2(acc[i][4 * rg], acc[i][4 * rg + 1]), pack2(acc[i][4 * rg + 2], acc[i][4 * rg + 3]));
                    }
            }
        } else {
            const int sit = item - nprompt, sb = sit >> 5, h = sit & 31, g = h >> 3, pp = tid >> 2, nq = tid & 3;
            const float* st_in = in_[2] + (size_t)j * 32 * 262144; float* st_out = out_ + O_SSMS + (size_t)j * 32 * 262144;
            const bf16_t* Z = (const bf16_t*)(ws_ + B_R3); bf16_t* Y = (bf16_t*)(ws_ + B_R4);
            float* SSQS = (float*)(ws_ + B_SSQS);
            const size_t sbase = (((size_t)sb * 32 + h) * 64 + pp) * 128;
            float hs[32];
#pragma unroll
            for (int i = 0; i < 8; ++i) { const f32x4 v = __builtin_nontemporal_load((const f32x4*)(st_in + sbase + 4 * nq + 16 * i)); hs[4 * i] = v[0]; hs[4 * i + 1] = v[1]; hs[4 * i + 2] = v[2]; hs[4 * i + 3] = v[3]; }
            const float Dh = in_[18][j * 32 + h];
#pragma unroll 1
            for (int s = 0; s < 4; ++s) {
                const int tok = TP + sb * 4 + s;
                const float dt = DTS[(size_t)tok * 32 + h], dA = __expf(ACS[(size_t)tok * 32 + h]);
                const float x = bf2f(act[(size_t)tok * CONVD + h * 64 + pp]), xdt = x * dt;
                float yp = 0.f;
#pragma unroll
                for (int i = 0; i < 8; ++i) {
                    float bf[4], cf[4];
                    unpack4(*(const uint2*)(act + (size_t)tok * CONVD + DI + g * 128 + 4 * nq + 16 * i), bf);
                    unpack4(*(const uint2*)(act + (size_t)tok * CONVD + DI + 512 + g * 128 + 4 * nq + 16 * i), cf);
#pragma unroll
                    for (int e = 0; e < 4; ++e) { hs[4 * i + e] = dA * hs[4 * i + e] + xdt * bf[e]; yp += hs[4 * i + e] * cf[e]; }
                }
                yp += __shfl_xor(yp, 1); yp += __shfl_xor(yp, 2);
                const float yv = (yp + Dh * x) * silu_f(bf2f(Z[(size_t)tok * DI + h * 64 + pp]));
                if (nq == 0) Y[(size_t)tok * DI + h * 64 + pp] = f2bf(yv);
                const float tot = wave_sum(nq == 0 ? yv * yv : 0.f);
                if ((tid & 63) == 0) unsafeAtomicAdd(SSQS + (tok - TP) * 4 + g, tot);
            }
#pragma unroll
            for (int i = 0; i < 8; ++i) __builtin_nontemporal_store((f32x4){hs[4 * i], hs[4 * i + 1], hs[4 * i + 2], hs[4 * i + 3]}, (f32x4*)(st_out + sbase + 4 * nq + 16 * i));
        }
    }
}

DEVI void ssm_scan_phase(const Params& p, int j) {
    int z_; asm volatile("s_mov_b32 %0, 0" : "=s"(z_)); unsigned char* ws_ = p.ws + z_; float* out_ = p.out + z_; (void)ws_; (void)out_; KIN_DECL;
    bf16_t* ST = (bf16_t*)(ws_ + B_R6);
    const float* ACS = (const float*)(ws_ + B_ACS);
    float* outp = out_ + O_SSMP + (size_t)j * 2 * 262144;
    const int gtid = bidx() * 256 + tidx(), gsz = VGRID * 256;
    {
        bf16_t* Y = (bf16_t*)(ws_ + B_R4); const float* SSQS = (const float*)(ws_ + B_SSQS);
        for (int it = gtid; it < TS * 256; it += gsz) {
            const int tk = it >> 8, c8 = (it & 255) * 8;
            const float inv = rsqrtf(SSQS[tk * 4 + (c8 >> 9)] * (1.f / 512.f) + EPS);
            uint4* yp = (uint4*)(Y + (size_t)(TP + tk) * DI + c8);
            float f[8]; unpack8(*yp, f);
            *yp = make_uint4(pack2(f[0] * inv, f[1] * inv), pack2(f[2] * inv, f[3] * inv), pack2(f[4] * inv, f[5] * inv), pack2(f[6] * inv, f[7] * inv));
        }
    }
    for (int it = gtid; it < 2 * 32 * 2048; it += gsz) {
        const int b = it >> 16, h = (it >> 11) & 31, e4 = (it & 2047) * 4;
        float s0 = 0.f, s1 = 0.f, s2 = 0.f, s3 = 0.f;
#pragma unroll 16
        for (int cc = 0; cc < 64; ++cc) {
            const int c = b * 64 + cc;
            uint2* ptr = (uint2*)(ST + ((size_t)c * 32 + h) * 8192 + e4);
            float f[4]; unpack4(*ptr, f);
            *ptr = make_uint2(pack2(s0, s1), pack2(s2, s3));
            const float dec = __expf(ACS[(size_t)(c * 128 + 127) * 32 + h]);
            s0 = dec * s0 + f[0]; s1 = dec * s1 + f[1]; s2 = dec * s2 + f[2]; s3 = dec * s3 + f[3];
        }
        *(float4*)(outp + ((size_t)b * 32 + h) * 8192 + e4) = make_float4(s0, s1, s2, s3);
    }
}

DEVI void ssm_out_phase(const Params& p, int j) {
    int z_; asm volatile("s_mov_b32 %0, 0" : "=s"(z_)); unsigned char* ws_ = p.ws + z_; float* out_ = p.out + z_; (void)ws_; (void)out_; KIN_DECL;
    const bf16_t* act = (const bf16_t*)(ws_ + B_R5);
    const float* DTS = (const float*)(ws_ + B_DTS); const float* ACS = (const float*)(ws_ + B_ACS);
    const bf16_t* ST = (const bf16_t*)(ws_ + B_R6); const bf16_t* Z = (const bf16_t*)(ws_ + B_R3);
    bf16_t* Y = (bf16_t*)(ws_ + B_R4);
    const float* dsk = in_[18] + j * 32;
    const int tid = tidx(), lane = tid & 63, wave = tid >> 6, l31 = lane & 31, lh = lane >> 5;
    bf16_t* RA = (bf16_t*)VSMEM;
    bf16_t* RB = RA + 128 * SST;
    float* sacs = (float*)(RB + 128 * SST);
    float* sdts = sacs + 1024;
    for (int item = bidx(); item < 512; item += VGRID) {
        const int c = item >> 2, g = item & 3, t0 = c * 128;
        __syncthreads();
        for (int idx = tid; idx < 128 * 16; idx += 256) {
            const int q = idx >> 4, n8 = (idx & 15) * 8;
            *(uint4*)(RB + q * SST + n8) = *(const uint4*)(act + (size_t)(t0 + q) * CONVD + DI + g * 128 + n8);
            *(uint4*)(RA + q * SST + n8) = *(const uint4*)(act + (size_t)(t0 + q) * CONVD + DI + 512 + g * 128 + n8);
        }
        for (int idx = tid; idx < 1024; idx += 256) {
            const int hh = idx >> 7, q = idx & 127;
            sacs[idx] = ACS[(size_t)(t0 + q) * 32 + g * 8 + hh]; sdts[idx] = DTS[(size_t)(t0 + q) * 32 + g * 8 + hh];
        }
        __syncthreads();
        f32x16 X[4]; bf16x8 cf[8];
#pragma unroll
        for (int st = 0; st < 4; ++st)
#pragma unroll
            for (int e = 0; e < 16; ++e) X[st][e] = 0.f;
#pragma unroll
        for (int ks = 0; ks < 8; ++ks) {
            cf[ks] = ldsfrag(RA, 32 * wave + l31, SST, ks * 16 + 8 * lh);
#pragma unroll
            for (int st = 0; st < 4; ++st) X[st] = mfma32(ldsfrag(RB, 32 * st + l31, SST, ks * 16 + 8 * lh), cf[ks], X[st]);
        }
        const int q = 32 * wave + l31;
        float ssqk[4] = {0.f, 0.f, 0.f, 0.f};
        for (int hh = 0; hh < 8; ++hh) {
            const int h = g * 8 + hh;
            __syncthreads();
            for (int idx = tid; idx < 128 * 8; idx += 256) {
                const int s = idx >> 3, p8 = (idx & 7) * 8;
                float f[8]; unpack8(*(const uint4*)(act + (size_t)(t0 + s) * CONVD + h * 64 + p8), f);
                const float w = sdts[hh * 128 + s];
#pragma unroll
                for (int e = 0; e < 8; ++e) RA[(p8 + e) * SST + s] = f2bf(f[e] * w);
            }
            for (int idx = tid; idx < 64 * 16; idx += 256) {
                const int pp = idx >> 4, n8 = (idx & 15) * 8;
                *(uint4*)(RA + (64 + pp) * SST + n8) = *(const uint4*)(ST + (((size_t)c * 32 + h) * 64 + pp) * 128 + n8);
            }
            const float aq = sacs[hh * 128 + q];
#pragma unroll
            for (int st = 0; st < 4; ++st)
#pragma unroll
                for (int rg = 0; rg < 4; ++rg) {
                    const int s0 = 32 * st + 8 * rg + 4 * lh;
                    float m[4];
#pragma unroll
                    for (int e = 0; e < 4; ++e) { const int s = s0 + e; m[e] = (s <= q) ? X[st][4 * rg + e] * __expf(aq - sacs[hh * 128 + s]) : 0.f; }
                    *(uint2*)(RB + q * SST + s0) = make_uint2(pack2(m[0], m[1]), pack2(m[2], m[3]));
                }
            __syncthreads();
            f32x16 ad[2], ao[2];
#pragma unroll
            for (int i = 0; i < 2; ++i)
#pragma unroll
                for (int e = 0; e < 16; ++e) { ad[i][e] = 0.f; ao[i][e] = 0.f; }
#pragma unroll
            for (int ks = 0; ks < 8; ++ks) {
                const bf16x8 mb = ldsfrag(RB, q, SST, ks * 16 + 8 * lh);
#pragma unroll
                for (int i = 0; i < 2; ++i) {
                    ad[i] = mfma32(ldsfrag(RA, 32 * i + l31, SST, ks * 16 + 8 * lh), mb, ad[i]);
                    ao[i] = mfma32(ldsfrag(RA, 64 + 32 * i + l31, SST, ks * 16 + 8 * lh), cf[ks], ao[i]);
                }
            }
            const float eq = __expf(aq), Dh = dsk[h];
            float* sYw = (float*)(RB + q * SST);
#pragma unroll
            for (int i = 0; i < 2; ++i)
#pragma unroll
                for (int rg = 0; rg < 4; ++rg) {
                    f32x4 v;
#pragma unroll
                    for (int e = 0; e < 4; ++e) v[e] = ad[i][4 * rg + e] + eq * ao[i][4 * rg + e];
                    *(f32x4*)(sYw + 32 * i + 8 * rg + 4 * lh) = v;
                }
#pragma unroll
            for (int k = 0; k < 4; ++k) {
                const int qr = 32 * wave + (lane >> 3) + 8 * k, c8 = (lane & 7) * 8;
                const float* yr = (const float*)(RB + qr * SST) + c8;
                const f32x4 y0 = *(const f32x4*)yr, y1 = *(const f32x4*)(yr + 4);
                const size_t go = (size_t)(t0 + qr);
                float xf[8], zf[8], y[8];
                unpack8(*(const uint4*)(act + go * CONVD + h * 64 + c8), xf);
                unpack8(*(const uint4*)(Z + go * DI + h * 64 + c8), zf);
                float ps = 0.f;
#pragma unroll
                for (int e = 0; e < 8; ++e) { const float yr_ = e < 4 ? y0[e & 3] : y1[e & 3]; y[e] = (yr_ + Dh * xf[e]) * silu_f(zf[e]); ps += y[e] * y[e]; }
                ps += __shfl_xor(ps, 1); ps += __shfl_xor(ps, 2); ps += __shfl_xor(ps, 4);
                ssqk[k] += ps;
                *(uint4*)(Y + go * DI + h * 64 + c8) = make_uint4(pack2(y[0], y[1]), pack2(y[2], y[3]), pack2(y[4], y[5]), pack2(y[6], y[7]));
                if (k & 1) __builtin_amdgcn_sched_barrier(0);
            }
        }
#pragma unroll
        for (int k = 0; k < 4; ++k) {
            const float inv = rsqrtf(ssqk[k] * (1.f / 512.f) + EPS);
            const int qr = 32 * wave + (lane >> 3) + 8 * k, c8 = (lane & 7) * 8;
            const size_t go = (size_t)(t0 + qr);
            for (int hh = 0; hh < 8; ++hh) {
                uint4* yp = (uint4*)(Y + go * DI + (g * 8 + hh) * 64 + c8);
                float f[8]; unpack8(*yp, f);
                *yp = make_uint4(pack2(f[0] * inv, f[1] * inv), pack2(f[2] * inv, f[3] * inv), pack2(f[4] * inv, f[5] * inv), pack2(f[6] * inv, f[7] * inv));
            }
        }
    }
}

constexpr int GCH = 64;
DEVI void gla_gate_phase(const Params& p) {
    int z_; asm volatile("s_mov_b32 %0, 0" : "=s"(z_)); unsigned char* ws_ = p.ws + z_; float* out_ = p.out + z_; (void)ws_; (void)out_; KIN_DECL;
    const float* GLOW = (const float*)(ws_ + B_GLOW); float* BC = (float*)(ws_ + B_HB);
    const float* wg = in_[22]; const float* gb = in_[23];
    const int tid = tidx();
    const int nitems = TP / GCH + 32;
    for (int item = bidx(); item < nitems; item += VGRID) {
        int t0, len;
        if (item < TP / GCH) { t0 = item * GCH; len = GCH; } else { t0 = TP + (item - TP / GCH) * 4; len = 4; }
        float w0[16], w1[16];
#pragma unroll
        for (int r = 0; r < 16; ++r) { w0[r] = wg[r * 512 + tid]; w1[r] = wg[r * 512 + 256 + tid]; }
        const float b0 = gb[tid], b1 = gb[256 + tid];
        float* sg = (float*)VSMEM;
        __syncthreads();
        if (tid * 4 < len * 16) *(float4*)(sg + tid * 4) = *(const float4*)(GLOW + (size_t)t0 * 16 + tid * 4);
        __syncthreads();
        float r0 = 0.f, r1 = 0.f;
        for (int q = 0; q < len; ++q) {
            const float* gl = sg + q * 16;
            float a0 = b0, a1 = b1;
#pragma unroll
            for (int r = 0; r < 16; ++r) { const float gv = gl[r]; a0 += gv * w0[r]; a1 += gv * w1[r]; }
            r0 += logsigmoid_f(a0) * (1.f / 16.f); r1 += logsigmoid_f(a1) * (1.f / 16.f);
            BC[(size_t)(t0 + q) * 512 + tid] = r0; BC[(size_t)(t0 + q) * 512 + 256 + tid] = r1;
        }
    }
}

constexpr int QST = 72;
DEVI void gla_state_phase(const Params& p) {
    int z_; asm volatile("s_mov_b32 %0, 0" : "=s"(z_)); unsigned char* ws_ = p.ws + z_; float* out_ = p.out + z_; (void)ws_; (void)out_; KIN_DECL;
    const bf16_t* QK = (const bf16_t*)(ws_ + B_R4);
    const float* BC = (const float*)(ws_ + B_HB);
    bf16_t* U = (bf16_t*)(ws_ + B_R6);
    const int tid = tidx(), lane = tid & 63, wave = tid >> 6, l31 = lane & 31, lh = lane >> 5;
    bf16_t* sVt = (bf16_t*)VSMEM;
    bf16_t* sKt = sVt + 256 * QST;
    const int nprompt = (TP / GCH) * 4, nitems = nprompt + 128;
    for (int item = bidx(); item < nitems; item += VGRID) {
        __syncthreads();
        if (item < nprompt) {
            const int c = item >> 2, h = item & 3, t0 = c * GCH;
            for (int idx = tid; idx < GCH * 32; idx += 256) {
                const int q = idx >> 5, v8 = (idx & 31) * 8;
                const uint4 v = *(const uint4*)(QK + (size_t)(t0 + q) * 3072 + 1024 + h * 256 + v8);
                const unsigned short* s = (const unsigned short*)&v;
#pragma unroll
                for (int e = 0; e < 8; ++e) sVt[(v8 + e) * QST + q] = s[e];
            }
            for (int idx = tid; idx < GCH * 16; idx += 256) {
                const int q = idx >> 4, k8 = (idx & 15) * 8;
                float f[8]; unpack8(*(const uint4*)(QK + (size_t)(t0 + q) * 3072 + 512 + h * 128 + k8), f);
                const float* bl = BC + (size_t)(t0 + GCH - 1) * 512 + h * 128 + k8; const float* bq = BC + (size_t)(t0 + q) * 512 + h * 128 + k8;
#pragma unroll
                for (int e = 0; e < 8; ++e) sKt[(k8 + e) * QST + q] = f2bf(f[e] * __expf(bl[e] - bq[e]));
            }
            __syncthreads();
            f32x16 acc[2][4];
#pragma unroll
            for (int i = 0; i < 2; ++i)
#pragma unroll
                for (int kk = 0; kk < 4; ++kk)
#pragma unroll
                    for (int e = 0; e < 16; ++e) acc[i][kk][e] = 0.f;
#pragma unroll
            for (int ks = 0; ks < 4; ++ks) {
                bf16x8 vb[2];
#pragma unroll
                for (int i = 0; i < 2; ++i) vb[i] = ldsfrag(sVt, 64 * wave + 32 * i + l31, QST, ks * 16 + 8 * lh);
#pragma unroll
                for (int kk = 0; kk < 4; ++kk) {
                    const bf16x8 ka = ldsfrag(sKt, 32 * kk + l31, QST, ks * 16 + 8 * lh);
#pragma unroll
                    for (int i = 0; i < 2; ++i) acc[i][kk] = mfma32(ka, vb[i], acc[i][kk]);
                }
            }
#pragma unroll
            for (int i = 0; i < 2; ++i)
#pragma unroll
                for (int kk = 0; kk < 4; ++kk)
#pragma unroll
                    for (int rg = 0; rg < 4; ++rg) {
                        const int v = 64 * wave + 32 * i + l31, k = 32 * kk + 8 * rg + 4 * lh;
                        *(uint2*)(U + (((size_t)c * 4 + h) * 256 + v) * 128 + k) = make_uint2(pack2(acc[i][kk][4 * rg], acc[i][kk][4 * rg + 1]), pack2(acc[i][kk][4 * rg + 2], acc[i][kk][4 * rg + 3]));
                    }
        } else {
            const int sb = (item - nprompt) >> 2, h = (item - nprompt) & 3, v = tid;
            const float* s_in = in_[4] + ((size_t)sb * 4 + h) * 32768; float* s_out = out_ + O_GLAS + ((size_t)sb * 4 + h) * 32768;
            bf16_t* OG = (bf16_t*)(ws_ + B_R3);
            float* sq = (float*)VSMEM; float* sk = sq + 128; float* sa = sk + 128; float* red = sa + 128;
            float S[128];
#pragma unroll
            for (int k = 0; k < 128; ++k) S[k] = __builtin_nontemporal_load(s_in + (size_t)k * 256 + v);
            for (int s = 0; s < 4; ++s) {
                const int tok = TP + sb * 4 + s;
                __syncthreads();
                if (tid < 128) {
                    sq[tid] = bf2f(QK[(size_t)tok * 3072 + h * 128 + tid]) * 0.08838834764831845f;
                    sk[tid] = bf2f(QK[(size_t)tok * 3072 + 512 + h * 128 + tid]);
                    const float bcur = BC[(size_t)tok * 512 + h * 128 + tid], bprev = s ? BC[(size_t)(tok - 1) * 512 + h * 128 + tid] : 0.f;
                    sa[tid] = __expf(bcur - bprev);
                }
                __syncthreads();
                const float vv = bf2f(QK[(size_t)tok * 3072 + 1024 + h * 256 + v]);
                float o = 0.f;
#pragma unroll
                for (int k = 0; k < 128; ++k) { S[k] = sa[k] * S[k] + sk[k] * vv; o += sq[k] * S[k]; }
                red[tid] = o * o;
                __syncthreads();
                for (int st = 128; st > 0; st >>= 1) { if (tid < st) red[tid] += red[tid + st]; __syncthreads(); }
                const float inv = rsqrtf(red[0] * (1.f / 256.f) + EPS);
                const float r = bf2f(QK[(size_t)tok * 3072 + 2048 + h * 256 + v]);
                OG[(size_t)tok * D + h * 256 + v] = f2bf(o * inv * silu_f(r));
            }
#pragma unroll
            for (int k = 0; k < 128; ++k) __builtin_nontemporal_store(S[k], s_out + (size_t)k * 256 + v);
        }
    }
}

DEVI void gla_scan_phase(const Params& p) {
    int z_; asm volatile("s_mov_b32 %0, 0" : "=s"(z_)); unsigned char* ws_ = p.ws + z_; float* out_ = p.out + z_; (void)ws_; (void)out_; KIN_DECL;
    bf16_t* U = (bf16_t*)(ws_ + B_R6);
    const float* BC = (const float*)(ws_ + B_HB);
    float* outp = out_ + O_GLAP;
    const int gtid = bidx() * 256 + tidx(), gsz = VGRID * 256;
    for (int it = gtid; it < 2 * 4 * 8192; it += gsz) {
        const int b = it >> 15, h = (it >> 13) & 3, v = (it >> 5) & 255, k4 = (it & 31) * 4;
        float s0 = 0.f, s1 = 0.f, s2 = 0.f, s3 = 0.f;
#pragma unroll 16
        for (int cc = 0; cc < SEQ / GCH; ++cc) {
            const int c = b * (SEQ / GCH) + cc;
            uint2* ptr = (uint2*)(U + (((size_t)c * 4 + h) * 256 + v) * 128 + k4);
            float f[4]; unpack4(*ptr, f);
            *ptr = make_uint2(pack2(s0, s1), pack2(s2, s3));
            const float4 bl = *(const float4*)(BC + (size_t)(c * GCH + GCH - 1) * 512 + h * 128 + k4);
            s0 = __expf(bl.x) * s0 + f[0]; s1 = __expf(bl.y) * s1 + f[1]; s2 = __expf(bl.z) * s2 + f[2]; s3 = __expf(bl.w) * s3 + f[3];
        }
        float* o = outp + (((size_t)b * 4 + h) * 128 + k4) * 256 + v;
        o[0] = s0; o[256] = s1; o[512] = s2; o[768] = s3;
    }
}

DEVI void gla_out_phase(const Params& p) {
    int z_; asm volatile("s_mov_b32 %0, 0" : "=s"(z_)); unsigned char* ws_ = p.ws + z_; float* out_ = p.out + z_; (void)ws_; (void)out_; KIN_DECL;
    const bf16_t* QK = (const bf16_t*)(ws_ + B_R4);
    const float* BC = (const float*)(ws_ + B_HB);
    const bf16_t* U = (const bf16_t*)(ws_ + B_R6);
    bf16_t* OG = (bf16_t*)(ws_ + B_R3);
    const int tid = tidx(), lane = tid & 63, wave = tid >> 6, l31 = lane & 31, lh = lane >> 5;
    bf16_t* sQ = (bf16_t*)VSMEM;
    bf16_t* sK = sQ + 64 * SST;
    bf16_t* sVt = sK + 64 * SST;
    float* sred = (float*)(sVt + 256 * QST);
    const int nitems = (TP / GCH) * 4;
    for (int item = bidx(); item < nitems; item += VGRID) {
        const int c = item >> 2, h = item & 3, t0 = c * GCH;
        __syncthreads();
        for (int idx = tid; idx < GCH * 16; idx += 256) {
            const int q = idx >> 4, k8 = (idx & 15) * 8;
            float fq[8], fk[8];
            unpack8(*(const uint4*)(QK + (size_t)(t0 + q) * 3072 + h * 128 + k8), fq);
            unpack8(*(const uint4*)(QK + (size_t)(t0 + q) * 3072 + 512 + h * 128 + k8), fk);
            const float* bq = BC + (size_t)(t0 + q) * 512 + h * 128 + k8;
            unsigned wq[4], wk[4];
#pragma unroll
            for (int e = 0; e < 4; ++e) {
                const float e0 = __expf(bq[2 * e]), e1 = __expf(bq[2 * e + 1]);
                wq[e] = pack2(fq[2 * e] * e0 * 0.08838834764831845f, fq[2 * e + 1] * e1 * 0.08838834764831845f);
                wk[e] = pack2(fk[2 * e] / e0, fk[2 * e + 1] / e1);
            }
            *(uint4*)(sQ + q * SST + k8) = make_uint4(wq[0], wq[1], wq[2], wq[3]);
            *(uint4*)(sK + q * SST + k8) = make_uint4(wk[0], wk[1], wk[2], wk[3]);
        }
        for (int idx = tid; idx < GCH * 32; idx += 256) {
            const int q = idx >> 5, v8 = (idx & 31) * 8;
            const uint4 v = *(const uint4*)(QK + (size_t)(t0 + q) * 3072 + 1024 + h * 256 + v8);
            const unsigned short* s = (const unsigned short*)&v;
#pragma unroll
            for (int e = 0; e < 8; ++e) sVt[(v8 + e) * QST + q] = s[e];
        }
        __syncthreads();
        const int qt = wave & 1, stl = wave >> 1;
        f32x16 at;
#pragma unroll
        for (int e = 0; e < 16; ++e) at[e] = 0.f;
#pragma unroll
        for (int ks = 0; ks < 8; ++ks) at = mfma32(ldsfrag(sK, 32 * stl + l31, SST, ks * 16 + 8 * lh), ldsfrag(sQ, 32 * qt + l31, SST, ks * 16 + 8 * lh), at);
        f32x16 acc[2][2];
#pragma unroll
        for (int i = 0; i < 2; ++i)
#pragma unroll
            for (int jq = 0; jq < 2; ++jq)
#pragma unroll
                for (int e = 0; e < 16; ++e) acc[i][jq][e] = 0.f;
        const bf16_t* Uc = U + ((size_t)c * 4 + h) * 32768;
#pragma unroll
        for (int ks = 0; ks < 8; ++ks) {
            bf16x8 qb[2];
#pragma unroll
            for (int jq = 0; jq < 2; ++jq) qb[jq] = ldsfrag(sQ, 32 * jq + l31, SST, ks * 16 + 8 * lh);
#pragma unroll
            for (int i = 0; i < 2; ++i) {
                const bf16x8 sa = *(const bf16x8*)(Uc + (size_t)(64 * wave + 32 * i + l31) * 128 + ks * 16 + 8 * lh);
#pragma unroll
                for (int jq = 0; jq < 2; ++jq) acc[i][jq] = mfma32(sa, qb[jq], acc[i][jq]);
            }
        }
        __syncthreads();
        bf16_t* sP = sK;
        {
            const int q = 32 * qt + l31;
#pragma unroll
            for (int rg = 0; rg < 4; ++rg) {
                const int s0 = 32 * stl + 8 * rg + 4 * lh;
                float m[4];
#pragma unroll
                for (int e = 0; e < 4; ++e) m[e] = (s0 + e <= q) ? at[4 * rg + e] : 0.f;
                *(uint2*)(sP + q * QST + s0) = make_uint2(pack2(m[0], m[1]), pack2(m[2], m[3]));
            }
        }
        __syncthreads();
#pragma unroll
        for (int ks = 0; ks < 4; ++ks) {
            bf16x8 pb[2];
#pragma unroll
            for (int jq = 0; jq < 2; ++jq) pb[jq] = ldsfrag(sP, 32 * jq + l31, QST, ks * 16 + 8 * lh);
#pragma unroll
            for (int i = 0; i < 2; ++i) {
                const bf16x8 va = ldsfrag(sVt, 64 * wave + 32 * i + l31, QST, ks * 16 + 8 * lh);
#pragma unroll
                for (int jq = 0; jq < 2; ++jq) acc[i][jq] = mfma32(va, pb[jq], acc[i][jq]);
            }
        }
        float ss[2] = {0.f, 0.f};
#pragma unroll
        for (int jq = 0; jq < 2; ++jq)
#pragma unroll
            for (int i = 0; i < 2; ++i)
#pragma unroll
                for (int e = 0; e < 16; ++e) ss[jq] += acc[i][jq][e] * acc[i][jq][e];
#pragma unroll
        for (int jq = 0; jq < 2; ++jq) { ss[jq] += __shfl_xor(ss[jq], 32); if (lh == 0) sred[wave * 64 + 32 * jq + l31] = ss[jq]; }
        __syncthreads();
#pragma unroll
        for (int jq = 0; jq < 2; ++jq) {
            const int q = 32 * jq + l31;
            const float tot = sred[q] + sred[64 + q] + sred[128 + q] + sred[192 + q];
            const float inv = rsqrtf(tot * (1.f / 256.f) + EPS);
            const size_t trow = (size_t)(t0 + q);
#pragma unroll
            for (int i = 0; i < 2; ++i)
#pragma unroll
                for (int rg = 0; rg < 4; ++rg) {
                    const int vc = h * 256 + 64 * wave + 32 * i + 8 * rg + 4 * lh;
                    float rf[4]; unpack4(*(const uint2*)(QK + trow * 3072 + 2048 + vc), rf);
                    float o[4];
#pragma unroll
                    for (int e = 0; e < 4; ++e) o[e] = acc[i][jq][4 * rg + e] * inv * silu_f(rf[e]);
                    *(uint2*)(OG + trow * D + vc) = make_uint2(pack2(o[0], o[1]), pack2(o[2], o[3]));
                }
        }
    }
}

DEVI void rope_table(const Params& p) {
    int z_; asm volatile("s_mov_b32 %0, 0" : "=s"(z_)); unsigned char* ws_ = p.ws + z_;
    float* CS = (float*)(ws_ + B_ROPE);
    const int gtid = bidx() * 256 + tidx(), gsz = VGRID * 256;
    for (int it = gtid; it < (SEQ + 4) * 8; it += gsz) {
        const int pos = it >> 3, i = it & 7;
        const float fr = powf(500000.f, -(float)i * 0.125f);
        float sv, cv; sincosf((float)pos * fr, &sv, &cv);
        CS[(size_t)pos * 16 + i] = cv; CS[(size_t)pos * 16 + 8 + i] = sv;
    }
}

DEVI void att_rope_phase(const Params& p) {
    int z_; asm volatile("s_mov_b32 %0, 0" : "=s"(z_)); unsigned char* ws_ = p.ws + z_; float* out_ = p.out + z_; (void)ws_; (void)out_; KIN_DECL;
    bf16_t* QKV = (bf16_t*)(ws_ + B_R4);
    const float* CS = (const float*)(ws_ + B_ROPE);
    const int gtid = bidx() * 256 + tidx(), gsz = VGRID * 256;
    for (int it = gtid; it < T * 96; it += gsz) {
        const int t = it / 96, rem = it - t * 96, hd = rem >> 3, l8 = rem & 7, g = hd >> 2, hg = hd & 3;
        const bool samp = t >= TP;
        const int pos = samp ? SEQ + ((t - TP) & 3) : (t & (SEQ - 1));
        bf16_t* qp = QKV + (size_t)t * QKVD + hd * 64 + 8 * l8; bf16_t* kp = qp + 768; const bf16_t* vp = qp + 1536;
        float cs[8], sn[8], qf[8], kf[8], vf[8];
        unpack8(*(const uint4*)kp, kf);
        if (l8 < 2) {
            unpack8(*(const uint4*)qp, qf);
            const float4* cp = (const float4*)(CS + (size_t)pos * 16);
            const float4 c0 = cp[0], c1 = cp[1], s0 = cp[2], s1 = cp[3];
            cs[0] = c0.x; cs[1] = c0.y; cs[2] = c0.z; cs[3] = c0.w; cs[4] = c1.x; cs[5] = c1.y; cs[6] = c1.z; cs[7] = c1.w;
            sn[0] = s0.x; sn[1] = s0.y; sn[2] = s0.z; sn[3] = s0.w; sn[4] = s1.x; sn[5] = s1.y; sn[6] = s1.z; sn[7] = s1.w;
        } else {
#pragma unroll
            for (int e = 0; e < 8; ++e) { qf[e] = 0.f; cs[e] = 1.f; sn[e] = 0.f; }
        }
#pragma unroll
        for (int e = 0; e < 8; ++e) {
            const float qo = __shfl_xor(qf[e], 1), ko = __shfl_xor(kf[e], 1);
            if (l8 == 0) { qf[e] = qf[e] * cs[e] - qo * sn[e]; kf[e] = kf[e] * cs[e] - ko * sn[e]; }
            else if (l8 == 1) { qf[e] = qf[e] * cs[e] + qo * sn[e]; kf[e] = kf[e] * cs[e] + ko * sn[e]; }
        }
        if (l8 < 2) {
            *(uint4*)qp = make_uint4(pack2(qf[0], qf[1]), pack2(qf[2], qf[3]), pack2(qf[4], qf[5]), pack2(qf[6], qf[7]));
            const uint4 kw = make_uint4(pack2(kf[0], kf[1]), pack2(kf[2], kf[3]), pack2(kf[4], kf[5]), pack2(kf[6], kf[7]));
            *(uint4*)kp = kw; unpack8(kw, kf);
        }
        const int W = 128 << (2 * g);
        float* dst = nullptr;
        if (!samp) { const int b = t >> 13, tp = t & (SEQ - 1); if (tp >= SEQ - W) dst = out_ + (g == 0 ? O_KV0P : (g == 1 ? O_KV1P : O_KV2P)) + (((size_t)b * W + (tp - (SEQ - W))) * 2) * 256 + hg * 64 + 8 * l8; }
        else { const int sb = (t - TP) >> 2, sq = (t - TP) & 3; dst = out_ + (g == 0 ? O_KV0S : (g == 1 ? O_KV1S : O_KV2S)) + (((size_t)sb * W + (W - 4 + sq)) * 2) * 256 + hg * 64 + 8 * l8; }
        if (dst) {
            unpack8(*(const uint4*)vp, vf);
            ((float4*)dst)[0] = make_float4(kf[0], kf[1], kf[2], kf[3]); ((float4*)dst)[1] = make_float4(kf[4], kf[5], kf[6], kf[7]);
            ((float4*)(dst + 256))[0] = make_float4(vf[0], vf[1], vf[2], vf[3]); ((float4*)(dst + 256))[1] = make_float4(vf[4], vf[5], vf[6], vf[7]);
        }
    }
}

DEVI void att_phase(const Params& p) {
    int z_; asm volatile("s_mov_b32 %0, 0" : "=s"(z_)); unsigned char* ws_ = p.ws + z_; float* out_ = p.out + z_; (void)ws_; (void)out_; KIN_DECL;
    const bf16_t* QKV = (const bf16_t*)(ws_ + B_R4);
    bf16_t* AO = (bf16_t*)(ws_ + B_R3);
    float* LSE = (float*)(ws_ + B_DT);
    const int lane = tidx() & 63, wib = tidx() >> 6;
    const int wv = (bidx() * 256 + tidx()) >> 6, nw = (VGRID * 256) >> 6;
    float* sq = (float*)VSMEM + wib * 256;
    float* sp = sq + 64;
    for (int it = wv; it < TS * 12; it += nw) {
        const int t = TP + it / 12, hd = it % 12, g = hd >> 2, hg = hd & 3;
        const int sb = (t - TP) >> 2, s = (t - TP) & 3;
        const int d = (g == 0) ? 1 : (g == 1 ? 4 : 16), W = 128 * d;
        const float* cache = (g == 0) ? in_[5] : (g == 1 ? in_[6] : in_[7]);
        sq[lane] = bf2f(QKV[(size_t)t * QKVD + hd * 64 + lane]) * 0.125f;
        float sc[3];
#pragma unroll
        for (int r = 0; r < 3; ++r) {
            const int jj = r * 64 + lane;
            float v = -INFINITY;
            if (jj <= 128) {
                const int idx = W + s - jj * d;
                float a = 0.f;
                if (idx >= W) {
                    const bf16_t* kp = QKV + (size_t)(TP + sb * 4 + (idx - W)) * QKVD + 768 + hd * 64;
#pragma unroll
                    for (int i = 0; i < 8; ++i) { float f[8]; unpack8(*(const uint4*)(kp + 8 * i), f);
#pragma unroll
                        for (int e = 0; e < 8; ++e) a += f[e] * sq[8 * i + e]; }
                } else {
                    const float4* kp = (const float4*)(cache + (((size_t)sb * W + idx) * 2) * 256 + hg * 64);
#pragma unroll
                    for (int i = 0; i < 16; ++i) { const float4 f = kp[i]; a += f.x * sq[4 * i] + f.y * sq[4 * i + 1] + f.z * sq[4 * i + 2] + f.w * sq[4 * i + 3]; }
                }
                v = a;
            }
            sc[r] = v;
        }
        const float mx = wave_max(fmaxf(sc[0], fmaxf(sc[1], sc[2])));
        float ps = 0.f;
#pragma unroll
        for (int r = 0; r < 3; ++r) { const float e = (sc[r] == -INFINITY) ? 0.f : __expf(sc[r] - mx); sp[r * 64 + lane] = e; ps += e; }
        const float den = wave_sum(ps);
        const int jn = s / d;
        float a = 0.f;
        for (int jj = 0; jj <= jn; ++jj) a += sp[jj] * bf2f(QKV[(size_t)(TP + sb * 4 + (s - jj * d)) * QKVD + 1536 + hd * 64 + lane]);
        const float* vb = cache + (((size_t)sb * W) * 2 + 1) * 256 + hg * 64 + lane;
#pragma unroll 8
        for (int jj = jn + 1; jj <= 128; ++jj) a += sp[jj] * vb[(size_t)(W + s - jj * d) * 512];
        AO[(size_t)t * ATTD + hd * 64 + lane] = f2bf(a / den);
        if (lane == 0) LSE[(size_t)t * 12 + hd] = mx + __logf(den);
    }
}

constexpr int VST = 264;
DEVI void att_prompt_phase(const Params& p) {
    int z_; asm volatile("s_mov_b32 %0, 0" : "=s"(z_)); unsigned char* ws_ = p.ws + z_; float* out_ = p.out + z_; (void)ws_; (void)out_; KIN_DECL;
    const bf16_t* QKV = (const bf16_t*)(ws_ + B_R4);
    bf16_t* AO = (bf16_t*)(ws_ + B_R3);
    float* LSE = (float*)(ws_ + B_DT);
    const int tid = tidx(), lane = tid & 63, wave = tid >> 6, l31 = lane & 31, lh = lane >> 5;
    bf16_t* sK = (bf16_t*)VSMEM;
    bf16_t* sVt = sK + 256 * GST;
    for (int item = bidx(); item < 2 * 12 * 64; item += VGRID) {
        const int b = item / 768, hd = (item / 64) % 12, blk = item & 63, g = hd >> 2;
        const int d = (g == 0) ? 1 : (g == 1 ? 4 : 16), nbr = (SEQ / d) / 128, r = blk / nbr, u0 = (blk % nbr) * 128;
        const size_t tb = (size_t)b * SEQ + r;
        __syncthreads();
        for (int idx = tid; idx < 256 * 8; idx += 256) {
            const int kj = idx >> 3, c8 = (idx & 7) * 8, u = u0 - 128 + kj;
            u32x4 kv = {0u, 0u, 0u, 0u}, vv = {0u, 0u, 0u, 0u};
            if (u >= 0) { const bf16_t* src = QKV + (tb + (size_t)u * d) * QKVD + 768 + hd * 64 + c8; kv = *(const u32x4*)src; vv = *(const u32x4*)(src + 768); }
            *(u32x4*)(sK + kj * GST + c8) = kv;
#pragma unroll
            for (int e = 0; e < 4; ++e) { sVt[(c8 + 2 * e) * VST + kj] = (bf16_t)(vv[e] & 0xffffu); sVt[(c8 + 2 * e + 1) * VST + kj] = (bf16_t)(vv[e] >> 16); }
        }
        const int qi = 32 * wave + l31;
        const size_t tq = tb + (size_t)(u0 + qi) * d;
        bf16x8 qf[4];
#pragma unroll
        for (int ks = 0; ks < 4; ++ks) qf[ks] = *(const bf16x8*)(QKV + tq * QKVD + hd * 64 + ks * 16 + 8 * lh);
        __syncthreads();
        f32x16 S[5];
#pragma unroll
        for (int tt = 0; tt < 5; ++tt) {
#pragma unroll
            for (int e = 0; e < 16; ++e) S[tt][e] = 0.f;
#pragma unroll
            for (int ks = 0; ks < 4; ++ks) S[tt] = mfma32(ldsfrag(sK, 32 * (wave + tt) + l31, GST, ks * 16 + 8 * lh), qf[ks], S[tt]);
        }
        float mx = -INFINITY;
#pragma unroll
        for (int tt = 0; tt < 5; ++tt)
#pragma unroll
            for (int e = 0; e < 16; ++e) {
                const int kj = 32 * (wave + tt) + (e & 3) + 8 * (e >> 2) + 4 * lh;
                const bool valid = (kj >= qi) && (kj <= qi + 128) && (u0 - 128 + kj >= 0);
                const float sv = valid ? S[tt][e] * 0.125f : -INFINITY;
                S[tt][e] = sv; mx = fmaxf(mx, sv);
            }
        mx = fmaxf(mx, __shfl_xor(mx, 32));
        float den = 0.f;
#pragma unroll
        for (int tt = 0; tt < 5; ++tt)
#pragma unroll
            for (int e = 0; e < 16; ++e) { const float pe = __expf(S[tt][e] - mx); S[tt][e] = pe; den += pe; }
        den += __shfl_xor(den, 32);
        f32x16 O[2];
#pragma unroll
        for (int i = 0; i < 2; ++i)
#pragma unroll
            for (int e = 0; e < 16; ++e) O[i][e] = 0.f;
#pragma unroll
        for (int tt = 0; tt < 5; ++tt)
#pragma unroll
            for (int s2 = 0; s2 < 2; ++s2) {
                union { bf16x8 v; unsigned u[4]; } pb;
#pragma unroll
                for (int e = 0; e < 4; ++e) pb.u[e] = pack2(S[tt][8 * s2 + 2 * e], S[tt][8 * s2 + 2 * e + 1]);
#pragma unroll
                for (int i = 0; i < 2; ++i) {
                    const bf16_t* vp = sVt + (32 * i + l31) * VST + 32 * (wave + tt) + 16 * s2 + 4 * lh;
                    union { bf16x8 v; uint2 h[2]; } va;
                    va.h[0] = *(const uint2*)vp; va.h[1] = *(const uint2*)(vp + 8);
                    O[i] = mfma32(va.v, pb.v, O[i]);
                }
            }
        const float rden = 1.f / den;
#pragma unroll
        for (int i = 0; i < 2; ++i)
#pragma unroll
            for (int rg = 0; rg < 4; ++rg)
                *(uint2*)(AO + tq * ATTD + hd * 64 + 32 * i + 8 * rg + 4 * lh) = make_uint2(pack2(O[i][4 * rg] * rden, O[i][4 * rg + 1] * rden), pack2(O[i][4 * rg + 2] * rden, O[i][4 * rg + 3] * rden));
        if (lh == 0) LSE[tq * 12 + hd] = mx + __logf(den);
    }
}

DEVI void att_mix_phase(const Params& p) {
    int z_; asm volatile("s_mov_b32 %0, 0" : "=s"(z_)); unsigned char* ws_ = p.ws + z_; float* out_ = p.out + z_; (void)ws_; (void)out_; KIN_DECL;
    bf16_t* AO = (bf16_t*)(ws_ + B_R3);
    const float* LSE = (const float*)(ws_ + B_DT);
    const int gtid = bidx() * 256 + tidx(), gsz = VGRID * 256;
    for (int it = gtid; it < T * 32; it += gsz) {
        const int t = it >> 5, hg = (it >> 3) & 3, c8 = (it & 7) * 8;
        const float l0 = LSE[(size_t)t * 12 + hg], l1 = LSE[(size_t)t * 12 + 4 + hg], l2 = LSE[(size_t)t * 12 + 8 + hg];
        const float ml = fmaxf(l0, fmaxf(l1, l2));
        float al[3] = {__expf(l0 - ml), __expf(l1 - ml), __expf(l2 - ml)};
        const float rs = 1.f / (al[0] + al[1] + al[2]);
#pragma unroll
        for (int g = 0; g < 3; ++g) {
            u32x4* ptr = (u32x4*)(AO + (size_t)t * ATTD + (g * 4 + hg) * 64 + c8);
            const u32x4 v = *ptr; const float a = al[g] * rs;
            u32x4 o;
#pragma unroll
            for (int e = 0; e < 4; ++e) o[e] = pack2(__uint_as_float(v[e] << 16) * a, __uint_as_float(v[e] & 0xffff0000u) * a);
            *ptr = o;
        }
    }
}

enum { OP_INIT = 0, OP_NORM, OP_FINAL, OP_SSM_IN, OP_SSM_CONV, OP_SSM_STATE, OP_SSM_SCAN, OP_SSM_OUT, OP_SSM_OG, OP_GLA_IN, OP_GLA_GATE, OP_GLA_STATE, OP_GLA_SCAN,
       OP_GLA_OUT, OP_GLA_OG, OP_ATT_IN_, OP_ATT_ROPE, OP_ATT_ATT, OP_ATT_MIX, OP_ATT_OG, OP_FFN_GU, OP_FFN_DN };
constexpr int OP_ATT_IN = OP_ATT_IN_;
DEVI int phase_op(int ph, int& a) {
    int l, q, op; a = 0;
    if (ph == 0) return OP_INIT;
    if (ph <= 10) { l = 0; q = ph - 1; } else if (ph <= 20) { l = 1; q = ph - 11; } else if (ph <= 29) { l = 2; q = ph - 21; } else { l = 3; q = ph - 30; }
    const int nmix = (l == 2) ? 5 : 6;
    if (q < nmix) { op = (l == 1 ? OP_GLA_IN : (l == 2 ? OP_ATT_IN_ : OP_SSM_IN)) + q; a = l / 3; }
    else { const int k = q - nmix; op = (k == 0) ? OP_NORM : (k == 1 ? OP_FFN_GU : (k == 2 ? OP_FFN_DN : (l == 3 ? OP_FINAL : OP_NORM))); a = l; }
    return op;
}
DEVI int phase_op_only(int ph) { int a; return phase_op(ph, a); }
DEVI void run_phase(const Params& p, int ph) {
    const bf16_t* Hb = (const bf16_t*)(p.ws + B_HB);
    int a = 0; int op = phase_op(ph, a);
#ifdef ONLY_OP
    if (op != ONLY_OP) return;
    op = ONLY_OP;
#endif
    switch (op) {
        case OP_INIT: if (rbid() & 1) { copy_caches(p); convert_weights(p); } else { convert_weights(p); copy_caches(p); } rope_table(p); norm_phase(p, 0); break;
        case OP_NORM: norm_phase(p, 1); break;
        case OP_FINAL: norm_phase(p, 2); break;
        case OP_SSM_IN: gemm8<EPI_SSM_IN>(p, Hb, (const bf16_t*)(p.ws + W_SSM_IN) + (size_t)a * SSM_INP * D, MPAD, SSM_INP, D); break;
        case OP_SSM_CONV: ssm_conv_phase(p, a); break;
        case OP_SSM_STATE: ssm_state_phase(p, a); break;
        case OP_SSM_SCAN: ssm_scan_phase(p, a); break;
        case OP_SSM_OUT: ssm_out_phase(p, a); break;
        case OP_SSM_OG: gemm8<EPI_RESADD>(p, (const bf16_t*)(p.ws + B_R4), (const bf16_t*)(p.ws + W_SSM_OUT) + (size_t)a * D * DI, TP, D, DI, a == 0 ? p.in[0] : nullptr); gemm_phase<EPI_RESADD, DI>(p, (const bf16_t*)(p.ws + B_R4), (const bf16_t*)(p.ws + W_SSM_OUT) + (size_t)a * D * DI, 4, true); break;
        case OP_GLA_IN: gemm8<EPI_GLA_IN>(p, Hb, (const bf16_t*)(p.ws + W_GLA_IN), MPAD, GLA_INP, D); break;
        case OP_GLA_GATE: gla_gate_phase(p); break;
        case OP_GLA_STATE: gla_state_phase(p); break;
        case OP_GLA_SCAN: gla_scan_phase(p); break;
        case OP_GLA_OUT: gla_out_phase(p); break;
        case OP_GLA_OG: gemm8<EPI_RESADD>(p, (const bf16_t*)(p.ws + B_R3), (const bf16_t*)(p.ws + W_GLA_OUT), TP, D, D); gemm_phase<EPI_RESADD, D>(p, (const bf16_t*)(p.ws + B_R3), (const bf16_t*)(p.ws + W_GLA_OUT), 4, true); break;
        case OP_ATT_IN: gemm8<EPI_ATT_IN>(p, Hb, (const bf16_t*)(p.ws + W_ATT_QKV), MPAD, QKVD, D); break;
        case OP_ATT_ROPE: att_rope_phase(p); break;
        case OP_ATT_ATT: att_prompt_phase(p); __syncthreads(); att_phase(p); break;
        case OP_ATT_MIX: att_mix_phase(p); break;
        case OP_ATT_OG: gemm8<EPI_RESADD>(p, (const bf16_t*)(p.ws + B_R3), (const bf16_t*)(p.ws + W_ATT_OUT), TP, D, ATTD); gemm_phase<EPI_RESADD, ATTD>(p, (const bf16_t*)(p.ws + B_R3), (const bf16_t*)(p.ws + W_ATT_OUT), 4, true); break;
        case OP_FFN_GU: gemm8<EPI_SWIGLU>(p, Hb, (const bf16_t*)(p.ws + W_FFN_GU) + (size_t)a * 2 * DFF * D, MPAD, 2 * DFF, D); break;
        case OP_FFN_DN: gemm8<EPI_RESADD>(p, (const bf16_t*)(p.ws + B_R4), (const bf16_t*)(p.ws + W_FFN_DN) + (size_t)a * D * DFF, TP, D, DFF); gemm_phase<EPI_RESADD, DFF>(p, (const bf16_t*)(p.ws + B_R4), (const bf16_t*)(p.ws + W_FFN_DN) + (size_t)a * D * DFF, 4, true); break;
        default: break;
    }
}

#ifndef REPEAT_OP
#define REPEAT_OP -1
#endif
#ifndef REPEAT_N
#define REPEAT_N 1
#endif
__global__ void __launch_bounds__(512, 2) mega(Params p, int ph_lo, int ph_hi, int coop) {
    uint4* xb_words = (uint4*)(smem + 2 * LDS_BYTES);
    if (threadIdx.x == 0) *xb_words = make_uint4(0u, 0u, 0u, 0u);
    __syncthreads();
    XcdBarrier xb = xcd_barrier_post((unsigned*)(p.ws + B_BAR), (volatile LAS unsigned*)xb_words);
    if (coop < 0) cg::this_grid().sync();
    int rep = 0;
    for (int ph = ph_lo; ph < ph_hi;) {
        run_phase(p, ph);
        if (REPEAT_OP >= 0 && phase_op_only(ph) == REPEAT_OP && rep < REPEAT_N) { ++rep; __syncthreads(); continue; }
        rep = 0;
        if (ph + 1 < ph_hi) xcd_barrier(xb);
        ++ph;
    }
}

extern "C" void kernel_launch(void* const* d_in, const int* in_sizes, int n_in, void* d_out, int out_size, void* d_ws, size_t ws_size, hipStream_t stream) {
    if (ws_size < B_END) { fprintf(stderr, "workspace too small: %zu < %zu\n", ws_size, (size_t)B_END); return; }
    Params p; memset(&p, 0, sizeof(p));
    for (int i = 0; i < 29; ++i) p.in[i] = (const float*)d_in[i];
    p.out = (float*)d_out; p.ws = (unsigned char*)d_ws;
    p.nphase = 40;
    static int grid_blocks = 0;
    if (!grid_blocks) {
        int dev = 0, cus = 0, per_cu = 0;
        hipGetDevice(&dev);
        hipDeviceGetAttribute(&cus, hipDeviceAttributeMultiprocessorCount, dev);
        hipFuncSetAttribute((const void*)mega, hipFuncAttributeMaxDynamicSharedMemorySize, DYN_LDS);
        hipOccupancyMaxActiveBlocksPerMultiprocessor(&per_cu, mega, 512, DYN_LDS);
        if (per_cu > 1) per_cu = 1;
        if (per_cu < 1) per_cu = 1;
        grid_blocks = cus * per_cu;
    }
#if ONE_LAUNCH
    hipMemsetAsync(p.ws + B_BAR, 0, XCD_BAR_WORDS * 4, stream);
    int lo = 0, hi = p.nphase, coop = 1;
    void* args[] = {&p, &lo, &hi, &coop};
    hipError_t e = hipLaunchCooperativeKernel((void*)mega, dim3(grid_blocks), dim3(512), args, DYN_LDS, stream);
    if (e != hipSuccess) fprintf(stderr, "cooperative launch failed: %s (grid %d)\n", hipGetErrorString(e), grid_blocks);
#else
    for (int ph = 0; ph < p.nphase; ++ph) mega<<<grid_blocks, 512, DYN_LDS, stream>>>(p, ph, ph + 1, 0);
#endif
}
```

```cpp
#include <hip/hip_runtime.h>
#include <hip/hip_cooperative_groups.h>
#include <cstdio>
#include <cstring>
namespace cg = cooperative_groups;

#ifndef ONE_LAUNCH
#define ONE_LAUNCH 1
#endif

typedef unsigned short bf16_t;
typedef short bf16x8 __attribute__((ext_vector_type(8)));
typedef float f32x16 __attribute__((ext_vector_type(16)));
typedef float f32x4 __attribute__((ext_vector_type(4)));
typedef unsigned u32x4 __attribute__((ext_vector_type(4)));
#define DEVI __device__ __forceinline__

constexpr int D = 1024, TP = 16384, TS = 128, T = TP + TS, SEQ = 8192, DFF = 2816;
constexpr int SSM_IN = 5152, SSM_INP = 5376, DI = 2048, CONVD = 3072;
constexpr int GLA_IN = 3088, GLA_INP = 3328;
constexpr int QKVD = 2304, ATTD = 768;
constexpr float EPS = 1e-6f;
constexpr int MPAD = 16640;

constexpr size_t O_YP = 0, O_YS = O_YP + (size_t)TP * D, O_SSMP = O_YS + (size_t)TS * D, O_SSMS = O_SSMP + 2ull * 2 * 262144,
                 O_CONVP = O_SSMS + 2ull * 32 * 262144, O_CONVS = O_CONVP + 2ull * 2 * 3 * CONVD, O_GLAP = O_CONVS + 2ull * 32 * 3 * CONVD,
                 O_GLAS = O_GLAP + 2ull * 4 * 32768, O_KV0P = O_GLAS + 32ull * 4 * 32768, O_KV0S = O_KV0P + 2ull * 128 * 512,
                 O_KV1P = O_KV0S + 32ull * 128 * 512, O_KV1S = O_KV1P + 2ull * 512 * 512, O_KV2P = O_KV1S + 32ull * 512 * 512,
                 O_KV2S = O_KV2P + 2ull * 2048 * 512, O_END = O_KV2S + 32ull * 2048 * 512;

constexpr size_t al(size_t x) { return (x + 255) & ~(size_t)255; }
constexpr size_t W_SSM_IN = 0, W_SSM_OUT = W_SSM_IN + 2ull * SSM_INP * D * 2, W_GLA_IN = W_SSM_OUT + 2ull * D * DI * 2,
                 W_GLA_OUT = W_GLA_IN + (size_t)GLA_INP * D * 2, W_ATT_QKV = W_GLA_OUT + (size_t)D * D * 2, W_ATT_OUT = W_ATT_QKV + (size_t)QKVD * D * 2,
                 W_FFN_GU = W_ATT_OUT + (size_t)D * ATTD * 2, W_FFN_DN = W_FFN_GU + 4ull * 2 * DFF * D * 2, W_END = W_FFN_DN + 4ull * D * DFF * 2;
constexpr size_t B_HB = al(W_END), B_R3 = B_HB + (size_t)T * D * 2, B_R4 = B_R3 + (size_t)T * DI * 2, B_R5 = B_R4 + (size_t)T * CONVD * 2,
                 B_R6 = B_R5 + (size_t)T * CONVD * 2, B_DT = B_R6 + 67108864ull, B_DTS = B_DT + (size_t)T * 32 * 4, B_ACS = B_DTS + (size_t)T * 32 * 4,
                 B_GLOW = B_ACS + (size_t)T * 32 * 4, B_BAR = al(B_GLOW + (size_t)T * 16 * 4), B_SSQS = B_BAR + 16384, B_ROPE = B_SSQS + 4096, B_END = B_ROPE + 8196ull * 16 * 4;

struct WDesc { const float* src; const float* gain; bf16_t* dst; int K, N, mode, tile0, gmod; };
struct Params {
    const float* in[29];
    float* out;
    unsigned char* ws;
    int nphase, pad0;
};

constexpr int LDS_BYTES = 79872;
extern __shared__ __attribute__((aligned(16))) unsigned char smem[];
constexpr int DYN_LDS = 2 * LDS_BYTES + 16;

DEVI int rtid() { int t = threadIdx.x; asm volatile("" : "+v"(t)); return t; }
DEVI int rbid() { int b = blockIdx.x; asm volatile("" : "+s"(b)); return b; }
DEVI int vhalf() { return __builtin_amdgcn_readfirstlane(rtid() >> 8); }
DEVI int tidx() { return rtid() & 255; }
DEVI int bidx() { return rbid() * 2 + vhalf(); }
#define VGRID ((int)gridDim.x * 2)
#define CAS4 __attribute__((address_space(4)))
#define KIN_DECL const float* const CAS4* in_ = (const float* const CAS4*)((const CAS4 char*)__builtin_amdgcn_kernarg_segment_ptr() + z_); (void)in_
#define VSMEM (smem + vhalf() * LDS_BYTES)
DEVI unsigned short f2bf(float f) { unsigned u = __float_as_uint(f); u += 0x7fffu + ((u >> 16) & 1u); return (unsigned short)(u >> 16); }
DEVI float bf2f(unsigned short h) { return __uint_as_float(((unsigned)h) << 16); }
DEVI unsigned pack2(float a, float b) { return (unsigned)f2bf(a) | ((unsigned)f2bf(b) << 16); }
DEVI float silu_f(float x) { return x / (1.f + __expf(-x)); }
DEVI float softplus_f(float x) { return x > 20.f ? x : log1pf(__expf(x)); }
DEVI float logsigmoid_f(float x) { return fminf(x, 0.f) - log1pf(__expf(-fabsf(x))); }
DEVI float wave_sum(float v) { for (int o = 32; o > 0; o >>= 1) v += __shfl_xor(v, o); return v; }
DEVI float wave_max(float v) { for (int o = 32; o > 0; o >>= 1) v = fmaxf(v, __shfl_xor(v, o)); return v; }
DEVI bf16x8 ldsfrag(const bf16_t* base, int row, int stride, int k) { return *(const bf16x8*)(base + row * stride + k); }
DEVI f32x16 mfma32(bf16x8 a, bf16x8 b, f32x16 c) { return __builtin_amdgcn_mfma_f32_32x32x16_bf16(a, b, c, 0, 0, 0); }
DEVI void unpack8(uint4 v, float* f) {
    f[0] = __uint_as_float(v.x << 16); f[1] = __uint_as_float(v.x & 0xffff0000u); f[2] = __uint_as_float(v.y << 16); f[3] = __uint_as_float(v.y & 0xffff0000u);
    f[4] = __uint_as_float(v.z << 16); f[5] = __uint_as_float(v.z & 0xffff0000u); f[6] = __uint_as_float(v.w << 16); f[7] = __uint_as_float(v.w & 0xffff0000u);
}
DEVI void unpack4(uint2 v, float* f) {
    f[0] = __uint_as_float(v.x << 16); f[1] = __uint_as_float(v.x & 0xffff0000u); f[2] = __uint_as_float(v.y << 16); f[3] = __uint_as_float(v.y & 0xffff0000u);
}


#define XB_TMO      128
#define XB_XCNT(j)  (256  + 64 * (j))
#define XB_XSUB(j)  (1280 + 64 * (j))
#define XB_XGEN(j)  (2304 + 64 * (j))
#define XB_TOP      3328
#define XB_TOPGEN   3392
#define XCD_BAR_WORDS 3456
#define XB_SPIN_CAP (1u << 22)
#define LAS __attribute__((address_space(3)))
DEVI unsigned xb_ld(unsigned* p)              { return __hip_atomic_load(p, __ATOMIC_RELAXED, __HIP_MEMORY_SCOPE_AGENT); }
DEVI unsigned xb_add(unsigned* p, unsigned v) { return __hip_atomic_fetch_add(p, v, __ATOMIC_RELAXED, __HIP_MEMORY_SCOPE_AGENT); }
DEVI unsigned xb_xcc_id() { return (unsigned)__builtin_amdgcn_s_getreg((3 << 11) | 20) & 0xFu; }
#define XB_SPIN(cond, bar) do { unsigned _sp = 0; while (cond) { __builtin_amdgcn_s_sleep(1); \
    if ((++_sp & 255u) == 0u) { if (xb_ld(&(bar)[XB_TMO])) break; if (_sp > XB_SPIN_CAP) { atomicAdd(&(bar)[XB_TMO], 1u); break; } } } } while (0)
struct XcdBarrier { unsigned* bar; unsigned x; volatile LAS unsigned* st; };
DEVI XcdBarrier xcd_barrier_post(unsigned* bar, volatile LAS unsigned* st) {
    XcdBarrier b; b.bar = bar; b.x = xb_xcc_id(); b.st = st;
    if (threadIdx.x == 0) (void)xb_add(&bar[XB_XCNT(b.x)], 1u);
    return b;
}
DEVI void xcd_barrier_complete(unsigned* bar, unsigned x, unsigned& nloc, unsigned& nx) {
    const unsigned G = gridDim.x * gridDim.y * gridDim.z;
    unsigned sum, cnt, mine, sp = 0u;
    for (;;) {
        sum = 0u; cnt = 0u; mine = 0u;
#pragma unroll
        for (unsigned j = 0; j < 16; ++j) { const unsigned c = xb_ld(&bar[XB_XCNT(j)]); sum += c; cnt += (c > 0u) ? 1u : 0u; mine = (j == x) ? c : mine; }
        if (sum == G) break;
        __builtin_amdgcn_s_sleep(1);
        if ((++sp & 255u) == 0u) { if (xb_ld(&bar[XB_TMO])) break; if (sp > XB_SPIN_CAP) { atomicAdd(&bar[XB_TMO], 1u); break; } }
    }
    nloc = mine > 0u ? mine : 1u; nx = cnt > 0u ? cnt : 1u;
}
DEVI void xcd_barrier(const XcdBarrier& b) {
    asm volatile("s_waitcnt vmcnt(0)" ::: "memory");
    __syncthreads();
    if (threadIdx.x == 0) {
        unsigned* bar = b.bar;
        __builtin_amdgcn_s_waitcnt(0);
        unsigned nloc = b.st[0], nx = b.st[1];
        if (nloc == 0u) { xcd_barrier_complete(bar, b.x, nloc, nx); b.st[0] = nloc; b.st[1] = nx; }
        const unsigned old = xb_add(&bar[XB_XSUB(b.x)], 1u);
        const unsigned gen = old / nloc;
        if (old + 1u == (gen + 1u) * nloc) {
            __builtin_amdgcn_fence(__ATOMIC_RELEASE, "agent");
            asm volatile("s_waitcnt vmcnt(0)" ::: "memory");
            const unsigned og = xb_add(&bar[XB_TOP], 1u);
            const unsigned tg = og / nx;
            if (og + 1u == (tg + 1u) * nx) xb_add(&bar[XB_TOPGEN], 1u);
            else XB_SPIN(xb_ld(&bar[XB_TOPGEN]) == tg, bar);
            __builtin_amdgcn_fence(__ATOMIC_ACQUIRE, "agent");
            xb_add(&bar[XB_XGEN(b.x)], 1u);
            asm volatile("s_waitcnt vmcnt(0)" ::: "memory");
        } else {
            XB_SPIN(xb_ld(&bar[XB_XGEN(b.x)]) == gen, bar);
            __builtin_amdgcn_fence(__ATOMIC_ACQUIRE, "agent");
            asm volatile("s_waitcnt vmcnt(0)" ::: "memory");
        }
    }
    __syncthreads();
}

DEVI void convert_weights(const Params& p) {
    int z_; asm volatile("s_mov_b32 %0, 0" : "=s"(z_)); unsigned char* ws_ = p.ws + z_; float* out_ = p.out + z_; (void)ws_; (void)out_; KIN_DECL;
    float* tile = (float*)VSMEM;
    const int tid = tidx();
    constexpr int T_SI = (SSM_INP / 64) * (D / 64), T_SO = (D / 64) * (DI / 64), T_GI = (GLA_INP / 64) * (D / 64), T_GO = (D / 64) * (D / 64),
                  T_AQ = (QKVD / 64) * (D / 64), T_AO = (D / 64) * (ATTD / 64), T_FF = (DFF / 64) * (D / 64);
    constexpr int P0 = 2 * (T_SI + T_SO), P1 = P0 + T_GI, P2 = P1 + T_GO, P3 = P2 + T_AQ, P4 = P3 + T_AO, WT = P4 + 12 * T_FF;
    auto decode = [&](int it, WDesc& d) {
        d.gain = nullptr; d.mode = 0; d.gmod = 1 << 30;
        if (it < P0) {
            const int j = it / (T_SI + T_SO), r = it - j * (T_SI + T_SO);
            if (r < T_SI) { d.src = in_[13] + (size_t)j * D * SSM_IN; d.gain = in_[8] + j * 3 * D; d.dst = (bf16_t*)(ws_ + W_SSM_IN) + (size_t)j * SSM_INP * D; d.K = D; d.N = SSM_IN; d.tile0 = j * (T_SI + T_SO); }
            else { d.src = in_[20] + (size_t)j * DI * D; d.gain = in_[19] + j * DI; d.dst = (bf16_t*)(ws_ + W_SSM_OUT) + (size_t)j * D * DI; d.K = DI; d.N = D; d.tile0 = j * (T_SI + T_SO) + T_SI; }
        } else if (it < P1) { d.src = in_[21]; d.gain = in_[8] + D; d.dst = (bf16_t*)(ws_ + W_GLA_IN); d.K = D; d.N = GLA_IN; d.tile0 = P0; }
        else if (it < P2) { d.src = in_[25]; d.gain = in_[24]; d.gmod = 256; d.dst = (bf16_t*)(ws_ + W_GLA_OUT); d.K = D; d.N = D; d.tile0 = P1; }
        else if (it < P3) { d.src = in_[26]; d.gain = in_[8] + 2 * D; d.dst = (bf16_t*)(ws_ + W_ATT_QKV); d.K = D; d.N = QKVD; d.tile0 = P2; }
        else if (it < P4) { d.src = in_[27]; d.dst = (bf16_t*)(ws_ + W_ATT_OUT); d.K = ATTD; d.N = D; d.tile0 = P3; }
        else {
            const int q = (it - P4) / T_FF, l = q / 3, w = q - l * 3;
            d.tile0 = P4 + q * T_FF;
            if (w < 2) { d.src = (w == 0 ? in_[10] : in_[11]) + (size_t)l * D * DFF; d.gain = in_[9] + l * D; d.dst = (bf16_t*)(ws_ + W_FFN_GU) + (size_t)l * 2 * DFF * D; d.K = D; d.N = DFF; d.mode = 1 + w; }
            else { d.src = in_[12] + (size_t)l * DFF * D; d.dst = (bf16_t*)(ws_ + W_FFN_DN) + (size_t)l * D * DFF; d.K = DFF; d.N = D; }
        }
    };
    auto load_tile = [&](int it, const WDesc& d, float (&v)[16]) {
        const int lt = it - d.tile0, nkt = d.K / 64, ntile = lt / nkt, ktile = lt - ntile * nkt, n = ntile * 64 + (tid & 63), k0 = ktile * 64;
#pragma unroll
        for (int r = 0; r < 16; ++r) {
            const int kk = (tid >> 6) + 4 * r;
            float x = 0.f;
            if (n < d.N) { x = __builtin_nontemporal_load(d.src + (size_t)(k0 + kk) * d.N + n); if (d.gain) x *= d.gain[(k0 + kk) & (d.gmod - 1)]; }
            v[r] = x;
        }
    };
    int it = bidx(); bool have = it < WT;
    WDesc d; float v[16];
    if (have) { decode(it, d); load_tile(it, d, v); }
    while (have) {
        const int itn = it + VGRID; const bool hn = itn < WT;
        WDesc dn = d; float vn[16];
        if (hn) { decode(itn, dn); load_tile(itn, dn, vn); }
        __syncthreads();
#pragma unroll
        for (int r = 0; r < 16; ++r) tile[((tid >> 6) + 4 * r) * 65 + (tid & 63)] = v[r];
        __syncthreads();
        {
            const int lt = it - d.tile0, nkt = d.K / 64, ntile = lt / nkt, ktile = lt - ntile * nkt, n0 = ntile * 64, k0 = ktile * 64;
            const int r = tid >> 2, seg = tid & 3, n = n0 + r;
            int drow = n;
            if (d.mode) { const int t = n >> 7, c = n & 127; drow = t * 256 + (d.mode == 2 ? 128 : 0) + c; }
            unsigned w[8];
#pragma unroll
            for (int e = 0; e < 8; ++e) w[e] = pack2(tile[(seg * 16 + 2 * e) * 65 + r], tile[(seg * 16 + 2 * e + 1) * 65 + r]);
            uint4* dp = (uint4*)(d.dst + (size_t)drow * d.K + k0 + seg * 16);
            dp[0] = make_uint4(w[0], w[1], w[2], w[3]); dp[1] = make_uint4(w[4], w[5], w[6], w[7]);
        }
        it = itn; have = hn; d = dn;
#pragma unroll
        for (int r = 0; r < 16; ++r) v[r] = vn[r];
    }
}

DEVI void copy_caches(const Params& p) {
    int z_; asm volatile("s_mov_b32 %0, 0" : "=s"(z_)); unsigned char* ws_ = p.ws + z_; float* out_ = p.out + z_; (void)ws_; (void)out_; KIN_DECL;
    const unsigned gtid = (unsigned)(bidx() * 256 + tidx()), gsz = (unsigned)(VGRID * 256);
#pragma unroll
    for (int g = 0; g < 3; ++g) {
        const unsigned W = g == 0 ? 128u : (g == 1 ? 512u : 2048u);
        const unsigned per = (W - 4u) * 128u, tot = 32u * per;
        const f32x4* src = (const f32x4*)(g == 0 ? in_[5] : (g == 1 ? in_[6] : in_[7]));
        f32x4* dst = (f32x4*)(out_ + (g == 0 ? O_KV0S : (g == 1 ? O_KV1S : O_KV2S)));
        for (unsigned base = gtid; base < tot; base += 8u * gsz) {
            f32x4 v[8]; unsigned di[8];
#pragma unroll
            for (int u = 0; u < 8; ++u) {
                const unsigned i = base + (unsigned)u * gsz, ic = i < tot ? i : tot - 1u, sb = ic / per, rem = ic - sb * per;
                di[u] = sb * W * 128u + rem;
                v[u] = __builtin_nontemporal_load(src + (sb * W + 4u) * 128u + rem);
            }
#pragma unroll
            for (int u = 0; u < 8; ++u) if (base + (unsigned)u * gsz < tot) __builtin_nontemporal_store(v[u], dst + di[u]);
        }
    }
}

DEVI void norm_phase(const Params& p, int mode) {
    int z_; asm volatile("s_mov_b32 %0, 0" : "=s"(z_)); unsigned char* ws_ = p.ws + z_; float* out_ = p.out + z_; (void)ws_; (void)out_; KIN_DECL;
    const int lane = tidx() & 63, wv = (bidx() * 256 + tidx()) >> 6, nw = (VGRID * 256) >> 6;
    float* X = out_;
    bf16_t* Hb = (bf16_t*)(ws_ + B_HB);
    for (int r0 = wv; r0 < T; r0 += 2 * nw) {
        const int r1 = r0 + nw; const bool h1 = r1 < T; const int rr[2] = {r0, h1 ? r1 : r0};
        float4 v[2][4]; float ss[2] = {0.f, 0.f};
#pragma unroll
        for (int k = 0; k < 2; ++k) {
            const int r = rr[k];
            const float* src = mode == 0 ? (r < TP ? in_[0] + (size_t)r * D : in_[1] + (size_t)(r - TP) * D) : X + (size_t)r * D;
#pragma unroll
            for (int i = 0; i < 4; ++i) v[k][i] = ((const float4*)src)[i * 64 + lane];
        }
#pragma unroll
        for (int k = 0; k < 2; ++k) {
#pragma unroll
            for (int i = 0; i < 4; ++i) ss[k] += v[k][i].x * v[k][i].x + v[k][i].y * v[k][i].y + v[k][i].z * v[k][i].z + v[k][i].w * v[k][i].w;
            ss[k] = wave_sum(ss[k]);
        }
#pragma unroll
        for (int k = 0; k < 2; ++k) {
            if (k == 1 && !h1) break;
            const int r = rr[k];
            const float inv = rsqrtf(ss[k] * (1.f / D) + EPS);
            if (mode == 2) {
                const float4* g = (const float4*)in_[28];
#pragma unroll
                for (int i = 0; i < 4; ++i) { float4 gg = g[i * 64 + lane]; ((float4*)(X + (size_t)r * D))[i * 64 + lane] = make_float4(v[k][i].x * inv * gg.x, v[k][i].y * inv * gg.y, v[k][i].z * inv * gg.z, v[k][i].w * inv * gg.w); }
            } else {
#pragma unroll
                for (int i = 0; i < 4; ++i) {
                    if (mode == 0 && r >= TP) ((float4*)(X + (size_t)r * D))[i * 64 + lane] = v[k][i];
                    ((uint2*)(Hb + (size_t)r * D))[i * 64 + lane] = make_uint2(pack2(v[k][i].x * inv, v[k][i].y * inv), pack2(v[k][i].z * inv, v[k][i].w * inv));
                }
            }
        }
    }
}

enum { EPI_SSM_IN = 0, EPI_GLA_IN = 1, EPI_ATT_IN = 2, EPI_RESADD = 3, EPI_SWIGLU = 4 };
constexpr int GST = 72;
constexpr int GBUF = 2 * 128 * GST;

template <int EPI, int K>
DEVI void gemm_phase(const Params& p, const bf16_t* __restrict__ A, const bf16_t* __restrict__ Bt, int nN, bool only_split = false) {
    int z_; asm volatile("s_mov_b32 %0, 0" : "=s"(z_)); unsigned char* ws_ = p.ws + z_; float* out_ = p.out + z_; (void)ws_; (void)out_; KIN_DECL;
    const int tid = rtid(), lane = tid & 63, wave = tid >> 6, wm = wave >> 2, wn = wave & 3, l31 = lane & 31, lh = lane >> 5;
    constexpr int SBUF = 2 * 256 * GST;
    bf16_t* const s0 = (bf16_t*)smem;
    constexpr int nkfull = K / 64, KCH = 2;
    const int nMt = (EPI == EPI_RESADD) ? 64 : 65;
    const int nfull = nMt * nN, nch = (EPI == EPI_RESADD) ? (nkfull + KCH - 1) / KCH : 0, nunits = nfull + nch * nN;
    const int bid = rbid(), xcd = bid & 7, lb = bid >> 3, nper = (int)gridDim.x >> 3;
    const int u0 = only_split ? nfull : 0;
    for (int rnd = 0; u0 + rnd * (int)gridDim.x < nunits; ++rnd) {
        const int u = u0 + (rnd * 8 + xcd) * nper + lb;
        if (u >= nunits) continue;
        int mt, nt, kt0, kt1; bool atomic = false;
        if (u < nfull) {
            const int per_group = 8 * nN, gm = u / per_group, rem = u - gm * per_group, fm = gm * 8, gsz = (nMt - fm) < 8 ? (nMt - fm) : 8;
            mt = fm + rem % gsz; nt = rem / gsz; kt0 = 0; kt1 = nkfull;
        } else {
            const int v = u - nfull, ch = v / nN; mt = 64; nt = v - ch * nN; kt0 = ch * KCH; kt1 = (kt0 + KCH < nkfull) ? kt0 + KCH : nkfull; atomic = true;
        }
        const int nk = kt1 - kt0;
        const char* Ab = (const char*)A + (size_t)kt0 * 128; const char* Bb = (const char*)(Bt + (size_t)nt * 256 * K) + (size_t)kt0 * 128;
        unsigned aoff[4];
#pragma unroll
        for (int i = 0; i < 4; ++i) { int gr = mt * 256 + (tid >> 3) + 64 * i; gr = gr < T ? gr : T - 1; aoff[i] = (unsigned)gr * (unsigned)(K * 2) + (unsigned)((tid & 7) * 16); }
        const unsigned boff = (unsigned)(tid >> 3) * (unsigned)(K * 2) + (unsigned)((tid & 7) * 16);
        const unsigned lso = (unsigned)((tid >> 3) * GST + (tid & 7) * 8);
        f32x16 acc[4][2];
#pragma unroll
        for (int i = 0; i < 4; ++i)
#pragma unroll
            for (int j = 0; j < 2; ++j)
#pragma unroll
                for (int e = 0; e < 16; ++e) acc[i][j][e] = 0.f;
        u32x4 ra[4], rb[4];
#define G_LOAD(KT) { const int kk_ = (KT) < nk ? (KT) : nk - 1; const char* ab_ = Ab + (size_t)kk_ * 128; const char* bb_ = Bb + (size_t)kk_ * 128; \
            _Pragma("unroll") for (int i = 0; i < 4; ++i) ra[i] = *(const u32x4*)(ab_ + aoff[i]); \
            _Pragma("unroll") for (int i = 0; i < 4; ++i) rb[i] = *(const u32x4*)(bb_ + (size_t)i * 128 * K + boff); }
#define G_STORE(BUF) { bf16_t* sa_ = s0 + (BUF) * SBUF; bf16_t* sb_ = sa_ + 256 * GST; \
            _Pragma("unroll") for (int i = 0; i < 4; ++i) *(u32x4*)(sa_ + lso + i * 64 * GST) = ra[i]; \
            _Pragma("unroll") for (int i = 0; i < 4; ++i) *(u32x4*)(sb_ + lso + i * 64 * GST) = rb[i]; }
        __syncthreads();
        G_LOAD(0); G_STORE(0); G_LOAD(1);
        __syncthreads();
        for (int kt = 0; kt < nk; ++kt) {
            if (kt + 1 < nk) G_STORE((kt + 1) & 1);
            G_LOAD(kt + 2);
            const bf16_t* cA = s0 + (kt & 1) * SBUF; const bf16_t* cB = cA + 256 * GST;
#pragma unroll
            for (int ks = 0; ks < 4; ++ks) {
                bf16x8 a[4], b[2];
#pragma unroll
                for (int i = 0; i < 4; ++i) a[i] = ldsfrag(cA, 128 * wm + 32 * i + l31, GST, ks * 16 + 8 * lh);
#pragma unroll
                for (int j = 0; j < 2; ++j) b[j] = ldsfrag(cB, 64 * wn + 32 * j + l31, GST, ks * 16 + 8 * lh);
#pragma unroll
                for (int i = 0; i < 4; ++i)
#pragma unroll
                    for (int j = 0; j < 2; ++j) acc[i][j] = mfma32(a[i], b[j], acc[i][j]);
            }
            __syncthreads();
        }
        static_assert(EPI == EPI_RESADD, "own GEMM is only used for the residual-add phases");
        if (mt * 256 + 128 * wm < T) {
#pragma unroll
            for (int i = 0; i < 4; ++i)
#pragma unroll
                for (int j = 0; j < 2; ++j)
#pragma unroll
                    for (int e = 0; e < 16; ++e) {
                        const int row = mt * 256 + 128 * wm + 32 * i + (e & 3) + 8 * (e >> 2) + 4 * lh, col = nt * 256 + 64 * wn + 32 * j + l31;
                        if (row < T) {
                            float* xf = out_ + (size_t)row * D + col;
                            if (atomic) unsafeAtomicAdd(xf, acc[i][j][e]); else *xf += acc[i][j][e];
                        }
                    }
        }
    }
    __syncthreads();
}


namespace pg8 {
#define PG8_LAS __attribute__((address_space(3)))
constexpr int BM = 256, BK = 64, HALF = 128, HTB = HALF * BK * 2  , STAGE_BYTES = 8 * HTB, NXCD = 8, WGM = 8;

__host__ __device__ __forceinline__ int lds_byte(int r, int c) { const int st = (r >> 4) * 2 + (c >> 5), rr = r & 15, cc = c & 31, ob = rr * 64 + cc * 2; return st * 1024 + (ob ^ (((ob >> 9) & 1) << 5)); }
__host__ __device__ __forceinline__ void stage_rc(int b, int& R, int& C) { const int st = b / 1024, sb = b % 1024, swz = sb ^ (((sb >> 9) & 1) << 5); R = (st >> 1) * 16 + swz / 64; C = (st & 1) * 32 + (swz % 64) / 2; }
__host__ __device__ __forceinline__ int perm32(int rho) { const int n = rho >> 4, i = rho & 15; return 8 * (i >> 2) + 4 * n + (i & 3); }

struct Unit { int pm, pn; };
struct Gemm { const bf16_t* A; const bf16_t* Bt; int M, N, K; };
struct StaticOrder {
    int nM, nN, nwg, G, c;
    __host__ __device__ void init(int M, int N, int G_, int c_) { nM = M / BM; nN = N / BM; nwg = nM * nN; G = G_; c = c_; }
    __host__ __device__ bool next(int i, Unit& u) const {
        const long L = (long)i * G + c; if (L >= nwg) return false;
        int wgid = (int)L; { const int q = nwg / NXCD, r = nwg % NXCD, xcd = wgid % NXCD, off = wgid / NXCD; wgid = (xcd < r ? xcd * (q + 1) : r * (q + 1) + (xcd - r) * q) + off; }
        const int nig = WGM * nN, gid = wgid / nig, fm = gid * WGM, gsz = (nM - fm) < WGM ? (nM - fm) : WGM;
        u.pm = fm + ((wgid % nig) % gsz); u.pn = (wgid % nig) / gsz; return true;
    }
    __device__ __forceinline__ void a_ready(const Unit&) const {}
    __device__ __forceinline__ void done(const Unit&) const {}
};
template <class Epi, class Sched, bool STAMP = false>
__device__ __forceinline__ void gemm_phase(PG8_LAS unsigned char* lds, const Gemm g, const Sched& S, const Epi& E, unsigned long long* stamps) {
    const int tid = rtid(), wid = __builtin_amdgcn_readfirstlane(tid >> 6), lane = tid & 63, wr = wid >> 2, wc = wid & 3, fr = lane & 15, fq = lane >> 4;
    const int K = g.K, nt = K / BK;
    int ts_lo = 0, ts_hi = 0, nts = 0; const unsigned long long rt_entry = STAMP ? (unsigned long long)0ull : 0ull;
#define PG8_STAMP() do { if (STAMP && wid == 0 && nts < 64) { const unsigned long long _c = (unsigned long long)clock64(); \
        ts_lo = (lane == nts) ? (int)(unsigned)_c : ts_lo; ts_hi = (lane == nts) ? (int)(unsigned)(_c >> 32) : ts_hi; ++nts; } } while (0)
    PG8_STAMP();
    unsigned voffA[2], voffB[2];
#pragma unroll
    for (int i = 0; i < 2; ++i) { int R, C; stage_rc(tid * 16 + i * 8192, R, C); const int Rb = Epi::PERM ? ((R & ~31) + perm32(R & 31)) : R;
        voffA[i] = (unsigned)(R * K + C) * 2u; voffB[i] = (unsigned)(Rb * K + C) * 2u; }
    const size_t kstep = (size_t)(BK * 2);
    const size_t hstep = (size_t)HALF * K * 2;
    const size_t tstep = 2 * hstep;
    const unsigned ldsw = (unsigned)wid * 1024u;
    const int aoff = lds_byte(wr * 64 + fr, fq * 8), boff = lds_byte(wc * 32 + fr, fq * 8);
#define PG8_SA(b, h) (((b) * 2 + (h)) * HTB)
#define PG8_SB(b, h) ((4 + (b) * 2 + (h)) * HTB)
#define PG8_STAGE(bufoff, gbase, voff) do { _Pragma("unroll") for (int _i = 0; _i < 2; ++_i) \
        __builtin_amdgcn_global_load_lds((const unsigned*)((const char*)(gbase) + (voff)[_i]), (PG8_LAS unsigned*)(lds + (bufoff) + ldsw + _i * 8192), 16, 0, 0); } while (0)
#define PG8_LDA(dst, b, h) do { _Pragma("unroll") for (int m = 0; m < 4; ++m) _Pragma("unroll") for (int k = 0; k < 2; ++k) dst[m][k] = *(const PG8_LAS bf16x8*)(lds + PG8_SA(b, h) + aoff + m * 2048 + k * 1024); } while (0)
#define PG8_LDB(dst, b, h) do { _Pragma("unroll") for (int n = 0; n < 2; ++n) _Pragma("unroll") for (int k = 0; k < 2; ++k) dst[n][k] = *(const PG8_LAS bf16x8*)(lds + PG8_SB(b, h) + boff + n * 2048 + k * 1024); } while (0)
#define PG8_MMA(ai, bj, At, Bt) do { __builtin_amdgcn_s_setprio(1); _Pragma("unroll") for (int m = 0; m < 4; ++m) _Pragma("unroll") for (int n = 0; n < 2; ++n) _Pragma("unroll") for (int k = 0; k < 2; ++k) \
        acc[ai][bj][m][n] = __builtin_amdgcn_mfma_f32_16x16x32_bf16(Bt[n][k], At[m][k], acc[ai][bj][m][n], 0, 0, 0); __builtin_amdgcn_s_setprio(0); } while (0)
#define PG8_WAIT_V(n) asm volatile("s_waitcnt vmcnt(" #n ")" ::: "memory")
#define PG8_WAIT_L(n) asm volatile("s_waitcnt lgkmcnt(" #n ")" ::: "memory")
#define PG8_BAR __builtin_amdgcn_s_barrier()
#define PG8_SCHED __builtin_amdgcn_sched_barrier(0)
    Unit cur, nxt; int ui = 0;
    if (!S.next(0, cur)) return;
    f32x4 acc[2][2][4][2];
#pragma unroll
    for (int a = 0; a < 2; ++a)
#pragma unroll
        for (int b = 0; b < 2; ++b)
#pragma unroll
            for (int m = 0; m < 4; ++m)
#pragma unroll
                for (int n = 0; n < 2; ++n) acc[a][b][m][n] = (f32x4){0.f, 0.f, 0.f, 0.f};
    bf16x8 At[4][2], B0[2][2], B1[2][2];
    const char* cA = (const char*)g.A + (size_t)cur.pm * tstep; const char* cB = (const char*)g.Bt + (size_t)cur.pn * tstep;
    S.a_ready(cur);
    PG8_STAGE(PG8_SB(0, 0), cB, voffB); PG8_STAGE(PG8_SA(0, 0), cA, voffA); PG8_STAGE(PG8_SB(0, 1), cB + hstep, voffB); PG8_STAGE(PG8_SA(0, 1), cA + hstep, voffA);
    if (wr == 1) PG8_BAR;
    PG8_WAIT_V(4); PG8_BAR;
    PG8_STAGE(PG8_SB(1, 0), cB + kstep, voffB); PG8_STAGE(PG8_SA(1, 0), cA + kstep, voffA); PG8_STAGE(PG8_SB(1, 1), cB + hstep + kstep, voffB);
    PG8_WAIT_V(6); PG8_BAR;
    PG8_STAMP();
    for (;;) {
        const bool has_next = S.next(ui + 1, nxt);
        const char* nA = has_next ? (const char*)g.A + (size_t)nxt.pm * tstep : cA; const char* nB = has_next ? (const char*)g.Bt + (size_t)nxt.pn * tstep : cB;
        for (int t = 0; t < nt; t += 2) {
            const bool last = (t == nt - 2);
            const char* a1 = cA + (size_t)(t + 1) * kstep;
            const char* a2 = last ? nA : cA + (size_t)(t + 2) * kstep; const char* b2 = last ? nB : cB + (size_t)(t + 2) * kstep;
            const char* a3 = a2 + kstep; const char* b3 = b2 + kstep;
            if (last && has_next) S.a_ready(nxt);
            PG8_LDB(B0, 0, 0); PG8_SCHED; PG8_LDA(At, 0, 0); PG8_STAGE(PG8_SA(1, 1), a1 + hstep, voffA);
            PG8_WAIT_L(8); PG8_BAR; PG8_WAIT_L(0); PG8_MMA(0, 0, At, B0); PG8_BAR; PG8_SCHED;
            PG8_LDB(B1, 0, 1); PG8_STAGE(PG8_SB(0, 0), b2, voffB);
            PG8_BAR; PG8_WAIT_L(0); PG8_MMA(0, 1, At, B1); PG8_BAR;
            PG8_LDA(At, 0, 1); PG8_STAGE(PG8_SA(0, 0), a2, voffA);
            PG8_BAR; PG8_WAIT_L(0); PG8_MMA(1, 0, At, B0); PG8_BAR; PG8_SCHED;
            PG8_STAGE(PG8_SB(0, 1), b2 + hstep, voffB);
            PG8_WAIT_V(6); PG8_BAR; PG8_MMA(1, 1, At, B1); PG8_BAR;
            PG8_LDB(B0, 1, 0); PG8_SCHED; PG8_LDA(At, 1, 0); PG8_STAGE(PG8_SA(0, 1), a2 + hstep, voffA);
            PG8_WAIT_L(8); PG8_BAR; PG8_WAIT_L(0); PG8_MMA(0, 0, At, B0); PG8_BAR; PG8_SCHED;
            PG8_LDB(B1, 1, 1); PG8_STAGE(PG8_SB(1, 0), b3, voffB);
            PG8_BAR; PG8_WAIT_L(0); PG8_MMA(0, 1, At, B1); PG8_BAR;
            PG8_LDA(At, 1, 1); PG8_STAGE(PG8_SA(1, 0), a3, voffA);
            PG8_BAR; PG8_WAIT_L(0); PG8_MMA(1, 0, At, B0); PG8_BAR; PG8_SCHED;
            PG8_STAGE(PG8_SB(1, 1), b3 + hstep, voffB);
            PG8_WAIT_V(6); PG8_BAR; PG8_MMA(1, 1, At, B1); PG8_BAR;
        }
        PG8_STAMP();
        if constexpr (!Epi::AFTER_DRAIN) { E(acc, cur, wr, wc, fr, fq); S.done(cur); }
        PG8_STAMP();
        if (!has_next) break;
#pragma unroll
        for (int a = 0; a < 2; ++a)
#pragma unroll
            for (int b = 0; b < 2; ++b)
#pragma unroll
                for (int m = 0; m < 4; ++m)
#pragma unroll
                    for (int n = 0; n < 2; ++n) acc[a][b][m][n] = (f32x4){0.f, 0.f, 0.f, 0.f};
        cur = nxt; cA = nA; cB = nB; ++ui;
    }
    PG8_WAIT_V(0);
    if (wr == 0) PG8_BAR;
    PG8_BAR;
    if constexpr (Epi::AFTER_DRAIN) { E.fused(acc, cur, wr, wc, fr, fq, lds, wid, lane); S.done(cur); }
    PG8_STAMP();
    if (STAMP && wid == 0) { stamps[lane] = lane < nts ? (((unsigned long long)(unsigned)ts_hi << 32) | (unsigned)ts_lo) : 0ull;
        if (lane == 62) stamps[62] = rt_entry; if (lane == 63) stamps[63] = (unsigned long long)0ull; }
#undef PG8_STAMP
#undef PG8_SA
#undef PG8_SB
#undef PG8_STAGE
#undef PG8_LDA
#undef PG8_LDB
#undef PG8_MMA
#undef PG8_WAIT_V
#undef PG8_WAIT_L
#undef PG8_BAR
#undef PG8_SCHED
}
}

template <int EPI> struct EpiMk {
    static constexpr bool PERM = (EPI == EPI_SSM_IN || EPI == EPI_GLA_IN || EPI == EPI_ATT_IN || EPI == EPI_SWIGLU), AFTER_DRAIN = false;
    unsigned char* ws; float* out; const float* xin;
    DEVI void operator()(const f32x4 (&acc)[2][2][4][2], const pg8::Unit& u, int wr, int wc, int fr, int fq) const {
        const int row0 = u.pm * 256 + wr * 64 + fr, col0 = u.pn * 256 + wc * 32 + 4 * fq;
#pragma unroll
        for (int ai = 0; ai < 2; ++ai)
#pragma unroll
            for (int m = 0; m < 4; ++m) {
                const int row = row0 + ai * 128 + m * 16;
                if (row < T) {
                    if (EPI == EPI_SWIGLU) {
                        const int hc = u.pn * 128 + wc * 32 + 8 * fq;
                        unsigned w[4];
#pragma unroll
                        for (int n = 0; n < 2; ++n) {
                            const f32x4 g = acc[ai][0][m][n], up = acc[ai][1][m][n];
                            float o[4];
#pragma unroll
                            for (int e = 0; e < 4; ++e) o[e] = g[e] * __builtin_amdgcn_rcpf(1.f + __expf(-g[e])) * up[e];
                            w[2 * n] = pack2(o[0], o[1]); w[2 * n + 1] = pack2(o[2], o[3]);
                        }
                        *(uint4*)((bf16_t*)(ws + B_R4) + (size_t)row * DFF + hc) = make_uint4(w[0], w[1], w[2], w[3]);
                    } else
#pragma unroll
                    for (int bj = 0; bj < 2; ++bj) {
                        if (PERM) {
                            const int col = u.pn * 256 + bj * 128 + wc * 32 + 8 * fq;
                            const f32x4 v0 = acc[ai][bj][m][0], v1 = acc[ai][bj][m][1];
                            const uint4 pk = make_uint4(pack2(v0[0], v0[1]), pack2(v0[2], v0[3]), pack2(v1[0], v1[1]), pack2(v1[2], v1[3]));
                            if (EPI == EPI_SSM_IN) {
                                if (col < DI) *(uint4*)((bf16_t*)(ws + B_R3) + (size_t)row * DI + col) = pk;
                                else if (col < DI + CONVD) *(uint4*)((bf16_t*)(ws + B_R4) + (size_t)row * CONVD + (col - DI)) = pk;
                                else if (col < SSM_IN) { float4* dp = (float4*)((float*)(ws + B_DT) + (size_t)row * 32 + (col - DI - CONVD)); dp[0] = make_float4(v0[0], v0[1], v0[2], v0[3]); dp[1] = make_float4(v1[0], v1[1], v1[2], v1[3]); }
                            } else if (EPI == EPI_GLA_IN) {
                                if (col < 3072) *(uint4*)((bf16_t*)(ws + B_R4) + (size_t)row * 3072 + col) = pk;
                                else if (col < GLA_IN) { float4* dp = (float4*)((float*)(ws + B_GLOW) + (size_t)row * 16 + (col - 3072)); dp[0] = make_float4(v0[0], v0[1], v0[2], v0[3]); dp[1] = make_float4(v1[0], v1[1], v1[2], v1[3]); }
                            } else {
                                *(uint4*)((bf16_t*)(ws + B_R4) + (size_t)row * QKVD + col) = pk;
                            }
                        } else if (EPI == EPI_SWIGLU) {
                            const f32x4 g = acc[ai][bj][m][0], up = acc[ai][bj][m][1];
                            const int hc = u.pn * 128 + bj * 64 + wc * 16 + 4 * fq;
                            float o[4];
#pragma unroll
                            for (int e = 0; e < 4; ++e) o[e] = g[e] * __builtin_amdgcn_rcpf(1.f + __expf(-g[e])) * up[e];
                            *(uint2*)((bf16_t*)(ws + B_R4) + (size_t)row * DFF + hc) = make_uint2(pack2(o[0], o[1]), pack2(o[2], o[3]));
                        } else {
#pragma unroll
                            for (int n = 0; n < 2; ++n) {
                                const int col = col0 + bj * 128 + n * 16;
                                const f32x4 v = acc[ai][bj][m][n];
                                if (EPI == EPI_RESADD) {
                                    float4* xp = (float4*)(out + (size_t)row * D + col);
                                    float4 x = xin ? *(const float4*)(xin + (size_t)row * D + col) : *xp; x.x += v[0]; x.y += v[1]; x.z += v[2]; x.w += v[3]; *xp = x;
                                } else if (EPI == EPI_SSM_IN) {
                                    const uint2 pk = make_uint2(pack2(v[0], v[1]), pack2(v[2], v[3]));
                                    if (col < DI) *(uint2*)((bf16_t*)(ws + B_R3) + (size_t)row * DI + col) = pk;
                                    else if (col < DI + CONVD) *(uint2*)((bf16_t*)(ws + B_R4) + (size_t)row * CONVD + (col - DI)) = pk;
                                    else if (col < SSM_IN) *(float4*)((float*)(ws + B_DT) + (size_t)row * 32 + (col - DI - CONVD)) = make_float4(v[0], v[1], v[2], v[3]);
                                } else if (EPI == EPI_GLA_IN) {
                                    if (col < 3072) *(uint2*)((bf16_t*)(ws + B_R4) + (size_t)row * 3072 + col) = make_uint2(pack2(v[0], v[1]), pack2(v[2], v[3]));
                                    else if (col < GLA_IN) *(float4*)((float*)(ws + B_GLOW) + (size_t)row * 16 + (col - 3072)) = make_float4(v[0], v[1], v[2], v[3]);
                                } else {
                                    *(uint2*)((bf16_t*)(ws + B_R4) + (size_t)row * QKVD + col) = make_uint2(pack2(v[0], v[1]), pack2(v[2], v[3]));
                                }
                            }
                        }
                    }
                }
            }
    }
};

template <int EPI>
DEVI void gemm8(const Params& p, const bf16_t* A, const bf16_t* Bt, int Mrows, int N, int K, const float* xin = nullptr) {
    int z_; asm volatile("s_mov_b32 %0, 0" : "=s"(z_));
    EpiMk<EPI> E; E.ws = p.ws + z_; E.out = p.out + z_; E.xin = xin;
    pg8::Gemm g; g.A = A + z_; g.Bt = Bt + z_; g.M = Mrows; g.N = N; g.K = K;
    pg8::StaticOrder S; S.init(Mrows, N, (int)gridDim.x, rbid());
    __syncthreads();
    pg8::gemm_phase<EpiMk<EPI>, pg8::StaticOrder, false>((PG8_LAS unsigned char*)smem, g, S, E, nullptr);
    __syncthreads();
}

DEVI void ssm_conv_phase(const Params& p, int j) {
    int z_; asm volatile("s_mov_b32 %0, 0" : "=s"(z_)); unsigned char* ws_ = p.ws + z_; float* out_ = p.out + z_; (void)ws_; (void)out_; KIN_DECL;
    const bf16_t* raw = (const bf16_t*)(ws_ + B_R4);
    bf16_t* act = (bf16_t*)(ws_ + B_R5);
    const float* cw = in_[14] + (size_t)j * 4 * CONVD; const float* cb = in_[15] + (size_t)j * CONVD;
    const float* sbuf = in_[3] + (size_t)j * 32 * 3 * CONVD;
    float* convp = out_ + O_CONVP + (size_t)j * 2 * 3 * CONVD; float* convs = out_ + O_CONVS + (size_t)j * 32 * 3 * CONVD;
    const size_t gtid = (size_t)bidx() * 256 + tidx(), gsz = (size_t)VGRID * 256;
    {
        const size_t totp = (size_t)(TP / 16) * (CONVD / 8);
        for (size_t it = gtid; it < totp; it += gsz) {
            const int run = (int)(it / (CONVD / 8)), c8 = (int)(it % (CONVD / 8)) * 8;
            const int t0 = run * 16, pos0 = t0 & (SEQ - 1);
            float w[4][8], bb[8], x1[8], x2[8], x3[8];
#pragma unroll
            for (int d = 0; d < 4; ++d)
#pragma unroll
                for (int e = 0; e < 8; ++e) w[d][e] = cw[(size_t)d * CONVD + c8 + e];
#pragma unroll
            for (int e = 0; e < 8; ++e) bb[e] = cb[c8 + e];
            if (pos0 >= 3) {
                unpack8(*(const uint4*)(raw + (size_t)(t0 - 1) * CONVD + c8), x1); unpack8(*(const uint4*)(raw + (size_t)(t0 - 2) * CONVD + c8), x2); unpack8(*(const uint4*)(raw + (size_t)(t0 - 3) * CONVD + c8), x3);
            } else {
#pragma unroll
                for (int e = 0; e < 8; ++e) { x1[e] = 0.f; x2[e] = 0.f; x3[e] = 0.f; }
            }
#pragma unroll
            for (int r = 0; r < 16; ++r) {
                const int t = t0 + r;
                float x0[8]; unpack8(*(const uint4*)(raw + (size_t)t * CONVD + c8), x0);
                unsigned o[4];
#pragma unroll
                for (int e = 0; e < 4; ++e) {
                    const float a0 = bb[2 * e] + w[3][2 * e] * x0[2 * e] + w[2][2 * e] * x1[2 * e] + w[1][2 * e] * x2[2 * e] + w[0][2 * e] * x3[2 * e];
                    const float a1 = bb[2 * e + 1] + w[3][2 * e + 1] * x0[2 * e + 1] + w[2][2 * e + 1] * x1[2 * e + 1] + w[1][2 * e + 1] * x2[2 * e + 1] + w[0][2 * e + 1] * x3[2 * e + 1];
                    o[e] = pack2(silu_f(a0), silu_f(a1));
                }
                *(uint4*)(act + (size_t)t * CONVD + c8) = make_uint4(o[0], o[1], o[2], o[3]);
                const int pos = pos0 + r;
                if (pos >= SEQ - 3) {
                    float* op = convp + ((size_t)(t >> 13) * 3 + (pos - (SEQ - 3))) * CONVD + c8;
#pragma unroll
                    for (int e = 0; e < 8; ++e) op[e] = x0[e];
                }
#pragma unroll
                for (int e = 0; e < 8; ++e) { x3[e] = x2[e]; x2[e] = x1[e]; x1[e] = x0[e]; }
            }
        }
    }
    const size_t tot = (size_t)TS * (CONVD / 8);
    for (size_t it = gtid; it < tot; it += gsz) {
        const int t = TP + (int)(it / (CONVD / 8)), c8 = (int)(it % (CONVD / 8)) * 8;
        int pos, sb = 0; bool samp = t >= TP;
        if (samp) { sb = (t - TP) >> 2; pos = (t - TP) & 3; } else pos = t & (SEQ - 1);
        float accv[8], xr[4][8];
#pragma unroll
        for (int e = 0; e < 8; ++e) accv[e] = cb[c8 + e];
#pragma unroll
        for (int d = 0; d < 4; ++d) {
            if (pos - d >= 0) unpack8(*(const uint4*)(raw + (size_t)(t - d) * CONVD + c8), xr[d]);
            else if (samp) {
                const float* bp = sbuf + ((size_t)sb * 3 + (3 + pos - d)) * CONVD + c8;
#pragma unroll
                for (int e = 0; e < 8; ++e) xr[d][e] = bp[e];
            } else {
#pragma unroll
                for (int e = 0; e < 8; ++e) xr[d][e] = 0.f;
            }
            const float* wp = cw + (size_t)(3 - d) * CONVD + c8;
#pragma unroll
            for (int e = 0; e < 8; ++e) accv[e] += xr[d][e] * wp[e];
        }
        unsigned w[4];
#pragma unroll
        for (int e = 0; e < 4; ++e) w[e] = pack2(silu_f(accv[2 * e]), silu_f(accv[2 * e + 1]));
        *(uint4*)(act + (size_t)t * CONVD + c8) = make_uint4(w[0], w[1], w[2], w[3]);
        if (!samp && pos >= SEQ - 3) {
            float* o = convp + ((size_t)(t >> 13) * 3 + (pos - (SEQ - 3))) * CONVD + c8;
#pragma unroll
            for (int e = 0; e < 8; ++e) o[e] = xr[0][e];
        }
        if (samp && pos >= 1) {
            float* o = convs + ((size_t)sb * 3 + (pos - 1)) * CONVD + c8;
#pragma unroll
            for (int e = 0; e < 8; ++e) o[e] = xr[0][e];
        }
    }
    const float* DT = (const float*)(ws_ + B_DT); float* DTS = (float*)(ws_ + B_DTS); float* ACS = (float*)(ws_ + B_ACS);
    if (gtid < TS * 4) ((float*)(ws_ + B_SSQS))[gtid] = 0.f;
    const float* dtb = in_[16] + j * 32; const float* alog = in_[17] + j * 32;
    {
        const int lane = tidx() & 63, wv = (bidx() * 256 + tidx()) >> 6, nw = VGRID * 4;
        for (int it = wv; it < 128 * 32; it += nw) {
            const int c = it >> 5, h = it & 31;
            const float Ah = -__expf(alog[h]), bh = dtb[h];
            float carry = 0.f;
#pragma unroll
            for (int ps = 0; ps < 2; ++ps) {
                const size_t o = (size_t)(c * 128 + ps * 64 + lane) * 32 + h;
                const float d = softplus_f(DT[o] + bh); DTS[o] = d;
                float a = Ah * d;
#pragma unroll
                for (int off = 1; off < 64; off <<= 1) { const float t = __shfl_up(a, off); if (lane >= off) a += t; }
                a += carry; ACS[o] = a; carry = __shfl(a, 63);
            }
        }
    }
    for (size_t it = gtid; it < TS * 32; it += gsz) {
        const int r = (int)it, h = r & 31; const size_t o = (size_t)(TP + (r >> 5)) * 32 + h;
        const float d = softplus_f(DT[o] + dtb[h]); DTS[o] = d; ACS[o] = -__expf(alog[h]) * d;
    }
}

constexpr int SST = 136;
DEVI void ssm_state_phase(const Params& p, int j) {
    int z_; asm volatile("s_mov_b32 %0, 0" : "=s"(z_)); unsigned char* ws_ = p.ws + z_; float* out_ = p.out + z_; (void)ws_; (void)out_; KIN_DECL;
    const bf16_t* act = (const bf16_t*)(ws_ + B_R5);
    const float* DTS = (const float*)(ws_ + B_DTS); const float* ACS = (const float*)(ws_ + B_ACS);
    bf16_t* ST = (bf16_t*)(ws_ + B_R6);
    const int tid = tidx(), lane = tid & 63, wave = tid >> 6, l31 = lane & 31, lh = lane >> 5;
    bf16_t* sBt = (bf16_t*)VSMEM;
    bf16_t* sXt = sBt + 128 * SST;
    float* sw = (float*)(sXt + 64 * SST);
    const int nprompt = 128 * 4, nitems = nprompt + 32 * 32;
    for (int item = bidx(); item < nitems; item += VGRID) {
        if (item < nprompt) {
            const int c = item >> 2, g = item & 3, t0 = c * 128;
            __syncthreads();
            for (int idx = tid; idx < 128 * 16; idx += 256) {
                const int q = idx >> 4, n8 = (idx & 15) * 8;
                const uint4 v = *(const uint4*)(act + (size_t)(t0 + q) * CONVD + DI + g * 128 + n8);
                const unsigned short* s = (const unsigned short*)&v;
#pragma unroll
                for (int e = 0; e < 8; ++e) sBt[(n8 + e) * SST + q] = s[e];
            }
            for (int hh = 0; hh < 8; ++hh) {
                const int h = g * 8 + hh;
                __syncthreads();
                if (tid < 128) sw[tid] = DTS[(size_t)(t0 + tid) * 32 + h] * __expf(ACS[(size_t)(t0 + 127) * 32 + h] - ACS[(size_t)(t0 + tid) * 32 + h]);
                __syncthreads();
                for (int idx = tid; idx < 128 * 8; idx += 256) {
                    const int q = idx >> 3, p8 = (idx & 7) * 8;
                    float f[8]; unpack8(*(const uint4*)(act + (size_t)(t0 + q) * CONVD + h * 64 + p8), f);
                    const float w = sw[q];
#pragma unroll
                    for (int e = 0; e < 8; ++e) sXt[(p8 + e) * SST + q] = f2bf(f[e] * w);
                }
                __syncthreads();
                f32x16 acc[2];
#pragma unroll
                for (int i = 0; i < 2; ++i)
#pragma unroll
                    for (int e = 0; e < 16; ++e) acc[i][e] = 0.f;
#pragma unroll
                for (int ks = 0; ks < 8; ++ks) {
                    const bf16x8 a = ldsfrag(sBt, 32 * wave + l31, SST, ks * 16 + 8 * lh);
#pragma unroll
                    for (int i = 0; i < 2; ++i) acc[i] = mfma32(a, ldsfrag(sXt, 32 * i + l31, SST, ks * 16 + 8 * lh), acc[i]);
                }
#pragma unroll
                for (int i = 0; i < 2; ++i)
#pragma unroll
                    for (int rg = 0; rg < 4; ++rg) {
                        const int n = 32 * wave + 8 * rg + 4 * lh, pp = 32 * i + l31;
                        *(uint2*)(ST + (((size_t)c * 32 + h) * 64 + pp) * 128 + n) = make_uint2(pack2(acc[i][4 * rg], acc[i][4 * rg + 1]), pack2(acc[i][4 * rg + 2], acc[i][4 * rg + 3]));
                    }
            }
        } else {
            const int sit = item - nprompt, sb = sit >> 5, h = sit & 31, g = h >> 3, pp = tid >> 2, nq = tid & 3;
            const float* st_in = in_[2] + (size_t)j * 32 * 262144; float* st_out = out_ + O_SSMS + (size_t)j * 32 * 262144;
            const bf16_t* Z = (const bf16_t*)(ws_ + B_R3); bf16_t* Y = (bf16_t*)(ws_ + B_R4);
            float* SSQS = (float*)(ws_ + B_SSQS);
            const size_t sbase = (((size_t)sb * 32 + h) * 64 + pp) * 128;
            float hs[32];
#pragma unroll
            for (int i = 0; i < 8; ++i) { const f32x4 v = __builtin_nontemporal_load((const f32x4*)(st_in + sbase + 4 * nq + 16 * i)); hs[4 * i] = v[0]; hs[4 * i + 1] = v[1]; hs[4 * i + 2] = v[2]; hs[4 * i + 3] = v[3]; }
            const float Dh = in_[18][j * 32 + h];
#pragma unroll 1
            for (int s = 0; s < 4; ++s) {
                const int tok = TP + sb * 4 + s;
                const float dt = DTS[(size_t)tok * 32 + h], dA = __expf(ACS[(size_t)tok * 32 + h]);
                const float x = bf2f(act[(size_t)tok * CONVD + h * 64 + pp]), xdt = x * dt;
                float yp = 0.f;
#pragma unroll
                for (int i = 0; i < 8; ++i) {
                    float bf[4], cf[4];
                    unpack4(*(const uint2*)(act + (size_t)tok * CONVD + DI + g * 128 + 4 * nq + 16 * i), bf);
                    unpack4(*(const uint2*)(act + (size_t)tok * CONVD + DI + 512 + g * 128 + 4 * nq + 16 * i), cf);
#pragma unroll
                    for (int e = 0; e < 4; ++e) { hs[4 * i + e] = dA * hs[4 * i + e] + xdt * bf[e]; yp += hs[4 * i + e] * cf[e]; }
                }
                yp += __shfl_xor(yp, 1); yp += __shfl_xor(yp, 2);
                const float yv = (yp + Dh * x) * silu_f(bf2f(Z[(size_t)tok * DI + h * 64 + pp]));
                if (nq == 0) Y[(size_t)tok * DI + h * 64 + pp] = f2bf(yv);
                const float tot = wave_sum(nq == 0 ? yv * yv : 0.f);
                if ((tid & 63) == 0) unsafeAtomicAdd(SSQS + (tok - TP) * 4 + g, tot);
            }
#pragma unroll
            for (int i = 0; i < 8; ++i) __builtin_nontemporal_store((f32x4){hs[4 * i], hs[4 * i + 1], hs[4 * i + 2], hs[4 * i + 3]}, (f32x4*)(st_out + sbase + 4 * nq + 16 * i));
        }
    }
}

DEVI void ssm_scan_phase(const Params& p, int j) {
    int z_; asm volatile("s_mov_b32 %0, 0" : "=s"(z_)); unsigned char* ws_ = p.ws + z_; float* out_ = p.out + z_; (void)ws_; (void)out_; KIN_DECL;
    bf16_t* ST = (bf16_t*)(ws_ + B_R6);
    const float* ACS = (const float*)(ws_ + B_ACS);
    float* outp = out_ + O_SSMP + (size_t)j * 2 * 262144;
    const int gtid = bidx() * 256 + tidx(), gsz = VGRID * 256;
    {
        bf16_t* Y = (bf16_t*)(ws_ + B_R4); const float* SSQS = (const float*)(ws_ + B_SSQS);
        for (int it = gtid; it < TS * 256; it += gsz) {
            const int tk = it >> 8, c8 = (it & 255) * 8;
            const float inv = rsqrtf(SSQS[tk * 4 + (c8 >> 9)] * (1.f / 512.f) + EPS);
            uint4* yp = (uint4*)(Y + (size_t)(TP + tk) * DI + c8);
            float f[8]; unpack8(*yp, f);
            *yp = make_uint4(pack2(f[0] * inv, f[1] * inv), pack2(f[2] * inv, f[3] * inv), pack2(f[4] * inv, f[5] * inv), pack2(f[6] * inv, f[7] * inv));
        }
    }
    for (int it = gtid; it < 2 * 32 * 2048; it += gsz) {
        const int b = it >> 16, h = (it >> 11) & 31, e4 = (it & 2047) * 4;
        float s0 = 0.f, s1 = 0.f, s2 = 0.f, s3 = 0.f;
#pragma unroll 16
        for (int cc = 0; cc < 64; ++cc) {
            const int c = b * 64 + cc;
            uint2* ptr = (uint2*)(ST + ((size_t)c * 32 + h) * 8192 + e4);
            float f[4]; unpack4(*ptr, f);
            *ptr = make_uint2(pack2(s0, s1), pack2(s2, s3));
            const float dec = __expf(ACS[(size_t)(c * 128 + 127) * 32 + h]);
            s0 = dec * s0 + f[0]; s1 = dec * s1 + f[1]; s2 = dec * s2 + f[2]; s3 = dec * s3 + f[3];
        }
        *(float4*)(outp + ((size_t)b * 32 + h) * 8192 + e4) = make_float4(s0, s1, s2, s3);
    }
}

DEVI void ssm_out_phase(const Params& p, int j) {
    int z_; asm volatile("s_mov_b32 %0, 0" : "=s"(z_)); unsigned char* ws_ = p.ws + z_; float* out_ = p.out + z_; (void)ws_; (void)out_; KIN_DECL;
    const bf16_t* act = (const bf16_t*)(ws_ + B_R5);
    const float* DTS = (const float*)(ws_ + B_DTS); const float* ACS = (const float*)(ws_ + B_ACS);
    const bf16_t* ST = (const bf16_t*)(ws_ + B_R6); const bf16_t* Z = (const bf16_t*)(ws_ + B_R3);
    bf16_t* Y = (bf16_t*)(ws_ + B_R4);
    const float* dsk = in_[18] + j * 32;
    const int tid = tidx(), lane = tid & 63, wave = tid >> 6, l31 = lane & 31, lh = lane >> 5;
    bf16_t* RA = (bf16_t*)VSMEM;
    bf16_t* RB = RA + 128 * SST;
    float* sacs = (float*)(RB + 128 * SST);
    float* sdts = sacs + 1024;
    for (int item = bidx(); item < 512; item += VGRID) {
        const int c = item >> 2, g = item & 3, t0 = c * 128;
        __syncthreads();
        for (int idx = tid; idx < 128 * 16; idx += 256) {
            const int q = idx >> 4, n8 = (idx & 15) * 8;
            *(uint4*)(RB + q * SST + n8) = *(const uint4*)(act + (size_t)(t0 + q) * CONVD + DI + g * 128 + n8);
            *(uint4*)(RA + q * SST + n8) = *(const uint4*)(act + (size_t)(t0 + q) * CONVD + DI + 512 + g * 128 + n8);
        }
        for (int idx = tid; idx < 1024; idx += 256) {
            const int hh = idx >> 7, q = idx & 127;
            sacs[idx] = ACS[(size_t)(t0 + q) * 32 + g * 8 + hh]; sdts[idx] = DTS[(size_t)(t0 + q) * 32 + g * 8 + hh];
        }
        __syncthreads();
        f32x16 X[4]; bf16x8 cf[8];
#pragma unroll
        for (int st = 0; st < 4; ++st)
#pragma unroll
            for (int e = 0; e < 16; ++e) X[st][e] = 0.f;
#pragma unroll
        for (int ks = 0; ks < 8; ++ks) {
            cf[ks] = ldsfrag(RA, 32 * wave + l31, SST, ks * 16 + 8 * lh);
#pragma unroll
            for (int st = 0; st < 4; ++st) X[st] = mfma32(ldsfrag(RB, 32 * st + l31, SST, ks * 16 + 8 * lh), cf[ks], X[st]);
        }
        const int q = 32 * wave + l31;
        float ssqk[4] = {0.f, 0.f, 0.f, 0.f};
        for (int hh = 0; hh < 8; ++hh) {
            const int h = g * 8 + hh;
            __syncthreads();
            for (int idx = tid; idx < 128 * 8; idx += 256) {
                const int s = idx >> 3, p8 = (idx & 7) * 8;
                float f[8]; unpack8(*(const uint4*)(act + (size_t)(t0 + s) * CONVD + h * 64 + p8), f);
                const float w = sdts[hh * 128 + s];
#pragma unroll
                for (int e = 0; e < 8; ++e) RA[(p8 + e) * SST + s] = f2bf(f[e] * w);
            }
            for (int idx = tid; idx < 64 * 16; idx += 256) {
                const int pp = idx >> 4, n8 = (idx & 15) * 8;
                *(uint4*)(RA + (64 + pp) * SST + n8) = *(const uint4*)(ST + (((size_t)c * 32 + h) * 64 + pp) * 128 + n8);
            }
            const float aq = sacs[hh * 128 + q];
#pragma unroll
            for (int st = 0; st < 4; ++st)
#pragma unroll
                for (int rg = 0; rg < 4; ++rg) {
                    const int s0 = 32 * st + 8 * rg + 4 * lh;
                    float m[4];
#pragma unroll
                    for (int e = 0; e < 4; ++e) { const int s = s0 + e; m[e] = (s <= q) ? X[st][4 * rg + e] * __expf(aq - sacs[hh * 128 + s]) : 0.f; }
                    *(uint2*)(RB + q * SST + s0) = make_uint2(pack2(m[0], m[1]), pack2(m[2], m[3]));
                }
            __syncthreads();
            f32x16 ad[2], ao[2];
#pragma unroll
            for (int i = 0; i < 2; ++i)
#pragma unroll
                for (int e = 0; e < 16; ++e) { ad[i][e] = 0.f; ao[i][e] = 0.f; }
#pragma unroll
            for (int ks = 0; ks < 8; ++ks) {
                const bf16x8 mb = ldsfrag(RB, q, SST, ks * 16 + 8 * lh);
#pragma unroll
                for (int i = 0; i < 2; ++i) {
                    ad[i] = mfma32(ldsfrag(RA, 32 * i + l31, SST, ks * 16 + 8 * lh), mb, ad[i]);
                    ao[i] = mfma32(ldsfrag(RA, 64 + 32 * i + l31, SST, ks * 16 + 8 * lh), cf[ks], ao[i]);
                }
            }
            const float eq = __expf(aq), Dh = dsk[h];
            float* sYw = (float*)(RB + q * SST);
#pragma unroll
            for (int i = 0; i < 2; ++i)
#pragma unroll
                for (int rg = 0; rg < 4; ++rg) {
                    f32x4 v;
#pragma unroll
                    for (int e = 0; e < 4; ++e) v[e] = ad[i][4 * rg + e] + eq * ao[i][4 * rg + e];
                    *(f32x4*)(sYw + 32 * i + 8 * rg + 4 * lh) = v;
                }
#pragma unroll
            for (int k = 0; k < 4; ++k) {
                const int qr = 32 * wave + (lane >> 3) + 8 * k, c8 = (lane & 7) * 8;
                const float* yr = (const float*)(RB + qr * SST) + c8;
                const f32x4 y0 = *(const f32x4*)yr, y1 = *(const f32x4*)(yr + 4);
                const size_t go = (size_t)(t0 + qr);
                float xf[8], zf[8], y[8];
                unpack8(*(const uint4*)(act + go * CONVD + h * 64 + c8), xf);
                unpack8(*(const uint4*)(Z + go * DI + h * 64 + c8), zf);
                float ps = 0.f;
#pragma unroll
                for (int e = 0; e < 8; ++e) { const float yr_ = e < 4 ? y0[e & 3] : y1[e & 3]; y[e] = (yr_ + Dh * xf[e]) * silu_f(zf[e]); ps += y[e] * y[e]; }
                ps += __shfl_xor(ps, 1); ps += __shfl_xor(ps, 2); ps += __shfl_xor(ps, 4);
                ssqk[k] += ps;
                *(uint4*)(Y + go * DI + h * 64 + c8) = make_uint4(pack2(y[0], y[1]), pack2(y[2], y[3]), pack2(y[4], y[5]), pack2(y[6], y[7]));
                if (k & 1) __builtin_amdgcn_sched_barrier(0);
            }
        }
#pragma unroll
        for (int k = 0; k < 4; ++k) {
            const float inv = rsqrtf(ssqk[k] * (1.f / 512.f) + EPS);
            const int qr = 32 * wave + (lane >> 3) + 8 * k, c8 = (lane & 7) * 8;
            const size_t go = (size_t)(t0 + qr);
            for (int hh = 0; hh < 8; ++hh) {
                uint4* yp = (uint4*)(Y + go * DI + (g * 8 + hh) * 64 + c8);
                float f[8]; unpack8(*yp, f);
                *yp = make_uint4(pack2(f[0] * inv, f[1] * inv), pack2(f[2] * inv, f[3] * inv), pack2(f[4] * inv, f[5] * inv), pack2(f[6] * inv, f[7] * inv));
            }
        }
    }
}

constexpr int GCH = 64;
DEVI void gla_gate_phase(const Params& p) {
    int z_; asm volatile("s_mov_b32 %0, 0" : "=s"(z_)); unsigned char* ws_ = p.ws + z_; float* out_ = p.out + z_; (void)ws_; (void)out_; KIN_DECL;
    const float* GLOW = (const float*)(ws_ + B_GLOW); float* BC = (float*)(ws_ + B_HB);
    const float* wg = in_[22]; const float* gb = in_[23];
    const int tid = tidx();
    const int nitems = TP / GCH + 32;
    for (int item = bidx(); item < nitems; item += VGRID) {
        int t0, len;
        if (item < TP / GCH) { t0 = item * GCH; len = GCH; } else { t0 = TP + (item - TP / GCH) * 4; len = 4; }
        float w0[16], w1[16];
#pragma unroll
        for (int r = 0; r < 16; ++r) { w0[r] = wg[r * 512 + tid]; w1[r] = wg[r * 512 + 256 + tid]; }
        const float b0 = gb[tid], b1 = gb[256 + tid];
        float* sg = (float*)VSMEM;
        __syncthreads();
        if (tid * 4 < len * 16) *(float4*)(sg + tid * 4) = *(const float4*)(GLOW + (size_t)t0 * 16 + tid * 4);
        __syncthreads();
        float r0 = 0.f, r1 = 0.f;
        for (int q = 0; q < len; ++q) {
            const float* gl = sg + q * 16;
            float a0 = b0, a1 = b1;
#pragma unroll
            for (int r = 0; r < 16; ++r) { const float gv = gl[r]; a0 += gv * w0[r]; a1 += gv * w1[r]; }
            r0 += logsigmoid_f(a0) * (1.f / 16.f); r1 += logsigmoid_f(a1) * (1.f / 16.f);
            BC[(size_t)(t0 + q) * 512 + tid] = r0; BC[(size_t)(t0 + q) * 512 + 256 + tid] = r1;
        }
    }
}

constexpr int QST = 72;
DEVI void gla_state_phase(const Params& p) {
    int z_; asm volatile("s_mov_b32 %0, 0" : "=s"(z_)); unsigned char* ws_ = p.ws + z_; float* out_ = p.out + z_; (void)ws_; (void)out_; KIN_DECL;
    const bf16_t* QK = (const bf16_t*)(ws_ + B_R4);
    const float* BC = (const float*)(ws_ + B_HB);
    bf16_t* U = (bf16_t*)(ws_ + B_R6);
    const int tid = tidx(), lane = tid & 63, wave = tid >> 6, l31 = lane & 31, lh = lane >> 5;
    bf16_t* sVt = (bf16_t*)VSMEM;
    bf16_t* sKt = sVt + 256 * QST;
    const int nprompt = (TP / GCH) * 4, nitems = nprompt + 128;
    for (int item = bidx(); item < nitems; item += VGRID) {
        __syncthreads();
        if (item < nprompt) {
            const int c = item >> 2, h = item & 3, t0 = c * GCH;
            for (int idx = tid; idx < GCH * 32; idx += 256) {
                const int q = idx >> 5, v8 = (idx & 31) * 8;
                const uint4 v = *(const uint4*)(QK + (size_t)(t0 + q) * 3072 + 1024 + h * 256 + v8);
                const unsigned short* s = (const unsigned short*)&v;
#pragma unroll
                for (int e = 0; e < 8; ++e) sVt[(v8 + e) * QST + q] = s[e];
            }
            for (int idx = tid; idx < GCH * 16; idx += 256) {
                const int q = idx >> 4, k8 = (idx & 15) * 8;
                float f[8]; unpack8(*(const uint4*)(QK + (size_t)(t0 + q) * 3072 + 512 + h * 128 + k8), f);
                const float* bl = BC + (size_t)(t0 + GCH - 1) * 512 + h * 128 + k8; const float* bq = BC + (size_t)(t0 + q) * 512 + h * 128 + k8;
#pragma unroll
                for (int e = 0; e < 8; ++e) sKt[(k8 + e) * QST + q] = f2bf(f[e] * __expf(bl[e] - bq[e]));
            }
            __syncthreads();
            f32x16 acc[2][4];
#pragma unroll
            for (int i = 0; i < 2; ++i)
#pragma unroll
                for (int kk = 0; kk < 4; ++kk)
#pragma unroll
                    for (int e = 0; e < 16; ++e) acc[i][kk][e] = 0.f;
#pragma unroll
            for (int ks = 0; ks < 4; ++ks) {
                bf16x8 vb[2];
#pragma unroll
                for (int i = 0; i < 2; ++i) vb[i] = ldsfrag(sVt, 64 * wave + 32 * i + l31, QST, ks * 16 + 8 * lh);
#pragma unroll
                for (int kk = 0; kk < 4; ++kk) {
                    const bf16x8 ka = ldsfrag(sKt, 32 * kk + l31, QST, ks * 16 + 8 * lh);
#pragma unroll
                    for (int i = 0; i < 2; ++i) acc[i][kk] = mfma32(ka, vb[i], acc[i][kk]);
                }
            }
#pragma unroll
            for (int i = 0; i < 2; ++i)
#pragma unroll
                for (int kk = 0; kk < 4; ++kk)
#pragma unroll
                    for (int rg = 0; rg < 4; ++rg) {
                        const int v = 64 * wave + 32 * i + l31, k = 32 * kk + 8 * rg + 4 * lh;
                        *(uint2*)(U + (((size_t)c * 4 + h) * 256 + v) * 128 + k) = make_uint2(pack2(acc[i][kk][4 * rg], acc[i][kk][4 * rg + 1]), pack2(acc[i][kk][4 * rg + 2], acc[i][kk][4 * rg + 3]));
                    }
        } else {
            const int sb = (item - nprompt) >> 2, h = (item - nprompt) & 3, v = tid;
            const float* s_in = in_[4] + ((size_t)sb * 4 + h) * 32768; float* s_out = out_ + O_GLAS + ((size_t)sb * 4 + h) * 32768;
            bf16_t* OG = (bf16_t*)(ws_ + B_R3);
            float* sq = (float*)VSMEM; float* sk = sq + 128; float* sa = sk + 128; float* red = sa + 128;
            float S[128];
#pragma unroll
            for (int k = 0; k < 128; ++k) S[k] = __builtin_nontemporal_load(s_in + (size_t)k * 256 + v);
            for (int s = 0; s < 4; ++s) {
                const int tok = TP + sb * 4 + s;
                __syncthreads();
                if (tid < 128) {
                    sq[tid] = bf2f(QK[(size_t)tok * 3072 + h * 128 + tid]) * 0.08838834764831845f;
                    sk[tid] = bf2f(QK[(size_t)tok * 3072 + 512 + h * 128 + tid]);
                    const float bcur = BC[(size_t)tok * 512 + h * 128 + tid], bprev = s ? BC[(size_t)(tok - 1) * 512 + h * 128 + tid] : 0.f;
                    sa[tid] = __expf(bcur - bprev);
                }
                __syncthreads();
                const float vv = bf2f(QK[(size_t)tok * 3072 + 1024 + h * 256 + v]);
                float o = 0.f;
#pragma unroll
                for (int k = 0; k < 128; ++k) { S[k] = sa[k] * S[k] + sk[k] * vv; o += sq[k] * S[k]; }
                red[tid] = o * o;
                __syncthreads();
                for (int st = 128; st > 0; st >>= 1) { if (tid < st) red[tid] += red[tid + st]; __syncthreads(); }
                const float inv = rsqrtf(red[0] * (1.f / 256.f) + EPS);
                const float r = bf2f(QK[(size_t)tok * 3072 + 2048 + h * 256 + v]);
                OG[(size_t)tok * D + h * 256 + v] = f2bf(o * inv * silu_f(r));
            }
#pragma unroll
            for (int k = 0; k < 128; ++k) __builtin_nontemporal_store(S[k], s_out + (size_t)k * 256 + v);
        }
    }
}

DEVI void gla_scan_phase(const Params& p) {
    int z_; asm volatile("s_mov_b32 %0, 0" : "=s"(z_)); unsigned char* ws_ = p.ws + z_; float* out_ = p.out + z_; (void)ws_; (void)out_; KIN_DECL;
    bf16_t* U = (bf16_t*)(ws_ + B_R6);
    const float* BC = (const float*)(ws_ + B_HB);
    float* outp = out_ + O_GLAP;
    const int gtid = bidx() * 256 + tidx(), gsz = VGRID * 256;
    for (int it = gtid; it < 2 * 4 * 8192; it += gsz) {
        const int b = it >> 15, h = (it >> 13) & 3, v = (it >> 5) & 255, k4 = (it & 31) * 4;
        float s0 = 0.f, s1 = 0.f, s2 = 0.f, s3 = 0.f;
#pragma unroll 16
        for (int cc = 0; cc < SEQ / GCH; ++cc) {
            const int c = b * (SEQ / GCH) + cc;
            uint2* ptr = (uint2*)(U + (((size_t)c * 4 + h) * 256 + v) * 128 + k4);
            float f[4]; unpack4(*ptr, f);
            *ptr = make_uint2(pack2(s0, s1), pack2(s2, s3));
            const float4 bl = *(const float4*)(BC + (size_t)(c * GCH + GCH - 1) * 512 + h * 128 + k4);
            s0 = __expf(bl.x) * s0 + f[0]; s1 = __expf(bl.y) * s1 + f[1]; s2 = __expf(bl.z) * s2 + f[2]; s3 = __expf(bl.w) * s3 + f[3];
        }
        float* o = outp + (((size_t)b * 4 + h) * 128 + k4) * 256 + v;
        o[0] = s0; o[256] = s1; o[512] = s2; o[768] = s3;
    }
}

DEVI void gla_out_phase(const Params& p) {
    int z_; asm volatile("s_mov_b32 %0, 0" : "=s"(z_)); unsigned char* ws_ = p.ws + z_; float* out_ = p.out + z_; (void)ws_; (void)out_; KIN_DECL;
    const bf16_t* QK = (const bf16_t*)(ws_ + B_R4);
    const float* BC = (const float*)(ws_ + B_HB);
    const bf16_t* U = (const bf16_t*)(ws_ + B_R6);
    bf16_t* OG = (bf16_t*)(ws_ + B_R3);
    const int tid = tidx(), lane = tid & 63, wave = tid >> 6, l31 = lane & 31, lh = lane >> 5;
    bf16_t* sQ = (bf16_t*)VSMEM;
    bf16_t* sK = sQ + 64 * SST;
    bf16_t* sVt = sK + 64 * SST;
    float* sred = (float*)(sVt + 256 * QST);
    const int nitems = (TP / GCH) * 4;
    for (int item = bidx(); item < nitems; item += VGRID) {
        const int c = item >> 2, h = item & 3, t0 = c * GCH;
        __syncthreads();
        for (int idx = tid; idx < GCH * 16; idx += 256) {
            const int q = idx >> 4, k8 = (idx & 15) * 8;
            float fq[8], fk[8];
            unpack8(*(const uint4*)(QK + (size_t)(t0 + q) * 3072 + h * 128 + k8), fq);
            unpack8(*(const uint4*)(QK + (size_t)(t0 + q) * 3072 + 512 + h * 128 + k8), fk);
            const float* bq = BC + (size_t)(t0 + q) * 512 + h * 128 + k8;
            unsigned wq[4], wk[4];
#pragma unroll
            for (int e = 0; e < 4; ++e) {
                const float e0 = __expf(bq[2 * e]), e1 = __expf(bq[2 * e + 1]);
                wq[e] = pack2(fq[2 * e] * e0 * 0.08838834764831845f, fq[2 * e + 1] * e1 * 0.08838834764831845f);
                wk[e] = pack2(fk[2 * e] / e0, fk[2 * e + 1] / e1);
            }
            *(uint4*)(sQ + q * SST + k8) = make_uint4(wq[0], wq[1], wq[2], wq[3]);
            *(uint4*)(sK + q * SST + k8) = make_uint4(wk[0], wk[1], wk[2], wk[3]);
        }
        for (int idx = tid; idx < GCH * 32; idx += 256) {
            const int q = idx >> 5, v8 = (idx & 31) * 8;
            const uint4 v = *(const uint4*)(QK + (size_t)(t0 + q) * 3072 + 1024 + h * 256 + v8);
            const unsigned short* s = (const unsigned short*)&v;
#pragma unroll
            for (int e = 0; e < 8; ++e) sVt[(v8 + e) * QST + q] = s[e];
        }
        __syncthreads();
        const int qt = wave & 1, stl = wave >> 1;
        f32x16 at;
#pragma unroll
        for (int e = 0; e < 16; ++e) at[e] = 0.f;
#pragma unroll
        for (int ks = 0; ks < 8; ++ks) at = mfma32(ldsfrag(sK, 32 * stl + l31, SST, ks * 16 + 8 * lh), ldsfrag(sQ, 32 * qt + l31, SST, ks * 16 + 8 * lh), at);
        f32x16 acc[2][2];
#pragma unroll
        for (int i = 0; i < 2; ++i)
#pragma unroll
            for (int jq = 0; jq < 2; ++jq)
#pragma unroll
                for (int e = 0; e < 16; ++e) acc[i][jq][e] = 0.f;
        const bf16_t* Uc = U + ((size_t)c * 4 + h) * 32768;
#pragma unroll
        for (int ks = 0; ks < 8; ++ks) {
            bf16x8 qb[2];
#pragma unroll
            for (int jq = 0; jq < 2; ++jq) qb[jq] = ldsfrag(sQ, 32 * jq + l31, SST, ks * 16 + 8 * lh);
#pragma unroll
            for (int i = 0; i < 2; ++i) {
                const bf16x8 sa = *(const bf16x8*)(Uc + (size_t)(64 * wave + 32 * i + l31) * 128 + ks * 16 + 8 * lh);
#pragma unroll
                for (int jq = 0; jq < 2; ++jq) acc[i][jq] = mfma32(sa, qb[jq], acc[i][jq]);
            }
        }
        __syncthreads();
        bf16_t* sP = sK;
        {
            const int q = 32 * qt + l31;
#pragma unroll
            for (int rg = 0; rg < 4; ++rg) {
                const int s0 = 32 * stl + 8 * rg + 4 * lh;
                float m[4];
#pragma unroll
                for (int e = 0; e < 4; ++e) m[e] = (s0 + e <= q) ? at[4 * rg + e] : 0.f;
                *(uint2*)(sP + q * QST + s0) = make_uint2(pack2(m[0], m[1]), pack2(m[2], m[3]));
            }
        }
        __syncthreads();
#pragma unroll
        for (int ks = 0; ks < 4; ++ks) {
            bf16x8 pb[2];
#pragma unroll
            for (int jq = 0; jq < 2; ++jq) pb[jq] = ldsfrag(sP, 32 * jq + l31, QST, ks * 16 + 8 * lh);
#pragma unroll
            for (int i = 0; i < 2; ++i) {
                const bf16x8 va = ldsfrag(sVt, 64 * wave + 32 * i + l31, QST, ks * 16 + 8 * lh);
#pragma unroll
                for (int jq = 0; jq < 2; ++jq) acc[i][jq] = mfma32(va, pb[jq], acc[i][jq]);
            }
        }
        float ss[2] = {0.f, 0.f};
#pragma unroll
        for (int jq = 0; jq < 2; ++jq)
#pragma unroll
            for (int i = 0; i < 2; ++i)
#pragma unroll
                for (int e = 0; e < 16; ++e) ss[jq] += acc[i][jq][e] * acc[i][jq][e];
#pragma unroll
        for (int jq = 0; jq < 2; ++jq) { ss[jq] += __shfl_xor(ss[jq], 32); if (lh == 0) sred[wave * 64 + 32 * jq + l31] = ss[jq]; }
        __syncthreads();
#pragma unroll
        for (int jq = 0; jq < 2; ++jq) {
            const int q = 32 * jq + l31;
            const float tot = sred[q] + sred[64 + q] + sred[128 + q] + sred[192 + q];
            const float inv = rsqrtf(tot * (1.f / 256.f) + EPS);
            const size_t trow = (size_t)(t0 + q);
#pragma unroll
            for (int i = 0; i < 2; ++i)
#pragma unroll
                for (int rg = 0; rg < 4; ++rg) {
                    const int vc = h * 256 + 64 * wave + 32 * i + 8 * rg + 4 * lh;
                    float rf[4]; unpack4(*(const uint2*)(QK + trow * 3072 + 2048 + vc), rf);
                    float o[4];
#pragma unroll
                    for (int e = 0; e < 4; ++e) o[e] = acc[i][jq][4 * rg + e] * inv * silu_f(rf[e]);
                    *(uint2*)(OG + trow * D + vc) = make_uint2(pack2(o[0], o[1]), pack2(o[2], o[3]));
                }
        }
    }
}

DEVI void rope_table(const Params& p) {
    int z_; asm volatile("s_mov_b32 %0, 0" : "=s"(z_)); unsigned char* ws_ = p.ws + z_;
    float* CS = (float*)(ws_ + B_ROPE);
    const int gtid = bidx() * 256 + tidx(), gsz = VGRID * 256;
    for (int it = gtid; it < (SEQ + 4) * 8; it += gsz) {
        const int pos = it >> 3, i = it & 7;
        const float fr = powf(500000.f, -(float)i * 0.125f);
        float sv, cv; sincosf((float)pos * fr, &sv, &cv);
        CS[(size_t)pos * 16 + i] = cv; CS[(size_t)pos * 16 + 8 + i] = sv;
    }
}

DEVI void att_rope_phase(const Params& p) {
    int z_; asm volatile("s_mov_b32 %0, 0" : "=s"(z_)); unsigned char* ws_ = p.ws + z_; float* out_ = p.out + z_; (void)ws_; (void)out_; KIN_DECL;
    bf16_t* QKV = (bf16_t*)(ws_ + B_R4);
    const float* CS = (const float*)(ws_ + B_ROPE);
    const int gtid = bidx() * 256 + tidx(), gsz = VGRID * 256;
    for (int it = gtid; it < T * 96; it += gsz) {
        const int t = it / 96, rem = it - t * 96, hd = rem >> 3, l8 = rem & 7, g = hd >> 2, hg = hd & 3;
        const bool samp = t >= TP;
        const int pos = samp ? SEQ + ((t - TP) & 3) : (t & (SEQ - 1));
        bf16_t* qp = QKV + (size_t)t * QKVD + hd * 64 + 8 * l8; bf16_t* kp = qp + 768; const bf16_t* vp = qp + 1536;
        float cs[8], sn[8], qf[8], kf[8], vf[8];
        unpack8(*(const uint4*)kp, kf);
        if (l8 < 2) {
            unpack8(*(const uint4*)qp, qf);
            const float4* cp = (const float4*)(CS + (size_t)pos * 16);
            const float4 c0 = cp[0], c1 = cp[1], s0 = cp[2], s1 = cp[3];
            cs[0] = c0.x; cs[1] = c0.y; cs[2] = c0.z; cs[3] = c0.w; cs[4] = c1.x; cs[5] = c1.y; cs[6] = c1.z; cs[7] = c1.w;
            sn[0] = s0.x; sn[1] = s0.y; sn[2] = s0.z; sn[3] = s0.w; sn[4] = s1.x; sn[5] = s1.y; sn[6] = s1.z; sn[7] = s1.w;
        } else {
#pragma unroll
            for (int e = 0; e < 8; ++e) { qf[e] = 0.f; cs[e] = 1.f; sn[e] = 0.f; }
        }
#pragma unroll
        for (int e = 0; e < 8; ++e) {
            const float qo = __shfl_xor(qf[e], 1), ko = __shfl_xor(kf[e], 1);
            if (l8 == 0) { qf[e] = qf[e] * cs[e] - qo * sn[e]; kf[e] = kf[e] * cs[e] - ko * sn[e]; }
            else if (l8 == 1) { qf[e] = qf[e] * cs[e] + qo * sn[e]; kf[e] = kf[e] * cs[e] + ko * sn[e]; }
        }
        if (l8 < 2) {
            *(uint4*)qp = make_uint4(pack2(qf[0], qf[1]), pack2(qf[2], qf[3]), pack2(qf[4], qf[5]), pack2(qf[6], qf[7]));
            const uint4 kw = make_uint4(pack2(kf[0], kf[1]), pack2(kf[2], kf[3]), pack2(kf[4], kf[5]), pack2(kf[6], kf[7]));
            *(uint4*)kp = kw; unpack8(kw, kf);
        }
        const int W = 128 << (2 * g);
        float* dst = nullptr;
        if (!samp) { const int b = t >> 13, tp = t & (SEQ - 1); if (tp >= SEQ - W) dst = out_ + (g == 0 ? O_KV0P : (g == 1 ? O_KV1P : O_KV2P)) + (((size_t)b * W + (tp - (SEQ - W))) * 2) * 256 + hg * 64 + 8 * l8; }
        else { const int sb = (t - TP) >> 2, sq = (t - TP) & 3; dst = out_ + (g == 0 ? O_KV0S : (g == 1 ? O_KV1S : O_KV2S)) + (((size_t)sb * W + (W - 4 + sq)) * 2) * 256 + hg * 64 + 8 * l8; }
        if (dst) {
            unpack8(*(const uint4*)vp, vf);
            ((float4*)dst)[0] = make_float4(kf[0], kf[1], kf[2], kf[3]); ((float4*)dst)[1] = make_float4(kf[4], kf[5], kf[6], kf[7]);
            ((float4*)(dst + 256))[0] = make_float4(vf[0], vf[1], vf[2], vf[3]); ((float4*)(dst + 256))[1] = make_float4(vf[4], vf[5], vf[6], vf[7]);
        }
    }
}

DEVI void att_phase(const Params& p) {
    int z_; asm volatile("s_mov_b32 %0, 0" : "=s"(z_)); unsigned char* ws_ = p.ws + z_; float* out_ = p.out + z_; (void)ws_; (void)out_; KIN_DECL;
    const bf16_t* QKV = (const bf16_t*)(ws_ + B_R4);
    bf16_t* AO = (bf16_t*)(ws_ + B_R3);
    float* LSE = (float*)(ws_ + B_DT);
    const int lane = tidx() & 63, wib = tidx() >> 6;
    const int wv = (bidx() * 256 + tidx()) >> 6, nw = (VGRID * 256) >> 6;
    float* sq = (float*)VSMEM + wib * 256;
    float* sp = sq + 64;
    for (int it = wv; it < TS * 12; it += nw) {
        const int t = TP + it / 12, hd = it % 12, g = hd >> 2, hg = hd & 3;
        const int sb = (t - TP) >> 2, s = (t - TP) & 3;
        const int d = (g == 0) ? 1 : (g == 1 ? 4 : 16), W = 128 * d;
        const float* cache = (g == 0) ? in_[5] : (g == 1 ? in_[6] : in_[7]);
        sq[lane] = bf2f(QKV[(size_t)t * QKVD + hd * 64 + lane]) * 0.125f;
        float sc[3];
#pragma unroll
        for (int r = 0; r < 3; ++r) {
            const int jj = r * 64 + lane;
            float v = -INFINITY;
            if (jj <= 128) {
                const int idx = W + s - jj * d;
                float a = 0.f;
                if (idx >= W) {
                    const bf16_t* kp = QKV + (size_t)(TP + sb * 4 + (idx - W)) * QKVD + 768 + hd * 64;
#pragma unroll
                    for (int i = 0; i < 8; ++i) { float f[8]; unpack8(*(const uint4*)(kp + 8 * i), f);
#pragma unroll
                        for (int e = 0; e < 8; ++e) a += f[e] * sq[8 * i + e]; }
                } else {
                    const float4* kp = (const float4*)(cache + (((size_t)sb * W + idx) * 2) * 256 + hg * 64);
#pragma unroll
                    for (int i = 0; i < 16; ++i) { const float4 f = kp[i]; a += f.x * sq[4 * i] + f.y * sq[4 * i + 1] + f.z * sq[4 * i + 2] + f.w * sq[4 * i + 3]; }
                }
                v = a;
            }
            sc[r] = v;
        }
        const float mx = wave_max(fmaxf(sc[0], fmaxf(sc[1], sc[2])));
        float ps = 0.f;
#pragma unroll
        for (int r = 0; r < 3; ++r) { const float e = (sc[r] == -INFINITY) ? 0.f : __expf(sc[r] - mx); sp[r * 64 + lane] = e; ps += e; }
        const float den = wave_sum(ps);
        const int jn = s / d;
        float a = 0.f;
        for (int jj = 0; jj <= jn; ++jj) a += sp[jj] * bf2f(QKV[(size_t)(TP + sb * 4 + (s - jj * d)) * QKVD + 1536 + hd * 64 + lane]);
        const float* vb = cache + (((size_t)sb * W) * 2 + 1) * 256 + hg * 64 + lane;
#pragma unroll 8
        for (int jj = jn + 1; jj <= 128; ++jj) a += sp[jj] * vb[(size_t)(W + s - jj * d) * 512];
        AO[(size_t)t * ATTD + hd * 64 + lane] = f2bf(a / den);
        if (lane == 0) LSE[(size_t)t * 12 + hd] = mx + __logf(den);
    }
}

constexpr int VST = 264;
DEVI void att_prompt_phase(const Params& p) {
    int z_; asm volatile("s_mov_b32 %0, 0" : "=s"(z_)); unsigned char* ws_ = p.ws + z_; float* out_ = p.out + z_; (void)ws_; (void)out_; KIN_DECL;
    const bf16_t* QKV = (const bf16_t*)(ws_ + B_R4);
    bf16_t* AO = (bf16_t*)(ws_ + B_R3);
    float* LSE = (float*)(ws_ + B_DT);
    const int tid = tidx(), lane = tid & 63, wave = tid >> 6, l31 = lane & 31, lh = lane >> 5;
    bf16_t* sK = (bf16_t*)VSMEM;
    bf16_t* sVt = sK + 256 * GST;
    for (int item = bidx(); item < 2 * 12 * 64; item += VGRID) {
        const int b = item / 768, hd = (item / 64) % 12, blk = item & 63, g = hd >> 2;
        const int d = (g == 0) ? 1 : (g == 1 ? 4 : 16), nbr = (SEQ / d) / 128, r = blk / nbr, u0 = (blk % nbr) * 128;
        const size_t tb = (size_t)b * SEQ + r;
        __syncthreads();
        for (int idx = tid; idx < 256 * 8; idx += 256) {
            const int kj = idx >> 3, c8 = (idx & 7) * 8, u = u0 - 128 + kj;
            u32x4 kv = {0u, 0u, 0u, 0u}, vv = {0u, 0u, 0u, 0u};
            if (u >= 0) { const bf16_t* src = QKV + (tb + (size_t)u * d) * QKVD + 768 + hd * 64 + c8; kv = *(const u32x4*)src; vv = *(const u32x4*)(src + 768); }
            *(u32x4*)(sK + kj * GST + c8) = kv;
#pragma unroll
            for (int e = 0; e < 4; ++e) { sVt[(c8 + 2 * e) * VST + kj] = (bf16_t)(vv[e] & 0xffffu); sVt[(c8 + 2 * e + 1) * VST + kj] = (bf16_t)(vv[e] >> 16); }
        }
        const int qi = 32 * wave + l31;
        const size_t tq = tb + (size_t)(u0 + qi) * d;
        bf16x8 qf[4];
#pragma unroll
        for (int ks = 0; ks < 4; ++ks) qf[ks] = *(const bf16x8*)(QKV + tq * QKVD + hd * 64 + ks * 16 + 8 * lh);
        __syncthreads();
        f32x16 S[5];
#pragma unroll
        for (int tt = 0; tt < 5; ++tt) {
#pragma unroll
            for (int e = 0; e < 16; ++e) S[tt][e] = 0.f;
#pragma unroll
            for (int ks = 0; ks < 4; ++ks) S[tt] = mfma32(ldsfrag(sK, 32 * (wave + tt) + l31, GST, ks * 16 + 8 * lh), qf[ks], S[tt]);
        }
        float mx = -INFINITY;
#pragma unroll
        for (int tt = 0; tt < 5; ++tt)
#pragma unroll
            for (int e = 0; e < 16; ++e) {
                const int kj = 32 * (wave + tt) + (e & 3) + 8 * (e >> 2) + 4 * lh;
                const bool valid = (kj >= qi) && (kj <= qi + 128) && (u0 - 128 + kj >= 0);
                const float sv = valid ? S[tt][e] * 0.125f : -INFINITY;
                S[tt][e] = sv; mx = fmaxf(mx, sv);
            }
        mx = fmaxf(mx, __shfl_xor(mx, 32));
        float den = 0.f;
#pragma unroll
        for (int tt = 0; tt < 5; ++tt)
#pragma unroll
            for (int e = 0; e < 16; ++e) { const float pe = __expf(S[tt][e] - mx); S[tt][e] = pe; den += pe; }
        den += __shfl_xor(den, 32);
        f32x16 O[2];
#pragma unroll
        for (int i = 0; i < 2; ++i)
#pragma unroll
            for (int e = 0; e < 16; ++e) O[i][e] = 0.f;
#pragma unroll
        for (int tt = 0; tt < 5; ++tt)
#pragma unroll
            for (int s2 = 0; s2 < 2; ++s2) {
                union { bf16x8 v; unsigned u[4]; } pb;
#pragma unroll
                for (int e = 0; e < 4; ++e) pb.u[e] = pack2(S[tt][8 * s2 + 2 * e], S[tt][8 * s2 + 2 * e + 1]);
#pragma unroll
                for (int i = 0; i < 2; ++i) {
                    const bf16_t* vp = sVt + (32 * i + l31) * VST + 32 * (wave + tt) + 16 * s2 + 4 * lh;
                    union { bf16x8 v; uint2 h[2]; } va;
                    va.h[0] = *(const uint2*)vp; va.h[1] = *(const uint2*)(vp + 8);
                    O[i] = mfma32(va.v, pb.v, O[i]);
                }
            }
        const float rden = 1.f / den;
#pragma unroll
        for (int i = 0; i < 2; ++i)
#pragma unroll
            for (int rg = 0; rg < 4; ++rg)
                *(uint2*)(AO + tq * ATTD + hd * 64 + 32 * i + 8 * rg + 4 * lh) = make_uint2(pack2(O[i][4 * rg] * rden, O[i][4 * rg + 1] * rden), pack2(O[i][4 * rg + 2] * rden, O[i][4 * rg + 3] * rden));
        if (lh == 0) LSE[tq * 12 + hd] = mx + __logf(den);
    }
}

DEVI void att_mix_phase(const Params& p) {
    int z_; asm volatile("s_mov_b32 %0, 0" : "=s"(z_)); unsigned char* ws_ = p.ws + z_; float* out_ = p.out + z_; (void)ws_; (void)out_; KIN_DECL;
    bf16_t* AO = (bf16_t*)(ws_ + B_R3);
    const float* LSE = (const float*)(ws_ + B_DT);
    const int gtid = bidx() * 256 + tidx(), gsz = VGRID * 256;
    for (int it = gtid; it < T * 32; it += gsz) {
        const int t = it >> 5, hg = (it >> 3) & 3, c8 = (it & 7) * 8;
        const float l0 = LSE[(size_t)t * 12 + hg], l1 = LSE[(size_t)t * 12 + 4 + hg], l2 = LSE[(size_t)t * 12 + 8 + hg];
        const float ml = fmaxf(l0, fmaxf(l1, l2));
        float al[3] = {__expf(l0 - ml), __expf(l1 - ml), __expf(l2 - ml)};
        const float rs = 1.f / (al[0] + al[1] + al[2]);
#pragma unroll
        for (int g = 0; g < 3; ++g) {
            u32x4* ptr = (u32x4*)(AO + (size_t)t * ATTD + (g * 4 + hg) * 64 + c8);
            const u32x4 v = *ptr; const float a = al[g] * rs;
            u32x4 o;
#pragma unroll
            for (int e = 0; e < 4; ++e) o[e] = pack2(__uint_as_float(v[e] << 16) * a, __uint_as_float(v[e] & 0xffff0000u) * a);
            *ptr = o;
        }
    }
}

enum { OP_INIT = 0, OP_NORM, OP_FINAL, OP_SSM_IN, OP_SSM_CONV, OP_SSM_STATE, OP_SSM_SCAN, OP_SSM_OUT, OP_SSM_OG, OP_GLA_IN, OP_GLA_GATE, OP_GLA_STATE, OP_GLA_SCAN,
       OP_GLA_OUT, OP_GLA_OG, OP_ATT_IN_, OP_ATT_ROPE, OP_ATT_ATT, OP_ATT_MIX, OP_ATT_OG, OP_FFN_GU, OP_FFN_DN };
constexpr int OP_ATT_IN = OP_ATT_IN_;
DEVI int phase_op(int ph, int& a) {
    int l, q, op; a = 0;
    if (ph == 0) return OP_INIT;
    if (ph <= 10) { l = 0; q = ph - 1; } else if (ph <= 20) { l = 1; q = ph - 11; } else if (ph <= 29) { l = 2; q = ph - 21; } else { l = 3; q = ph - 30; }
    const int nmix = (l == 2) ? 5 : 6;
    if (q < nmix) { op = (l == 1 ? OP_GLA_IN : (l == 2 ? OP_ATT_IN_ : OP_SSM_IN)) + q; a = l / 3; }
    else { const int k = q - nmix; op = (k == 0) ? OP_NORM : (k == 1 ? OP_FFN_GU : (k == 2 ? OP_FFN_DN : (l == 3 ? OP_FINAL : OP_NORM))); a = l; }
    return op;
}
DEVI int phase_op_only(int ph) { int a; return phase_op(ph, a); }
DEVI void run_phase(const Params& p, int ph) {
    const bf16_t* Hb = (const bf16_t*)(p.ws + B_HB);
    int a = 0; int op = phase_op(ph, a);
#ifdef ONLY_OP
    if (op != ONLY_OP) return;
    op = ONLY_OP;
#endif
    switch (op) {
        case OP_INIT: if (rbid() & 1) { copy_caches(p); convert_weights(p); } else { convert_weights(p); copy_caches(p); } rope_table(p); norm_phase(p, 0); break;
        case OP_NORM: norm_phase(p, 1); break;
        case OP_FINAL: norm_phase(p, 2); break;
        case OP_SSM_IN: gemm8<EPI_SSM_IN>(p, Hb, (const bf16_t*)(p.ws + W_SSM_IN) + (size_t)a * SSM_INP * D, MPAD, SSM_INP, D); break;
        case OP_SSM_CONV: ssm_conv_phase(p, a); break;
        case OP_SSM_STATE: ssm_state_phase(p, a); break;
        case OP_SSM_SCAN: ssm_scan_phase(p, a); break;
        case OP_SSM_OUT: ssm_out_phase(p, a); break;
        case OP_SSM_OG: gemm8<EPI_RESADD>(p, (const bf16_t*)(p.ws + B_R4), (const bf16_t*)(p.ws + W_SSM_OUT) + (size_t)a * D * DI, TP, D, DI, a == 0 ? p.in[0] : nullptr); gemm_phase<EPI_RESADD, DI>(p, (const bf16_t*)(p.ws + B_R4), (const bf16_t*)(p.ws + W_SSM_OUT) + (size_t)a * D * DI, 4, true); break;
        case OP_GLA_IN: gemm8<EPI_GLA_IN>(p, Hb, (const bf16_t*)(p.ws + W_GLA_IN), MPAD, GLA_INP, D); break;
        case OP_GLA_GATE: gla_gate_phase(p); break;
        case OP_GLA_STATE: gla_state_phase(p); break;
        case OP_GLA_SCAN: gla_scan_phase(p); break;
        case OP_GLA_OUT: gla_out_phase(p); break;
        case OP_GLA_OG: gemm8<EPI_RESADD>(p, (const bf16_t*)(p.ws + B_R3), (const bf16_t*)(p.ws + W_GLA_OUT), TP, D, D); gemm_phase<EPI_RESADD, D>(p, (const bf16_t*)(p.ws + B_R3), (const bf16_t*)(p.ws + W_GLA_OUT), 4, true); break;
        case OP_ATT_IN: gemm8<EPI_ATT_IN>(p, Hb, (const bf16_t*)(p.ws + W_ATT_QKV), MPAD, QKVD, D); break;
        case OP_ATT_ROPE: att_rope_phase(p); break;
        case OP_ATT_ATT: att_prompt_phase(p); __syncthreads(); att_phase(p); break;
        case OP_ATT_MIX: att_mix_phase(p); break;
        case OP_ATT_OG: gemm8<EPI_RESADD>(p, (const bf16_t*)(p.ws + B_R3), (const bf16_t*)(p.ws + W_ATT_OUT), TP, D, ATTD); gemm_phase<EPI_RESADD, ATTD>(p, (const bf16_t*)(p.ws + B_R3), (const bf16_t*)(p.ws + W_ATT_OUT), 4, true); break;
        case OP_FFN_GU: gemm8<EPI_SWIGLU>(p, Hb, (const bf16_t*)(p.ws + W_FFN_GU) + (size_t)a * 2 * DFF * D, MPAD, 2 * DFF, D); break;
        case OP_FFN_DN: gemm8<EPI_RESADD>(p, (const bf16_t*)(p.ws + B_R4), (const bf16_t*)(p.ws + W_FFN_DN) + (size_t)a * D * DFF, TP, D, DFF); gemm_phase<EPI_RESADD, DFF>(p, (const bf16_t*)(p.ws + B_R4), (const bf16_t*)(p.ws + W_FFN_DN) + (size_t)a * D * DFF, 4, true); break;
        default: break;
    }
}

#ifndef REPEAT_OP
#define REPEAT_OP -1
#endif
#ifndef REPEAT_N
#define REPEAT_N 1
#endif
__global__ void __launch_bounds__(512, 2) mega(Params p, int ph_lo, int ph_hi, int coop) {
    uint4* xb_words = (uint4*)(smem + 2 * LDS_BYTES);
    if (threadIdx.x == 0) *xb_words = make_uint4(0u, 0u, 0u, 0u);
    __syncthreads();
    XcdBarrier xb = xcd_barrier_post((unsigned*)(p.ws + B_BAR), (volatile LAS unsigned*)xb_words);
    if (coop < 0) cg::this_grid().sync();
    int rep = 0;
    for (int ph = ph_lo; ph < ph_hi;) {
        run_phase(p, ph);
        if (REPEAT_OP >= 0 && phase_op_only(ph) == REPEAT_OP && rep < REPEAT_N) { ++rep; __syncthreads(); continue; }
        rep = 0;
        if (ph + 1 < ph_hi) xcd_barrier(xb);
        ++ph;
    }
}

extern "C" void kernel_launch(void* const* d_in, const int* in_sizes, int n_in, void* d_out, int out_size, void* d_ws, size_t ws_size, hipStream_t stream) {
    if (ws_size < B_END) { fprintf(stderr, "workspace too small: %zu < %zu\n", ws_size, (size_t)B_END); return; }
    Params p; memset(&p, 0, sizeof(p));
    for (int i = 0; i < 29; ++i) p.in[i] = (const float*)d_in[i];
    p.out = (float*)d_out; p.ws = (unsigned char*)d_ws;
    p.nphase = 40;
    static int grid_blocks = 0;
    if (!grid_blocks) {
        int dev = 0, cus = 0, per_cu = 0;
        hipGetDevice(&dev);
        hipDeviceGetAttribute(&cus, hipDeviceAttributeMultiprocessorCount, dev);
        hipFuncSetAttribute((const void*)mega, hipFuncAttributeMaxDynamicSharedMemorySize, DYN_LDS);
        hipOccupancyMaxActiveBlocksPerMultiprocessor(&per_cu, mega, 512, DYN_LDS);
        if (per_cu > 1) per_cu = 1;
        if (per_cu < 1) per_cu = 1;
        grid_blocks = cus * per_cu;
    }
#if ONE_LAUNCH
    hipMemsetAsync(p.ws + B_BAR, 0, XCD_BAR_WORDS * 4, stream);
    int lo = 0, hi = p.nphase, coop = 1;
    void* args[] = {&p, &lo, &hi, &coop};
    hipError_t e = hipLaunchCooperativeKernel((void*)mega, dim3(grid_blocks), dim3(512), args, DYN_LDS, stream);
    if (e != hipSuccess) fprintf(stderr, "cooperative launch failed: %s (grid %d)\n", hipGetErrorString(e), grid_blocks);
#else
    for (int ph = 0; ph < p.nphase; ++ph) mega<<<grid_blocks, 512, DYN_LDS, stream>>>(p, ph, ph + 1, 0);
#endif
}
```
